# Optimizing an MI355X kernel written in HIP

```python
import math
import jax, jax.numpy as jnp
from jax import lax
import numpy as np

D_MODEL = 1024
BATCH = 8
SEQ = 4096
DEPTH = 2

N_MIXERS = 2
EPS = 1e-6
MEM_LEN = 256

MIX_WIDTH = D_MODEL
MEM_HEADS = 4
MEM_HEAD_DIM = 64
MEM_WIDTH = MEM_HEADS * MEM_HEAD_DIM
SEQ_WIDTH = MIX_WIDTH - MEM_WIDTH

A_HEAD_DIM = 64
A_HEADS = SEQ_WIDTH // A_HEAD_DIM
A_KV_RANK = 256
IDX_HEADS = 8
IDX_DIM = 64
IDX_TOPK_MAX = 256
Q_BLOCK = 128

REL_BUCKETS = 32
REL_MAX_DIST = 128

SSM_HEAD_DIM = 64
SSM_HEADS = SEQ_WIDTH // SSM_HEAD_DIM
SSM_GROUPS = 2
HEADS_PER_GROUP = SSM_HEADS // SSM_GROUPS
SSM_STATE = 128
CONV_WIDTH = 4
SSD_CHUNK = 128
CONV_DIM = SEQ_WIDTH + 2 * SSM_GROUPS * SSM_STATE

PEER_HEADS = 8
PEER_KEYS = 128
PEER_EXPERTS = PEER_KEYS * PEER_KEYS
PEER_QDIM = 256
PEER_TOPK = 16
TOKEN_BLOCK = 128

N_A_LAYERS = (DEPTH + 1) // 2
N_B_LAYERS = DEPTH // 2


def _split_points(widths):
    pts, acc = [], 0
    for w in widths[:-1]:
        acc += w
        pts.append(acc)
    return pts


A_WIDTHS = [SEQ_WIDTH, A_KV_RANK, IDX_HEADS * IDX_DIM, IDX_DIM, IDX_HEADS, MEM_WIDTH]
B_WIDTHS = [SEQ_WIDTH, CONV_DIM, SSM_HEADS, MEM_WIDTH]
A_IN = sum(A_WIDTHS)
B_IN = sum(B_WIDTHS)
A_SPLITS = _split_points(A_WIDTHS)
B_SPLITS = _split_points(B_WIDTHS)

kernel_name = "hybrid_dsa_ssd_peer_trunk"


def rms_norm(x, g):
    xf = x.astype(jnp.float32)
    y = xf * lax.rsqrt(jnp.mean(xf * xf, axis=-1, keepdims=True) + EPS)
    return (y * g.astype(jnp.float32)).astype(x.dtype)


def t5_causal_bucket(dist):
    n = jnp.maximum(dist, 0)
    max_exact = REL_BUCKETS // 2
    nf = jnp.maximum(n, max_exact).astype(jnp.float32)
    large = max_exact + (jnp.log(nf / max_exact) / math.log(REL_MAX_DIST / max_exact)
                         * (REL_BUCKETS - max_exact)).astype(jnp.int32)
    large = jnp.minimum(large, REL_BUCKETS - 1)
    return jnp.where(n < max_exact, n, large)


def memory_attention(q, mem_n, w_kv):
    b, s, _ = q.shape
    k, v = jnp.split(mem_n @ w_kv, 2, axis=-1)
    q = q.reshape(b, s, MEM_HEADS, MEM_HEAD_DIM)
    k = k.reshape(b, -1, MEM_HEADS, MEM_HEAD_DIM)
    v = v.reshape(b, -1, MEM_HEADS, MEM_HEAD_DIM)
    logits = jnp.einsum('bqhd,bmhd->bhqm', q, k).astype(jnp.float32) * (MEM_HEAD_DIM ** -0.5)
    p = jax.nn.softmax(logits, axis=-1).astype(v.dtype)
    o = jnp.einsum('bhqm,bmhd->bqhd', p, v)
    return o.reshape(b, s, MEM_WIDTH)


def dsa_attention(q, c_kv, iq, ik, iw, w_uk, w_uv, rel_bias):
    b, s = c_kv.shape[:2]
    topk = min(IDX_TOPK_MAX, s // 4)
    n_blk = s // Q_BLOCK
    key_pos = jnp.arange(s, dtype=jnp.int32)

    def block(i):
        t0 = i * Q_BLOCK
        qb = lax.dynamic_slice_in_dim(q, t0, Q_BLOCK, axis=1)
        iqb = lax.dynamic_slice_in_dim(iq, t0, Q_BLOCK, axis=1)
        iwb = lax.dynamic_slice_in_dim(iw, t0, Q_BLOCK, axis=1)
        q_pos = t0 + jnp.arange(Q_BLOCK, dtype=jnp.int32)
        rel = jax.nn.relu(jnp.einsum('bqhd,bsd->bqhs', iqb, ik).astype(jnp.float32) * (IDX_DIM ** -0.5))
        score = jnp.einsum('bqhs,bqh->bqs', rel, iwb.astype(jnp.float32) * (IDX_HEADS ** -0.5))
        causal = key_pos[None, :] <= q_pos[:, None]
        score = jnp.where(causal[None], score, -jnp.inf)
        _, sel = lax.top_k(score, topk)
        c_sel = jax.vmap(lambda c, idx: c[idx])(c_kv, sel)
        q_lat = jnp.einsum('bqhd,hcd->bqhc', qb, w_uk)
        logits = jnp.einsum('bqhc,bqkc->bhqk', q_lat, c_sel).astype(jnp.float32) * (A_HEAD_DIM ** -0.5)
        dist = q_pos[None, :, None] - sel
        bias = rel_bias[t5_causal_bucket(dist)]
        logits = logits + jnp.moveaxis(bias, -1, 1).astype(jnp.float32)
        logits = jnp.where((dist >= 0)[:, None], logits, -jnp.inf)
        p = jax.nn.softmax(logits, axis=-1).astype(c_sel.dtype)
        o_lat = jnp.einsum('bhqk,bqkc->bqhc', p, c_sel)
        o = jnp.einsum('bqhc,hcd->bqhd', o_lat, w_uv)
        return o.reshape(b, Q_BLOCK, SEQ_WIDTH)

    out = lax.map(block, jnp.arange(n_blk))
    return jnp.moveaxis(out, 0, 1).reshape(b, s, SEQ_WIDTH)


def causal_depthwise_conv(x, w, bias):
    c = x.shape[-1]
    y = lax.conv_general_dilated(x, w[:, None, :].astype(x.dtype), window_strides=(1,),
                                 padding=[(CONV_WIDTH - 1, 0)],
                                 dimension_numbers=('NWC', 'WIO', 'NWC'),
                                 feature_group_count=c)
    return y + bias.astype(x.dtype)


def ssd_scan(xh, dt, a, bm, cm):
    b, s, g, r, p = xh.shape
    n = bm.shape[-1]
    l = SSD_CHUNK
    c = s // l
    f32 = jnp.float32
    x = (xh.astype(f32) * dt[..., None]).reshape(b, c, l, g, r, p)
    da = (dt * a).reshape(b, c, l, g, r)
    bc = bm.astype(f32).reshape(b, c, l, g, n)
    cc = cm.astype(f32).reshape(b, c, l, g, n)
    a_cs = jnp.cumsum(da, axis=2)
    seg = a_cs[:, :, :, None] - a_cs[:, :, None, :]
    tri = jnp.tril(jnp.ones((l, l), dtype=bool))[None, None, :, :, None, None]
    decay = jnp.exp(jnp.where(tri, seg, -jnp.inf))
    cb = jnp.einsum('bclgn,bcsgn->bclsg', cc, bc)
    y_diag = jnp.einsum('bclsg,bclsgr,bcsgrp->bclgrp', cb, decay, x)
    decay_to_end = jnp.exp(a_cs[:, :, -1:] - a_cs)
    states = jnp.einsum('bclgn,bclgr,bclgrp->bcgrpn', bc, decay_to_end, x)
    chunk_decay = jnp.exp(a_cs[:, :, -1])

    def step(h, inp):
        st, dec = inp
        return h * dec[..., None, None] + st, h

    h0 = jnp.zeros((b, g, r, p, n), f32)
    _, h_prev = lax.scan(step, h0, (jnp.moveaxis(states, 1, 0), jnp.moveaxis(chunk_decay, 1, 0)))
    h_prev = jnp.moveaxis(h_prev, 0, 1)
    y_off = jnp.einsum('bclgn,bcgrpn,bclgr->bclgrp', cc, h_prev, jnp.exp(a_cs))
    return (y_diag + y_off).reshape(b, s, g, r, p)


def mamba2_mixer(z, xbc, dt_raw, conv_w, conv_b, dt_bias, a_log, d_skip, out_norm):
    b, s, _ = z.shape
    xbc = jax.nn.silu(causal_depthwise_conv(xbc, conv_w, conv_b))
    xs, bm, cm = jnp.split(xbc, [SEQ_WIDTH, SEQ_WIDTH + SSM_GROUPS * SSM_STATE], axis=-1)
    xh = xs.reshape(b, s, SSM_GROUPS, HEADS_PER_GROUP, SSM_HEAD_DIM)
    bm = bm.reshape(b, s, SSM_GROUPS, SSM_STATE)
    cm = cm.reshape(b, s, SSM_GROUPS, SSM_STATE)
    dt = jax.nn.softplus(dt_raw.astype(jnp.float32) + dt_bias.astype(jnp.float32))
    dt = dt.reshape(b, s, SSM_GROUPS, HEADS_PER_GROUP)
    a = -jnp.exp(a_log.astype(jnp.float32)).reshape(SSM_GROUPS, HEADS_PER_GROUP)
    d = d_skip.astype(jnp.float32).reshape(SSM_GROUPS, HEADS_PER_GROUP)
    y = ssd_scan(xh, dt, a, bm, cm) + xh.astype(jnp.float32) * d[..., None]
    y = y.reshape(b, s, SEQ_WIDTH) * jax.nn.silu(z.astype(jnp.float32))
    return rms_norm(y, out_norm).astype(z.dtype)


def peer_ffn(h, w_q, sub_keys, u, v):
    b, s, d = h.shape
    q = (h @ w_q).reshape(b, s, PEER_HEADS, 2, PEER_QDIM // 2)
    scores = jnp.einsum('bshic,ikc->bshik', q, sub_keys).astype(jnp.float32)
    top_s, top_i = lax.top_k(scores, PEER_TOPK)
    cand_s = top_s[..., 0, :, None] + top_s[..., 1, None, :]
    cand_i = top_i[..., 0, :, None] * PEER_KEYS + top_i[..., 1, None, :]
    cand_s = cand_s.reshape(b, s, PEER_HEADS, PEER_TOPK * PEER_TOPK)
    cand_i = cand_i.reshape(b, s, PEER_HEADS, PEER_TOPK * PEER_TOPK)
    best_s, pos = lax.top_k(cand_s, PEER_TOPK)
    expert = jnp.take_along_axis(cand_i, pos, axis=-1)
    gate = jax.nn.softmax(best_s, axis=-1).astype(h.dtype)
    nb = (b * s) // TOKEN_BLOCK
    hb = h.reshape(nb, TOKEN_BLOCK, d)
    eb = expert.reshape(nb, TOKEN_BLOCK, PEER_HEADS, PEER_TOPK)
    gb = gate.reshape(nb, TOKEN_BLOCK, PEER_HEADS, PEER_TOPK)

    def block(args):
        xt, et, gt = args
        act = jax.nn.gelu(jnp.einsum('td,thkd->thk', xt, u[et]), approximate=False)
        return jnp.einsum('thk,thkd->td', act * gt, v[et])

    out = lax.map(block, (hb, eb, gb))
    return out.reshape(b, s, d)


def setup_inputs(seed: int = 0) -> dict:
    key = jax.random.key(seed)
    ks = jax.random.split(key, 26)
    f32 = jnp.float32
    nA, nB = N_A_LAYERS, N_B_LAYERS

    def nrm(k, shape, scale):
        return jax.random.normal(k, shape, f32) * scale

    def gain(k, shape):
        return 1.0 + 0.05 * jax.random.normal(k, shape, f32)

    dt0 = jnp.exp(jax.random.uniform(ks[14], (nB, SSM_HEADS), f32, math.log(1e-3), math.log(1e-1)))
    return {
        "x": jax.random.normal(ks[0], (BATCH, SEQ, D_MODEL), f32),
        "mem": jax.random.normal(ks[1], (BATCH, MEM_LEN, D_MODEL), f32),
        "mem_norm": gain(ks[2], (D_MODEL,)),
        "rel_bias": nrm(ks[3], (REL_BUCKETS, A_HEADS), 0.5),
        "mix_norm": gain(ks[4], (DEPTH, D_MODEL)),
        "ffn_norm": gain(ks[5], (DEPTH, D_MODEL)),
        "final_norm": gain(ks[6], (D_MODEL,)),
        "w_o": nrm(ks[7], (DEPTH, MIX_WIDTH, D_MODEL), MIX_WIDTH ** -0.5),
        "w_mem_kv": nrm(ks[8], (DEPTH, D_MODEL, 2 * MEM_WIDTH), D_MODEL ** -0.5),
        "a_w_in": nrm(ks[9], (nA, D_MODEL, A_IN), D_MODEL ** -0.5),
        "a_kv_norm": gain(ks[10], (nA, A_KV_RANK)),
        "a_w_uk": nrm(ks[11], (nA, A_HEADS, A_KV_RANK, A_HEAD_DIM), A_KV_RANK ** -0.5),
        "a_w_uv": nrm(ks[12], (nA, A_HEADS, A_KV_RANK, A_HEAD_DIM), A_KV_RANK ** -0.5),
        "b_w_in": nrm(ks[13], (nB, D_MODEL, B_IN), D_MODEL ** -0.5),
        "b_conv_w": nrm(ks[15], (nB, CONV_WIDTH, CONV_DIM), CONV_WIDTH ** -0.5),
        "b_conv_b": nrm(ks[16], (nB, CONV_DIM), 0.02),
        "b_dt_bias": dt0 + jnp.log(-jnp.expm1(-dt0)),
        "b_a_log": jnp.log(jax.random.uniform(ks[17], (nB, SSM_HEADS), f32, 1.0, 16.0)),
        "b_d_skip": 1.0 + 0.1 * jax.random.normal(ks[18], (nB, SSM_HEADS), f32),
        "b_out_norm": gain(ks[19], (nB, SEQ_WIDTH)),
        "peer_w_q": nrm(ks[20], (DEPTH, D_MODEL, PEER_HEADS * PEER_QDIM), D_MODEL ** -0.5),
        "peer_sub_keys": nrm(ks[21], (DEPTH, 2, PEER_KEYS, PEER_QDIM // 2), (PEER_QDIM // 2) ** -0.5),
        "peer_u": nrm(ks[22], (DEPTH, PEER_EXPERTS, D_MODEL), D_MODEL ** -0.5),
        "peer_v": nrm(ks[23], (DEPTH, PEER_EXPERTS, D_MODEL), D_MODEL ** -0.5),
    }


def reference(x, mem, mem_norm, rel_bias, mix_norm, ffn_norm, final_norm, w_o, w_mem_kv,
              a_w_in, a_kv_norm, a_w_uk, a_w_uv,
              b_w_in, b_conv_w, b_conv_b, b_dt_bias, b_a_log, b_d_skip, b_out_norm,
              peer_w_q, peer_sub_keys, peer_u, peer_v):
    b, s, _ = x.shape
    mem_n = rms_norm(mem, mem_norm)
    for i in range(DEPTH):
        h = rms_norm(x, mix_norm[i])
        j = i // N_MIXERS
        if i % N_MIXERS == 0:
            q, c_kv, iq, ik, iw, q_mem = jnp.split(h @ a_w_in[j], A_SPLITS, axis=-1)
            c_kv = rms_norm(c_kv, a_kv_norm[j])
            seq_out = dsa_attention(q.reshape(b, s, A_HEADS, A_HEAD_DIM), c_kv,
                                    iq.reshape(b, s, IDX_HEADS, IDX_DIM), ik, iw,
                                    a_w_uk[j], a_w_uv[j], rel_bias)
        else:
            z, xbc, dt_raw, q_mem = jnp.split(h @ b_w_in[j], B_SPLITS, axis=-1)
            seq_out = mamba2_mixer(z, xbc, dt_raw, b_conv_w[j], b_conv_b[j], b_dt_bias[j],
                                   b_a_log[j], b_d_skip[j], b_out_norm[j])
        mem_out = memory_attention(q_mem, mem_n, w_mem_kv[i])
        x = x + jnp.concatenate([seq_out, mem_out], axis=-1) @ w_o[i]
        x = x + peer_ffn(rms_norm(x, ffn_norm[i]), peer_w_q[i], peer_sub_keys[i], peer_u[i], peer_v[i])
    return rms_norm(x, final_norm)
```

```cpp
#include <hip/hip_runtime.h>
#include <cstdio>
#include <cstdint>
#ifndef PROBE_MASK
#define PROBE_MASK 0
#endif
#ifndef DSA_PROBE
#define DSA_PROBE 0
#endif
#ifndef PEER_PROBE
#define PEER_PROBE 0
#endif
#ifndef PEER_WGSYNC
#define PEER_WGSYNC 3
#endif
#ifndef MK_PER_PHASE
#define MK_PER_PHASE 0
#endif
namespace pg8 {
#define PG8_LAS __attribute__((address_space(3)))
typedef unsigned short bf16_t;
typedef short bf16x8 __attribute__((ext_vector_type(8)));
typedef float f32x4 __attribute__((ext_vector_type(4)));
typedef unsigned u32x4 __attribute__((ext_vector_type(4)));
constexpr int BM = 256, BK = 64, HALF = 128, HTB = HALF * BK * 2  , STAGE_BYTES = 8 * HTB, NXCD = 8, WGM = 8;

__host__ __device__ __forceinline__ int lds_byte(int r, int c) { const int st = (r >> 4) * 2 + (c >> 5), rr = r & 15, cc = c & 31, ob = rr * 64 + cc * 2; return st * 1024 + (ob ^ (((ob >> 9) & 1) << 5)); }
__host__ __device__ __forceinline__ void stage_rc(int b, int& R, int& C) { const int st = b / 1024, sb = b % 1024, swz = sb ^ (((sb >> 9) & 1) << 5); R = (st >> 1) * 16 + swz / 64; C = (st & 1) * 32 + (swz % 64) / 2; }
__host__ __device__ __forceinline__ int perm32(int rho) { const int n = rho >> 4, i = rho & 15; return 8 * (i >> 2) + 4 * n + (i & 3); }

struct Unit { int pm, pn; };
struct Gemm { const bf16_t* A; const bf16_t* Bt; int M, N, K; };

struct StaticOrder {
    int nM, nN, nwg, G, c;
    __host__ __device__ void init(int M, int N, int G_, int c_) { nM = M / BM; nN = N / BM; nwg = nM * nN; G = G_; c = c_; }
    __host__ __device__ bool next(int i, Unit& u) const {
        const long L = (long)i * G + c; if (L >= nwg) return false;
        int wgid = (int)L; { const int q = nwg / NXCD, r = nwg % NXCD, xcd = wgid % NXCD, off = wgid / NXCD; wgid = (xcd < r ? xcd * (q + 1) : r * (q + 1) + (xcd - r) * q) + off; }
        const int nig = WGM * nN, gid = wgid / nig, fm = gid * WGM, gsz = (nM - fm) < WGM ? (nM - fm) : WGM;
        u.pm = fm + ((wgid % nig) % gsz); u.pn = (wgid % nig) / gsz; return true;
    }
    __device__ __forceinline__ void a_ready(const Unit&) const {}
    __device__ __forceinline__ void done(const Unit&) const {}
};
__device__ __forceinline__ unsigned cvt_pk_bf16(float lo, float hi) { unsigned r; asm volatile("v_cvt_pk_bf16_f32 %0, %1, %2" : "=v"(r) : "v"(lo), "v"(hi)); return r; }
template <class Epi, class Sched, bool ALIGN_EPI = false, bool SP2 = false>
__device__ __forceinline__ void gemm_phase(PG8_LAS unsigned char* lds, const Gemm g, const Sched& S, const Epi& E) {
    const int tid = threadIdx.x, wid = __builtin_amdgcn_readfirstlane(tid >> 6), lane = tid & 63, wr = wid >> 2, wc = wid & 3, fr = lane & 15, fq = lane >> 4;
    const int K = g.K, nt = K / BK;
    unsigned voffA[2], voffB[2];
#pragma unroll
    for (int i = 0; i < 2; ++i) { int R, C; stage_rc(tid * 16 + i * 8192, R, C); const int Rb = Epi::PERM ? ((R & ~31) + perm32(R & 31)) : R;
        voffA[i] = (unsigned)(R * K + C) * 2u; voffB[i] = (unsigned)(Rb * K + C) * 2u; }
    const size_t kstep = (size_t)(BK * 2);
    const size_t hstep = (size_t)HALF * K * 2;
    const size_t tstep = 2 * hstep;
    const unsigned ldsw = (unsigned)wid * 1024u;
    const int aoff = lds_byte(wr * 64 + fr, fq * 8), boff = lds_byte(wc * 32 + fr, fq * 8);
#define PG8_SA(b, h) (((b) * 2 + (h)) * HTB)
#define PG8_SB(b, h) ((4 + (b) * 2 + (h)) * HTB)
#define PG8_STAGE(bufoff, gbase, voff) do { _Pragma("unroll") for (int _i = 0; _i < 2; ++_i) \
        __builtin_amdgcn_global_load_lds((const unsigned*)((const char*)(gbase) + (voff)[_i]), (PG8_LAS unsigned*)(lds + (bufoff) + ldsw + _i * 8192), 16, 0, 0); } while (0)
#define PG8_LDA(dst, b, h) do { _Pragma("unroll") for (int m = 0; m < 4; ++m) _Pragma("unroll") for (int k = 0; k < 2; ++k) dst[m][k] = *(const PG8_LAS bf16x8*)(lds + PG8_SA(b, h) + aoff + m * 2048 + k * 1024); } while (0)
#define PG8_LDB(dst, b, h) do { _Pragma("unroll") for (int n = 0; n < 2; ++n) _Pragma("unroll") for (int k = 0; k < 2; ++k) dst[n][k] = *(const PG8_LAS bf16x8*)(lds + PG8_SB(b, h) + boff + n * 2048 + k * 1024); } while (0)
#define PG8_MMA(ai, bj, At, Bt) do { __builtin_amdgcn_s_setprio(1); _Pragma("unroll") for (int m = 0; m < 4; ++m) _Pragma("unroll") for (int n = 0; n < 2; ++n) _Pragma("unroll") for (int k = 0; k < 2; ++k) \
        acc[ai][bj][m][n] = __builtin_amdgcn_mfma_f32_16x16x32_bf16(Bt[n][k], At[m][k], acc[ai][bj][m][n], 0, 0, 0); __builtin_amdgcn_s_setprio(0); } while (0)
#define PG8_WAIT_V(n) asm volatile("s_waitcnt vmcnt(" #n ")" ::: "memory")
#define PG8_WAIT_L(n) asm volatile("s_waitcnt lgkmcnt(" #n ")" ::: "memory")
#define PG8_BAR __builtin_amdgcn_s_barrier()
#define PG8_SCHED __builtin_amdgcn_sched_barrier(0)
    Unit cur, nxt; int ui = 0;
    if (!S.next(0, cur)) return;
    f32x4 acc[2][2][4][2];
#pragma unroll
    for (int a = 0; a < 2; ++a)
#pragma unroll
        for (int b = 0; b < 2; ++b)
#pragma unroll
            for (int m = 0; m < 4; ++m)
#pragma unroll
                for (int n = 0; n < 2; ++n) acc[a][b][m][n] = (f32x4){0.f, 0.f, 0.f, 0.f};
    bf16x8 At[4][2], B0[2][2], B1[2][2];
    const char* cA = (const char*)g.A + (size_t)cur.pm * tstep; const char* cB = (const char*)g.Bt + (size_t)cur.pn * tstep;
    S.a_ready(cur);
    if constexpr (SP2) {
        PG8_STAGE(PG8_SB(0, 0), cB, voffB); PG8_STAGE(PG8_SB(0, 1), cB + hstep, voffB); PG8_STAGE(PG8_SA(0, 0), cA, voffA); PG8_STAGE(PG8_SA(0, 1), cA + hstep, voffA);
        if (wr == 1) PG8_BAR;
        PG8_WAIT_V(2); PG8_BAR;
        PG8_STAGE(PG8_SB(1, 0), cB + kstep, voffB); PG8_STAGE(PG8_SA(1, 0), cA + kstep, voffA); PG8_STAGE(PG8_SB(1, 1), cB + hstep + kstep, voffB);
        PG8_WAIT_V(6); PG8_BAR;
    } else {
        PG8_STAGE(PG8_SB(0, 0), cB, voffB); PG8_STAGE(PG8_SA(0, 0), cA, voffA); PG8_STAGE(PG8_SB(0, 1), cB + hstep, voffB); PG8_STAGE(PG8_SA(0, 1), cA + hstep, voffA);
        if (wr == 1) PG8_BAR;
        PG8_WAIT_V(4); PG8_BAR;
        PG8_STAGE(PG8_SB(1, 0), cB + kstep, voffB); PG8_STAGE(PG8_SA(1, 0), cA + kstep, voffA); PG8_STAGE(PG8_SB(1, 1), cB + hstep + kstep, voffB);
        PG8_WAIT_V(6); PG8_BAR;
    }
    for (;;) {
        const bool has_next = S.next(ui + 1, nxt);
        const char* nA = has_next ? (const char*)g.A + (size_t)nxt.pm * tstep : cA; const char* nB = has_next ? (const char*)g.Bt + (size_t)nxt.pn * tstep : cB;
        for (int t = 0; t < nt; t += 2) {
            const bool last = (t == nt - 2);
            const char* a1 = cA + (size_t)(t + 1) * kstep;
            const char* a2 = last ? nA : cA + (size_t)(t + 2) * kstep; const char* b2 = last ? nB : cB + (size_t)(t + 2) * kstep;
            const char* a3 = a2 + kstep; const char* b3 = b2 + kstep;
            if (last && has_next) S.a_ready(nxt);
            if constexpr (SP2) {
            PG8_LDB(B0, 0, 0); PG8_LDB(B1, 0, 1); PG8_SCHED; PG8_LDA(At, 0, 0); PG8_STAGE(PG8_SA(1, 1), a1 + hstep, voffA);
            PG8_WAIT_V(8); PG8_WAIT_L(0); PG8_BAR; PG8_MMA(0, 0, At, B0); PG8_MMA(0, 1, At, B1); PG8_BAR; PG8_SCHED;
            PG8_LDA(At, 0, 1); PG8_STAGE(PG8_SB(0, 0), b2, voffB); PG8_STAGE(PG8_SB(0, 1), b2 + hstep, voffB); PG8_STAGE(PG8_SA(0, 0), a2, voffA);
            PG8_WAIT_V(8); PG8_WAIT_L(0); PG8_BAR; PG8_MMA(1, 0, At, B0); PG8_MMA(1, 1, At, B1); PG8_BAR; PG8_SCHED;
            PG8_LDB(B0, 1, 0); PG8_LDB(B1, 1, 1); PG8_SCHED; PG8_LDA(At, 1, 0); PG8_STAGE(PG8_SA(0, 1), a2 + hstep, voffA);
            PG8_WAIT_V(8); PG8_WAIT_L(0); PG8_BAR; PG8_MMA(0, 0, At, B0); PG8_MMA(0, 1, At, B1); PG8_BAR; PG8_SCHED;
            PG8_LDA(At, 1, 1); PG8_STAGE(PG8_SB(1, 0), b3, voffB); PG8_STAGE(PG8_SB(1, 1), b3 + hstep, voffB); PG8_STAGE(PG8_SA(1, 0), a3, voffA);
            PG8_WAIT_V(8); PG8_WAIT_L(0); PG8_BAR; PG8_MMA(1, 0, At, B0); PG8_MMA(1, 1, At, B1); PG8_BAR; PG8_SCHED;
            } else {
            PG8_LDB(B0, 0, 0); PG8_SCHED; PG8_LDA(At, 0, 0); PG8_STAGE(PG8_SA(1, 1), a1 + hstep, voffA);
            PG8_WAIT_L(8); PG8_BAR; PG8_WAIT_L(0); PG8_MMA(0, 0, At, B0); PG8_BAR; PG8_SCHED;
            PG8_LDB(B1, 0, 1); PG8_STAGE(PG8_SB(0, 0), b2, voffB);
            PG8_BAR; PG8_WAIT_L(0); PG8_MMA(0, 1, At, B1); PG8_BAR;
            PG8_LDA(At, 0, 1); PG8_STAGE(PG8_SA(0, 0), a2, voffA);
            PG8_BAR; PG8_WAIT_L(0); PG8_MMA(1, 0, At, B0); PG8_BAR; PG8_SCHED;
            PG8_STAGE(PG8_SB(0, 1), b2 + hstep, voffB);
            PG8_WAIT_V(6); PG8_BAR; PG8_MMA(1, 1, At, B1); PG8_BAR;
            PG8_LDB(B0, 1, 0); PG8_SCHED; PG8_LDA(At, 1, 0); PG8_STAGE(PG8_SA(0, 1), a2 + hstep, voffA);
            PG8_WAIT_L(8); PG8_BAR; PG8_WAIT_L(0); PG8_MMA(0, 0, At, B0); PG8_BAR; PG8_SCHED;
            PG8_LDB(B1, 1, 1); PG8_STAGE(PG8_SB(1, 0), b3, voffB);
            PG8_BAR; PG8_WAIT_L(0); PG8_MMA(0, 1, At, B1); PG8_BAR;
            PG8_LDA(At, 1, 1); PG8_STAGE(PG8_SA(1, 0), a3, voffA);
            PG8_BAR; PG8_WAIT_L(0); PG8_MMA(1, 0, At, B0); PG8_BAR; PG8_SCHED;
            PG8_STAGE(PG8_SB(1, 1), b3 + hstep, voffB);
            PG8_WAIT_V(6); PG8_BAR; PG8_MMA(1, 1, At, B1); PG8_BAR;
            }
        }
        if constexpr (ALIGN_EPI) { if (wr == 0) PG8_BAR; }
        if constexpr (!Epi::AFTER_DRAIN) { E(acc, cur, wr, wc, fr, fq); S.done(cur); }
        if (!has_next) break;
#pragma unroll
        for (int a = 0; a < 2; ++a)
#pragma unroll
            for (int b = 0; b < 2; ++b)
#pragma unroll
                for (int m = 0; m < 4; ++m)
#pragma unroll
                    for (int n = 0; n < 2; ++n) acc[a][b][m][n] = (f32x4){0.f, 0.f, 0.f, 0.f};
        cur = nxt; cA = nA; cB = nB; ++ui;
        if constexpr (ALIGN_EPI) { if (wr == 1) PG8_BAR; }
    }
    PG8_WAIT_V(0);
    if constexpr (!ALIGN_EPI) { if (wr == 0) PG8_BAR; }
    PG8_BAR;
    if constexpr (Epi::AFTER_DRAIN) { E.fused(acc, cur, wr, wc, fr, fq, lds, wid, lane); S.done(cur); }
#undef PG8_SA
#undef PG8_SB
#undef PG8_STAGE
#undef PG8_LDA
#undef PG8_LDB
#undef PG8_MMA
#undef PG8_WAIT_V
#undef PG8_WAIT_L
#undef PG8_BAR
#undef PG8_SCHED
}
}

#define LAS __attribute__((address_space(3)))
typedef unsigned short bf16;
typedef short bf16x8 __attribute__((ext_vector_type(8)));
typedef short bf16x4 __attribute__((ext_vector_type(4)));
typedef float f32x4 __attribute__((ext_vector_type(4)));
typedef float f32x16 __attribute__((ext_vector_type(16)));
typedef unsigned u32x4 __attribute__((ext_vector_type(4)));
typedef unsigned u32x2 __attribute__((ext_vector_type(2)));
typedef __bf16 bf16v2_t __attribute__((ext_vector_type(2)));
__device__ __forceinline__ unsigned cvt_pk_bf16(float lo, float hi) { bf16v2_t v; v.x = (__bf16)lo; v.y = (__bf16)hi; return __builtin_bit_cast(unsigned, v); }

constexpr int NWAVES = 8, NTHR = 512;
constexpr int D = 1024, BATCH = 8, SEQ = 4096, M = BATCH * SEQ, MEMLEN = 256;
constexpr int NA = 2048, NB = 2560;
constexpr float EPS = 1e-6f;
constexpr int NPHASE = 19;

constexpr size_t MiB = 1u << 20;
constexpr size_t WS_CTL = 0, CTL_ZERO_BYTES = 1 * MiB;
constexpr size_t WS_WA = 1 * MiB, WS_WB = 5 * MiB, WS_WO = 10 * MiB, WS_WKV = 14 * MiB, WS_WQ = 16 * MiB;
constexpr size_t WS_DEC = 25 * MiB + 512 * 1024, WS_TSC = 26 * MiB, WS_SS = 27 * MiB;
constexpr size_t WS_UK = 24 * MiB, WS_UVT = 24 * MiB + 512 * 1024, WS_SUBK = 25 * MiB;
constexpr size_t WS_MEMN = 32 * MiB, WS_KV = 36 * MiB, WS_HB = 40 * MiB, WS_MIX = 104 * MiB, WS_TAB = 168 * MiB, WS_AR = 232 * MiB, WS_END = 512 * MiB;
constexpr size_t AR_CKV32 = 0, AR_CKV = 32 * MiB, AR_IQ = 48 * MiB, AR_IK = 80 * MiB, AR_IW = 84 * MiB, AR_QL = 88 * MiB, AR_QMEM = 136 * MiB;
constexpr size_t AR_Z = 0, AR_XBC = 48 * MiB, AR_DT = 128 * MiB, AR_XC = 152 * MiB, AR_ST = 232 * MiB, AR_Y = 48 * MiB;
constexpr size_t AR_PQ = 152 * MiB, AR_TOPK = 0;
constexpr int CW_XS = 8192;
constexpr int CW_BAR = 4096;

constexpr int LDS_BYTES = 163840;
constexpr int LDS_SCR = 0, LDS_SCR_BYTES = 161792;
constexpr int LDS_CTL = 161792;

__device__ __forceinline__ float bf2f(unsigned short b) { return __uint_as_float(((unsigned)b) << 16); }
__device__ __forceinline__ float wave_sum(float v) {
#pragma unroll
    for (int o = 1; o < 64; o <<= 1) v += __shfl_xor(v, o);
    return v;
}
__device__ __forceinline__ float wave_max(float v) {
#pragma unroll
    for (int o = 1; o < 64; o <<= 1) v = fmaxf(v, __shfl_xor(v, o));
    return v;
}
#define LDS_WAIT() asm volatile("s_waitcnt lgkmcnt(0)" ::: "memory")
#define VM_WAIT() asm volatile("s_waitcnt vmcnt(0)" ::: "memory")

#define XB_TMO      128
#define XB_XCNT(j)  (256  + 64 * (j))
#define XB_XSUB(j)  (1280 + 64 * (j))
#define XB_XGEN(j)  (2304 + 64 * (j))
#define XB_TOP      3328
#define XB_TOPGEN   3392
#define XCD_BAR_WORDS 3456
#define XB_SPIN_CAP (1u << 22)

__device__ __forceinline__ unsigned xb_ld(unsigned* p)              { return __hip_atomic_load(p, __ATOMIC_RELAXED, __HIP_MEMORY_SCOPE_AGENT); }
__device__ __forceinline__ unsigned xb_add(unsigned* p, unsigned v) { return __hip_atomic_fetch_add(p, v, __ATOMIC_RELAXED, __HIP_MEMORY_SCOPE_AGENT); }
__device__ __forceinline__ unsigned xb_xcc_id() { return (unsigned)__builtin_amdgcn_s_getreg((3 << 11) | 20) & 0xFu; }
#define XB_SPIN(cond, bar) do { unsigned _sp = 0; while (cond) { __builtin_amdgcn_s_sleep(1); \
    if ((++_sp & 255u) == 0u) { if (xb_ld(&(bar)[XB_TMO])) break; if (_sp > XB_SPIN_CAP) { atomicAdd(&(bar)[XB_TMO], 1u); break; } } } } while (0)

struct XcdBarrier {
    unsigned* bar; unsigned x;
    volatile LAS unsigned* st;
};

__device__ __forceinline__ XcdBarrier xcd_barrier_post(unsigned* bar, volatile LAS unsigned* st) {
    XcdBarrier b; b.bar = bar; b.x = xb_xcc_id(); b.st = st;
    if (threadIdx.x == 0) (void)xb_add(&bar[XB_XCNT(b.x)], 1u);
    return b;
}
__device__ __forceinline__ void xcd_barrier_complete(unsigned* bar, unsigned x, unsigned& nloc, unsigned& nx) {
    const unsigned G = gridDim.x * gridDim.y * gridDim.z;
    unsigned sum, cnt, mine, sp = 0u;
    for (;;) {
        sum = 0u; cnt = 0u; mine = 0u;
#pragma unroll
        for (unsigned j = 0; j < 16; ++j) { const unsigned c = xb_ld(&bar[XB_XCNT(j)]); sum += c; cnt += (c > 0u) ? 1u : 0u; mine = (j == x) ? c : mine; }
        if (sum == G) break;
        __builtin_amdgcn_s_sleep(1);
        if ((++sp & 255u) == 0u) { if (xb_ld(&bar[XB_TMO])) break; if (sp > XB_SPIN_CAP) { atomicAdd(&bar[XB_TMO], 1u); break; } }
    }
    nloc = mine > 0u ? mine : 1u; nx = cnt > 0u ? cnt : 1u;
}

__device__ __forceinline__ void xcd_barrier(const XcdBarrier& b) {
    asm volatile("s_waitcnt vmcnt(0)" ::: "memory");
    __syncthreads();
    if (threadIdx.x == 0) {
        unsigned* bar = b.bar;
        __builtin_amdgcn_s_waitcnt(0);
        unsigned nloc = b.st[0], nx = b.st[1];
        if (nloc == 0u) { xcd_barrier_complete(bar, b.x, nloc, nx); b.st[0] = nloc; b.st[1] = nx; }
        const unsigned old = xb_add(&bar[XB_XSUB(b.x)], 1u);
        const unsigned gen = old / nloc;
        if (old + 1u == (gen + 1u) * nloc) {
            __builtin_amdgcn_fence(__ATOMIC_RELEASE, "agent");
            asm volatile("s_waitcnt vmcnt(0)" ::: "memory");
            const unsigned og = xb_add(&bar[XB_TOP], 1u);
            const unsigned tg = og / nx;
            if (og + 1u == (tg + 1u) * nx) xb_add(&bar[XB_TOPGEN], 1u);
            else XB_SPIN(xb_ld(&bar[XB_TOPGEN]) == tg, bar);
            __builtin_amdgcn_fence(__ATOMIC_ACQUIRE, "agent");
            xb_add(&bar[XB_XGEN(b.x)], 1u);
            asm volatile("s_waitcnt vmcnt(0)" ::: "memory");
        } else {
            XB_SPIN(xb_ld(&bar[XB_XGEN(b.x)]) == gen, bar);
            __builtin_amdgcn_fence(__ATOMIC_ACQUIRE, "agent");
            asm volatile("s_waitcnt vmcnt(0)" ::: "memory");
        }
    }
    __syncthreads();
}

struct Args { const float* in[24]; float* out; unsigned char* ws; int ph_lo, ph_hi; };
enum { I_X = 0, I_MEM, I_MEMNORM, I_RELBIAS, I_MIXNORM, I_FFNNORM, I_FINALNORM, I_WO, I_WMEMKV, I_AWIN, I_AKVNORM, I_AWUK, I_AWUV,
       I_BWIN, I_BCONVW, I_BCONVB, I_BDTBIAS, I_BALOG, I_BDSKIP, I_BOUTNORM, I_PWQ, I_PSUBK, I_PU, I_PV };

__device__ __forceinline__ u32x4 pack8(const f32x4 v0, const f32x4 v1) {
    u32x4 w; w.x = pg8::cvt_pk_bf16(v0[0], v0[1]); w.y = pg8::cvt_pk_bf16(v0[2], v0[3]); w.z = pg8::cvt_pk_bf16(v1[0], v1[1]); w.w = pg8::cvt_pk_bf16(v1[2], v1[3]); return w;
}
struct EpiPlain {
    static constexpr bool PERM = true, AFTER_DRAIN = false;
    bf16* O; int ld;
    __device__ __forceinline__ void operator()(const f32x4 (&acc)[2][2][4][2], const pg8::Unit& u, int wr, int wc, int fr, int fq) const {
        const int row0 = u.pm * 256 + wr * 64 + fr, col0 = u.pn * 256 + wc * 32 + 8 * fq;
#pragma unroll
        for (int ai = 0; ai < 2; ++ai)
#pragma unroll
            for (int m = 0; m < 4; ++m) { bf16* rowp = O + (size_t)(row0 + ai * 128 + m * 16) * ld + col0;
#pragma unroll
                for (int bj = 0; bj < 2; ++bj) *(u32x4*)(rowp + bj * 128) = pack8(acc[ai][bj][m][0], acc[ai][bj][m][1]); }
    }
};
struct EpiInA {
    static constexpr bool PERM = true, AFTER_DRAIN = false;
    bf16* Q; float* CKV32; bf16* IQ; bf16* QMEM; bf16* IK; float* IW;
    __device__ __forceinline__ void operator()(const f32x4 (&acc)[2][2][4][2], const pg8::Unit& u, int wr, int wc, int fr, int fq) const {
        const int row0 = u.pm * 256 + wr * 64 + fr, cb0 = wc * 32 + 8 * fq, pn = u.pn;
#pragma unroll
        for (int ai = 0; ai < 2; ++ai)
#pragma unroll
            for (int m = 0; m < 4; ++m) { const size_t row = (size_t)(row0 + ai * 128 + m * 16);
#pragma unroll
                for (int bj = 0; bj < 2; ++bj) { const int cb = cb0 + bj * 128; const f32x4 v0 = acc[ai][bj][m][0], v1 = acc[ai][bj][m][1];
                    if (pn < 3) *(u32x4*)(Q + row * 768 + pn * 256 + cb) = pack8(v0, v1);
                    else if (pn == 3) { *(f32x4*)(CKV32 + row * 256 + cb) = v0; *(f32x4*)(CKV32 + row * 256 + cb + 4) = v1; }
                    else if (pn < 6) *(u32x4*)(IQ + row * 512 + (pn - 4) * 256 + cb) = pack8(v0, v1);
                    else if (pn == 6) *(u32x4*)(QMEM + row * 256 + cb) = pack8(v0, v1);
                    else { if (cb < 64) *(u32x4*)(IK + row * 64 + cb) = pack8(v0, v1);
                           else if (cb == 64) { *(f32x4*)(IW + row * 8) = v0; *(f32x4*)(IW + row * 8 + 4) = v1; } } } }
    }
};
struct EpiInB {
    static constexpr bool PERM = true, AFTER_DRAIN = false;
    bf16* Z; bf16* XBC; bf16* QMEM; float* DT;
    __device__ __forceinline__ void operator()(const f32x4 (&acc)[2][2][4][2], const pg8::Unit& u, int wr, int wc, int fr, int fq) const {
        const int row0 = u.pm * 256 + wr * 64 + fr, cb0 = wc * 32 + 8 * fq, pn = u.pn;
#pragma unroll
        for (int ai = 0; ai < 2; ++ai)
#pragma unroll
            for (int m = 0; m < 4; ++m) { const size_t row = (size_t)(row0 + ai * 128 + m * 16);
#pragma unroll
                for (int bj = 0; bj < 2; ++bj) { const int cb = cb0 + bj * 128; const f32x4 v0 = acc[ai][bj][m][0], v1 = acc[ai][bj][m][1];
                    if (pn < 3) *(u32x4*)(Z + row * 768 + pn * 256 + cb) = pack8(v0, v1);
                    else if (pn < 8) *(u32x4*)(XBC + row * 1280 + (pn - 3) * 256 + cb) = pack8(v0, v1);
                    else if (pn == 8) *(u32x4*)(QMEM + row * 256 + cb) = pack8(v0, v1);
                    else if (cb < 16) { *(f32x4*)(DT + row * 16 + cb) = v0; *(f32x4*)(DT + row * 16 + cb + 4) = v1; } } }
    }
};
template <bool RES_BF16> struct EpiResid {
    static constexpr bool PERM = false, AFTER_DRAIN = false;
    const void* RES; bf16* XB; float* SS;
    __device__ __forceinline__ void operator()(const f32x4 (&acc)[2][2][4][2], const pg8::Unit& u, int wr, int wc, int fr, int fq) const {
        const int row0 = u.pm * 256 + wr * 64 + fr, col0 = u.pn * 256 + wc * 32 + 4 * fq;
#pragma unroll
        for (int ai = 0; ai < 2; ++ai) {
            f32x4 r[4][2][2];
#pragma unroll
            for (int m = 0; m < 4; ++m) { const size_t ro = (size_t)(row0 + ai * 128 + m * 16) * 1024 + col0;
#pragma unroll
                for (int bj = 0; bj < 2; ++bj)
#pragma unroll
                    for (int n = 0; n < 2; ++n) {
                        if (RES_BF16) { const u32x2 t = *(const u32x2*)((const bf16*)RES + ro + bj * 128 + n * 16);
                            r[m][bj][n] = (f32x4){__uint_as_float(t.x << 16), __uint_as_float(t.x & 0xffff0000u), __uint_as_float(t.y << 16), __uint_as_float(t.y & 0xffff0000u)}; }
                        else r[m][bj][n] = *(const f32x4*)((const float*)RES + ro + bj * 128 + n * 16); } }
#pragma unroll
            for (int m = 0; m < 4; ++m) { const int row = row0 + ai * 128 + m * 16; const size_t ro = (size_t)row * 1024 + col0; float ss = 0.f;
#pragma unroll
                for (int bj = 0; bj < 2; ++bj)
#pragma unroll
                    for (int n = 0; n < 2; ++n) { const f32x4 o = r[m][bj][n] + acc[ai][bj][m][n];
                        u32x2 w; w.x = cvt_pk_bf16(o[0], o[1]); w.y = cvt_pk_bf16(o[2], o[3]); *(u32x2*)(XB + ro + bj * 128 + n * 16) = w;
                        ss += (o[0] * o[0] + o[1] * o[1]) + (o[2] * o[2] + o[3] * o[3]); }
                { const auto a = __builtin_amdgcn_permlane16_swap(__float_as_uint(ss), __float_as_uint(ss), false, false); ss = __uint_as_float(a[0]) + __uint_as_float(a[1]); }
                { const auto b = __builtin_amdgcn_permlane32_swap(__float_as_uint(ss), __float_as_uint(ss), false, false); ss = __uint_as_float(b[0]) + __uint_as_float(b[1]); }
                if (fq == 0) atomicAdd(SS + row, ss); } }
    }
};
struct EpiPQ {
    static constexpr bool PERM = true, AFTER_DRAIN = false;
    bf16* O; const float* SS;
    __device__ __forceinline__ void operator()(const f32x4 (&acc)[2][2][4][2], const pg8::Unit& u, int wr, int wc, int fr, int fq) const {
        const int row0 = u.pm * 256 + wr * 64 + fr, col0 = u.pn * 256 + wc * 32 + 8 * fq;
#pragma unroll
        for (int ai = 0; ai < 2; ++ai)
#pragma unroll
            for (int m = 0; m < 4; ++m) { const int row = row0 + ai * 128 + m * 16; const float rs = 1.0f / sqrtf(SS[row] * (1.f / 1024.f) + EPS); bf16* rowp = O + (size_t)row * 2048 + col0;
#pragma unroll
                for (int bj = 0; bj < 2; ++bj) *(u32x4*)(rowp + bj * 128) = pack8(acc[ai][bj][m][0] * rs, acc[ai][bj][m][1] * rs); }
    }
};

__device__ __forceinline__ void transpose_item(const float* W, int ldw, int src0, int ncols, bf16* WT, int dst0, LAS float* scr, int item, int lane, const float* kgain = nullptr) {
    const int nblk = (ncols + 31) >> 5, kb = item / nblk, nb = item - kb * nblk, k0 = 64 * kb, n0 = 32 * nb;
    const int nn = n0 + (lane & 31);
#pragma unroll 8
    for (int i = 0; i < 32; ++i) { const int kk = 2 * i + (lane >> 5); const float gk = kgain ? kgain[k0 + kk] : 1.0f; scr[kk * 33 + (lane & 31)] = (nn < ncols) ? W[(size_t)(k0 + kk) * ldw + src0 + nn] * gk : 0.f; }
    LDS_WAIT(); asm volatile("" ::: "memory");
    const int c = lane & 7;
#pragma unroll
    for (int j = 0; j < 4; ++j) { const int n = (lane >> 3) + 8 * j; const LAS float* s = scr + (8 * c) * 33 + n;
        u32x4 o; o.x = cvt_pk_bf16(s[0 * 33], s[1 * 33]); o.y = cvt_pk_bf16(s[2 * 33], s[3 * 33]); o.z = cvt_pk_bf16(s[4 * 33], s[5 * 33]); o.w = cvt_pk_bf16(s[6 * 33], s[7 * 33]);
        if (n0 + n < ncols) *(u32x4*)(WT + (size_t)(dst0 + n0 + n) * 1024 + k0 + 8 * c) = o; }
    LDS_WAIT(); asm volatile("" ::: "memory");
}
__device__ __forceinline__ int titems(int ncols) { return 16 * ((ncols + 31) >> 5); }
__device__ __forceinline__ void rms_row_to_bf16(const float* xrow, const float* g, bf16* orow, int lane) {
    const f32x4* xr = (const f32x4*)xrow + lane; const f32x4* gr = (const f32x4*)g + lane;
    f32x4 v[4]; float s = 0.f;
#pragma unroll
    for (int j = 0; j < 4; ++j) { v[j] = xr[64 * j]; s += (v[j].x * v[j].x + v[j].y * v[j].y) + (v[j].z * v[j].z + v[j].w * v[j].w); }
    const float rstd = 1.0f / sqrtf(wave_sum(s) * (1.f / 1024.f) + EPS);
    u32x2* o8 = (u32x2*)orow + lane;
#pragma unroll
    for (int j = 0; j < 4; ++j) { const f32x4 gg = gr[64 * j]; u32x2 o; o.x = cvt_pk_bf16(v[j].x * rstd * gg.x, v[j].y * rstd * gg.y); o.y = cvt_pk_bf16(v[j].z * rstd * gg.z, v[j].w * rstd * gg.w); o8[64 * j] = o; }
}
__device__ __forceinline__ void rms_rows4_to_bf16(const float* x0, size_t rstride, const float* g, bf16* o0, int lane) {
    f32x4 v[4][4];
#pragma unroll
    for (int i = 0; i < 4; ++i) { const f32x4* xr = (const f32x4*)(x0 + (size_t)i * rstride) + lane;
#pragma unroll
        for (int j = 0; j < 4; ++j) v[i][j] = xr[64 * j]; }
    const f32x4* gr = (const f32x4*)g + lane;
#pragma unroll
    for (int i = 0; i < 4; ++i) { float s = 0.f;
#pragma unroll
        for (int j = 0; j < 4; ++j) s += (v[i][j].x * v[i][j].x + v[i][j].y * v[i][j].y) + (v[i][j].z * v[i][j].z + v[i][j].w * v[i][j].w);
        const float rstd = 1.0f / sqrtf(wave_sum(s) * (1.f / 1024.f) + EPS);
        u32x2* o8 = (u32x2*)(o0 + (size_t)i * rstride) + lane;
#pragma unroll
        for (int j = 0; j < 4; ++j) { const f32x4 gg = gr[64 * j]; u32x2 o; o.x = cvt_pk_bf16(v[i][j].x * rstd * gg.x, v[i][j].y * rstd * gg.y); o.y = cvt_pk_bf16(v[i][j].z * rstd * gg.z, v[i][j].w * rstd * gg.w); o8[64 * j] = o; } }
}
__device__ __forceinline__ void rms_row_to_f32(const float* xrow, const float* g, float* orow, int lane) {
    const f32x4* xr = (const f32x4*)xrow + lane; const f32x4* gr = (const f32x4*)g + lane;
    f32x4 v[4]; float s = 0.f;
#pragma unroll
    for (int j = 0; j < 4; ++j) { v[j] = xr[64 * j]; s += (v[j].x * v[j].x + v[j].y * v[j].y) + (v[j].z * v[j].z + v[j].w * v[j].w); }
    const float rstd = 1.0f / sqrtf(wave_sum(s) * (1.f / 1024.f) + EPS);
    f32x4* o = (f32x4*)orow + lane;
#pragma unroll
    for (int j = 0; j < 4; ++j) { const f32x4 gg = gr[64 * j]; o[64 * j] = v[j] * rstd * gg; }
}
__device__ __forceinline__ void cvt_stream(const float* src, bf16* dst, size_t n, size_t gtid, size_t gthreads) {
    for (size_t i = gtid * 8; i < n; i += gthreads * 8) { const f32x4 a = *(const f32x4*)(src + i), b = *(const f32x4*)(src + i + 4); *(u32x4*)(dst + i) = pack8(a, b); }
}

__device__ __forceinline__ void memattn_unit(LAS unsigned char* lds, int unit, int layer, const bf16* KV, const bf16* QMEM, bf16* MIX, int tid, int wave, int lane) {
    const int b = unit >> 6, qb = (unit >> 2) & 15, hd = unit & 3;
    const bf16* kvb = KV + (size_t)(b * 256) * 1024 + layer * 512 + hd * 64;
    LAS unsigned char* Ks = lds; LAS unsigned char* Vt = lds + 36864;
    for (int idx = tid; idx < 2048; idx += NTHR) { const int key = idx >> 3, ch = idx & 7;
        const u32x4 kk = *(const u32x4*)(kvb + (size_t)key * 1024 + ch * 8);
        *(LAS u32x4*)(Ks + key * 144 + ch * 16) = kk;
        const u32x4 vv = *(const u32x4*)(kvb + 256 + (size_t)key * 1024 + ch * 8);
#pragma unroll
        for (int e = 0; e < 4; ++e) { const unsigned w = vv[e];
            *(LAS unsigned short*)(Vt + (ch * 8 + 2 * e) * 520 + key * 2) = (unsigned short)(w & 0xffffu);
            *(LAS unsigned short*)(Vt + (ch * 8 + 2 * e + 1) * 520 + key * 2) = (unsigned short)(w >> 16); } }
    __syncthreads();
    const int q = lane & 31, hh = lane >> 5;
    const size_t t = (size_t)b * SEQ + qb * 256 + wave * 32 + q;
    bf16x8 qf[4];
#pragma unroll
    for (int ks = 0; ks < 4; ++ks) qf[ks] = *(const bf16x8*)(QMEM + t * 256 + hd * 64 + ks * 16 + hh * 8);
    f32x16 s[8];
#pragma unroll
    for (int kt = 0; kt < 8; ++kt) {
#pragma unroll
        for (int r = 0; r < 16; ++r) s[kt][r] = 0.f;
#pragma unroll
        for (int ks = 0; ks < 4; ++ks) { const bf16x8 a = *(const LAS bf16x8*)(Ks + (kt * 32 + q) * 144 + (ks * 16 + hh * 8) * 2);
            s[kt] = __builtin_amdgcn_mfma_f32_32x32x16_bf16(a, qf[ks], s[kt], 0, 0, 0); } }
    float mx = -3.0e38f;
#pragma unroll
    for (int kt = 0; kt < 8; ++kt)
#pragma unroll
        for (int r = 0; r < 16; ++r) mx = fmaxf(mx, s[kt][r]);
    mx = fmaxf(mx, __shfl_xor(mx, 32));
    float l = 0.f;
#pragma unroll
    for (int kt = 0; kt < 8; ++kt)
#pragma unroll
        for (int r = 0; r < 16; ++r) { const float p = __expf((s[kt][r] - mx) * 0.125f); s[kt][r] = p; l += p; }
    l += __shfl_xor(l, 32);
    f32x16 o[2];
#pragma unroll
    for (int dt = 0; dt < 2; ++dt)
#pragma unroll
        for (int r = 0; r < 16; ++r) o[dt][r] = 0.f;
#pragma unroll
    for (int kt = 0; kt < 8; ++kt)
#pragma unroll
        for (int si = 0; si < 2; ++si) {
            union { bf16x8 v; unsigned u[4]; } pb;
#pragma unroll
            for (int e = 0; e < 4; ++e) pb.u[e] = cvt_pk_bf16(s[kt][8 * si + 2 * e], s[kt][8 * si + 2 * e + 1]);
#pragma unroll
            for (int dt = 0; dt < 2; ++dt) { const LAS unsigned char* vp = Vt + (dt * 32 + q) * 520 + (kt * 32 + 16 * si + 4 * hh) * 2;
                union { bf16x8 v; u32x2 h[2]; } va; va.h[0] = *(const LAS u32x2*)vp; va.h[1] = *(const LAS u32x2*)(vp + 16);
                o[dt] = __builtin_amdgcn_mfma_f32_32x32x16_bf16(va.v, pb.v, o[dt], 0, 0, 0); } }
    const float inv = 1.0f / l;
#pragma unroll
    for (int dt = 0; dt < 2; ++dt)
#pragma unroll
        for (int g = 0; g < 4; ++g) { u32x2 w; w.x = cvt_pk_bf16(o[dt][4 * g] * inv, o[dt][4 * g + 1] * inv); w.y = cvt_pk_bf16(o[dt][4 * g + 2] * inv, o[dt][4 * g + 3] * inv);
            *(u32x2*)(MIX + t * 1024 + 768 + hd * 64 + dt * 32 + 8 * g + 4 * hh) = w; }
    __syncthreads();
}

constexpr int SS_ACS = 0, SS_DTV = 6144, SS_WW = 12288, SS_XS = 18432;
constexpr int SS_BT = SS_XS + 6 * 64 * 272;
static_assert(SS_BT + 128 * 272 <= LDS_SCR_BYTES, "SSD LDS map");

__device__ __forceinline__ float softplus_f(float x) { return fmaxf(x, 0.f) + log1pf(__expf(-fabsf(x))); }
__device__ __forceinline__ float silu_f(float v) { return v / (1.0f + __expf(-v)); }

__device__ __forceinline__ void ssd_chunk_scalars(LAS unsigned char* lds, const float* DT, size_t t0, const float* dt_bias, const float* a_log, float* dec, int wave, int lane) {
    LAS float* ACS = (LAS float*)(lds + SS_ACS); LAS float* DTV = (LAS float*)(lds + SS_DTV); LAS float* WW = (LAS float*)(lds + SS_WW);
    for (int h = wave; h < 12; h += NWAVES) {
        const float bias = dt_bias[h], a = -__expf(a_log[h]);
        const float d0 = softplus_f(DT[(t0 + 2 * lane) * 16 + h] + bias), d1 = softplus_f(DT[(t0 + 2 * lane + 1) * 16 + h] + bias);
        const float da0 = d0 * a, da1 = d1 * a;
        float v = da0 + da1;
#pragma unroll
        for (int o = 1; o < 64; o <<= 1) { const float t = __shfl_up(v, o); if (lane >= o) v += t; }
        const float total = __shfl(v, 63);
        const float c1 = v, c0 = v - da1;
        ACS[h * 128 + 2 * lane] = c0; ACS[h * 128 + 2 * lane + 1] = c1;
        DTV[h * 128 + 2 * lane] = d0; DTV[h * 128 + 2 * lane + 1] = d1;
        WW[h * 128 + 2 * lane] = __expf(total - c0) * d0; WW[h * 128 + 2 * lane + 1] = __expf(total - c1) * d1;
        if (dec != nullptr && lane == 0) dec[h] = __expf(total);
    }
}

__device__ __forceinline__ void ssd_states_unit(LAS unsigned char* lds, int unit, const bf16* XBC, const float* DT, const float* conv_w, const float* conv_b,
                                                const float* dt_bias, const float* a_log, bf16* XC, bf16* STATES, float* DEC, int tid, int wave, int lane) {
    const int b = unit >> 5, c = unit & 31; const size_t t0 = (size_t)b * SEQ + c * 128;
    __syncthreads();
    ssd_chunk_scalars(lds, DT, t0, dt_bias, a_log, DEC + (size_t)unit * 12, wave, lane);
    __syncthreads();
    const LAS float* WW = (const LAS float*)(lds + SS_WW);
    const int q = lane & 31, hh = lane >> 5;
    for (int g = 0; g < 2; ++g) {
        for (int idx = tid; idx < 1280; idx += NTHR) {
            const int cg = idx % 80, tg = idx / 80;
            const int col = cg < 48 ? g * 384 + cg * 8 : (cg < 64 ? 768 + g * 128 + (cg - 48) * 8 : 1024 + g * 128 + (cg - 64) * 8);
            float w[4][8], bs[8];
#pragma unroll
            for (int j = 0; j < 4; ++j) { const f32x4 a = *(const f32x4*)(conv_w + j * 1280 + col), bb = *(const f32x4*)(conv_w + j * 1280 + col + 4);
                w[j][0] = a.x; w[j][1] = a.y; w[j][2] = a.z; w[j][3] = a.w; w[j][4] = bb.x; w[j][5] = bb.y; w[j][6] = bb.z; w[j][7] = bb.w; }
            { const f32x4 a = *(const f32x4*)(conv_b + col), bb = *(const f32x4*)(conv_b + col + 4); bs[0] = a.x; bs[1] = a.y; bs[2] = a.z; bs[3] = a.w; bs[4] = bb.x; bs[5] = bb.y; bs[6] = bb.z; bs[7] = bb.w; }
            u32x4 rows[11];
#pragma unroll
            for (int i = 0; i < 11; ++i) { const int lt = tg * 8 - 3 + i;
                rows[i] = (c * 128 + lt >= 0) ? *(const u32x4*)(XBC + (t0 + lt) * 1280 + col) : (u32x4){0u, 0u, 0u, 0u}; }
            float o[8][8];
#pragma unroll
            for (int tt = 0; tt < 8; ++tt)
#pragma unroll
                for (int e = 0; e < 8; ++e) { float acc = bs[e];
#pragma unroll
                    for (int j = 0; j < 4; ++j) { const unsigned wd = rows[tt + j][e >> 1]; const float xv = (e & 1) ? __uint_as_float(wd & 0xffff0000u) : __uint_as_float(wd << 16); acc += w[j][e] * xv; }
                    o[tt][e] = silu_f(acc); }
#pragma unroll
            for (int tt = 0; tt < 8; ++tt) { u32x4 pk; pk.x = pg8::cvt_pk_bf16(o[tt][0], o[tt][1]); pk.y = pg8::cvt_pk_bf16(o[tt][2], o[tt][3]); pk.z = pg8::cvt_pk_bf16(o[tt][4], o[tt][5]); pk.w = pg8::cvt_pk_bf16(o[tt][6], o[tt][7]);
                *(u32x4*)(XC + (t0 + tg * 8 + tt) * 1280 + col) = pk; }
            if (cg < 48) {
                const int hl = cg >> 3, h = g * 6 + hl;
                float ws8[8];
#pragma unroll
                for (int tt = 0; tt < 8; ++tt) ws8[tt] = WW[h * 128 + tg * 8 + tt];
#pragma unroll
                for (int e = 0; e < 8; ++e) { u32x4 pk; pk.x = pg8::cvt_pk_bf16(o[0][e] * ws8[0], o[1][e] * ws8[1]); pk.y = pg8::cvt_pk_bf16(o[2][e] * ws8[2], o[3][e] * ws8[3]);
                    pk.z = pg8::cvt_pk_bf16(o[4][e] * ws8[4], o[5][e] * ws8[5]); pk.w = pg8::cvt_pk_bf16(o[6][e] * ws8[6], o[7][e] * ws8[7]);
                    *(LAS u32x4*)(lds + SS_XS + (cg * 8 + e) * 272 + tg * 16) = pk; }
            } else if (cg < 64) {
#pragma unroll
                for (int e = 0; e < 8; ++e) { u32x4 pk; pk.x = pg8::cvt_pk_bf16(o[0][e], o[1][e]); pk.y = pg8::cvt_pk_bf16(o[2][e], o[3][e]); pk.z = pg8::cvt_pk_bf16(o[4][e], o[5][e]); pk.w = pg8::cvt_pk_bf16(o[6][e], o[7][e]);
                    *(LAS u32x4*)(lds + SS_BT + ((cg - 48) * 8 + e) * 272 + tg * 16) = pk; }
            }
        }
        __syncthreads();
        const int pt = wave >> 2, nt = wave & 3;
#pragma unroll 1
        for (int hl = 0; hl < 6; ++hl) {
            f32x16 acc;
#pragma unroll
            for (int r = 0; r < 16; ++r) acc[r] = 0.f;
#pragma unroll
            for (int ks = 0; ks < 8; ++ks) {
                const bf16x8 a = *(const LAS bf16x8*)(lds + SS_XS + (hl * 64 + pt * 32 + q) * 272 + (ks * 16 + hh * 8) * 2);
                const bf16x8 bb = *(const LAS bf16x8*)(lds + SS_BT + (nt * 32 + q) * 272 + (ks * 16 + hh * 8) * 2);
                acc = __builtin_amdgcn_mfma_f32_32x32x16_bf16(a, bb, acc, 0, 0, 0); }
            bf16* st = STATES + ((size_t)unit * 12 + g * 6 + hl) * 8192 + nt * 32 + q;
#pragma unroll
            for (int r = 0; r < 16; ++r) { const int p = pt * 32 + (r & 3) + 8 * (r >> 2) + 4 * hh; st[p * 128] = (bf16)(cvt_pk_bf16(acc[r], 0.f) & 0xffffu); }
        }
        __syncthreads();
    }
}

__device__ __forceinline__ void ssd_scan(bf16* STATES, const float* DEC, size_t gtid, size_t gthreads) {
    for (size_t i = gtid; i < (size_t)BATCH * 12 * 64 * 16; i += gthreads) {
        const int b = (int)(i / (12 * 64 * 16)); const int rem = (int)(i - (size_t)b * (12 * 64 * 16)); const int h = rem / 1024, pn = rem - h * 1024;
        float hs[8];
#pragma unroll
        for (int e = 0; e < 8; ++e) hs[e] = 0.f;
        bf16* base = STATES + ((size_t)b * 32 * 12 + h) * 8192 + (size_t)pn * 8;
#pragma unroll 4
        for (int c = 0; c < 32; ++c) {
            bf16* p = base + (size_t)c * 12 * 8192;
            const u32x4 sv = *(const u32x4*)p; const float dc = DEC[(b * 32 + c) * 12 + h];
            u32x4 ov; ov.x = cvt_pk_bf16(hs[0], hs[1]); ov.y = cvt_pk_bf16(hs[2], hs[3]); ov.z = cvt_pk_bf16(hs[4], hs[5]); ov.w = cvt_pk_bf16(hs[6], hs[7]);
            *(u32x4*)p = ov;
#pragma unroll
            for (int e = 0; e < 4; ++e) { hs[2 * e] = hs[2 * e] * dc + __uint_as_float(sv[e] << 16); hs[2 * e + 1] = hs[2 * e + 1] * dc + __uint_as_float(sv[e] & 0xffff0000u); }
        }
    }
}

__device__ __forceinline__ void ssd_out_unit(LAS unsigned char* lds, int unit, const bf16* XC, const float* DT, const bf16* Z, const bf16* HPREV, const float* dt_bias, const float* a_log,
                                             const float* d_skip, const float* out_norm, bf16* Y, bf16* MIX, int tid, int wave, int lane) {
    const int b = unit >> 5, c = unit & 31; const size_t t0 = (size_t)b * SEQ + c * 128;
    __syncthreads();
    ssd_chunk_scalars(lds, DT, t0, dt_bias, a_log, nullptr, wave, lane);
    const LAS float* ACS = (const LAS float*)(lds + SS_ACS); const LAS float* DTV = (const LAS float*)(lds + SS_DTV);
    const int q = lane & 31, hh = lane >> 5, lt = wave >> 1, pt = wave & 1;
    const bf16* hp = HPREV + (size_t)unit * 12 * 8192;
    unsigned dmask = 0u;
#pragma unroll
    for (int r = 0; r < 16; ++r) dmask |= (((r & 3) + 8 * (r >> 2) + 4 * hh) <= q) ? (1u << r) : 0u;
    for (int g = 0; g < 2; ++g) {
        __syncthreads();
        for (int idx = tid; idx < 768; idx += NTHR) { const int cg = idx % 48, tg = idx / 48;
            u32x4 rows[8];
#pragma unroll
            for (int i = 0; i < 8; ++i) rows[i] = *(const u32x4*)(XC + (t0 + tg * 8 + i) * 1280 + g * 384 + cg * 8);
#pragma unroll
            for (int e = 0; e < 8; ++e) { u32x4 pk;
#pragma unroll
                for (int k2 = 0; k2 < 4; ++k2) { const unsigned lo = rows[2 * k2][e >> 1], hi2 = rows[2 * k2 + 1][e >> 1];
                    pk[k2] = (e & 1) ? ((lo >> 16) | (hi2 & 0xffff0000u)) : ((lo & 0xffffu) | (hi2 << 16)); }
                *(LAS u32x4*)(lds + SS_XS + (cg * 8 + e) * 272 + tg * 16) = pk; } }
        bf16x8 cf[8];
#pragma unroll
        for (int ks = 0; ks < 8; ++ks) cf[ks] = *(const bf16x8*)(XC + (t0 + lt * 32 + q) * 1280 + 1024 + g * 128 + ks * 16 + hh * 8);
        f32x16 cb[4];
#pragma unroll
        for (int st = 0; st < 4; ++st) {
#pragma unroll
            for (int r = 0; r < 16; ++r) cb[st][r] = 0.f;
            if (st <= lt) {
#pragma unroll
                for (int ks = 0; ks < 8; ++ks) { const bf16x8 a = *(const bf16x8*)(XC + (t0 + st * 32 + q) * 1280 + 768 + g * 128 + ks * 16 + hh * 8);
                    cb[st] = __builtin_amdgcn_mfma_f32_32x32x16_bf16(a, cf[ks], cb[st], 0, 0, 0); } } }
        __syncthreads();
#pragma unroll 1
        for (int hl = 0; hl < 6; ++hl) {
            const int h = g * 6 + hl;
            f32x16 yd, yo;
#pragma unroll
            for (int r = 0; r < 16; ++r) { yd[r] = 0.f; yo[r] = 0.f; }
            const int l = lt * 32 + q; const float al = ACS[h * 128 + l];
#pragma unroll
            for (int st = 0; st < 4; ++st) {
                if (st <= lt) {
                    float mm[16];
#pragma unroll
                    for (int r = 0; r < 16; ++r) { const int s = st * 32 + (r & 3) + 8 * (r >> 2) + 4 * hh;
                        const float v = cb[st][r] * __expf(al - ACS[h * 128 + s]) * DTV[h * 128 + s]; mm[r] = (st < lt || ((dmask >> r) & 1u)) ? v : 0.f; }
#pragma unroll
                    for (int si = 0; si < 2; ++si) {
                        union { bf16x8 v; unsigned u[4]; } af;
#pragma unroll
                        for (int e = 0; e < 4; ++e) af.u[e] = cvt_pk_bf16(mm[8 * si + 2 * e], mm[8 * si + 2 * e + 1]);
                        const LAS unsigned char* xp = lds + SS_XS + (hl * 64 + pt * 32 + q) * 272 + (st * 32 + 16 * si + 4 * hh) * 2;
                        union { bf16x8 v; u32x2 hv[2]; } xb; xb.hv[0] = *(const LAS u32x2*)xp; xb.hv[1] = *(const LAS u32x2*)(xp + 16);
                        yd = __builtin_amdgcn_mfma_f32_32x32x16_bf16(af.v, xb.v, yd, 0, 0, 0); } } }
#pragma unroll
            for (int ks = 0; ks < 8; ++ks) { const bf16x8 hb = *(const bf16x8*)(hp + (size_t)h * 8192 + (pt * 32 + q) * 128 + ks * 16 + hh * 8);
                yo = __builtin_amdgcn_mfma_f32_32x32x16_bf16(cf[ks], hb, yo, 0, 0, 0); }
            const float dsk = d_skip[h];
#pragma unroll
            for (int qd = 0; qd < 4; ++qd) { const int l0 = lt * 32 + 8 * qd + 4 * hh;
                const u32x2 xv = *(const LAS u32x2*)(lds + SS_XS + (hl * 64 + pt * 32 + q) * 272 + l0 * 2);
#pragma unroll
                for (int e = 0; e < 4; ++e) { const int r = 4 * qd + e; const unsigned wd = xv[e >> 1]; const float xs = (e & 1) ? __uint_as_float(wd & 0xffff0000u) : __uint_as_float(wd << 16);
                    const float yv = yd[r] + __expf(ACS[h * 128 + l0 + e]) * yo[r] + xs * dsk;
                    Y[(t0 + l0 + e) * 768 + h * 64 + pt * 32 + q] = (bf16)(cvt_pk_bf16(yv, 0.f) & 0xffffu); } }
        }
    }
    VM_WAIT(); __syncthreads();
    __builtin_amdgcn_fence(__ATOMIC_ACQUIRE, "agent"); VM_WAIT();
    for (int t4 = wave * 16; t4 < wave * 16 + 16; t4 += 4) {
        u32x2 yv[4][3], zv[4][3];
#pragma unroll
        for (int k = 0; k < 4; ++k)
#pragma unroll
            for (int j = 0; j < 3; ++j) { const size_t t = t0 + t4 + k; yv[k][j] = *(const u32x2*)(Y + t * 768 + j * 256 + lane * 4); zv[k][j] = *(const u32x2*)(Z + t * 768 + j * 256 + lane * 4); }
#pragma unroll
        for (int k = 0; k < 4; ++k) { const size_t t = t0 + t4 + k;
            float v[12]; float ss = 0.f;
#pragma unroll
            for (int j = 0; j < 3; ++j)
#pragma unroll
                for (int e = 0; e < 4; ++e) { const unsigned yw = yv[k][j][e >> 1], zw = zv[k][j][e >> 1];
                    const float yy = (e & 1) ? __uint_as_float(yw & 0xffff0000u) : __uint_as_float(yw << 16), zz = (e & 1) ? __uint_as_float(zw & 0xffff0000u) : __uint_as_float(zw << 16);
                    const float x = yy * silu_f(zz); v[4 * j + e] = x; ss += x * x; }
            const float rstd = 1.0f / sqrtf(wave_sum(ss) * (1.f / 768.f) + EPS);
#pragma unroll
            for (int j = 0; j < 3; ++j) { const f32x4 gg = *(const f32x4*)(out_norm + j * 256 + lane * 4);
                u32x2 o; o.x = cvt_pk_bf16(v[4 * j] * rstd * gg.x, v[4 * j + 1] * rstd * gg.y); o.y = cvt_pk_bf16(v[4 * j + 2] * rstd * gg.z, v[4 * j + 3] * rstd * gg.w);
                *(u32x2*)(MIX + t * 1024 + j * 256 + lane * 4) = o; } } }
}

constexpr int DS_IKL = 145408;
constexpr int DS_SC = 0, DS_IMG = 0, DS_IMG_W = 32 * 528, DS_QL = 0, DS_SEL = 8 * DS_IMG_W, DS_RB = DS_SEL + 8192, DS_END = DS_RB + 2048;
static_assert(DS_SEL >= 8 * 4096 * 4 && DS_END <= DS_IKL && DS_IKL + 16384 <= LDS_SCR_BYTES, "DSA LDS map");
typedef short s16x4 __attribute__((ext_vector_type(4)));

__device__ __forceinline__ int t5_bucket(int n) {
    if (n < 16) return n;
    const float v = logf((float)n / 16.0f) / 2.0794415416798357f * 16.0f;
    const int l = 16 + (int)v; return l < 31 ? l : 31;
}
__device__ __forceinline__ unsigned sortable_u32(float f) { const unsigned b = __float_as_uint(f); return b ^ ((unsigned)((int)b >> 31) | 0x80000000u); }
__device__ __forceinline__ unsigned mbcnt64(unsigned long long m) { return __builtin_amdgcn_mbcnt_hi((unsigned)(m >> 32), __builtin_amdgcn_mbcnt_lo((unsigned)m, 0u)); }
__device__ __forceinline__ unsigned wave_sum_u32(unsigned x) {
    x += (unsigned)__builtin_amdgcn_update_dpp(0, (int)x, 0xB1, 0xf, 0xf, false);
    x += (unsigned)__builtin_amdgcn_update_dpp(0, (int)x, 0x4E, 0xf, 0xf, false);
    x += (unsigned)__builtin_amdgcn_update_dpp(0, (int)x, 0x141, 0xf, 0xf, false);
    x += (unsigned)__builtin_amdgcn_update_dpp(0, (int)x, 0x140, 0xf, 0xf, false);
    { const auto a = __builtin_amdgcn_permlane16_swap(x, x, false, false); x = a[0] + a[1]; }
    { const auto b = __builtin_amdgcn_permlane32_swap(x, x, false, false); x = b[0] + b[1]; }
    return x;
}
__device__ __forceinline__ float kg_max(float v) {
    { const auto a = __builtin_amdgcn_permlane16_swap(__float_as_uint(v), __float_as_uint(v), false, false); v = fmaxf(__uint_as_float(a[0]), __uint_as_float(a[1])); }
    { const auto b = __builtin_amdgcn_permlane32_swap(__float_as_uint(v), __float_as_uint(v), false, false); v = fmaxf(__uint_as_float(b[0]), __uint_as_float(b[1])); }
    return v;
}
#define CNT_GE(cnt, uu, cand) asm volatile("v_cmp_ge_u32 vcc, %1, %2\n\tv_addc_co_u32 %0, vcc, 0, %0, vcc" : "+v"(cnt) : "v"(uu), "v"(cand) : "vcc")
#define CNT_GT(cnt, uu, cand) asm volatile("v_cmp_gt_u32 vcc, %1, %2\n\tv_addc_co_u32 %0, vcc, 0, %0, vcc" : "+v"(cnt) : "v"(uu), "v"(cand) : "vcc")
__device__ __forceinline__ f32x4 mfma16(bf16x8 a, bf16x8 b, f32x4 c) { return __builtin_amdgcn_mfma_f32_16x16x32_bf16(a, b, c, 0, 0, 0); }

__device__ __forceinline__ void dsa_unit(LAS unsigned char* lds, int unit, bf16* QL, const bf16* CKV, const bf16* IQ, const bf16* IK, const float* IW, int tid, int wave, int lane_in) {
    const int lane = lane_in;
    const int b = unit & 7, qb = unit >> 3, t0 = qb * 8; const size_t tok0 = (size_t)b * SEQ + t0;
    LAS float* SC = (LAS float*)(lds + DS_SC); LAS unsigned* SEL = (LAS unsigned*)(lds + DS_SEL); const LAS float* RB = (const LAS float*)(lds + DS_RB);
    __syncthreads();
    for (int _ra = 0; _ra <= (DSA_PROBE & 1); ++_ra) {
        int lnA = lane; asm volatile("" : "+v"(lnA));
        int tid_a = tid; asm volatile("" : "+v"(tid_a));
        const int mt = wave & 1, q = lnA & 31, hh = lnA >> 5;
        const int qi = 4 * mt + 2 * ((q >> 2) & 1) + (q >> 4), hi = ((q >> 3) & 1) * 4 + (q & 3);
        bf16x8 af[4];
#pragma unroll
        for (int ks = 0; ks < 4; ++ks) af[ks] = *(const bf16x8*)(IQ + (tok0 + qi) * 512 + hi * 64 + ks * 16 + hh * 8);
        float wv[16];
        { const f32x4 a0 = *(const f32x4*)(IW + (tok0 + 4 * mt + 2 * hh) * 8), a1 = *(const f32x4*)(IW + (tok0 + 4 * mt + 2 * hh) * 8 + 4);
          const f32x4 b0 = *(const f32x4*)(IW + (tok0 + 4 * mt + 2 * hh + 1) * 8), b1 = *(const f32x4*)(IW + (tok0 + 4 * mt + 2 * hh + 1) * 8 + 4);
#pragma unroll
          for (int e = 0; e < 4; ++e) { wv[e] = a0[e]; wv[4 + e] = a1[e]; wv[8 + e] = b0[e]; wv[12 + e] = b1[e]; } }
        const int nkt = (t0 + 8 + 31) >> 5, ngr = (nkt + 3) >> 2;
        LAS unsigned char* IKL = lds + DS_IKL;
        const u32x4* ikg = (const u32x4*)(IK + (size_t)b * SEQ * 64) + tid_a;
        const int st0 = (tid_a >> 3) * 128 + (((tid_a & 7) ^ ((tid_a >> 3) & 7)) << 4), st1 = st0 + 64 * 128;
        const int jt = wave >> 1;
        const int rd0 = (jt * 32 + q) * 128; const int rx = (jt * 32 + q) & 7;
        u32x4 g0 = ikg[0], g1 = ikg[512];
#pragma unroll 1
        for (int g = 0; g < ngr; ++g) {
            __syncthreads();
            *(LAS u32x4*)(IKL + st0) = g0; *(LAS u32x4*)(IKL + st1) = g1;
            __syncthreads();
            if (g + 1 < ngr) { g0 = ikg[(size_t)(g + 1) * 1024]; g1 = ikg[(size_t)(g + 1) * 1024 + 512]; }
            const int kt = g * 4 + jt;
            if (kt < nkt) {
                f32x16 acc;
#pragma unroll
                for (int r = 0; r < 16; ++r) acc[r] = 0.f;
#pragma unroll
                for (int ks = 0; ks < 4; ++ks) { const bf16x8 bf = *(const LAS bf16x8*)(IKL + rd0 + (((2 * ks + hh) ^ rx) << 4)); acc = __builtin_amdgcn_mfma_f32_32x32x16_bf16(af[ks], bf, acc, 0, 0, 0); }
                float s0 = 0.f, s1 = 0.f;
#pragma unroll
                for (int r = 0; r < 8; ++r) { s0 += wv[r] * fmaxf(acc[r], 0.f); s1 += wv[8 + r] * fmaxf(acc[8 + r], 0.f); }
                const int key = kt * 32 + q;
                SC[(4 * mt + 2 * hh) * 4096 + key] = s0; SC[(4 * mt + 2 * hh + 1) * 4096 + key] = s1; }
        }
    }
    __syncthreads();
    int lnD = lane_in; asm volatile("" : "+v"(lnD));
    const int fr = lnD & 15, kg = lnD >> 4;
    bf16x8 ql[8];
#pragma unroll
    for (int ks = 0; ks < 8; ++ks) ql[ks] = (fr < 12) ? *(const bf16x8*)(QL + ((tok0 + wave) * 12 + fr) * 256 + ks * 32 + kg * 8) : (bf16x8){0, 0, 0, 0, 0, 0, 0, 0};
    const int t = t0 + wave, n = t + 1; const int nsel = n < 256 ? n : 256;
    for (int _rb = 0; _rb <= ((DSA_PROBE >> 1) & 1); ++_rb) {
        int lane = lane_in; asm volatile("" : "+v"(lane));
        LAS unsigned* selw = SEL + wave * 256;
        if (n <= 256) {
            for (int i = lane; i < n; i += 64) selw[i] = (unsigned)i | ((unsigned)t5_bucket(t - i) << 16);
        } else {
            const LAS float* sc = SC + wave * 4096;
            const int ni = (n + 63) >> 6;
            unsigned u[64];
#pragma unroll
            for (int i = 0; i < 64; ++i) { const int s = 64 * i + lane; u[i] = (s < n) ? sortable_u32(sc[s]) : 0u; }
            unsigned T = 0u;
            for (int bit = 31; bit >= 0; --bit) {
                const unsigned cand = T | (1u << bit); unsigned cl = 0u;
#pragma unroll
                for (int g4 = 0; g4 < 4; ++g4) if (ni > 16 * g4) {
#pragma unroll
                    for (int i = 16 * g4; i < 16 * g4 + 16; ++i) CNT_GE(cl, u[i], cand); }
                asm volatile("s_nop 1" ::: "memory");
                const unsigned cnt = (unsigned)__builtin_amdgcn_readfirstlane((int)wave_sum_u32(cl));
                if (cnt >= 256u) T = cand;
                if (cnt == 256u) break;
            }
            unsigned G;
            { unsigned gl = 0u;
#pragma unroll
              for (int g4 = 0; g4 < 4; ++g4) if (ni > 16 * g4) {
#pragma unroll
                  for (int i = 16 * g4; i < 16 * g4 + 16; ++i) CNT_GT(gl, u[i], T); }
              asm volatile("s_nop 1" ::: "memory");
              G = (unsigned)__builtin_amdgcn_readfirstlane((int)wave_sum_u32(gl)); }
            const unsigned need_eq = 256u - G;
            unsigned pos = 0u, eq_used = 0u;
#pragma unroll
            for (int g4 = 0; g4 < 4; ++g4) if (ni > 16 * g4) {
#pragma unroll
                for (int i = 16 * g4; i < 16 * g4 + 16; ++i) {
                    const bool gt = u[i] > T, eq = u[i] == T;
                    const unsigned long long meq = __ballot(eq);
                    const bool sl = gt || (eq && (eq_used + mbcnt64(meq) < need_eq));
                    const unsigned long long msl = __ballot(sl);
                    if (sl) selw[pos + mbcnt64(msl)] = (unsigned)(64 * i + lane);
                    pos += (unsigned)__popcll(msl); eq_used += (unsigned)__popcll(meq); } }
#pragma unroll 1
            for (int i = lane; i < 256; i += 64) { const unsigned s = selw[i]; selw[i] = s | ((unsigned)t5_bucket(t - (int)s) << 16); }
        }
    }
    __syncthreads();
    f32x4 O[16];
#pragma unroll
    for (int ct = 0; ct < 16; ++ct) O[ct] = (f32x4){0.f, 0.f, 0.f, 0.f};
    float mrun = -3.0e38f, lrun = 0.f;
    for (int _rd = 0; _rd <= ((DSA_PROBE >> 3) & 1); ++_rd) {
        const unsigned rowmask = ((DSA_PROBE & 32) && _rd == 0) ? 0x7ffu : 0xffffu;
        if (_rd) { mrun = -3.0e38f; lrun = 0.f;
_Pragma("unroll") for (int ct = 0; ct < 16; ++ct) O[ct] = (f32x4){0.f, 0.f, 0.f, 0.f}; }
        const LAS unsigned* selw = SEL + wave * 256;
        LAS unsigned char* img = lds + DS_IMG + wave * DS_IMG_W;
        const int nsteps = (nsel + 31) >> 5;
        const int hh2 = lnD >> 5, c32 = lnD & 31; const bf16* ckr = CKV + (size_t)b * SEQ * 256 + c32 * 8;
        bf16x8 b0[8], b1[8], b2[8];
#pragma unroll
        for (int ks = 0; ks < 8; ++ks) { b0[ks] = (bf16x8){0, 0, 0, 0, 0, 0, 0, 0}; b1[ks] = b0[ks]; b2[ks] = b0[ks]; }
        const int ntiles = 2 * nsteps;
#define DSA_GATHER(X, tile) do { _Pragma("unroll") for (int j = 0; j < 8; ++j) { const int k_ = (tile) * 16 + 2 * j + hh2; const unsigned e_ = selw[k_ < nsel ? k_ : nsel - 1]; \
            if (!((DSA_PROBE & 128) && _rd == 0)) X[j] = *(const bf16x8*)(ckr + (size_t)(e_ & rowmask) * 256); } } while (0)
#define DSA_STEP(X0, X1, st) do { \
            f32x4 d0 = {0.f, 0.f, 0.f, 0.f}, d1 = {0.f, 0.f, 0.f, 0.f}; \
            _Pragma("unroll") for (int j = 0; j < 8; ++j) *(LAS bf16x8*)(img + (2 * j + hh2) * 528 + c32 * 16) = X0[j]; \
            if (2 * (st) + 3 < ntiles) DSA_GATHER(X0, 2 * (st) + 3);                \
            _Pragma("unroll") for (int j = 0; j < 8; ++j) *(LAS bf16x8*)(img + (16 + 2 * j + hh2) * 528 + c32 * 16) = X1[j]; \
            if (2 * (st) + 4 < ntiles) DSA_GATHER(X1, 2 * (st) + 4); \
            _Pragma("unroll") for (int k4 = 0; k4 < 8; k4 += 2) { bf16x8 fa[2], fb[2]; \
                _Pragma("unroll") for (int ks = 0; ks < 2; ++ks) { fa[ks] = *(const LAS bf16x8*)(img + fr * 528 + ((k4 + ks) * 32 + kg * 8) * 2); fb[ks] = *(const LAS bf16x8*)(img + (16 + fr) * 528 + ((k4 + ks) * 32 + kg * 8) * 2); } \
                _Pragma("unroll") for (int ks = 0; ks < 2; ++ks) { d0 = mfma16(fa[ks], ql[k4 + ks], d0); d1 = mfma16(fb[ks], ql[k4 + ks], d1); } } \
            const u32x4 s0 = *(const LAS u32x4*)(selw + (st) * 32 + kg * 4), s1 = *(const LAS u32x4*)(selw + (st) * 32 + 16 + kg * 4); \
            float lg[8]; float mloc = -3.0e38f; \
            _Pragma("unroll") for (int r = 0; r < 4; ++r) { \
                const float v0 = d0[r] + RB[((s0[r] >> 16) & 31u) * 16 + fr], v1 = d1[r] + RB[((s1[r] >> 16) & 31u) * 16 + fr]; \
                lg[r] = ((st) * 32 + kg * 4 + r < nsel) ? v0 : -3.0e38f; lg[4 + r] = ((st) * 32 + 16 + kg * 4 + r < nsel) ? v1 : -3.0e38f; \
                mloc = fmaxf(mloc, fmaxf(lg[r], lg[4 + r])); } \
            if (__any(mloc > mrun + 16.0f)) {                                       \
                mloc = kg_max(mloc); \
                const float mnew = fmaxf(mrun, mloc); \
                const float alpha = __expf(mrun - mnew); lrun *= alpha; \
                float ar[4]; \
                _Pragma("unroll") for (int r = 0; r < 4; ++r) ar[r] = __shfl(alpha, kg * 4 + r); \
                _Pragma("unroll") for (int ct = 0; ct < 16; ++ct) _Pragma("unroll") for (int r = 0; r < 4; ++r) O[ct][r] *= ar[r]; \
                mrun = mnew; } \
            float p[8]; \
            _Pragma("unroll") for (int r = 0; r < 8; ++r) { p[r] = (lg[r] > -1.0e38f) ? __expf(lg[r] - mrun) : 0.f; lrun += p[r]; } \
            union { bf16x8 v; unsigned w[4]; } pa; \
            pa.w[0] = cvt_pk_bf16(p[0], p[1]); pa.w[1] = cvt_pk_bf16(p[2], p[3]); pa.w[2] = cvt_pk_bf16(p[4], p[5]); pa.w[3] = cvt_pk_bf16(p[6], p[7]); \
            const LAS unsigned char* tb = img + (kg * 4 + (fr >> 2)) * 528 + (fr & 3) * 8; \
            if (!((DSA_PROBE & 64) && _rd == 0)) { \
            _Pragma("unroll") for (int c8 = 0; c8 < 16; c8 += 4) { \
                union { bf16x8 v; s16x4 h[2]; } bb[4]; \
                _Pragma("unroll") for (int cj = 0; cj < 4; ++cj) { bb[cj].h[0] = __builtin_amdgcn_ds_read_tr16_b64_v4i16((LAS s16x4*)(tb + (c8 + cj) * 32)); \
                    bb[cj].h[1] = __builtin_amdgcn_ds_read_tr16_b64_v4i16((LAS s16x4*)(tb + 16 * 528 + (c8 + cj) * 32)); } \
                _Pragma("unroll") for (int cj = 0; cj < 4; ++cj) O[c8 + cj] = mfma16(pa.v, bb[cj].v, O[c8 + cj]); } } } while (0)
        DSA_GATHER(b0, 0); DSA_GATHER(b1, 1); if (ntiles > 2) DSA_GATHER(b2, 2);
        for (int st = 0; st < nsteps; st += 3) {
            DSA_STEP(b0, b1, st);
            if (st + 1 < nsteps) DSA_STEP(b2, b0, st + 1);
            if (st + 2 < nsteps) DSA_STEP(b1, b2, st + 2);
        }
    }
#undef DSA_GATHER
#undef DSA_STEP
    lrun += __shfl_xor(lrun, 16); lrun += __shfl_xor(lrun, 32);
    const float inv = 1.0f / lrun;
    float ir[4];
#pragma unroll
    for (int r = 0; r < 4; ++r) ir[r] = __shfl(inv, kg * 4 + r);
    __syncthreads();
    if (kg < 3) {
#pragma unroll
        for (int ct = 0; ct < 16; ++ct)
#pragma unroll
            for (int r = 0; r < 4; ++r) *(LAS unsigned short*)(lds + DS_QL + ((wave * 12 + kg * 4 + r) * 256 + ct * 16 + fr) * 2) = (unsigned short)(cvt_pk_bf16(O[ct][r] * ir[r], 0.f) & 0xffffu);
    }
    __syncthreads();
    { const LAS u32x4* src = (const LAS u32x4*)(lds + DS_QL + wave * 12 * 256 * 2); u32x4* dst = (u32x4*)(QL + (tok0 + wave) * 12 * 256);
#pragma unroll
      for (int j = 0; j < 6; ++j) dst[j * 64 + lnD] = src[j * 64 + lnD]; }
}

__device__ __forceinline__ void qlat_phase(LAS unsigned char* lds, int u0, int ustep, int nunits, const bf16* Q, const bf16* UK, bf16* QL, int tid, int wave, int lane_in) {
    int lane = lane_in; asm volatile("" : "+v"(lane));
    const int q = lane & 31, hh = lane >> 5;
    u32x4 pre[2]; bf16x8 af[4];
#define QL_LOAD(unit) do { const int tb_ = (unit) / 12, h_ = (unit) - tb_ * 12; \
        _Pragma("unroll") for (int i = 0; i < 2; ++i) { const int idx = tid + i * NTHR, row = idx >> 3, ch = idx & 7; pre[i] = *(const u32x4*)(Q + ((size_t)tb_ * 128 + row) * 768 + h_ * 64 + ch * 8); } \
        _Pragma("unroll") for (int ks = 0; ks < 4; ++ks) af[ks] = *(const bf16x8*)(UK + ((size_t)h_ * 256 + wave * 32 + q) * 64 + ks * 16 + hh * 8); } while (0)
    if (u0 < nunits) QL_LOAD(u0);
    for (int unit = u0; unit < nunits; unit += ustep) {
        const int tb = unit / 12, h = unit - tb * 12; const size_t tok0 = (size_t)tb * 128;
        __syncthreads();
#pragma unroll
        for (int i = 0; i < 2; ++i) { const int idx = tid + i * NTHR, row = idx >> 3, ch = idx & 7; *(LAS u32x4*)(lds + row * 144 + ch * 16) = pre[i]; }
        bf16x8 afc[4];
#pragma unroll
        for (int ks = 0; ks < 4; ++ks) afc[ks] = af[ks];
        __syncthreads();
        if (unit + ustep < nunits) QL_LOAD(unit + ustep);
#pragma unroll
        for (int nt = 0; nt < 4; ++nt) {
            f32x16 acc;
#pragma unroll
            for (int r = 0; r < 16; ++r) acc[r] = 0.f;
#pragma unroll
            for (int ks = 0; ks < 4; ++ks) { const bf16x8 bq = *(const LAS bf16x8*)(lds + (nt * 32 + q) * 144 + (ks * 16 + hh * 8) * 2); acc = __builtin_amdgcn_mfma_f32_32x32x16_bf16(afc[ks], bq, acc, 0, 0, 0); }
#pragma unroll
            for (int g = 0; g < 4; ++g) { u32x2 w; w.x = cvt_pk_bf16(acc[4 * g] * 0.125f, acc[4 * g + 1] * 0.125f); w.y = cvt_pk_bf16(acc[4 * g + 2] * 0.125f, acc[4 * g + 3] * 0.125f);
                *(LAS u32x2*)(lds + 18432 + (nt * 32 + q) * 528 + (wave * 32 + 8 * g + 4 * hh) * 2) = w; }
        }
        __syncthreads();
        for (int idx = tid; idx < 4096; idx += NTHR) { const int row = idx >> 5, ch = idx & 31;
            *(u32x4*)(QL + ((tok0 + row) * 12 + h) * 256 + ch * 8) = *(const LAS u32x4*)(lds + 18432 + row * 528 + ch * 16); }
    }
#undef QL_LOAD
}
__device__ __forceinline__ void uv_phase(LAS unsigned char* lds, int u0, int ustep, int nunits, const bf16* QL, const bf16* UVT, bf16* MIX, int tid, int wave, int lane_in) {
    int lane = lane_in; asm volatile("" : "+v"(lane));
    const int q = lane & 31, hh = lane >> 5, mt = wave >> 1, nt = wave & 1;
    u32x4 pre[8];
#define UV_LOAD(unit) do { const int tb_ = (unit) / 12, h_ = (unit) - tb_ * 12; _Pragma("unroll") for (int i = 0; i < 8; ++i) { const int idx = tid + i * NTHR, row = idx >> 5, ch = idx & 31; \
        pre[i] = *(const u32x4*)(QL + (((size_t)tb_ * 128 + row) * 12 + h_) * 256 + ch * 8); } } while (0)
    if (u0 < nunits) UV_LOAD(u0);
    for (int unit = u0; unit < nunits; unit += ustep) {
        const int tb = unit / 12, h = unit - tb * 12; const size_t tok0 = (size_t)tb * 128;
        __syncthreads();
#pragma unroll
        for (int i = 0; i < 8; ++i) { const int idx = tid + i * NTHR, row = idx >> 5, ch = idx & 31; *(LAS u32x4*)(lds + row * 528 + ch * 16) = pre[i]; }
        const bf16* bp = UVT + ((size_t)h * 64 + nt * 32 + q) * 256 + hh * 8;
        bf16x8 bw[16];
#pragma unroll
        for (int ks = 0; ks < 16; ++ks) bw[ks] = *(const bf16x8*)(bp + ks * 16);
        __syncthreads();
        if (unit + ustep < nunits) UV_LOAD(unit + ustep);
        f32x16 acc;
#pragma unroll
        for (int r = 0; r < 16; ++r) acc[r] = 0.f;
#pragma unroll
        for (int ks = 0; ks < 16; ++ks) { const bf16x8 a = *(const LAS bf16x8*)(lds + (mt * 32 + q) * 528 + (ks * 16 + hh * 8) * 2); acc = __builtin_amdgcn_mfma_f32_32x32x16_bf16(a, bw[ks], acc, 0, 0, 0); }
#pragma unroll
        for (int r = 0; r < 16; ++r) *(LAS unsigned short*)(lds + 67584 + (mt * 32 + (r & 3) + 8 * (r >> 2) + 4 * hh) * 144 + (nt * 32 + q) * 2) = (unsigned short)(cvt_pk_bf16(acc[r], 0.f) & 0xffffu);
        __syncthreads();
        for (int idx = tid; idx < 1024; idx += NTHR) { const int row = idx >> 3, ch = idx & 7;
            *(u32x4*)(MIX + (tok0 + row) * 1024 + h * 64 + ch * 8) = *(const LAS u32x4*)(lds + 67584 + row * 144 + ch * 16); }
    }
#undef UV_LOAD
}

typedef __bf16 bf16v2_tt __attribute__((ext_vector_type(2)));
typedef float f32x2 __attribute__((ext_vector_type(2)));
__device__ __forceinline__ float dot2bf(unsigned a, unsigned b, float c) { return __builtin_amdgcn_fdot2_f32_bf16(__builtin_bit_cast(bf16v2_tt, a), __builtin_bit_cast(bf16v2_tt, b), c, false); }
__device__ __forceinline__ float unsortable_f32(unsigned u) { return __uint_as_float((u & 0x80000000u) ? (u ^ 0x80000000u) : ~u); }

constexpr int PA_SK = 0, PA_WB = 2 * 128 * 272, PA_WBYTES = 32 * 272;
static_assert(PA_WB + 8 * PA_WBYTES <= LDS_SCR_BYTES, "PEER-A LDS map");
__device__ __forceinline__ float wave_min_f32(float x) {
    x = fminf(x, __uint_as_float((unsigned)__builtin_amdgcn_update_dpp(0, (int)__float_as_uint(x), 0xB1, 0xf, 0xf, false)));
    x = fminf(x, __uint_as_float((unsigned)__builtin_amdgcn_update_dpp(0, (int)__float_as_uint(x), 0x4E, 0xf, 0xf, false)));
    x = fminf(x, __uint_as_float((unsigned)__builtin_amdgcn_update_dpp(0, (int)__float_as_uint(x), 0x141, 0xf, 0xf, false)));
    x = fminf(x, __uint_as_float((unsigned)__builtin_amdgcn_update_dpp(0, (int)__float_as_uint(x), 0x140, 0xf, 0xf, false)));
    { const auto a = __builtin_amdgcn_permlane16_swap(__float_as_uint(x), __float_as_uint(x), false, false); x = fminf(__uint_as_float(a[0]), __uint_as_float(a[1])); }
    { const auto b = __builtin_amdgcn_permlane32_swap(__float_as_uint(x), __float_as_uint(x), false, false); x = fminf(__uint_as_float(b[0]), __uint_as_float(b[1])); }
    return x;
}
__device__ __forceinline__ float wave_max_f32(float x) {
    x = fmaxf(x, __uint_as_float((unsigned)__builtin_amdgcn_update_dpp(0, (int)__float_as_uint(x), 0xB1, 0xf, 0xf, false)));
    x = fmaxf(x, __uint_as_float((unsigned)__builtin_amdgcn_update_dpp(0, (int)__float_as_uint(x), 0x4E, 0xf, 0xf, false)));
    x = fmaxf(x, __uint_as_float((unsigned)__builtin_amdgcn_update_dpp(0, (int)__float_as_uint(x), 0x141, 0xf, 0xf, false)));
    x = fmaxf(x, __uint_as_float((unsigned)__builtin_amdgcn_update_dpp(0, (int)__float_as_uint(x), 0x140, 0xf, 0xf, false)));
    { const auto a = __builtin_amdgcn_permlane16_swap(__float_as_uint(x), __float_as_uint(x), false, false); x = fmaxf(__uint_as_float(a[0]), __uint_as_float(a[1])); }
    { const auto b = __builtin_amdgcn_permlane32_swap(__float_as_uint(x), __float_as_uint(x), false, false); x = fmaxf(__uint_as_float(b[0]), __uint_as_float(b[1])); }
    return x;
}
__device__ __forceinline__ unsigned wave_max_u32(unsigned x) {
    { const unsigned t = (unsigned)__builtin_amdgcn_update_dpp(0, (int)x, 0xB1, 0xf, 0xf, false); x = t > x ? t : x; }
    { const unsigned t = (unsigned)__builtin_amdgcn_update_dpp(0, (int)x, 0x4E, 0xf, 0xf, false); x = t > x ? t : x; }
    { const unsigned t = (unsigned)__builtin_amdgcn_update_dpp(0, (int)x, 0x141, 0xf, 0xf, false); x = t > x ? t : x; }
    { const unsigned t = (unsigned)__builtin_amdgcn_update_dpp(0, (int)x, 0x140, 0xf, 0xf, false); x = t > x ? t : x; }
    { const auto a = __builtin_amdgcn_permlane16_swap(x, x, false, false); x = a[0] > a[1] ? a[0] : a[1]; }
    { const auto b = __builtin_amdgcn_permlane32_swap(x, x, false, false); x = b[0] > b[1] ? b[0] : b[1]; }
    return (unsigned)__builtin_amdgcn_readfirstlane((int)x);
}
__device__ __forceinline__ void peer_topk_load_sk(LAS unsigned char* lds, const bf16* SK, int tid) {
    __syncthreads();
    for (int idx = tid; idx < 4096; idx += NTHR) { const int row = idx >> 4, ch = idx & 15;
        *(LAS u32x4*)(lds + PA_SK + row * 272 + ch * 16) = *(const u32x4*)(SK + (size_t)row * 128 + ch * 8); }
    __syncthreads();
}
__device__ __forceinline__ void peer_topk_task(LAS unsigned char* lds, int task, const bf16* PQ, u32x2* TOPK, int wave, int lane_in) {
    int lane = lane_in; asm volatile("" : "+v"(lane));
    const int tg = task >> 4, sl = task & 15, half = sl & 1, q = lane & 31, hh = lane >> 5;
    LAS unsigned char* wb = lds + PA_WB + wave * PA_WBYTES;
#pragma unroll
    for (int j = 0; j < 8; ++j) { const int row = 4 * j + (lane >> 4), ch = lane & 15;
        *(LAS u32x4*)(wb + row * 272 + ch * 16) = *(const u32x4*)(PQ + ((size_t)tg * 32 + row) * 2048 + sl * 128 + ch * 8); }
    bf16x8 bq[8];
#pragma unroll
    for (int ks = 0; ks < 8; ++ks) bq[ks] = *(const LAS bf16x8*)(wb + q * 272 + (ks * 16 + hh * 8) * 2);
    unsigned u[64];
    const LAS unsigned char* skp = lds + PA_SK + (half * 128 + q) * 272 + hh * 16;
#pragma unroll
    for (int kt = 0; kt < 4; ++kt) {
        f32x16 acc;
#pragma unroll
        for (int r = 0; r < 16; ++r) acc[r] = 0.f;
#pragma unroll
        for (int ks = 0; ks < 8; ++ks) { const bf16x8 a = *(const LAS bf16x8*)(skp + kt * 32 * 272 + ks * 32); acc = __builtin_amdgcn_mfma_f32_32x32x16_bf16(a, bq[ks], acc, 0, 0, 0); }
#pragma unroll
        for (int r = 0; r < 16; ++r) u[kt * 16 + r] = sortable_u32(acc[r] + 0.f);
    }
    unsigned T, bstart;
    { unsigned mn = 0xffffffffu, mxall = 0u;
#pragma unroll
      for (int g = 0; g < 8; ++g) { unsigned m = u[8 * g];
#pragma unroll
          for (int i = 1; i < 8; ++i) m = (u[8 * g + i] > m) ? u[8 * g + i] : m;
          mn = m < mn ? m : mn; mxall = m > mxall ? m : mxall; }
      { const auto a2 = __builtin_amdgcn_permlane32_swap(mn, mn, false, false); mn = a2[0] < a2[1] ? a2[0] : a2[1]; const auto b2 = __builtin_amdgcn_permlane32_swap(mxall, mxall, false, false); mxall = b2[0] > b2[1] ? b2[0] : b2[1]; }
      const unsigned df = mn ^ mxall;
      bstart = df ? (31u - (unsigned)__builtin_clz(df)) : 0u;
      T = (bstart >= 31u) ? 0u : (mn & ~((2u << bstart) - 1u)); }
    bool done = false;
    const int btop = (int)wave_max_u32(bstart);
#pragma unroll 1
    for (int bit = btop; bit >= 0; --bit) {
        const unsigned cand = T | (1u << bit); unsigned cnt = 0u;
#pragma unroll
        for (int i = 0; i < 64; ++i) CNT_GE(cnt, u[i], cand);
        asm volatile("s_nop 1" ::: "memory");
        const auto sw = __builtin_amdgcn_permlane32_swap(cnt, cnt, false, false);
        const unsigned tot = sw[0] + sw[1];
        if (!done && (unsigned)bit <= bstart && tot >= 16u) T = cand;
        done = done || ((unsigned)bit <= bstart && tot == 16u);
        if (__all(done)) break;
    }
    unsigned gtc = 0u, eqc = 0u;
#pragma unroll
    for (int i = 0; i < 64; ++i) { CNT_GT(gtc, u[i], T); asm volatile("v_cmp_eq_u32 vcc, %1, %2\n\tv_addc_co_u32 %0, vcc, 0, %0, vcc" : "+v"(eqc) : "v"(u[i]), "v"(T) : "vcc"); }
    asm volatile("s_nop 1" ::: "memory");
    unsigned pg, pe;
    { const auto a = __builtin_amdgcn_permlane32_swap(gtc, gtc, false, false); pg = a[0] + a[1] - gtc; const auto e = __builtin_amdgcn_permlane32_swap(eqc, eqc, false, false); pe = e[0] + e[1] - eqc; }
    const unsigned need_eq = 16u - (gtc + pg);
    const unsigned take0 = hh ? (pe < need_eq ? pe : need_eq) : (eqc < need_eq ? eqc : need_eq);
    const unsigned my_take = hh ? need_eq - take0 : take0;
    unsigned pos = hh ? (pg + take0) : 0u, eq_seen = 0u;
    LAS u32x2* stg = (LAS u32x2*)wb + q * 16;
#pragma unroll
    for (int i = 0; i < 64; ++i) {
        const bool eq = (u[i] == T); const bool sel = (u[i] > T) || (eq && eq_seen < my_take);
        if (sel) { u32x2 e; e.x = __float_as_uint(unsortable_f32(u[i])); e.y = (unsigned)((i >> 4) * 32 + (i & 3) + 8 * ((i >> 2) & 3) + 4 * hh); stg[pos] = e; pos += 1u; }
        eq_seen += eq ? 1u : 0u;
    }
#pragma unroll
    for (int j = 0; j < 4; ++j) { const int tk = 8 * j + (lane >> 3), ch = lane & 7;
        *(u32x4*)((unsigned char*)(TOPK + (((size_t)tg * 32 + tk) * 16 + sl) * 16) + ch * 16) = *(const LAS u32x4*)(wb + tk * 128 + ch * 16); }
}

template <bool LAST>
__device__ __forceinline__ void peer_tok(LAS unsigned char* lds_w, size_t tok, const u32x2* TOPK, const unsigned char* TABU, const unsigned char* TABV, const float* TSU, const float* TSV, bf16* HB, const float* SS, const float* gffn, float* xres, const float* gnext, int lane_in) {
    int lane = lane_in; asm volatile("" : "+v"(lane));
    LAS u32x2* EL = (LAS u32x2*)lds_w;
    LAS u32x4* EG = (LAS u32x4*)(lds_w + 1024);
    for (int _rp = 0; _rp <= (PEER_PROBE & 1); ++_rp)
#pragma unroll 1
    for (int head = 0; head < 8; ++head) {
        const u32x2* base = TOPK + (tok * 16 + head * 2) * 16;
        const u32x2 e0 = base[lane >> 2];
        const u32x4 e1a = *(const u32x4*)(base + 16 + 4 * (lane & 3)), e1b = *(const u32x4*)(base + 16 + 4 * (lane & 3) + 2);
        const float s0 = __uint_as_float(e0.x);
        float cs[4]; unsigned ck[4], u[4];
        cs[0] = s0 + __uint_as_float(e1a.x); ck[0] = e0.y * 128u + e1a.y; cs[1] = s0 + __uint_as_float(e1a.z); ck[1] = e0.y * 128u + e1a.w;
        cs[2] = s0 + __uint_as_float(e1b.x); ck[2] = e0.y * 128u + e1b.y; cs[3] = s0 + __uint_as_float(e1b.z); ck[3] = e0.y * 128u + e1b.w;
#pragma unroll
        for (int m = 0; m < 4; ++m) u[m] = sortable_u32(cs[m]);
        unsigned T = 0u;
#pragma unroll 1
        for (int bit = 31; bit >= 0; --bit) {
            const unsigned cand = T | (1u << bit); unsigned cnt = 0u;
#pragma unroll
            for (int m = 0; m < 4; ++m) cnt += (unsigned)__popcll(__ballot(u[m] >= cand));
            if (cnt >= 16u) T = cand;
            if (cnt == 16u) break;
        }
        unsigned G = 0u;
#pragma unroll
        for (int m = 0; m < 4; ++m) G += (unsigned)__popcll(__ballot(u[m] > T));
        const unsigned need_eq = 16u - G; unsigned pos = 0u, eq_used = 0u;
#pragma unroll
        for (int m = 0; m < 4; ++m) {
            const bool gt = u[m] > T, eq = u[m] == T;
            const unsigned long long meq = __ballot(eq);
            const bool sl = gt || (eq && (eq_used + mbcnt64(meq) < need_eq));
            const unsigned long long msl = __ballot(sl);
            if (sl) { u32x2 e; e.x = ck[m]; e.y = __float_as_uint(cs[m]); EL[head * 16 + pos + mbcnt64(msl)] = e; }
            pos += (unsigned)__popcll(msl); eq_used += (unsigned)__popcll(meq); }
    }
#pragma unroll
    for (int rep = 0; rep < 2; ++rep) { const int e = lane + 64 * rep; const u32x2 ent = EL[e]; const float sc = __uint_as_float(ent.y);
        const float su = TSU[ent.x], sv = TSV[ent.x];
        float mx = sc;
#pragma unroll
        for (int o = 1; o < 16; o <<= 1) mx = fmaxf(mx, __shfl_xor(mx, o));
        const float p = __expf(sc - mx); float sm = p;
#pragma unroll
        for (int o = 1; o < 16; o <<= 1) sm += __shfl_xor(sm, o);
        u32x4 w; w.x = ent.x; w.y = __float_as_uint(su); w.z = __float_as_uint(p / sm * sv); w.w = 0u; EG[e] = w; }
    int xq[4]; float sx;
    { const u32x4* hp = (const u32x4*)(HB + tok * 1024 + lane * 16); const u32x4 qa = hp[0], qb = hp[1]; float f[16]; float am = 0.f;
#pragma unroll
      for (int e = 0; e < 4; ++e) { f[2 * e] = __uint_as_float(qa[e] << 16); f[2 * e + 1] = __uint_as_float(qa[e] & 0xffff0000u); f[8 + 2 * e] = __uint_as_float(qb[e] << 16); f[8 + 2 * e + 1] = __uint_as_float(qb[e] & 0xffff0000u); }
      { const float rs_ = 1.0f / sqrtf(SS[tok] * (1.f / 1024.f) + EPS);
#pragma unroll
        for (int j = 0; j < 4; ++j) { const f32x4 gg = *(const f32x4*)(gffn + lane * 16 + 4 * j); f[4 * j] *= rs_ * gg[0]; f[4 * j + 1] *= rs_ * gg[1]; f[4 * j + 2] *= rs_ * gg[2]; f[4 * j + 3] *= rs_ * gg[3]; } }
#pragma unroll
      for (int c = 0; c < 16; ++c) am = fmaxf(am, fabsf(f[c]));
      am = wave_max(am); sx = am > 0.f ? am * (1.0f / 127.0f) : 1.0f; const float inv = 1.0f / sx;
#pragma unroll
      for (int e = 0; e < 4; ++e) { const int q0 = (int)rintf(f[4 * e] * inv), q1 = (int)rintf(f[4 * e + 1] * inv), q2 = (int)rintf(f[4 * e + 2] * inv), q3 = (int)rintf(f[4 * e + 3] * inv);
          xq[e] = (q0 & 0xff) | ((q1 & 0xff) << 8) | ((q2 & 0xff) << 16) | ((q3 & 0xff) << 24); } }
    f32x2 out2[8];
#pragma unroll
    for (int c = 0; c < 8; ++c) out2[c] = (f32x2){0.f, 0.f};
    const unsigned char* ubase = TABU + lane * 16; const unsigned char* vbase = TABV + lane * 16;
#define PT_LOAD(UB, VB, BT) do { _Pragma("unroll") for (int k = 0; k < 8; ++k) { const size_t ro = (size_t)EG[(BT) * 8 + k].x << 10; UB[k] = *(const u32x4*)(ubase + ro); VB[k] = *(const u32x4*)(vbase + ro); } } while (0)
#define PT_COMPUTE(UB, VB, BT) do { int di[8]; \
        _Pragma("unroll") for (int k = 0; k < 8; ++k) { int a0 = 0; \
            _Pragma("unroll") for (int e = 0; e < 4; ++e) a0 = __builtin_amdgcn_sdot4((int)UB[k][e], xq[e], a0, false); di[k] = a0; } \
        int r4[4], r2[2], v1; \
        { const bool h32 = (lane & 32) != 0; \
          _Pragma("unroll") for (int j = 0; j < 4; ++j) { const int send = h32 ? di[j] : di[j + 4], keep = h32 ? di[j + 4] : di[j]; r4[j] = keep + __shfl_xor(send, 32); } \
          const bool h16 = (lane & 16) != 0; \
          _Pragma("unroll") for (int j = 0; j < 2; ++j) { const int send = h16 ? r4[j] : r4[j + 2], keep = h16 ? r4[j + 2] : r4[j]; r2[j] = keep + __shfl_xor(send, 16); } \
          const bool h8 = (lane & 8) != 0; \
          { const int send = h8 ? r2[0] : r2[1], keep = h8 ? r2[1] : r2[0]; v1 = keep + __shfl_xor(send, 8); } \
          v1 += __shfl_xor(v1, 4); v1 += __shfl_xor(v1, 2); v1 += __shfl_xor(v1, 1); } \
        float act; { const u32x4 eg = EG[(BT) * 8 + (lane >> 3)]; const float v = (float)v1 * (__uint_as_float(eg.y) * sx); \
          const float t = __builtin_amdgcn_rcpf(fabsf(v) * 0.2316418882f + 1.0f); \
          float q = t * 0.5307027145f + (-0.7265760135f); q = q * t + 0.7107068705f; q = q * t + (-0.142248368f); q = q * t + 0.127414796f; q = q * t; \
          const float m = v * (q * __builtin_amdgcn_exp2f(v * v * (-0.72134752044f))); \
          act = (v < 0.f ? m : v - m) * __uint_as_float(eg.z); }                        \
        _Pragma("unroll") for (int k = 0; k < 8; ++k) { const float a = __uint_as_float(__builtin_amdgcn_readlane((int)__float_as_uint(act), 8 * k)); \
            _Pragma("unroll") for (int e = 0; e < 4; ++e) { out2[2 * e] += __builtin_amdgcn_cvt_pk_f32_fp8((int)VB[k][e], false) * a; out2[2 * e + 1] += __builtin_amdgcn_cvt_pk_f32_fp8((int)VB[k][e], true) * a; } } } while (0)
    {
        u32x4 ubA[8], vbA[8], ubB[8], vbB[8], ubC[8], vbC[8];
        PT_LOAD(ubA, vbA, 0); PT_LOAD(ubB, vbB, 1);
#pragma unroll 1
        for (int bt = 0; bt < 16; bt += 3) {
            { const int n2 = (bt + 2 < 16) ? bt + 2 : 15; PT_LOAD(ubC, vbC, n2); }
            PT_COMPUTE(ubA, vbA, bt);
            if (bt + 1 < 16) {
                { const int n3 = (bt + 3 < 16) ? bt + 3 : 15; PT_LOAD(ubA, vbA, n3); }
                PT_COMPUTE(ubB, vbB, bt + 1);
                { const int n4 = (bt + 4 < 16) ? bt + 4 : 15; PT_LOAD(ubB, vbB, n4); }
                PT_COMPUTE(ubC, vbC, bt + 2);
            }
        }
    }
#undef PT_LOAD
#undef PT_COMPUTE
    f32x4 xr[4]; float ss = 0.f;
    float* xq4 = xres + tok * 1024 + lane * 16;
#pragma unroll
    for (int j = 0; j < 4; ++j) { xr[j] = *(const f32x4*)(xq4 + 4 * j);
        xr[j][0] += out2[2 * j].x; xr[j][1] += out2[2 * j].y; xr[j][2] += out2[2 * j + 1].x; xr[j][3] += out2[2 * j + 1].y;
#pragma unroll
        for (int e = 0; e < 4; ++e) ss += xr[j][e] * xr[j][e]; }
    const float rstd = 1.0f / sqrtf(wave_sum(ss) * (1.f / 1024.f) + EPS);
    if (LAST) {
#pragma unroll
        for (int j = 0; j < 4; ++j) { const f32x4 gg = *(const f32x4*)(gnext + lane * 16 + 4 * j); *(f32x4*)(xq4 + 4 * j) = xr[j] * rstd * gg; }
    } else {
        u32x4 o0, o1;
#pragma unroll
        for (int j = 0; j < 4; ++j) { *(f32x4*)(xq4 + 4 * j) = xr[j]; const f32x4 gg = *(const f32x4*)(gnext + lane * 16 + 4 * j);
            const unsigned lo = cvt_pk_bf16(xr[j][0] * rstd * gg[0], xr[j][1] * rstd * gg[1]), hi = cvt_pk_bf16(xr[j][2] * rstd * gg[2], xr[j][3] * rstd * gg[3]);
            if (j < 2) { o0[2 * j] = lo; o0[2 * j + 1] = hi; } else { o1[2 * (j - 2)] = lo; o1[2 * (j - 2) + 1] = hi; } }
        u32x4* hq = (u32x4*)(HB + tok * 1024 + lane * 16); hq[0] = o0; hq[1] = o1;
    }
}

template <int R> __device__ __forceinline__ void rank_step(unsigned long long key, unsigned& rank) {
    const unsigned lo = (unsigned)__builtin_amdgcn_update_dpp(0, (int)(unsigned)key, 0x120 + R, 0xf, 0xf, false);
    const unsigned hi = (unsigned)__builtin_amdgcn_update_dpp(0, (int)(unsigned)(key >> 32), 0x120 + R, 0xf, 0xf, false);
    rank += ((((unsigned long long)hi << 32) | lo) > key) ? 1u : 0u;
    if constexpr (R < 15) rank_step<R + 1>(key, rank);
}
__device__ __forceinline__ void xcc_sync(unsigned* ctr, unsigned nloc, unsigned target);
constexpr int PW_SET = 6144, PW_HIST = 2 * PW_SET, PW_SL = PW_HIST + 1024, PW_BYTES = PW_SL + 512;
template <bool LAST>
__device__ __forceinline__ void peer_wave(LAS unsigned char* lds_w, int m0, int mstep, int mcount, const u32x2* TOPK, const unsigned char* TABU, const unsigned char* TABV, const float* TSU, const float* TSV,
                                          bf16* HB, const float* SS, const float* gffn, float* xres, const float* gnext, int lane_in, unsigned* xctr, unsigned nloc, unsigned xbase) {
    int lane = lane_in; asm volatile("" : "+v"(lane));
    LAS unsigned* HIST = (LAS unsigned*)(lds_w + PW_HIST);
    LAS u32x2* SLs = (LAS u32x2*)(lds_w + PW_SL);
    int ri, rj;
    { const int L = lane;
      if (L < 16) { ri = 0; rj = L; } else if (L < 24) { ri = 1; rj = L - 16; } else if (L < 29) { ri = 2; rj = L - 24; } else if (L < 33) { ri = 3; rj = L - 29; }
      else if (L < 36) { ri = 4; rj = L - 33; } else if (L < 38) { ri = 5; rj = L - 36; } else if (L < 40) { ri = 6; rj = L - 38; } else if (L < 42) { ri = 7; rj = L - 40; }
      else if (L < 50) { ri = L - 34; rj = 0; } else { ri = 0; rj = 0; } }
#define PW_CAND(tokC, head, ELc) do { \
        const u32x2 ent = TOPK[((tokC + (lane >> 5)) * 16 + head * 2) * 16 + (lane & 31)]; \
        const unsigned long long key = ((unsigned long long)sortable_u32(__uint_as_float(ent.x)) << 32) | (unsigned)(15 - (lane & 15)); \
        unsigned rank = 0u; rank_step<1>(key, rank); \
        SLs[(lane >> 4) * 16 + rank] = ent; \
_Pragma("unroll 1") \
        for (int tk = 0; tk < 2; ++tk) { \
            const u32x2 ea = SLs[(tk * 2) * 16 + ri], eb = SLs[(tk * 2 + 1) * 16 + rj]; \
            const float cs = __uint_as_float(ea.x) + __uint_as_float(eb.x); const unsigned ck = ea.y * 128u + eb.y; \
            const bool vld = lane < 50; \
              \
            float lo = wave_min_f32(vld ? cs : 3.0e38f), hi = wave_max_f32(vld ? cs : -3.0e38f); bool sl = false; bool conv = false; \
            _Pragma("unroll 1") for (int it = 0; it < 24; ++it) { \
                const float mid = 0.5f * lo + 0.5f * hi; const bool ge = vld && (cs >= mid); const unsigned cnt = (unsigned)__popcll(__ballot(ge)); \
                if (cnt == 16u) { sl = ge; conv = true; break; } \
                if (cnt > 16u) lo = mid; else hi = mid; } \
            if (!conv) {                                                                \
                const unsigned u = vld ? sortable_u32(cs) : 0u; \
                unsigned T = 0u; \
                _Pragma("unroll 1") for (int bit = 31; bit >= 0; --bit) { \
                    const unsigned cand = T | (1u << bit); const unsigned cnt = (unsigned)__popcll(__ballot(u >= cand)); \
                    if (cnt >= 16u) T = cand; \
                    if (cnt == 16u) break; \
                } \
                const unsigned G = (unsigned)__popcll(__ballot(u > T)); const unsigned need_eq = 16u - G; \
                const bool gt = u > T, eq = u == T; \
                const unsigned long long meq = __ballot(eq); \
                sl = gt || (eq && (mbcnt64(meq) < need_eq)); } \
            const unsigned long long msl = __ballot(sl); \
            if (sl) { u32x2 e; e.x = ck; e.y = __float_as_uint(cs); ELc[(tk * 8 + head) * 16 + mbcnt64(msl)] = e; } \
        } \
        } while (0)
    if (m0 >= mcount) return;
    {
        LAS u32x2* ELc = (LAS u32x2*)lds_w; LAS u32x4* EGc = (LAS u32x4*)(lds_w + 2048); const size_t tokC = (size_t)m0 * 2;
        HIST[lane] = 0u; HIST[64 + lane] = 0u;
        for (int _rp = 0; _rp <= (PEER_PROBE & 1); ++_rp)
#pragma unroll 1
        for (int head = 0; head < 8; ++head) PW_CAND(tokC, head, ELc);
    u32x4 ent4[4]; unsigned rk[4];
#pragma unroll
    for (int rep = 0; rep < 4; ++rep) { const int e = lane + 64 * rep; const u32x2 ent = ELc[e]; const float sc = __uint_as_float(ent.y);
        const float su = TSU[ent.x], sv = TSV[ent.x];
        float mx = sc;
#pragma unroll
        for (int o = 1; o < 16; o <<= 1) mx = fmaxf(mx, __shfl_xor(mx, o));
        const float p = __expf(sc - mx); float sm = p;
#pragma unroll
        for (int o = 1; o < 16; o <<= 1) sm += __shfl_xor(sm, o);
        ent4[rep].x = ent.x; ent4[rep].y = __float_as_uint(su); ent4[rep].z = __float_as_uint(p / sm * sv); ent4[rep].w = (unsigned)(rep >> 1);
        rk[rep] = atomicAdd((unsigned*)&HIST[ent.x >> 7], 1u); }
    { const unsigned c0 = HIST[2 * lane], c1 = HIST[2 * lane + 1]; unsigned inc = c0 + c1;
_Pragma("unroll")
      for (int o = 1; o < 64; o <<= 1) { const unsigned t = (unsigned)__shfl_up((int)inc, o); if (lane >= o) inc += t; }
      HIST[128 + 2 * lane] = inc - c0 - c1; HIST[128 + 2 * lane + 1] = inc - c1; }
#pragma unroll
    for (int rep = 0; rep < 4; ++rep) EGc[HIST[128 + (ent4[rep].x >> 7)] + rk[rep]] = ent4[rep];
    }
    int par = 0;
#pragma unroll 1
    for (int m = m0; m < mcount; m += mstep, par ^= 1) {
        const size_t tok0 = (size_t)m * 2; const bool has_next = (m + mstep) < mcount; const size_t tokC = (size_t)(m + mstep) * 2;
        if (PEER_WGSYNC == 1 || PEER_WGSYNC == 3) __syncthreads();
        if (PEER_WGSYNC == 2) xcc_sync(xctr, nloc, xbase + (unsigned)((m - m0) / mstep) + 1u);
        LAS u32x4* EGg = (LAS u32x4*)(lds_w + par * PW_SET + 2048);
        LAS u32x2* ELc = (LAS u32x2*)(lds_w + (par ^ 1) * PW_SET); LAS u32x4* EGc = (LAS u32x4*)(lds_w + (par ^ 1) * PW_SET + 2048);
        int x0q[4], x1q[4]; float sx0, sx1;
        {
    float gf[16];
#pragma unroll
    for (int j = 0; j < 4; ++j) { const f32x4 gg = *(const f32x4*)(gffn + lane * 16 + 4 * j); gf[4 * j] = gg[0]; gf[4 * j + 1] = gg[1]; gf[4 * j + 2] = gg[2]; gf[4 * j + 3] = gg[3]; }

#define PP_QUANT(xq, sx, tk) do { const u32x4* hp = (const u32x4*)(HB + (tok0 + (tk)) * 1024 + lane * 16); const u32x4 qa = hp[0], qb = hp[1]; float f[16]; float am = 0.f; \
        const float rs_ = 1.0f / sqrtf(SS[tok0 + (tk)] * (1.f / 1024.f) + EPS); \
        _Pragma("unroll") for (int e = 0; e < 4; ++e) { f[2 * e] = __uint_as_float(qa[e] << 16); f[2 * e + 1] = __uint_as_float(qa[e] & 0xffff0000u); f[8 + 2 * e] = __uint_as_float(qb[e] << 16); f[8 + 2 * e + 1] = __uint_as_float(qb[e] & 0xffff0000u); } \
        _Pragma("unroll") for (int c = 0; c < 16; ++c) f[c] *= rs_ * gf[c]; \
        _Pragma("unroll") for (int c = 0; c < 16; ++c) am = fmaxf(am, fabsf(f[c])); \
        am = wave_max(am); sx = am > 0.f ? am * (1.0f / 127.0f) : 1.0f; const float inv = 1.0f / sx; \
        _Pragma("unroll") for (int e = 0; e < 4; ++e) { const int q0 = (int)rintf(f[4 * e] * inv), q1 = (int)rintf(f[4 * e + 1] * inv), q2 = (int)rintf(f[4 * e + 2] * inv), q3 = (int)rintf(f[4 * e + 3] * inv); \
            xq[e] = (q0 & 0xff) | ((q1 & 0xff) << 8) | ((q2 & 0xff) << 16) | ((q3 & 0xff) << 24); } } while (0)
        PP_QUANT(x0q, sx0, 0); PP_QUANT(x1q, sx1, 1);
#undef PP_QUANT
        }
        f32x2 out0[8], out1[8];
#pragma unroll
        for (int c = 0; c < 8; ++c) { out0[c] = (f32x2){0.f, 0.f}; out1[c] = (f32x2){0.f, 0.f}; }
#define PP_LOAD(UB, VB, BT) do { _Pragma("unroll") for (int k = 0; k < 8; ++k) { const unsigned id = EGg[(BT) * 8 + k].x; UB[k] = *(const u32x4*)(TABU + (size_t)id * 2048 + lane * 16); VB[k] = *(const u32x4*)(TABV + (size_t)id * 2048 + lane * 16); } } while (0)
#define PP_COMPUTE(UB, VB, BT) do { int di[8]; \
        _Pragma("unroll") for (int k = 0; k < 8; ++k) { int a0 = 0; \
            const unsigned tkk = (unsigned)__builtin_amdgcn_readfirstlane((int)EGg[(BT) * 8 + k].w); \
            if (tkk) { _Pragma("unroll") for (int e = 0; e < 4; ++e) a0 = __builtin_amdgcn_sdot4((int)UB[k][e], x1q[e], a0, false); } \
            else     { _Pragma("unroll") for (int e = 0; e < 4; ++e) a0 = __builtin_amdgcn_sdot4((int)UB[k][e], x0q[e], a0, false); } \
            di[k] = a0; } \
        int r4[4], r2[2], v1; \
        { const bool h32 = (lane & 32) != 0; \
          _Pragma("unroll") for (int j = 0; j < 4; ++j) { const int send = h32 ? di[j] : di[j + 4], keep = h32 ? di[j + 4] : di[j]; r4[j] = keep + __shfl_xor(send, 32); } \
          const bool h16 = (lane & 16) != 0; \
          _Pragma("unroll") for (int j = 0; j < 2; ++j) { const int send = h16 ? r4[j] : r4[j + 2], keep = h16 ? r4[j + 2] : r4[j]; r2[j] = keep + __shfl_xor(send, 16); } \
          const bool h8 = (lane & 8) != 0; \
          { const int send = h8 ? r2[0] : r2[1], keep = h8 ? r2[1] : r2[0]; v1 = keep + __shfl_xor(send, 8); } \
          v1 += __shfl_xor(v1, 4); v1 += __shfl_xor(v1, 2); v1 += __shfl_xor(v1, 1); } \
        float act; { const u32x4 eg = EGg[(BT) * 8 + (lane >> 3)]; const float v = (float)v1 * __uint_as_float(eg.y) * (eg.w ? sx1 : sx0); \
          const float t = __builtin_amdgcn_rcpf(fabsf(v) * 0.2316418882f + 1.0f); \
          float q = t * 0.5307027145f + (-0.7265760135f); q = q * t + 0.7107068705f; q = q * t + (-0.142248368f); q = q * t + 0.127414796f; q = q * t; \
          const float m = v * (q * __builtin_amdgcn_exp2f(v * v * (-0.72134752044f))); \
          act = (v < 0.f ? m : v - m) * __uint_as_float(eg.z); } \
        _Pragma("unroll") for (int k = 0; k < 8; ++k) { const float a = __uint_as_float(__builtin_amdgcn_readlane((int)__float_as_uint(act), 8 * k)); \
            const unsigned tkk = (unsigned)__builtin_amdgcn_readfirstlane((int)EGg[(BT) * 8 + k].w); \
            if (tkk) { _Pragma("unroll") for (int e = 0; e < 4; ++e) { out1[2 * e] += __builtin_amdgcn_cvt_pk_f32_fp8((int)VB[k][e], false) * a; out1[2 * e + 1] += __builtin_amdgcn_cvt_pk_f32_fp8((int)VB[k][e], true) * a; } } \
            else     { _Pragma("unroll") for (int e = 0; e < 4; ++e) { out0[2 * e] += __builtin_amdgcn_cvt_pk_f32_fp8((int)VB[k][e], false) * a; out0[2 * e + 1] += __builtin_amdgcn_cvt_pk_f32_fp8((int)VB[k][e], true) * a; } } } } while (0)
        {
            u32x4 ubA[8], vbA[8], ubB[8], vbB[8];
            PP_LOAD(ubA, vbA, 0);
#pragma unroll 1
            for (int bt = 0; bt < 32; bt += 2) {
                if (PEER_WGSYNC == 3 && (bt & 7) == 0) __syncthreads();
                PP_LOAD(ubB, vbB, bt + 1);
                PP_COMPUTE(ubA, vbA, bt);
                const int nb = (bt + 2 < 32) ? bt + 2 : 31;
                if (has_next && (bt & 3) == 0) { const int head = bt >> 2; PW_CAND(tokC, head, ELc); }
                PP_LOAD(ubA, vbA, nb);
                PP_COMPUTE(ubB, vbB, bt + 1);
            }
        }
#undef PP_LOAD
#undef PP_COMPUTE
        if (has_next) {
            HIST[lane] = 0u; HIST[64 + lane] = 0u;
        u32x4 ent4[4]; unsigned rk[4];
#pragma unroll
        for (int rep = 0; rep < 4; ++rep) { const int e = lane + 64 * rep; const u32x2 ent = ELc[e]; const float sc = __uint_as_float(ent.y);
            const float su = TSU[ent.x], sv = TSV[ent.x];
            float mx = sc;
#pragma unroll
            for (int o = 1; o < 16; o <<= 1) mx = fmaxf(mx, __shfl_xor(mx, o));
            const float p = __expf(sc - mx); float sm = p;
#pragma unroll
            for (int o = 1; o < 16; o <<= 1) sm += __shfl_xor(sm, o);
            ent4[rep].x = ent.x; ent4[rep].y = __float_as_uint(su); ent4[rep].z = __float_as_uint(p / sm * sv); ent4[rep].w = (unsigned)(rep >> 1);
            rk[rep] = atomicAdd((unsigned*)&HIST[ent.x >> 7], 1u); }
        { const unsigned c0 = HIST[2 * lane], c1 = HIST[2 * lane + 1]; unsigned inc = c0 + c1;
_Pragma("unroll")
      for (int o = 1; o < 64; o <<= 1) { const unsigned t = (unsigned)__shfl_up((int)inc, o); if (lane >= o) inc += t; }
      HIST[128 + 2 * lane] = inc - c0 - c1; HIST[128 + 2 * lane + 1] = inc - c1; }
#pragma unroll
        for (int rep = 0; rep < 4; ++rep) EGc[HIST[128 + (ent4[rep].x >> 7)] + rk[rep]] = ent4[rep];
        }
#pragma unroll
        for (int tk = 0; tk < 2; ++tk) {
            float xr[16]; float ss = 0.f;
            { const u32x4* hp = (const u32x4*)(HB + (tok0 + tk) * 1024 + lane * 16); const u32x4 qa = hp[0], qb = hp[1];
#pragma unroll
              for (int e = 0; e < 4; ++e) { xr[2 * e] = __uint_as_float(qa[e] << 16); xr[2 * e + 1] = __uint_as_float(qa[e] & 0xffff0000u); xr[8 + 2 * e] = __uint_as_float(qb[e] << 16); xr[8 + 2 * e + 1] = __uint_as_float(qb[e] & 0xffff0000u); } }
#pragma unroll
            for (int c = 0; c < 16; ++c) { const f32x2 o2 = tk ? out1[c >> 1] : out0[c >> 1]; xr[c] += (c & 1) ? o2.y : o2.x; ss += xr[c] * xr[c]; }
            const float rstd = 1.0f / sqrtf(wave_sum(ss) * (1.f / 1024.f) + EPS);
            if (LAST) {
                float* xq = xres + (tok0 + tk) * 1024 + lane * 16;
#pragma unroll
                for (int j = 0; j < 4; ++j) { const f32x4 gg = *(const f32x4*)(gnext + lane * 16 + 4 * j); *(f32x4*)(xq + 4 * j) = (f32x4){xr[4 * j] * rstd * gg[0], xr[4 * j + 1] * rstd * gg[1], xr[4 * j + 2] * rstd * gg[2], xr[4 * j + 3] * rstd * gg[3]}; }
            } else {
                u32x4 o0, o1, r0, r1;
#pragma unroll
                for (int j = 0; j < 4; ++j) { const f32x4 gg = *(const f32x4*)(gnext + lane * 16 + 4 * j);
                    const unsigned lo = cvt_pk_bf16(xr[4 * j] * rstd * gg[0], xr[4 * j + 1] * rstd * gg[1]), hi = cvt_pk_bf16(xr[4 * j + 2] * rstd * gg[2], xr[4 * j + 3] * rstd * gg[3]);
                    const unsigned rl = cvt_pk_bf16(xr[4 * j], xr[4 * j + 1]), rh = cvt_pk_bf16(xr[4 * j + 2], xr[4 * j + 3]);
                    if (j < 2) { o0[2 * j] = lo; o0[2 * j + 1] = hi; r0[2 * j] = rl; r0[2 * j + 1] = rh; } else { o1[2 * (j - 2)] = lo; o1[2 * (j - 2) + 1] = hi; r1[2 * (j - 2)] = rl; r1[2 * (j - 2) + 1] = rh; } }
                u32x4* hq = (u32x4*)(HB + (tok0 + tk) * 1024 + lane * 16); hq[0] = o0; hq[1] = o1;
                u32x4* xq2 = (u32x4*)((bf16*)xres + (tok0 + tk) * 1024 + lane * 16); xq2[0] = r0; xq2[1] = r1;
            }
        }
    }
#undef PW_CAND
}

template <bool LAST>
__device__ __forceinline__ void peer_pair(LAS unsigned char* lds_w, size_t tok0, const u32x2* TOPK, const unsigned char* TABU, const unsigned char* TABV, const float* TSU, const float* TSV, bf16* HB, const float* SS, const float* gffn, float* xres, const float* gnext, int lane_in) {
    int lane = lane_in; asm volatile("" : "+v"(lane));
    LAS u32x2* EL = (LAS u32x2*)lds_w;
    LAS u32x4* EG = (LAS u32x4*)(lds_w + 2048);
    LAS unsigned* HIST = (LAS unsigned*)(lds_w + 2048 + 4096);
    if (lane < 32) HIST[lane] = 0u;
    int ri, rj;
    { const int L = lane;
      if (L < 16) { ri = 0; rj = L; } else if (L < 24) { ri = 1; rj = L - 16; } else if (L < 29) { ri = 2; rj = L - 24; } else if (L < 33) { ri = 3; rj = L - 29; }
      else if (L < 36) { ri = 4; rj = L - 33; } else if (L < 38) { ri = 5; rj = L - 36; } else if (L < 40) { ri = 6; rj = L - 38; } else if (L < 42) { ri = 7; rj = L - 40; }
      else if (L < 50) { ri = L - 34; rj = 0; } else { ri = 0; rj = 0; } }
    LAS u32x2* SLs = (LAS u32x2*)(lds_w + 6400);
    for (int _rp = 0; _rp <= (PEER_PROBE & 1); ++_rp)
#pragma unroll 1
    for (int head = 0; head < 8; ++head) {
        const u32x2 ent = TOPK[((tok0 + (lane >> 5)) * 16 + head * 2) * 16 + (lane & 31)];
        const unsigned long long key = ((unsigned long long)sortable_u32(__uint_as_float(ent.x)) << 32) | (unsigned)(15 - (lane & 15));
        unsigned rank = 0u; rank_step<1>(key, rank);
        SLs[(lane >> 4) * 16 + rank] = ent;
#pragma unroll 1
        for (int tk = 0; tk < 2; ++tk) {
            const u32x2 ea = SLs[(tk * 2) * 16 + ri], eb = SLs[(tk * 2 + 1) * 16 + rj];
            const float cs = __uint_as_float(ea.x) + __uint_as_float(eb.x); const unsigned ck = ea.y * 128u + eb.y;
            const unsigned u = (lane < 50) ? sortable_u32(cs) : 0u;
            unsigned T = 0u;
#pragma unroll 1
            for (int bit = 31; bit >= 0; --bit) {
                const unsigned cand = T | (1u << bit); const unsigned cnt = (unsigned)__popcll(__ballot(u >= cand));
                if (cnt >= 16u) T = cand;
                if (cnt == 16u) break;
            }
            const unsigned G = (unsigned)__popcll(__ballot(u > T)); const unsigned need_eq = 16u - G;
            const bool gt = u > T, eq = u == T;
            const unsigned long long meq = __ballot(eq);
            const bool sl = gt || (eq && (mbcnt64(meq) < need_eq));
            const unsigned long long msl = __ballot(sl);
            if (sl) { u32x2 e; e.x = ck; e.y = __float_as_uint(cs); EL[(tk * 8 + head) * 16 + mbcnt64(msl)] = e; }
        }
    }
    u32x4 ent4[4]; unsigned rk[4];
#pragma unroll
    for (int rep = 0; rep < 4; ++rep) { const int e = lane + 64 * rep; const u32x2 ent = EL[e]; const float sc = __uint_as_float(ent.y);
        const float su = TSU[ent.x], sv = TSV[ent.x];
        float mx = sc;
#pragma unroll
        for (int o = 1; o < 16; o <<= 1) mx = fmaxf(mx, __shfl_xor(mx, o));
        const float p = __expf(sc - mx); float sm = p;
#pragma unroll
        for (int o = 1; o < 16; o <<= 1) sm += __shfl_xor(sm, o);
        ent4[rep].x = ent.x; ent4[rep].y = __float_as_uint(su); ent4[rep].z = __float_as_uint(p / sm * sv); ent4[rep].w = (unsigned)(rep >> 1);
        rk[rep] = atomicAdd((unsigned*)&HIST[ent.x >> 9], 1u); }
    { unsigned c = (lane < 32) ? HIST[lane] : 0u, inc = c;
#pragma unroll
      for (int o = 1; o < 32; o <<= 1) { const unsigned t = (unsigned)__shfl_up((int)inc, o); if ((lane & 31) >= o) inc += t; }
      if (lane < 32) HIST[32 + lane] = inc - c; }
#pragma unroll
    for (int rep = 0; rep < 4; ++rep) EG[HIST[32 + (ent4[rep].x >> 9)] + rk[rep]] = ent4[rep];
    int x0q[4], x1q[4]; float sx0, sx1;
    float gf[16];
#pragma unroll
    for (int j = 0; j < 4; ++j) { const f32x4 gg = *(const f32x4*)(gffn + lane * 16 + 4 * j); gf[4 * j] = gg[0]; gf[4 * j + 1] = gg[1]; gf[4 * j + 2] = gg[2]; gf[4 * j + 3] = gg[3]; }
#define PP_QUANT(xq, sx, tk) do { const u32x4* hp = (const u32x4*)(HB + (tok0 + (tk)) * 1024 + lane * 16); const u32x4 qa = hp[0], qb = hp[1]; float f[16]; float am = 0.f; \
        const float rs_ = 1.0f / sqrtf(SS[tok0 + (tk)] * (1.f / 1024.f) + EPS); \
        _Pragma("unroll") for (int e = 0; e < 4; ++e) { f[2 * e] = __uint_as_float(qa[e] << 16); f[2 * e + 1] = __uint_as_float(qa[e] & 0xffff0000u); f[8 + 2 * e] = __uint_as_float(qb[e] << 16); f[8 + 2 * e + 1] = __uint_as_float(qb[e] & 0xffff0000u); } \
        _Pragma("unroll") for (int c = 0; c < 16; ++c) f[c] *= rs_ * gf[c]; \
        _Pragma("unroll") for (int c = 0; c < 16; ++c) am = fmaxf(am, fabsf(f[c])); \
        am = wave_max(am); sx = am > 0.f ? am * (1.0f / 127.0f) : 1.0f; const float inv = 1.0f / sx; \
        _Pragma("unroll") for (int e = 0; e < 4; ++e) { const int q0 = (int)rintf(f[4 * e] * inv), q1 = (int)rintf(f[4 * e + 1] * inv), q2 = (int)rintf(f[4 * e + 2] * inv), q3 = (int)rintf(f[4 * e + 3] * inv); \
            xq[e] = (q0 & 0xff) | ((q1 & 0xff) << 8) | ((q2 & 0xff) << 16) | ((q3 & 0xff) << 24); } } while (0)
    PP_QUANT(x0q, sx0, 0); PP_QUANT(x1q, sx1, 1);
#undef PP_QUANT
    f32x2 outp[16];
#pragma unroll
    for (int c = 0; c < 16; ++c) outp[c] = (f32x2){0.f, 0.f};
#define PP_LOAD(UB, VB, BT) do { _Pragma("unroll") for (int k = 0; k < 8; ++k) { const unsigned id = EG[(BT) * 8 + k].x; UB[k] = *(const u32x4*)(TABU + (size_t)id * 1024 + lane * 16); VB[k] = *(const u32x4*)(TABV + (size_t)id * 1024 + lane * 16); } } while (0)
#define PP_COMPUTE(UB, VB, BT) do { int di[8]; \
        _Pragma("unroll") for (int k = 0; k < 8; ++k) { int a0 = 0, a1 = 0; \
            _Pragma("unroll") for (int e = 0; e < 4; ++e) { a0 = __builtin_amdgcn_sdot4((int)UB[k][e], x0q[e], a0, false); a1 = __builtin_amdgcn_sdot4((int)UB[k][e], x1q[e], a1, false); } \
            const unsigned tkk = (unsigned)__builtin_amdgcn_readfirstlane((int)EG[(BT) * 8 + k].w); di[k] = tkk ? a1 : a0; } \
        int r4[4], r2[2], v1; \
        { const bool h32 = (lane & 32) != 0; \
          _Pragma("unroll") for (int j = 0; j < 4; ++j) { const int send = h32 ? di[j] : di[j + 4], keep = h32 ? di[j + 4] : di[j]; r4[j] = keep + __shfl_xor(send, 32); } \
          const bool h16 = (lane & 16) != 0; \
          _Pragma("unroll") for (int j = 0; j < 2; ++j) { const int send = h16 ? r4[j] : r4[j + 2], keep = h16 ? r4[j + 2] : r4[j]; r2[j] = keep + __shfl_xor(send, 16); } \
          const bool h8 = (lane & 8) != 0; \
          { const int send = h8 ? r2[0] : r2[1], keep = h8 ? r2[1] : r2[0]; v1 = keep + __shfl_xor(send, 8); } \
          v1 += __shfl_xor(v1, 4); v1 += __shfl_xor(v1, 2); v1 += __shfl_xor(v1, 1); } \
        float act; { const u32x4 eg = EG[(BT) * 8 + (lane >> 3)]; const float v = (float)v1 * __uint_as_float(eg.y) * (eg.w ? sx1 : sx0); \
          const float t = __builtin_amdgcn_rcpf(fabsf(v) * 0.2316418882f + 1.0f); \
          float q = t * 0.5307027145f + (-0.7265760135f); q = q * t + 0.7107068705f; q = q * t + (-0.142248368f); q = q * t + 0.127414796f; q = q * t; \
          const float m = v * (q * __builtin_amdgcn_exp2f(v * v * (-0.72134752044f))); \
          act = (v < 0.f ? m : v - m) * __uint_as_float(eg.z); }                        \
        _Pragma("unroll") for (int k = 0; k < 8; ++k) { const float a = __uint_as_float(__builtin_amdgcn_readlane((int)__float_as_uint(act), 8 * k)); \
            const unsigned tkk = (unsigned)__builtin_amdgcn_readfirstlane((int)EG[(BT) * 8 + k].w); \
            const f32x2 a2 = tkk ? (f32x2){0.f, a} : (f32x2){a, 0.f}; \
            _Pragma("unroll") for (int e = 0; e < 4; ++e) { const f32x2 lo = __builtin_amdgcn_cvt_pk_f32_fp8((int)VB[k][e], false), hi = __builtin_amdgcn_cvt_pk_f32_fp8((int)VB[k][e], true); \
                outp[4 * e] += a2 * lo.x; outp[4 * e + 1] += a2 * lo.y; outp[4 * e + 2] += a2 * hi.x; outp[4 * e + 3] += a2 * hi.y; } } } while (0)
    for (int _rg = ((PEER_PROBE & 6) ? 0 : 1); _rg < 2; ++_rg) {
        const bool noload = (PEER_PROBE & 4) && _rg == 0;
#pragma unroll
        for (int c = 0; c < 16; ++c) outp[c] = (f32x2){0.f, 0.f};
        u32x4 ubA[8], vbA[8], ubB[8], vbB[8];
#pragma unroll
        for (int k = 0; k < 8; ++k) { ubA[k] = (u32x4){0u, 0u, 0u, 0u}; vbA[k] = ubA[k]; ubB[k] = ubA[k]; vbB[k] = ubA[k]; }
        if (!noload) PP_LOAD(ubA, vbA, 0);
#pragma unroll 1
        for (int bt = 0; bt < 32; bt += 2) {
            if (!noload) PP_LOAD(ubB, vbB, bt + 1);
            PP_COMPUTE(ubA, vbA, bt);
            const int nb = (bt + 2 < 32) ? bt + 2 : 31;
            if (!noload) PP_LOAD(ubA, vbA, nb);
            PP_COMPUTE(ubB, vbB, bt + 1);
        }
    }
#undef PP_LOAD
#undef PP_COMPUTE
#pragma unroll
    for (int tk = 0; tk < 2; ++tk) {
        f32x4 xr[4]; float ss = 0.f;
        float* xq = xres + (tok0 + tk) * 1024 + lane * 16;
#pragma unroll
        for (int j = 0; j < 4; ++j) { xr[j] = *(const f32x4*)(xq + 4 * j);
#pragma unroll
            for (int e = 0; e < 4; ++e) { xr[j][e] += tk ? outp[4 * j + e].y : outp[4 * j + e].x; ss += xr[j][e] * xr[j][e]; } }
        const float rstd = 1.0f / sqrtf(wave_sum(ss) * (1.f / 1024.f) + EPS);
        if (LAST) {
#pragma unroll
            for (int j = 0; j < 4; ++j) { const f32x4 gg = *(const f32x4*)(gnext + lane * 16 + 4 * j); *(f32x4*)(xq + 4 * j) = xr[j] * rstd * gg; }
        } else {
            u32x4 o0, o1;
#pragma unroll
            for (int j = 0; j < 4; ++j) { *(f32x4*)(xq + 4 * j) = xr[j]; const f32x4 gg = *(const f32x4*)(gnext + lane * 16 + 4 * j);
                const unsigned lo = cvt_pk_bf16(xr[j][0] * rstd * gg[0], xr[j][1] * rstd * gg[1]), hi = cvt_pk_bf16(xr[j][2] * rstd * gg[2], xr[j][3] * rstd * gg[3]);
                if (j < 2) { o0[2 * j] = lo; o0[2 * j + 1] = hi; } else { o1[2 * (j - 2)] = lo; o1[2 * (j - 2) + 1] = hi; } }
            u32x4* hq = (u32x4*)(HB + (tok0 + tk) * 1024 + lane * 16); hq[0] = o0; hq[1] = o1;
        }
    }
}

__device__ __forceinline__ void pair_prepare(LAS unsigned char* lds_w, size_t tok0, const u32x2* TOPK, const float* TSU, const float* TSV, int lane_in) {
    int lane = lane_in; asm volatile("" : "+v"(lane));
    LAS u32x2* EL = (LAS u32x2*)lds_w;
    LAS u32x4* EG = (LAS u32x4*)(lds_w + 2048);
    LAS unsigned* HIST = (LAS unsigned*)(lds_w + 2048 + 4096);
    if (lane < 32) HIST[lane] = 0u;
    for (int _rp = 0; _rp <= (PEER_PROBE & 1); ++_rp)
#pragma unroll 1
    for (int th = 0; th < 16; ++th) { const int tk = th >> 3, head = th & 7;
        const u32x2* base = TOPK + ((tok0 + tk) * 16 + head * 2) * 16;
        const u32x2 e0 = base[lane >> 2];
        const u32x4 e1a = *(const u32x4*)(base + 16 + 4 * (lane & 3)), e1b = *(const u32x4*)(base + 16 + 4 * (lane & 3) + 2);
        const float s0 = __uint_as_float(e0.x);
        float cs[4]; unsigned ck[4], u[4];
        cs[0] = s0 + __uint_as_float(e1a.x); ck[0] = e0.y * 128u + e1a.y; cs[1] = s0 + __uint_as_float(e1a.z); ck[1] = e0.y * 128u + e1a.w;
        cs[2] = s0 + __uint_as_float(e1b.x); ck[2] = e0.y * 128u + e1b.y; cs[3] = s0 + __uint_as_float(e1b.z); ck[3] = e0.y * 128u + e1b.w;
#pragma unroll
        for (int m = 0; m < 4; ++m) u[m] = sortable_u32(cs[m]);
        unsigned T = 0u;
#pragma unroll 1
        for (int bit = 31; bit >= 0; --bit) {
            const unsigned cand = T | (1u << bit); unsigned cnt = 0u;
#pragma unroll
            for (int m = 0; m < 4; ++m) cnt += (unsigned)__popcll(__ballot(u[m] >= cand));
            if (cnt >= 16u) T = cand;
            if (cnt == 16u) break;
        }
        unsigned G = 0u;
#pragma unroll
        for (int m = 0; m < 4; ++m) G += (unsigned)__popcll(__ballot(u[m] > T));
        const unsigned need_eq = 16u - G; unsigned pos = 0u, eq_used = 0u;
#pragma unroll
        for (int m = 0; m < 4; ++m) {
            const bool gt = u[m] > T, eq = u[m] == T;
            const unsigned long long meq = __ballot(eq);
            const bool sl = gt || (eq && (eq_used + mbcnt64(meq) < need_eq));
            const unsigned long long msl = __ballot(sl);
            if (sl) { u32x2 e; e.x = ck[m]; e.y = __float_as_uint(cs[m]); EL[th * 16 + pos + mbcnt64(msl)] = e; }
            pos += (unsigned)__popcll(msl); eq_used += (unsigned)__popcll(meq); }
    }
    u32x4 ent4[4]; unsigned rk[4];
#pragma unroll
    for (int rep = 0; rep < 4; ++rep) { const int e = lane + 64 * rep; const u32x2 ent = EL[e]; const float sc = __uint_as_float(ent.y);
        const float su = TSU[ent.x], sv = TSV[ent.x];
        float mx = sc;
#pragma unroll
        for (int o = 1; o < 16; o <<= 1) mx = fmaxf(mx, __shfl_xor(mx, o));
        const float p = __expf(sc - mx); float sm = p;
#pragma unroll
        for (int o = 1; o < 16; o <<= 1) sm += __shfl_xor(sm, o);
        ent4[rep].x = ent.x; ent4[rep].y = __float_as_uint(su); ent4[rep].z = __float_as_uint(p / sm * sv); ent4[rep].w = (unsigned)(rep >> 1);
        rk[rep] = atomicAdd((unsigned*)&HIST[ent.x >> 9], 1u); }
    { unsigned c = (lane < 32) ? HIST[lane] : 0u, inc = c;
#pragma unroll
      for (int o = 1; o < 32; o <<= 1) { const unsigned t = (unsigned)__shfl_up((int)inc, o); if ((lane & 31) >= o) inc += t; }
      if (lane < 32) HIST[32 + lane] = inc - c; }
#pragma unroll
    for (int rep = 0; rep < 4; ++rep) EG[HIST[32 + (ent4[rep].x >> 9)] + rk[rep]] = ent4[rep];
}
__device__ __forceinline__ void pair_pass1(LAS unsigned char* lds_w, size_t tok0, const unsigned char* TABU, const bf16* HB, int lane_in) {
    int lane = lane_in; asm volatile("" : "+v"(lane));
    LAS u32x4* EG = (LAS u32x4*)(lds_w + 2048);
    f32x2 xp[16];
    { const u32x4* h0 = (const u32x4*)(HB + tok0 * 1024 + lane * 16); const u32x4* h1 = (const u32x4*)(HB + (tok0 + 1) * 1024 + lane * 16);
      const u32x4 a0 = h0[0], b0 = h0[1], a1 = h1[0], b1 = h1[1];
#pragma unroll
      for (int e = 0; e < 4; ++e) { xp[2 * e] = (f32x2){__uint_as_float(a0[e] << 16), __uint_as_float(a1[e] << 16)}; xp[2 * e + 1] = (f32x2){__uint_as_float(a0[e] & 0xffff0000u), __uint_as_float(a1[e] & 0xffff0000u)};
          xp[8 + 2 * e] = (f32x2){__uint_as_float(b0[e] << 16), __uint_as_float(b1[e] << 16)}; xp[8 + 2 * e + 1] = (f32x2){__uint_as_float(b0[e] & 0xffff0000u), __uint_as_float(b1[e] & 0xffff0000u)}; } }
    u32x4 ub[8];
#pragma unroll
    for (int k = 0; k < 8; ++k) ub[k] = *(const u32x4*)(TABU + (size_t)EG[k].x * 1024 + lane * 16);
#pragma unroll 1
    for (int bt = 0; bt < 32; ++bt) {
        u32x4 un[8];
        const int nb = (bt + 1 < 32) ? bt + 1 : bt;
#pragma unroll
        for (int k = 0; k < 8; ++k) un[k] = *(const u32x4*)(TABU + (size_t)EG[nb * 8 + k].x * 1024 + lane * 16);
        float d[8];
#pragma unroll
        for (int k = 0; k < 8; ++k) { f32x2 a = {0.f, 0.f};
#pragma unroll
            for (int e = 0; e < 4; ++e) { const f32x2 lo = __builtin_amdgcn_cvt_pk_f32_fp8((int)ub[k][e], false), hi = __builtin_amdgcn_cvt_pk_f32_fp8((int)ub[k][e], true);
                a += xp[4 * e] * lo.x; a += xp[4 * e + 1] * lo.y; a += xp[4 * e + 2] * hi.x; a += xp[4 * e + 3] * hi.y; }
            const unsigned tkk = (unsigned)__builtin_amdgcn_readfirstlane((int)EG[bt * 8 + k].w);
            d[k] = tkk ? a.y : a.x; }
        float r4[4], r2[2], v1;
        { const bool h32 = (lane & 32) != 0;
#pragma unroll
          for (int j = 0; j < 4; ++j) { const float send = h32 ? d[j] : d[j + 4], keep = h32 ? d[j + 4] : d[j]; r4[j] = keep + __shfl_xor(send, 32); }
          const bool h16 = (lane & 16) != 0;
#pragma unroll
          for (int j = 0; j < 2; ++j) { const float send = h16 ? r4[j] : r4[j + 2], keep = h16 ? r4[j + 2] : r4[j]; r2[j] = keep + __shfl_xor(send, 16); }
          const bool h8 = (lane & 8) != 0;
          { const float send = h8 ? r2[0] : r2[1], keep = h8 ? r2[1] : r2[0]; v1 = keep + __shfl_xor(send, 8); }
          v1 += __shfl_xor(v1, 4); v1 += __shfl_xor(v1, 2); v1 += __shfl_xor(v1, 1); }
        { const u32x4 eg = EG[bt * 8 + (lane >> 3)]; const float x = v1 * __uint_as_float(eg.y);
          const float act = 0.5f * x * (1.0f + erff(x * 0.70710678118654752f)) * __uint_as_float(eg.z);
          if ((lane & 7) == 0) *((LAS float*)&EG[bt * 8 + (lane >> 3)] + 1) = act; }
#pragma unroll
        for (int k = 0; k < 8; ++k) ub[k] = un[k];
    }
}
template <bool LAST>
__device__ __forceinline__ void pair_pass2(LAS unsigned char* lds_w, size_t tok0, const unsigned char* TABV, bf16* HB, float* xres, const float* gnext, int lane_in) {
    int lane = lane_in; asm volatile("" : "+v"(lane));
    LAS u32x4* EG = (LAS u32x4*)(lds_w + 2048);
    f32x2 outp[16];
#pragma unroll
    for (int c = 0; c < 16; ++c) outp[c] = (f32x2){0.f, 0.f};
    u32x4 vb[8];
#pragma unroll
    for (int k = 0; k < 8; ++k) vb[k] = *(const u32x4*)(TABV + (size_t)EG[k].x * 1024 + lane * 16);
#pragma unroll 1
    for (int bt = 0; bt < 32; ++bt) {
        u32x4 vn[8];
        const int nb = (bt + 1 < 32) ? bt + 1 : bt;
#pragma unroll
        for (int k = 0; k < 8; ++k) vn[k] = *(const u32x4*)(TABV + (size_t)EG[nb * 8 + k].x * 1024 + lane * 16);
#pragma unroll
        for (int k = 0; k < 8; ++k) { const u32x4 eg = EG[bt * 8 + k];
            const unsigned tkk = (unsigned)__builtin_amdgcn_readfirstlane((int)eg.w); const float a = __uint_as_float((unsigned)__builtin_amdgcn_readfirstlane((int)eg.y));
            const f32x2 a2 = tkk ? (f32x2){0.f, a} : (f32x2){a, 0.f};
#pragma unroll
            for (int e = 0; e < 4; ++e) { const f32x2 lo = __builtin_amdgcn_cvt_pk_f32_fp8((int)vb[k][e], false), hi = __builtin_amdgcn_cvt_pk_f32_fp8((int)vb[k][e], true);
                outp[4 * e] += a2 * lo.x; outp[4 * e + 1] += a2 * lo.y; outp[4 * e + 2] += a2 * hi.x; outp[4 * e + 3] += a2 * hi.y; } }
#pragma unroll
        for (int k = 0; k < 8; ++k) vb[k] = vn[k];
    }
#pragma unroll
    for (int tk = 0; tk < 2; ++tk) {
        f32x4 xr[4]; float ss = 0.f;
        float* xq = xres + (tok0 + tk) * 1024 + lane * 16;
#pragma unroll
        for (int j = 0; j < 4; ++j) { xr[j] = *(const f32x4*)(xq + 4 * j);
#pragma unroll
            for (int e = 0; e < 4; ++e) { xr[j][e] += tk ? outp[4 * j + e].y : outp[4 * j + e].x; ss += xr[j][e] * xr[j][e]; } }
        const float rstd = 1.0f / sqrtf(wave_sum(ss) * (1.f / 1024.f) + EPS);
        if (LAST) {
#pragma unroll
            for (int j = 0; j < 4; ++j) { const f32x4 gg = *(const f32x4*)(gnext + lane * 16 + 4 * j); *(f32x4*)(xq + 4 * j) = xr[j] * rstd * gg; }
        } else {
            u32x4 o0, o1;
#pragma unroll
            for (int j = 0; j < 4; ++j) { *(f32x4*)(xq + 4 * j) = xr[j]; const f32x4 gg = *(const f32x4*)(gnext + lane * 16 + 4 * j);
                const unsigned lo = cvt_pk_bf16(xr[j][0] * rstd * gg[0], xr[j][1] * rstd * gg[1]), hi = cvt_pk_bf16(xr[j][2] * rstd * gg[2], xr[j][3] * rstd * gg[3]);
                if (j < 2) { o0[2 * j] = lo; o0[2 * j + 1] = hi; } else { o1[2 * (j - 2)] = lo; o1[2 * (j - 2) + 1] = hi; } }
            u32x4* hq = (u32x4*)(HB + (tok0 + tk) * 1024 + lane * 16); hq[0] = o0; hq[1] = o1;
        }
    }
}

constexpr int PQ_EL = 0, PQ_EG = 4096, PQ_HIST = 12288, PQ_BYTES = 12800;
__device__ __forceinline__ void quad_prepare(LAS unsigned char* lds_w, size_t tok0, const u32x2* TOPK, const float* TSU, const float* TSV, int lane_in) {
    int lane = lane_in; asm volatile("" : "+v"(lane));
    LAS u32x2* EL = (LAS u32x2*)(lds_w + PQ_EL); LAS u32x4* EG = (LAS u32x4*)(lds_w + PQ_EG); LAS unsigned* HIST = (LAS unsigned*)(lds_w + PQ_HIST);
    if (lane < 32) HIST[lane] = 0u;
    for (int _rp = 0; _rp <= (PEER_PROBE & 1); ++_rp)
#pragma unroll 1
    for (int th = 0; th < 32; ++th) { const int tk = th >> 3, head = th & 7;
        const u32x2* base = TOPK + ((tok0 + tk) * 16 + head * 2) * 16;
        const u32x2 e0 = base[lane >> 2];
        const u32x4 e1a = *(const u32x4*)(base + 16 + 4 * (lane & 3)), e1b = *(const u32x4*)(base + 16 + 4 * (lane & 3) + 2);
        const float s0 = __uint_as_float(e0.x);
        float cs[4]; unsigned ck[4], u[4];
        cs[0] = s0 + __uint_as_float(e1a.x); ck[0] = e0.y * 128u + e1a.y; cs[1] = s0 + __uint_as_float(e1a.z); ck[1] = e0.y * 128u + e1a.w;
        cs[2] = s0 + __uint_as_float(e1b.x); ck[2] = e0.y * 128u + e1b.y; cs[3] = s0 + __uint_as_float(e1b.z); ck[3] = e0.y * 128u + e1b.w;
#pragma unroll
        for (int m = 0; m < 4; ++m) u[m] = sortable_u32(cs[m]);
        unsigned T = 0u;
#pragma unroll 1
        for (int bit = 31; bit >= 0; --bit) {
            const unsigned cand = T | (1u << bit); unsigned cnt = 0u;
#pragma unroll
            for (int m = 0; m < 4; ++m) cnt += (unsigned)__popcll(__ballot(u[m] >= cand));
            if (cnt >= 16u) T = cand;
            if (cnt == 16u) break;
        }
        unsigned G = 0u;
#pragma unroll
        for (int m = 0; m < 4; ++m) G += (unsigned)__popcll(__ballot(u[m] > T));
        const unsigned need_eq = 16u - G; unsigned pos = 0u, eq_used = 0u;
#pragma unroll
        for (int m = 0; m < 4; ++m) {
            const bool gt = u[m] > T, eq = u[m] == T;
            const unsigned long long meq = __ballot(eq);
            const bool sl = gt || (eq && (eq_used + mbcnt64(meq) < need_eq));
            const unsigned long long msl = __ballot(sl);
            if (sl) { u32x2 e; e.x = ck[m]; e.y = __float_as_uint(cs[m]); EL[th * 16 + pos + mbcnt64(msl)] = e; }
            pos += (unsigned)__popcll(msl); eq_used += (unsigned)__popcll(meq); }
    }
    u32x4 ent8[8]; unsigned rk[8];
#pragma unroll
    for (int rep = 0; rep < 8; ++rep) { const int e = lane + 64 * rep; const u32x2 ent = EL[e]; const float sc = __uint_as_float(ent.y);
        const float su = TSU[ent.x], sv = TSV[ent.x];
        float mx = sc;
#pragma unroll
        for (int o = 1; o < 16; o <<= 1) mx = fmaxf(mx, __shfl_xor(mx, o));
        const float p = __expf(sc - mx); float sm = p;
#pragma unroll
        for (int o = 1; o < 16; o <<= 1) sm += __shfl_xor(sm, o);
        ent8[rep].x = ent.x; ent8[rep].y = __float_as_uint(su); ent8[rep].z = __float_as_uint(p / sm * sv); ent8[rep].w = (unsigned)(rep >> 1);
        rk[rep] = atomicAdd((unsigned*)&HIST[ent.x >> 9], 1u); }
    { unsigned c = (lane < 32) ? HIST[lane] : 0u, inc = c;
#pragma unroll
      for (int o = 1; o < 32; o <<= 1) { const unsigned t = (unsigned)__shfl_up((int)inc, o); if ((lane & 31) >= o) inc += t; }
      if (lane < 32) HIST[32 + lane] = inc - c; }
#pragma unroll
    for (int rep = 0; rep < 8; ++rep) EG[HIST[32 + (ent8[rep].x >> 9)] + rk[rep]] = ent8[rep];
}
__device__ __forceinline__ void quad_pass1(LAS unsigned char* lds_w, size_t tok0, const unsigned char* TABU, const bf16* HB, int lane_in) {
    int lane = lane_in; asm volatile("" : "+v"(lane));
    LAS u32x4* EG = (LAS u32x4*)(lds_w + PQ_EG);
    float x0[16], x1[16], x2[16], x3[16];
#define PQ_LOADX(xx, tk) do { const u32x4* hp = (const u32x4*)(HB + (tok0 + (tk)) * 1024 + lane * 16); const u32x4 a = hp[0], b = hp[1]; \
        _Pragma("unroll") for (int e = 0; e < 4; ++e) { xx[2 * e] = __uint_as_float(a[e] << 16); xx[2 * e + 1] = __uint_as_float(a[e] & 0xffff0000u); xx[8 + 2 * e] = __uint_as_float(b[e] << 16); xx[8 + 2 * e + 1] = __uint_as_float(b[e] & 0xffff0000u); } } while (0)
    PQ_LOADX(x0, 0); PQ_LOADX(x1, 1); PQ_LOADX(x2, 2); PQ_LOADX(x3, 3);
#undef PQ_LOADX
    u32x4 ub[8];
#pragma unroll
    for (int k = 0; k < 8; ++k) ub[k] = *(const u32x4*)(TABU + (size_t)EG[k].x * 1024 + lane * 16);
#pragma unroll 1
    for (int bt = 0; bt < 64; ++bt) {
        u32x4 un[8];
        const int nb = (bt + 1 < 64) ? bt + 1 : bt;
#pragma unroll
        for (int k = 0; k < 8; ++k) un[k] = *(const u32x4*)(TABU + (size_t)EG[nb * 8 + k].x * 1024 + lane * 16);
        float d[8];
#pragma unroll
        for (int k = 0; k < 8; ++k) {
            float f[16];
#pragma unroll
            for (int e = 0; e < 4; ++e) { const f32x2 lo = __builtin_amdgcn_cvt_pk_f32_fp8((int)ub[k][e], false), hi = __builtin_amdgcn_cvt_pk_f32_fp8((int)ub[k][e], true); f[4 * e] = lo.x; f[4 * e + 1] = lo.y; f[4 * e + 2] = hi.x; f[4 * e + 3] = hi.y; }
            const unsigned tkk = (unsigned)__builtin_amdgcn_readfirstlane((int)EG[bt * 8 + k].w);
            float a = 0.f;
            if (tkk == 0u) {
#pragma unroll
                for (int c = 0; c < 16; ++c) a += f[c] * x0[c]; }
            else if (tkk == 1u) {
#pragma unroll
                for (int c = 0; c < 16; ++c) a += f[c] * x1[c]; }
            else if (tkk == 2u) {
#pragma unroll
                for (int c = 0; c < 16; ++c) a += f[c] * x2[c]; }
            else {
#pragma unroll
                for (int c = 0; c < 16; ++c) a += f[c] * x3[c]; }
            d[k] = a; }
        float r4[4], r2[2], v1;
        { const bool h32 = (lane & 32) != 0;
#pragma unroll
          for (int j = 0; j < 4; ++j) { const float send = h32 ? d[j] : d[j + 4], keep = h32 ? d[j + 4] : d[j]; r4[j] = keep + __shfl_xor(send, 32); }
          const bool h16 = (lane & 16) != 0;
#pragma unroll
          for (int j = 0; j < 2; ++j) { const float send = h16 ? r4[j] : r4[j + 2], keep = h16 ? r4[j + 2] : r4[j]; r2[j] = keep + __shfl_xor(send, 16); }
          const bool h8 = (lane & 8) != 0;
          { const float send = h8 ? r2[0] : r2[1], keep = h8 ? r2[1] : r2[0]; v1 = keep + __shfl_xor(send, 8); }
          v1 += __shfl_xor(v1, 4); v1 += __shfl_xor(v1, 2); v1 += __shfl_xor(v1, 1); }
        { const u32x4 eg = EG[bt * 8 + (lane >> 3)]; const float x = v1 * __uint_as_float(eg.y);
          const float act = 0.5f * x * (1.0f + erff(x * 0.70710678118654752f)) * __uint_as_float(eg.z);
          if ((lane & 7) == 0) *((LAS float*)&EG[bt * 8 + (lane >> 3)] + 1) = act; }
#pragma unroll
        for (int k = 0; k < 8; ++k) ub[k] = un[k];
    }
}
template <bool LAST>
__device__ __forceinline__ void quad_pass2(LAS unsigned char* lds_w, size_t tok0, const unsigned char* TABV, bf16* HB, float* xres, const float* gnext, int lane_in) {
    int lane = lane_in; asm volatile("" : "+v"(lane));
    LAS u32x4* EG = (LAS u32x4*)(lds_w + PQ_EG);
    float o0[16], o1[16], o2[16], o3[16];
#pragma unroll
    for (int c = 0; c < 16; ++c) { o0[c] = 0.f; o1[c] = 0.f; o2[c] = 0.f; o3[c] = 0.f; }
    u32x4 vb[8];
#pragma unroll
    for (int k = 0; k < 8; ++k) vb[k] = *(const u32x4*)(TABV + (size_t)EG[k].x * 1024 + lane * 16);
#pragma unroll 1
    for (int bt = 0; bt < 64; ++bt) {
        u32x4 vn[8];
        const int nb = (bt + 1 < 64) ? bt + 1 : bt;
#pragma unroll
        for (int k = 0; k < 8; ++k) vn[k] = *(const u32x4*)(TABV + (size_t)EG[nb * 8 + k].x * 1024 + lane * 16);
#pragma unroll
        for (int k = 0; k < 8; ++k) {
            float f[16];
#pragma unroll
            for (int e = 0; e < 4; ++e) { const f32x2 lo = __builtin_amdgcn_cvt_pk_f32_fp8((int)vb[k][e], false), hi = __builtin_amdgcn_cvt_pk_f32_fp8((int)vb[k][e], true); f[4 * e] = lo.x; f[4 * e + 1] = lo.y; f[4 * e + 2] = hi.x; f[4 * e + 3] = hi.y; }
            const u32x4 eg = EG[bt * 8 + k];
            const unsigned tkk = (unsigned)__builtin_amdgcn_readfirstlane((int)eg.w); const float a = __uint_as_float((unsigned)__builtin_amdgcn_readfirstlane((int)eg.y));
            if (tkk == 0u) {
#pragma unroll
                for (int c = 0; c < 16; ++c) o0[c] += a * f[c]; }
            else if (tkk == 1u) {
#pragma unroll
                for (int c = 0; c < 16; ++c) o1[c] += a * f[c]; }
            else if (tkk == 2u) {
#pragma unroll
                for (int c = 0; c < 16; ++c) o2[c] += a * f[c]; }
            else {
#pragma unroll
                for (int c = 0; c < 16; ++c) o3[c] += a * f[c]; } }
#pragma unroll
        for (int k = 0; k < 8; ++k) vb[k] = vn[k];
    }
#define PQ_FINAL(oo, tk) do { f32x4 xr[4]; float ss = 0.f; float* xq = xres + (tok0 + (tk)) * 1024 + lane * 16; \
        _Pragma("unroll") for (int j = 0; j < 4; ++j) { xr[j] = *(const f32x4*)(xq + 4 * j); _Pragma("unroll") for (int e = 0; e < 4; ++e) { xr[j][e] += oo[4 * j + e]; ss += xr[j][e] * xr[j][e]; } } \
        const float rstd = 1.0f / sqrtf(wave_sum(ss) * (1.f / 1024.f) + EPS); \
        if (LAST) { _Pragma("unroll") for (int j = 0; j < 4; ++j) { const f32x4 gg = *(const f32x4*)(gnext + lane * 16 + 4 * j); *(f32x4*)(xq + 4 * j) = xr[j] * rstd * gg; } } \
        else { u32x4 q0, q1; \
            _Pragma("unroll") for (int j = 0; j < 4; ++j) { *(f32x4*)(xq + 4 * j) = xr[j]; const f32x4 gg = *(const f32x4*)(gnext + lane * 16 + 4 * j); \
                const unsigned lo = cvt_pk_bf16(xr[j][0] * rstd * gg[0], xr[j][1] * rstd * gg[1]), hi = cvt_pk_bf16(xr[j][2] * rstd * gg[2], xr[j][3] * rstd * gg[3]); \
                if (j < 2) { q0[2 * j] = lo; q0[2 * j + 1] = hi; } else { q1[2 * (j - 2)] = lo; q1[2 * (j - 2) + 1] = hi; } } \
            u32x4* hq = (u32x4*)(HB + (tok0 + (tk)) * 1024 + lane * 16); hq[0] = q0; hq[1] = q1; } } while (0)
    PQ_FINAL(o0, 0); PQ_FINAL(o1, 1); PQ_FINAL(o2, 2); PQ_FINAL(o3, 3);
#undef PQ_FINAL
}
__device__ __forceinline__ void xcc_sync(unsigned* ctr, unsigned nloc, unsigned target) {
    __syncthreads();
    if (threadIdx.x == 0 && nloc > 0u) {
        __hip_atomic_fetch_add(ctr, 1u, __ATOMIC_RELAXED, __HIP_MEMORY_SCOPE_AGENT);
        unsigned sp = 0u;
        while (__hip_atomic_load(ctr, __ATOMIC_RELAXED, __HIP_MEMORY_SCOPE_AGENT) < nloc * target) { __builtin_amdgcn_s_sleep(1); if (++sp > (1u << 16)) break; }
    }
    __syncthreads();
}

__device__ __forceinline__ void row_to_fp8(const float* src, unsigned char* dst, float* scale, int lane) {
    const f32x4* sp = (const f32x4*)(src + lane * 16); f32x4 v[4]; float am = 0.f;
#pragma unroll
    for (int j = 0; j < 4; ++j) { v[j] = sp[j]; am = fmaxf(am, fmaxf(fmaxf(fabsf(v[j].x), fabsf(v[j].y)), fmaxf(fabsf(v[j].z), fabsf(v[j].w)))); }
    am = wave_max(am);
    const float sc = am > 0.f ? am * (1.0f / 448.0f) : 1.0f, inv = 1.0f / sc;
    u32x4 o;
#pragma unroll
    for (int j = 0; j < 4; ++j) { int w = 0; w = __builtin_amdgcn_cvt_pk_fp8_f32(v[j].x * inv, v[j].y * inv, w, false); w = __builtin_amdgcn_cvt_pk_fp8_f32(v[j].z * inv, v[j].w * inv, w, true); o[j] = (unsigned)w; }
    *(u32x4*)(dst + lane * 16) = o;
    if (lane == 0) *scale = sc;
}

__device__ __forceinline__ void row_to_int8(const float* src, unsigned char* dst, float* scale, int lane) {
    const f32x4* sp = (const f32x4*)(src + lane * 16); f32x4 v[4]; float am = 0.f;
#pragma unroll
    for (int j = 0; j < 4; ++j) { v[j] = sp[j]; am = fmaxf(am, fmaxf(fmaxf(fabsf(v[j].x), fabsf(v[j].y)), fmaxf(fabsf(v[j].z), fabsf(v[j].w)))); }
    am = wave_max(am);
    const float sc = am > 0.f ? am * (1.0f / 127.0f) : 1.0f, inv = 1.0f / sc;
    u32x4 o;
#pragma unroll
    for (int j = 0; j < 4; ++j) { const int q0 = (int)rintf(v[j].x * inv), q1 = (int)rintf(v[j].y * inv), q2 = (int)rintf(v[j].z * inv), q3 = (int)rintf(v[j].w * inv);
        o[j] = (unsigned)((q0 & 0xff) | ((q1 & 0xff) << 8) | ((q2 & 0xff) << 16) | ((q3 & 0xff) << 24)); }
    *(u32x4*)(dst + lane * 16) = o;
    if (lane == 0) *scale = sc;
}

template <bool FP8>
__device__ __forceinline__ void rows4_to_q8(const float* src, size_t rstride_f, unsigned char* dst, size_t rstride_b, float* scale, size_t sstride, int lane) {
    f32x4 v[4][4];
#pragma unroll
    for (int i = 0; i < 4; ++i) { const f32x4* sp = (const f32x4*)(src + (size_t)i * rstride_f + lane * 16);
#pragma unroll
        for (int j = 0; j < 4; ++j) v[i][j] = sp[j]; }
#pragma unroll
    for (int i = 0; i < 4; ++i) { float am = 0.f;
#pragma unroll
        for (int j = 0; j < 4; ++j) am = fmaxf(am, fmaxf(fmaxf(fabsf(v[i][j].x), fabsf(v[i][j].y)), fmaxf(fabsf(v[i][j].z), fabsf(v[i][j].w))));
        am = wave_max(am);
        const float sc = am > 0.f ? am * (FP8 ? (1.0f / 448.0f) : (1.0f / 127.0f)) : 1.0f, inv = 1.0f / sc;
        u32x4 o;
#pragma unroll
        for (int j = 0; j < 4; ++j) {
            if (FP8) { int w = 0; w = __builtin_amdgcn_cvt_pk_fp8_f32(v[i][j].x * inv, v[i][j].y * inv, w, false); w = __builtin_amdgcn_cvt_pk_fp8_f32(v[i][j].z * inv, v[i][j].w * inv, w, true); o[j] = (unsigned)w; }
            else { const int q0 = (int)rintf(v[i][j].x * inv), q1 = (int)rintf(v[i][j].y * inv), q2 = (int)rintf(v[i][j].z * inv), q3 = (int)rintf(v[i][j].w * inv);
                o[j] = (unsigned)((q0 & 0xff) | ((q1 & 0xff) << 8) | ((q2 & 0xff) << 16) | ((q3 & 0xff) << 24)); } }
        *(u32x4*)(dst + (size_t)i * rstride_b + lane * 16) = o;
        if (lane == 0) scale[(size_t)i * sstride] = sc; }
}

__global__ void __launch_bounds__(NTHR, 2) trunk_fwd(Args args) {
    extern __shared__ __attribute__((aligned(16))) unsigned char lds_raw[];
    LAS unsigned char* lds = (LAS unsigned char*)lds_raw;
    const int tid = threadIdx.x, lane = tid & 63, wave = __builtin_amdgcn_readfirstlane(tid >> 6);
    const int G = gridDim.x, bx = blockIdx.x;
    unsigned char* ws = args.ws;
    unsigned* ctl = (unsigned*)(ws + WS_CTL);
    volatile LAS unsigned* LCTL = (volatile LAS unsigned*)(lds + LDS_CTL);
    for (int u = tid; u < 512; u += NTHR) LCTL[u] = 0u;
    __syncthreads();
    XcdBarrier bar; bar.bar = ctl + CW_BAR; bar.x = 0; bar.st = nullptr;
    if (!MK_PER_PHASE) bar = xcd_barrier_post(ctl + CW_BAR, LCTL + 8);
    const int lo = args.ph_lo, hi = args.ph_hi;
#define IN(k) (lo <= (k) && (k) < hi)
#define SEAM(k) do { if (IN(k) && IN((k) + 1)) xcd_barrier(bar); } while (0)
#define SEAM2(k) do { if (IN(k) && IN((k) + 2)) xcd_barrier(bar); } while (0)
#define REP(k) for (int _r = 0; _r <= ((PROBE_MASK >> (k)) & 1); ++_r)
    const size_t gtid = (size_t)bx * NTHR + tid, gthreads = (size_t)G * NTHR;
    const int gw = bx * NWAVES + wave, NGW = G * NWAVES;

    const float* x_in = args.in[I_X];
    float* xres = args.out;
    bf16* WA = (bf16*)(ws + WS_WA); bf16* WB = (bf16*)(ws + WS_WB); bf16* WO = (bf16*)(ws + WS_WO); bf16* WKV = (bf16*)(ws + WS_WKV); bf16* WQ = (bf16*)(ws + WS_WQ);
    bf16* MEMN = (bf16*)(ws + WS_MEMN); bf16* KV = (bf16*)(ws + WS_KV); bf16* HB = (bf16*)(ws + WS_HB); bf16* MIX = (bf16*)(ws + WS_MIX);
    unsigned char* TAB8 = ws + WS_TAB;
    float* TSC = (float*)(ws + WS_TSC);
    unsigned char* AR = ws + WS_AR;
    bf16* QMEM = (bf16*)(AR + AR_QMEM);
    bf16* Qb = (bf16*)args.out; bf16* QMEM0 = (bf16*)args.out + (size_t)M * 768;
    bf16* QLb = (bf16*)(AR + AR_QL);
    bf16* Zb = (bf16*)(AR + AR_Z); bf16* XBC = (bf16*)(AR + AR_XBC); float* DTb = (float*)(AR + AR_DT); bf16* XC = (bf16*)(AR + AR_XC); bf16* STATES = (bf16*)(AR + AR_ST); bf16* Yb = (bf16*)(AR + AR_Y);
    float* DEC = (float*)(ws + WS_DEC); float* SSb = (float*)(ws + WS_SS);
    bf16* UKb = (bf16*)(ws + WS_UK); bf16* UVTb = (bf16*)(ws + WS_UVT); bf16* SUBKb = (bf16*)(ws + WS_SUBK);
    bf16* PQb = (bf16*)(AR + AR_PQ); u32x2* TOPK = (u32x2*)(AR + AR_TOPK);

    if (IN(0)) REP(0) {
        LAS float* scr = (LAS float*)(lds + LDS_SCR + wave * 8704);
        const float* awin = args.in[I_AWIN]; const float* bwin = args.in[I_BWIN];
        const int nA0 = titems(1536), nA1 = titems(256), nA2 = titems(64), nA3 = titems(8);
        const int nB0 = titems(2048), nB1 = titems(256), nB2 = titems(12);
        const int nO = titems(1024), nKV = titems(512), nQ = titems(2048);
        const int NIT = nA0 + nA1 + nA2 + nA3 + nB0 + nB1 + nB2 + 2 * nO + 2 * nKV + 2 * nQ;
        for (int it = gw; it < NIT; it += NGW) {
            int r = it;
            if (r < nA0) { transpose_item(awin, 1864, 0, 1536, WA, 0, scr, r, lane); continue; } r -= nA0;
            if (r < nA1) { transpose_item(awin, 1864, 1608, 256, WA, 1536, scr, r, lane); continue; } r -= nA1;
            if (r < nA2) { transpose_item(awin, 1864, 1536, 64, WA, 1792, scr, r, lane); continue; } r -= nA2;
            if (r < nA3) { transpose_item(awin, 1864, 1600, 8, WA, 1856, scr, r, lane); continue; } r -= nA3;
            if (r < nB0) { transpose_item(bwin, 2316, 0, 2048, WB, 0, scr, r, lane); continue; } r -= nB0;
            if (r < nB1) { transpose_item(bwin, 2316, 2060, 256, WB, 2048, scr, r, lane); continue; } r -= nB1;
            if (r < nB2) { transpose_item(bwin, 2316, 2048, 12, WB, 2304, scr, r, lane); continue; } r -= nB2;
            if (r < 2 * nO) { const int l = r / nO; transpose_item(args.in[I_WO] + (size_t)l * 1024 * 1024, 1024, 0, 1024, WO, l * 1024, scr, r - l * nO, lane); continue; } r -= 2 * nO;
            if (r < 2 * nKV) { const int l = r / nKV; transpose_item(args.in[I_WMEMKV] + (size_t)l * 1024 * 512, 512, 0, 512, WKV, l * 512, scr, r - l * nKV, lane); continue; } r -= 2 * nKV;
            { const int l = r / nQ; transpose_item(args.in[I_PWQ] + (size_t)l * 1024 * 2048, 2048, 0, 2048, WQ, l * 2048, scr, r - l * nQ, lane, args.in[I_FFNNORM] + l * D); }
        }
        for (size_t i = gtid; i < (size_t)(2048 - 1864) * 128; i += gthreads) *((u32x4*)(WA + (size_t)1864 * 1024) + i) = (u32x4){0u, 0u, 0u, 0u};
        for (size_t i = gtid; i < (size_t)(2560 - 2316) * 128; i += gthreads) *((u32x4*)(WB + (size_t)2316 * 1024) + i) = (u32x4){0u, 0u, 0u, 0u};
        for (size_t i = gtid; i < (size_t)2 * M; i += gthreads) SSb[i] = 0.f;
        for (int m = gw; m < BATCH * MEMLEN; m += NGW) rms_row_to_bf16(args.in[I_MEM] + (size_t)m * D, args.in[I_MEMNORM], MEMN + (size_t)m * D, lane);
        for (int m = gw; m < M; m += 4 * NGW) rms_rows4_to_bf16(x_in + (size_t)m * D, (size_t)NGW * D, args.in[I_MIXNORM], HB + (size_t)m * D, lane);
        cvt_stream(args.in[I_AWUK], UKb, (size_t)12 * 256 * 64, gtid, gthreads);
        for (size_t i = gtid; i < (size_t)12 * 64 * 256; i += gthreads) { const int h = (int)(i >> 14), d = (int)((i >> 8) & 63), c = (int)(i & 255);
            UVTb[i] = (bf16)(cvt_pk_bf16(args.in[I_AWUV][((size_t)h * 256 + c) * 64 + d], 0.f) & 0xffffu); }
        cvt_stream(args.in[I_PSUBK], SUBKb, (size_t)2 * 2 * 128 * 128, gtid, gthreads);
        for (int tbl = 0; tbl < 4; ++tbl) { const int l = tbl >> 1, tv = tbl & 1;
            const float* srcb = args.in[tv ? I_PV : I_PU] + (size_t)l * 16384 * 1024; unsigned char* dstb = TAB8 + (size_t)l * 32 * MiB + (size_t)tv * 1024; float* scb = TSC + (l * 2 + tv) * 16384;
            for (int e = gw; e < 16384; e += 4 * NGW) {
                if (tv) rows4_to_q8<true>(srcb + (size_t)e * 1024, (size_t)NGW * 1024, dstb + (size_t)e * 2048, (size_t)NGW * 2048, scb + e, NGW, lane);
                else rows4_to_q8<false>(srcb + (size_t)e * 1024, (size_t)NGW * 1024, dstb + (size_t)e * 2048, (size_t)NGW * 2048, scb + e, NGW, lane); } }
    }
    SEAM(0);
    if (IN(1)) REP(1) {
        { pg8::Gemm g{HB, WA, M, NA, D}; pg8::StaticOrder S; S.init(M, NA, G, bx);
          EpiInA E{Qb, (float*)(AR + AR_CKV32), (bf16*)(AR + AR_IQ), QMEM0, (bf16*)(AR + AR_IK), (float*)(AR + AR_IW)};
          pg8::gemm_phase<EpiInA, pg8::StaticOrder, true, true>(lds + LDS_SCR, g, S, E); }
        { pg8::Gemm g{MEMN, WKV, BATCH * MEMLEN, 1024, D}; pg8::StaticOrder S; S.init(BATCH * MEMLEN, 1024, G, bx);
          EpiPlain E{KV, 1024};
          pg8::gemm_phase<EpiPlain, pg8::StaticOrder, true, true>(lds + LDS_SCR, g, S, E); }
    }
    SEAM(1);
    if (IN(2)) REP(2) {
        { const float* src = (const float*)(AR + AR_CKV32); bf16* dst = (bf16*)(AR + AR_CKV); const f32x4 gg = *((const f32x4*)args.in[I_AKVNORM] + lane);
          for (int m = gw; m < M; m += 4 * NGW) {
              f32x4 v[4];
#pragma unroll
              for (int i = 0; i < 4; ++i) v[i] = *((const f32x4*)(src + (size_t)(m + i * NGW) * 256) + lane);
#pragma unroll
              for (int i = 0; i < 4; ++i) { const float ss = wave_sum((v[i].x * v[i].x + v[i].y * v[i].y) + (v[i].z * v[i].z + v[i].w * v[i].w)); const float rstd = 1.0f / sqrtf(ss * (1.f / 256.f) + EPS);
                  u32x2 o; o.x = cvt_pk_bf16(v[i].x * rstd * gg.x, v[i].y * rstd * gg.y); o.y = cvt_pk_bf16(v[i].z * rstd * gg.z, v[i].w * rstd * gg.w);
                  *((u32x2*)(dst + (size_t)(m + i * NGW) * 256) + lane) = o; } } }
        for (int u = bx; u < 512; u += G) memattn_unit(lds + LDS_SCR, u, 0, KV, QMEM0, MIX, tid, wave, lane);
        qlat_phase(lds + LDS_SCR, bx, G, 3072, Qb, UKb, QLb, tid, wave, lane);
    }
    SEAM(2);
    if (IN(3)) REP(3) {
        { LAS float* RB = (LAS float*)(lds + LDS_SCR + DS_RB); const float* rbias = args.in[I_RELBIAS];
          for (int i = tid; i < 512; i += NTHR) { const int bk = i >> 4, h = i & 15; RB[i] = h < 12 ? rbias[bk * 12 + h] : 0.f; } }
        for (int u = bx; u < 4096; u += G) dsa_unit(lds + LDS_SCR, u, QLb, (const bf16*)(AR + AR_CKV), (const bf16*)(AR + AR_IQ), (const bf16*)(AR + AR_IK), (const float*)(AR + AR_IW), tid, wave, lane);
    }
    SEAM(3);
    if (IN(4)) REP(4) { uv_phase(lds + LDS_SCR, bx, G, 3072, QLb, UVTb, MIX, tid, wave, lane); }
    SEAM(4);
    if (IN(5)) REP(5) {
        pg8::Gemm g{MIX, WO, M, D, D}; pg8::StaticOrder S; S.init(M, D, G, bx);
        EpiResid<false> E{x_in, HB, SSb};
        pg8::gemm_phase<EpiResid<false>, pg8::StaticOrder, true, true>(lds + LDS_SCR, g, S, E);
    }
    SEAM2(5);
    if (IN(7)) REP(7) {
        pg8::Gemm g{HB, WQ, M, 2048, D}; pg8::StaticOrder S; S.init(M, 2048, G, bx);
        EpiPQ E{PQb, SSb};
        pg8::gemm_phase<EpiPQ, pg8::StaticOrder, true, true>(lds + LDS_SCR, g, S, E);
    }
    SEAM(7);
    if (IN(8)) REP(8) { peer_topk_load_sk(lds + LDS_SCR, SUBKb, tid); for (int task = gw; task < 16384; task += NGW) peer_topk_task(lds + LDS_SCR, task, PQb, TOPK, wave, lane); }
    SEAM(8);
    if (IN(9)) { peer_wave<false>(lds + LDS_SCR + wave * PW_BYTES, gw, NGW, M / 2, TOPK, TAB8, TAB8 + 1024, TSC, TSC + 16384, HB, SSb, args.in[I_FFNNORM], xres, args.in[I_MIXNORM] + D, lane, ctl + CW_XS + 64 * xb_xcc_id(), MK_PER_PHASE ? 0u : LCTL[8], 0u); }
    SEAM(9);
    if (IN(10)) REP(10) {
        pg8::Gemm g{HB, WB, M, NB, D}; pg8::StaticOrder S; S.init(M, NB, G, bx);
        EpiInB E{(bf16*)(AR + AR_Z), (bf16*)(AR + AR_XBC), QMEM, (float*)(AR + AR_DT)};
        pg8::gemm_phase<EpiInB, pg8::StaticOrder, true, true>(lds + LDS_SCR, g, S, E);
    }
    SEAM(10);
    if (IN(11)) REP(11) {
        for (int u = bx; u < 512; u += G) memattn_unit(lds + LDS_SCR, u, 1, KV, QMEM, MIX, tid, wave, lane);
        for (int u = bx; u < 256; u += G) ssd_states_unit(lds + LDS_SCR, u, XBC, DTb, args.in[I_BCONVW], args.in[I_BCONVB], args.in[I_BDTBIAS], args.in[I_BALOG], XC, STATES, DEC, tid, wave, lane);
    }
    SEAM(11);
    if (IN(12)) { ssd_scan(STATES, DEC, gtid, gthreads); }
    SEAM(12);
    if (IN(13)) REP(13) { for (int u = bx; u < 256; u += G) ssd_out_unit(lds + LDS_SCR, u, XC, DTb, Zb, STATES, args.in[I_BDTBIAS], args.in[I_BALOG], args.in[I_BDSKIP], args.in[I_BOUTNORM], Yb, MIX, tid, wave, lane); }
    SEAM(13);
    if (IN(14)) {
        pg8::Gemm g{MIX, WO + (size_t)1024 * 1024, M, D, D}; pg8::StaticOrder S; S.init(M, D, G, bx);
        EpiResid<true> E{(const bf16*)xres, HB, SSb + M};
        pg8::gemm_phase<EpiResid<true>, pg8::StaticOrder, true, true>(lds + LDS_SCR, g, S, E);
    }
    SEAM2(14);
    if (IN(16)) REP(16) {
        pg8::Gemm g{HB, WQ + (size_t)2048 * 1024, M, 2048, D}; pg8::StaticOrder S; S.init(M, 2048, G, bx);
        EpiPQ E{PQb, SSb + M};
        pg8::gemm_phase<EpiPQ, pg8::StaticOrder, true, true>(lds + LDS_SCR, g, S, E);
    }
    SEAM(16);
    if (IN(17)) REP(17) { peer_topk_load_sk(lds + LDS_SCR, SUBKb + 32768, tid); for (int task = gw; task < 16384; task += NGW) peer_topk_task(lds + LDS_SCR, task, PQb, TOPK, wave, lane); }
    SEAM(17);
    if (IN(18)) { peer_wave<true>(lds + LDS_SCR + wave * PW_BYTES, gw, NGW, M / 2, TOPK, TAB8 + 32 * MiB, TAB8 + 32 * MiB + 1024, TSC + 32768, TSC + 49152, HB, SSb + M, args.in[I_FFNNORM] + D, xres, args.in[I_FINALNORM], lane, ctl + CW_XS + 64 * xb_xcc_id(), MK_PER_PHASE ? 0u : LCTL[8], 8u); }
#undef IN
#undef SEAM
#undef SEAM2
#undef REP
}

extern "C" void kernel_launch(void* const* d_in, const int* in_sizes, int n_in, void* d_out, int out_size, void* d_ws, size_t ws_size, hipStream_t stream) {
    static int grid = 0;
    if (grid == 0) {
        if (n_in != 24 || in_sizes[0] != M * D || out_size != M * D || ws_size < WS_END) { fprintf(stderr, "kernel_launch: unexpected shapes (n_in %d, ws %zu); nothing launched\n", n_in, ws_size); grid = -1; return; }
        int dev = 0, cus = 0, per_cu = 0;
        if (hipGetDevice(&dev) != hipSuccess || hipDeviceGetAttribute(&cus, hipDeviceAttributeMultiprocessorCount, dev) != hipSuccess) { grid = -1; return; }
        if (hipFuncSetAttribute((const void*)trunk_fwd, hipFuncAttributeMaxDynamicSharedMemorySize, LDS_BYTES) != hipSuccess) { fprintf(stderr, "kernel_launch: hipFuncSetAttribute failed\n"); grid = -1; return; }
        if (hipOccupancyMaxActiveBlocksPerMultiprocessor(&per_cu, (const void*)trunk_fwd, NTHR, LDS_BYTES) != hipSuccess || per_cu < 1) { fprintf(stderr, "kernel_launch: occupancy query says %d\n", per_cu); }
        (void)hipGetLastError();
        grid = cus;
    }
    if (grid < 0) return;
    if (hipMemsetAsync((char*)d_ws + WS_CTL, 0, CTL_ZERO_BYTES, stream) != hipSuccess) return;
    Args a{};
    for (int i = 0; i < 24; ++i) a.in[i] = (const float*)d_in[i];
    a.out = (float*)d_out; a.ws = (unsigned char*)d_ws;
#if MK_PER_PHASE
    for (int p = 0; p < NPHASE; ++p) { a.ph_lo = p; a.ph_hi = p + 1; hipLaunchKernelGGL(trunk_fwd, dim3(grid), dim3(NTHR), LDS_BYTES, stream, a); }
#else
    a.ph_lo = 0; a.ph_hi = NPHASE;
    hipLaunchKernelGGL(trunk_fwd, dim3(grid), dim3(NTHR), LDS_BYTES, stream, a);
#endif
}
```

```cpp
#include <hip/hip_runtime.h>
#include <cstdio>
#include <cstdint>
#ifndef PROBE_MASK
#define PROBE_MASK 0
#endif
#ifndef DSA_PROBE
#define DSA_PROBE 0
#endif
#ifndef PEER_PROBE
#define PEER_PROBE 0
#endif
#ifndef PEER_WGSYNC
#define PEER_WGSYNC 3
#endif
#ifndef MK_PER_PHASE
#define MK_PER_PHASE 0
#endif
namespace pg8 {
#define PG8_LAS __attribute__((address_space(3)))
typedef unsigned short bf16_t;
typedef short bf16x8 __attribute__((ext_vector_type(8)));
typedef float f32x4 __attribute__((ext_vector_type(4)));
typedef unsigned u32x4 __attribute__((ext_vector_type(4)));
constexpr int BM = 256, BK = 64, HALF = 128, HTB = HALF * BK * 2  , STAGE_BYTES = 8 * HTB, NXCD = 8, WGM = 8;

__host__ __device__ __forceinline__ int lds_byte(int r, int c) { const int st = (r >> 4) * 2 + (c >> 5), rr = r & 15, cc = c & 31, ob = rr * 64 + cc * 2; return st * 1024 + (ob ^ (((ob >> 9) & 1) << 5)); }
__host__ __device__ __forceinline__ void stage_rc(int b, int& R, int& C) { const int st = b / 1024, sb = b % 1024, swz = sb ^ (((sb >> 9) & 1) << 5); R = (st >> 1) * 16 + swz / 64; C = (st & 1) * 32 + (swz % 64) / 2; }
__host__ __device__ __forceinline__ int perm32(int rho) { const int n = rho >> 4, i = rho & 15; return 8 * (i >> 2) + 4 * n + (i & 3); }

struct Unit { int pm, pn; };
struct Gemm { const bf16_t* A; const bf16_t* Bt; int M, N, K; };

struct StaticOrder {
    int nM, nN, nwg, G, c;
    __host__ __device__ void init(int M, int N, int G_, int c_) { nM = M / BM; nN = N / BM; nwg = nM * nN; G = G_; c = c_; }
    __host__ __device__ bool next(int i, Unit& u) const {
        const long L = (long)i * G + c; if (L >= nwg) return false;
        int wgid = (int)L; { const int q = nwg / NXCD, r = nwg % NXCD, xcd = wgid % NXCD, off = wgid / NXCD; wgid = (xcd < r ? xcd * (q + 1) : r * (q + 1) + (xcd - r) * q) + off; }
        const int nig = WGM * nN, gid = wgid / nig, fm = gid * WGM, gsz = (nM - fm) < WGM ? (nM - fm) : WGM;
        u.pm = fm + ((wgid % nig) % gsz); u.pn = (wgid % nig) / gsz; return true;
    }
    __device__ __forceinline__ void a_ready(const Unit&) const {}
    __device__ __forceinline__ void done(const Unit&) const {}
};
__device__ __forceinline__ unsigned cvt_pk_bf16(float lo, float hi) { unsigned r; asm volatile("v_cvt_pk_bf16_f32 %0, %1, %2" : "=v"(r) : "v"(lo), "v"(hi)); return r; }
template <class Epi, class Sched, bool ALIGN_EPI = false, bool SP2 = false>
__device__ __forceinline__ void gemm_phase(PG8_LAS unsigned char* lds, const Gemm g, const Sched& S, const Epi& E) {
    const int tid = threadIdx.x, wid = __builtin_amdgcn_readfirstlane(tid >> 6), lane = tid & 63, wr = wid >> 2, wc = wid & 3, fr = lane & 15, fq = lane >> 4;
    const int K = g.K, nt = K / BK;
    unsigned voffA[2], voffB[2];
#pragma unroll
    for (int i = 0; i < 2; ++i) { int R, C; stage_rc(tid * 16 + i * 8192, R, C); const int Rb = Epi::PERM ? ((R & ~31) + perm32(R & 31)) : R;
        voffA[i] = (unsigned)(R * K + C) * 2u; voffB[i] = (unsigned)(Rb * K + C) * 2u; }
    const size_t kstep = (size_t)(BK * 2);
    const size_t hstep = (size_t)HALF * K * 2;
    const size_t tstep = 2 * hstep;
    const unsigned ldsw = (unsigned)wid * 1024u;
    const int aoff = lds_byte(wr * 64 + fr, fq * 8), boff = lds_byte(wc * 32 + fr, fq * 8);
#define PG8_SA(b, h) (((b) * 2 + (h)) * HTB)
#define PG8_SB(b, h) ((4 + (b) * 2 + (h)) * HTB)
#define PG8_STAGE(bufoff, gbase, voff) do { _Pragma("unroll") for (int _i = 0; _i < 2; ++_i) \
        __builtin_amdgcn_global_load_lds((const unsigned*)((const char*)(gbase) + (voff)[_i]), (PG8_LAS unsigned*)(lds + (bufoff) + ldsw + _i * 8192), 16, 0, 0); } while (0)
#define PG8_LDA(dst, b, h) do { _Pragma("unroll") for (int m = 0; m < 4; ++m) _Pragma("unroll") for (int k = 0; k < 2; ++k) dst[m][k] = *(const PG8_LAS bf16x8*)(lds + PG8_SA(b, h) + aoff + m * 2048 + k * 1024); } while (0)
#define PG8_LDB(dst, b, h) do { _Pragma("unroll") for (int n = 0; n < 2; ++n) _Pragma("unroll") for (int k = 0; k < 2; ++k) dst[n][k] = *(const PG8_LAS bf16x8*)(lds + PG8_SB(b, h) + boff + n * 2048 + k * 1024); } while (0)
#define PG8_MMA(ai, bj, At, Bt) do { __builtin_amdgcn_s_setprio(1); _Pragma("unroll") for (int m = 0; m < 4; ++m) _Pragma("unroll") for (int n = 0; n < 2; ++n) _Pragma("unroll") for (int k = 0; k < 2; ++k) \
        acc[ai][bj][m][n] = __builtin_amdgcn_mfma_f32_16x16x32_bf16(Bt[n][k], At[m][k], acc[ai][bj][m][n], 0, 0, 0); __builtin_amdgcn_s_setprio(0); } while (0)
#define PG8_WAIT_V(n) asm volatile("s_waitcnt vmcnt(" #n ")" ::: "memory")
#define PG8_WAIT_L(n) asm volatile("s_waitcnt lgkmcnt(" #n ")" ::: "memory")
#define PG8_BAR __builtin_amdgcn_s_barrier()
#define PG8_SCHED __builtin_amdgcn_sched_barrier(0)
    Unit cur, nxt; int ui = 0;
    if (!S.next(0, cur)) return;
    f32x4 acc[2][2][4][2];
#pragma unroll
    for (int a = 0; a < 2; ++a)
#pragma unroll
        for (int b = 0; b < 2; ++b)
#pragma unroll
            for (int m = 0; m < 4; ++m)
#pragma unroll
                for (int n = 0; n < 2; ++n) acc[a][b][m][n] = (f32x4){0.f, 0.f, 0.f, 0.f};
    bf16x8 At[4][2], B0[2][2], B1[2][2];
    const char* cA = (const char*)g.A + (size_t)cur.pm * tstep; const char* cB = (const char*)g.Bt + (size_t)cur.pn * tstep;
    S.a_ready(cur);
    if constexpr (SP2) {
        PG8_STAGE(PG8_SB(0, 0), cB, voffB); PG8_STAGE(PG8_SB(0, 1), cB + hstep, voffB); PG8_STAGE(PG8_SA(0, 0), cA, voffA); PG8_STAGE(PG8_SA(0, 1), cA + hstep, voffA);
        if (wr == 1) PG8_BAR;
        PG8_WAIT_V(2); PG8_BAR;
        PG8_STAGE(PG8_SB(1, 0), cB + kstep, voffB); PG8_STAGE(PG8_SA(1, 0), cA + kstep, voffA); PG8_STAGE(PG8_SB(1, 1), cB + hstep + kstep, voffB);
        PG8_WAIT_V(6); PG8_BAR;
    } else {
        PG8_STAGE(PG8_SB(0, 0), cB, voffB); PG8_STAGE(PG8_SA(0, 0), cA, voffA); PG8_STAGE(PG8_SB(0, 1), cB + hstep, voffB); PG8_STAGE(PG8_SA(0, 1), cA + hstep, voffA);
        if (wr == 1) PG8_BAR;
        PG8_WAIT_V(4); PG8_BAR;
        PG8_STAGE(PG8_SB(1, 0), cB + kstep, voffB); PG8_STAGE(PG8_SA(1, 0), cA + kstep, voffA); PG8_STAGE(PG8_SB(1, 1), cB + hstep + kstep, voffB);
        PG8_WAIT_V(6); PG8_BAR;
    }
    for (;;) {
        const bool has_next = S.next(ui + 1, nxt);
        const char* nA = has_next ? (const char*)g.A + (size_t)nxt.pm * tstep : cA; const char* nB = has_next ? (const char*)g.Bt + (size_t)nxt.pn * tstep : cB;
        for (int t = 0; t < nt; t += 2) {
            const bool last = (t == nt - 2);
            const char* a1 = cA + (size_t)(t + 1) * kstep;
            const char* a2 = last ? nA : cA + (size_t)(t + 2) * kstep; const char* b2 = last ? nB : cB + (size_t)(t + 2) * kstep;
            const char* a3 = a2 + kstep; const char* b3 = b2 + kstep;
            if (last && has_next) S.a_ready(nxt);
            if constexpr (SP2) {
            PG8_LDB(B0, 0, 0); PG8_LDB(B1, 0, 1); PG8_SCHED; PG8_LDA(At, 0, 0); PG8_STAGE(PG8_SA(1, 1), a1 + hstep, voffA);
            PG8_WAIT_V(8); PG8_WAIT_L(0); PG8_BAR; PG8_MMA(0, 0, At, B0); PG8_MMA(0, 1, At, B1); PG8_BAR; PG8_SCHED;
            PG8_LDA(At, 0, 1); PG8_STAGE(PG8_SB(0, 0), b2, voffB); PG8_STAGE(PG8_SB(0, 1), b2 + hstep, voffB); PG8_STAGE(PG8_SA(0, 0), a2, voffA);
            PG8_WAIT_V(8); PG8_WAIT_L(0); PG8_BAR; PG8_MMA(1, 0, At, B0); PG8_MMA(1, 1, At, B1); PG8_BAR; PG8_SCHED;
            PG8_LDB(B0, 1, 0); PG8_LDB(B1, 1, 1); PG8_SCHED; PG8_LDA(At, 1, 0); PG8_STAGE(PG8_SA(0, 1), a2 + hstep, voffA);
            PG8_WAIT_V(8); PG8_WAIT_L(0); PG8_BAR; PG8_MMA(0, 0, At, B0); PG8_MMA(0, 1, At, B1); PG8_BAR; PG8_SCHED;
            PG8_LDA(At, 1, 1); PG8_STAGE(PG8_SB(1, 0), b3, voffB); PG8_STAGE(PG8_SB(1, 1), b3 + hstep, voffB); PG8_STAGE(PG8_SA(1, 0), a3, voffA);
            PG8_WAIT_V(8); PG8_WAIT_L(0); PG8_BAR; PG8_MMA(1, 0, At, B0); PG8_MMA(1, 1, At, B1); PG8_BAR; PG8_SCHED;
            } else {
            PG8_LDB(B0, 0, 0); PG8_SCHED; PG8_LDA(At, 0, 0); PG8_STAGE(PG8_SA(1, 1), a1 + hstep, voffA);
            PG8_WAIT_L(8); PG8_BAR; PG8_WAIT_L(0); PG8_MMA(0, 0, At, B0); PG8_BAR; PG8_SCHED;
            PG8_LDB(B1, 0, 1); PG8_STAGE(PG8_SB(0, 0), b2, voffB);
            PG8_BAR; PG8_WAIT_L(0); PG8_MMA(0, 1, At, B1); PG8_BAR;
            PG8_LDA(At, 0, 1); PG8_STAGE(PG8_SA(0, 0), a2, voffA);
            PG8_BAR; PG8_WAIT_L(0); PG8_MMA(1, 0, At, B0); PG8_BAR; PG8_SCHED;
            PG8_STAGE(PG8_SB(0, 1), b2 + hstep, voffB);
            PG8_WAIT_V(6); PG8_BAR; PG8_MMA(1, 1, At, B1); PG8_BAR;
            PG8_LDB(B0, 1, 0); PG8_SCHED; PG8_LDA(At, 1, 0); PG8_STAGE(PG8_SA(0, 1), a2 + hstep, voffA);
            PG8_WAIT_L(8); PG8_BAR; PG8_WAIT_L(0); PG8_MMA(0, 0, At, B0); PG8_BAR; PG8_SCHED;
            PG8_LDB(B1, 1, 1); PG8_STAGE(PG8_SB(1, 0), b3, voffB);
            PG8_BAR; PG8_WAIT_L(0); PG8_MMA(0, 1, At, B1); PG8_BAR;
            PG8_LDA(At, 1, 1); PG8_STAGE(PG8_SA(1, 0), a3, voffA);
            PG8_BAR; PG8_WAIT_L(0); PG8_MMA(1, 0, At, B0); PG8_BAR; PG8_SCHED;
            PG8_STAGE(PG8_SB(1, 1), b3 + hstep, voffB);
            PG8_WAIT_V(6); PG8_BAR; PG8_MMA(1, 1, At, B1); PG8_BAR;
            }
        }
        if constexpr (ALIGN_EPI) { if (wr == 0) PG8_BAR; }
        if constexpr (!Epi::AFTER_DRAIN) { E(acc, cur, wr, wc, fr, fq); S.done(cur); }
        if (!has_next) break;
#pragma unroll
        for (int a = 0; a < 2; ++a)
#pragma unroll
            for (int b = 0; b < 2; ++b)
#pragma unroll
                for (int m = 0; m < 4; ++m)
#pragma unroll
                    for (int n = 0; n < 2; ++n) acc[a][b][m][n] = (f32x4){0.f, 0.f, 0.f, 0.f};
        cur = nxt; cA = nA; cB = nB; ++ui;
        if constexpr (ALIGN_EPI) { if (wr == 1) PG8_BAR; }
    }
    PG8_WAIT_V(0);
    if constexpr (!ALIGN_EPI) { if (wr == 0) PG8_BAR; }
    PG8_BAR;
    if constexpr (Epi::AFTER_DRAIN) { E.fused(acc, cur, wr, wc, fr, fq, lds, wid, lane); S.done(cur); }
#undef PG8_SA
#undef PG8_SB
#undef PG8_STAGE
#undef PG8_LDA
#undef PG8_LDB
#undef PG8_MMA
#undef PG8_WAIT_V
#undef PG8_WAIT_L
#undef PG8_BAR
#undef PG8_SCHED
}
}

#define LAS __attribute__((address_space(3)))
typedef unsigned short bf16;
typedef short bf16x8 __attribute__((ext_vector_type(8)));
typedef short bf16x4 __attribute__((ext_vector_type(4)));
typedef float f32x4 __attribute__((ext_vector_type(4)));
typedef float f32x16 __attribute__((ext_vector_type(16)));
typedef unsigned u32x4 __attribute__((ext_vector_type(4)));
typedef unsigned u32x2 __attribute__((ext_vector_type(2)));
typedef __bf16 bf16v2_t __attribute__((ext_vector_type(2)));
__device__ __forceinline__ unsigned cvt_pk_bf16(float lo, float hi) { bf16v2_t v; v.x = (__bf16)lo; v.y = (__bf16)hi; return __builtin_bit_cast(unsigned, v); }

constexpr int NWAVES = 8, NTHR = 512;
constexpr int D = 1024, BATCH = 8, SEQ = 4096, M = BATCH * SEQ, MEMLEN = 256;
constexpr int NA = 2048, NB = 2560;
constexpr float EPS = 1e-6f;
constexpr int NPHASE = 19;

constexpr size_t MiB = 1u << 20;
constexpr size_t WS_CTL = 0, CTL_ZERO_BYTES = 1 * MiB;
constexpr size_t WS_WA = 1 * MiB, WS_WB = 5 * MiB, WS_WO = 10 * MiB, WS_WKV = 14 * MiB, WS_WQ = 16 * MiB;
constexpr size_t WS_DEC = 25 * MiB + 512 * 1024, WS_TSC = 26 * MiB, WS_SS = 27 * MiB;
constexpr size_t WS_UK = 24 * MiB, WS_UVT = 24 * MiB + 512 * 1024, WS_SUBK = 25 * MiB;
constexpr size_t WS_MEMN = 32 * MiB, WS_KV = 36 * MiB, WS_HB = 40 * MiB, WS_MIX = 104 * MiB, WS_TAB = 168 * MiB, WS_AR = 232 * MiB, WS_END = 512 * MiB;
constexpr size_t AR_CKV32 = 0, AR_CKV = 32 * MiB, AR_IQ = 48 * MiB, AR_IK = 80 * MiB, AR_IW = 84 * MiB, AR_QL = 88 * MiB, AR_QMEM = 136 * MiB;
constexpr size_t AR_Z = 0, AR_XBC = 48 * MiB, AR_DT = 128 * MiB, AR_XC = 152 * MiB, AR_ST = 232 * MiB, AR_Y = 48 * MiB;
constexpr size_t AR_PQ = 152 * MiB, AR_TOPK = 0;
constexpr int CW_XS = 8192;
constexpr int CW_BAR = 4096;

constexpr int LDS_BYTES = 163840;
constexpr int LDS_SCR = 0, LDS_SCR_BYTES = 161792;
constexpr int LDS_CTL = 161792;

__device__ __forceinline__ float bf2f(unsigned short b) { return __uint_as_float(((unsigned)b) << 16); }
__device__ __forceinline__ float wave_sum(float v) {
#pragma unroll
    for (int o = 1; o < 64; o <<= 1) v += __shfl_xor(v, o);
    return v;
}
__device__ __forceinline__ float wave_max(float v) {
#pragma unroll
    for (int o = 1; o < 64; o <<= 1) v = fmaxf(v, __shfl_xor(v, o));
    return v;
}
#define LDS_WAIT() asm volatile("s_waitcnt lgkmcnt(0)" ::: "memory")
#define VM_WAIT() asm volatile("s_waitcnt vmcnt(0)" ::: "memory")

#define XB_TMO      128
#define XB_XCNT(j)  (256  + 64 * (j))
#define XB_XSUB(j)  (1280 + 64 * (j))
#define XB_XGEN(j)  (2304 + 64 * (j))
#define XB_TOP      3328
#define XB_TOPGEN   3392
#define XCD_BAR_WORDS 3456
#define XB_SPIN_CAP (1u << 22)

__device__ __forceinline__ unsigned xb_ld(unsigned* p)              { return __hip_atomic_load(p, __ATOMIC_RELAXED, __HIP_MEMORY_SCOPE_AGENT); }
__device__ __forceinline__ unsigned xb_add(unsigned* p, unsigned v) { return __hip_atomic_fetch_add(p, v, __ATOMIC_RELAXED, __HIP_MEMORY_SCOPE_AGENT); }
__device__ __forceinline__ unsigned xb_xcc_id() { return (unsigned)__builtin_amdgcn_s_getreg((3 << 11) | 20) & 0xFu; }
#define XB_SPIN(cond, bar) do { unsigned _sp = 0; while (cond) { __builtin_amdgcn_s_sleep(1); \
    if ((++_sp & 255u) == 0u) { if (xb_ld(&(bar)[XB_TMO])) break; if (_sp > XB_SPIN_CAP) { atomicAdd(&(bar)[XB_TMO], 1u); break; } } } } while (0)

struct XcdBarrier {
    unsigned* bar; unsigned x;
    volatile LAS unsigned* st;
};

__device__ __forceinline__ XcdBarrier xcd_barrier_post(unsigned* bar, volatile LAS unsigned* st) {
    XcdBarrier b; b.bar = bar; b.x = xb_xcc_id(); b.st = st;
    if (threadIdx.x == 0) (void)xb_add(&bar[XB_XCNT(b.x)], 1u);
    return b;
}
__device__ __forceinline__ void xcd_barrier_complete(unsigned* bar, unsigned x, unsigned& nloc, unsigned& nx) {
    const unsigned G = gridDim.x * gridDim.y * gridDim.z;
    unsigned sum, cnt, mine, sp = 0u;
    for (;;) {
        sum = 0u; cnt = 0u; mine = 0u;
#pragma unroll
        for (unsigned j = 0; j < 16; ++j) { const unsigned c = xb_ld(&bar[XB_XCNT(j)]); sum += c; cnt += (c > 0u) ? 1u : 0u; mine = (j == x) ? c : mine; }
        if (sum == G) break;
        __builtin_amdgcn_s_sleep(1);
        if ((++sp & 255u) == 0u) { if (xb_ld(&bar[XB_TMO])) break; if (sp > XB_SPIN_CAP) { atomicAdd(&bar[XB_TMO], 1u); break; } }
    }
    nloc = mine > 0u ? mine : 1u; nx = cnt > 0u ? cnt : 1u;
}

__device__ __forceinline__ void xcd_barrier(const XcdBarrier& b) {
    asm volatile("s_waitcnt vmcnt(0)" ::: "memory");
    __syncthreads();
    if (threadIdx.x == 0) {
        unsigned* bar = b.bar;
        __builtin_amdgcn_s_waitcnt(0);
        unsigned nloc = b.st[0], nx = b.st[1];
        if (nloc == 0u) { xcd_barrier_complete(bar, b.x, nloc, nx); b.st[0] = nloc; b.st[1] = nx; }
        const unsigned old = xb_add(&bar[XB_XSUB(b.x)], 1u);
        const unsigned gen = old / nloc;
        if (old + 1u == (gen + 1u) * nloc) {
            __builtin_amdgcn_fence(__ATOMIC_RELEASE, "agent");
            asm volatile("s_waitcnt vmcnt(0)" ::: "memory");
            const unsigned og = xb_add(&bar[XB_TOP], 1u);
            const unsigned tg = og / nx;
            if (og + 1u == (tg + 1u) * nx) xb_add(&bar[XB_TOPGEN], 1u);
            else XB_SPIN(xb_ld(&bar[XB_TOPGEN]) == tg, bar);
            __builtin_amdgcn_fence(__ATOMIC_ACQUIRE, "agent");
            xb_add(&bar[XB_XGEN(b.x)], 1u);
            asm volatile("s_waitcnt vmcnt(0)" ::: "memory");
        } else {
            XB_SPIN(xb_ld(&bar[XB_XGEN(b.x)]) == gen, bar);
            __builtin_amdgcn_fence(__ATOMIC_ACQUIRE, "agent");
            asm volatile("s_waitcnt vmcnt(0)" ::: "memory");
        }
    }
    __syncthreads();
}

struct Args { const float* in[24]; float* out; unsigned char* ws; int ph_lo, ph_hi; };
enum { I_X = 0, I_MEM, I_MEMNORM, I_RELBIAS, I_MIXNORM, I_FFNNORM, I_FINALNORM, I_WO, I_WMEMKV, I_AWIN, I_AKVNORM, I_AWUK, I_AWUV,
       I_BWIN, I_BCONVW, I_BCONVB, I_BDTBIAS, I_BALOG, I_BDSKIP, I_BOUTNORM, I_PWQ, I_PSUBK, I_PU, I_PV };

__device__ __forceinline__ u32x4 pack8(const f32x4 v0, const f32x4 v1) {
    u32x4 w; w.x = pg8::cvt_pk_bf16(v0[0], v0[1]); w.y = pg8::cvt_pk_bf16(v0[2], v0[3]); w.z = pg8::cvt_pk_bf16(v1[0], v1[1]); w.w = pg8::cvt_pk_bf16(v1[2], v1[3]); return w;
}
struct EpiPlain {
    static constexpr bool PERM = true, AFTER_DRAIN = false;
    bf16* O; int ld;
    __device__ __forceinline__ void operator()(const f32x4 (&acc)[2][2][4][2], const pg8::Unit& u, int wr, int wc, int fr, int fq) const {
        const int row0 = u.pm * 256 + wr * 64 + fr, col0 = u.pn * 256 + wc * 32 + 8 * fq;
#pragma unroll
        for (int ai = 0; ai < 2; ++ai)
#pragma unroll
            for (int m = 0; m < 4; ++m) { bf16* rowp = O + (size_t)(row0 + ai * 128 + m * 16) * ld + col0;
#pragma unroll
                for (int bj = 0; bj < 2; ++bj) *(u32x4*)(rowp + bj * 128) = pack8(acc[ai][bj][m][0], acc[ai][bj][m][1]); }
    }
};
struct EpiInA {
    static constexpr bool PERM = true, AFTER_DRAIN = false;
    bf16* Q; float* CKV32; bf16* IQ; bf16* QMEM; bf16* IK; float* IW;
    __device__ __forceinline__ void operator()(const f32x4 (&acc)[2][2][4][2], const pg8::Unit& u, int wr, int wc, int fr, int fq) const {
        const int row0 = u.pm * 256 + wr * 64 + fr, cb0 = wc * 32 + 8 * fq, pn = u.pn;
#pragma unroll
        for (int ai = 0; ai < 2; ++ai)
#pragma unroll
            for (int m = 0; m < 4; ++m) { const size_t row = (size_t)(row0 + ai * 128 + m * 16);
#pragma unroll
                for (int bj = 0; bj < 2; ++bj) { const int cb = cb0 + bj * 128; const f32x4 v0 = acc[ai][bj][m][0], v1 = acc[ai][bj][m][1];
                    if (pn < 3) *(u32x4*)(Q + row * 768 + pn * 256 + cb) = pack8(v0, v1);
                    else if (pn == 3) { *(f32x4*)(CKV32 + row * 256 + cb) = v0; *(f32x4*)(CKV32 + row * 256 + cb + 4) = v1; }
                    else if (pn < 6) *(u32x4*)(IQ + row * 512 + (pn - 4) * 256 + cb) = pack8(v0, v1);
                    else if (pn == 6) *(u32x4*)(QMEM + row * 256 + cb) = pack8(v0, v1);
                    else { if (cb < 64) *(u32x4*)(IK + row * 64 + cb) = pack8(v0, v1);
                           else if (cb == 64) { *(f32x4*)(IW + row * 8) = v0; *(f32x4*)(IW + row * 8 + 4) = v1; } } } }
    }
};
struct EpiInB {
    static constexpr bool PERM = true, AFTER_DRAIN = false;
    bf16* Z; bf16* XBC; bf16* QMEM; float* DT;
    __device__ __forceinline__ void operator()(const f32x4 (&acc)[2][2][4][2], const pg8::Unit& u, int wr, int wc, int fr, int fq) const {
        const int row0 = u.pm * 256 + wr * 64 + fr, cb0 = wc * 32 + 8 * fq, pn = u.pn;
#pragma unroll
        for (int ai = 0; ai < 2; ++ai)
#pragma unroll
            for (int m = 0; m < 4; ++m) { const size_t row = (size_t)(row0 + ai * 128 + m * 16);
#pragma unroll
                for (int bj = 0; bj < 2; ++bj) { const int cb = cb0 + bj * 128; const f32x4 v0 = acc[ai][bj][m][0], v1 = acc[ai][bj][m][1];
                    if (pn < 3) *(u32x4*)(Z + row * 768 + pn * 256 + cb) = pack8(v0, v1);
                    else if (pn < 8) *(u32x4*)(XBC + row * 1280 + (pn - 3) * 256 + cb) = pack8(v0, v1);
                    else if (pn == 8) *(u32x4*)(QMEM + row * 256 + cb) = pack8(v0, v1);
                    else if (cb < 16) { *(f32x4*)(DT + row * 16 + cb) = v0; *(f32x4*)(DT + row * 16 + cb + 4) = v1; } } }
    }
};
template <bool RES_BF16> struct EpiResid {
    static constexpr bool PERM = false, AFTER_DRAIN = false;
    const void* RES; bf16* XB; float* SS;
    __device__ __forceinline__ void operator()(const f32x4 (&acc)[2][2][4][2], const pg8::Unit& u, int wr, int wc, int fr, int fq) const {
        const int row0 = u.pm * 256 + wr * 64 + fr, col0 = u.pn * 256 + wc * 32 + 4 * fq;
#pragma unroll
        for (int ai = 0; ai < 2; ++ai) {
            f32x4 r[4][2][2];
#pragma unroll
            for (int m = 0; m < 4; ++m) { const size_t ro = (size_t)(row0 + ai * 128 + m * 16) * 1024 + col0;
#pragma unroll
                for (int bj = 0; bj < 2; ++bj)
#pragma unroll
                    for (int n = 0; n < 2; ++n) {
                        if (RES_BF16) { const u32x2 t = *(const u32x2*)((const bf16*)RES + ro + bj * 128 + n * 16);
                            r[m][bj][n] = (f32x4){__uint_as_float(t.x << 16), __uint_as_float(t.x & 0xffff0000u), __uint_as_float(t.y << 16), __uint_as_float(t.y & 0xffff0000u)}; }
                        else r[m][bj][n] = *(const f32x4*)((const float*)RES + ro + bj * 128 + n * 16); } }
#pragma unroll
            for (int m = 0; m < 4; ++m) { const int row = row0 + ai * 128 + m * 16; const size_t ro = (size_t)row * 1024 + col0; float ss = 0.f;
#pragma unroll
                for (int bj = 0; bj < 2; ++bj)
#pragma unroll
                    for (int n = 0; n < 2; ++n) { const f32x4 o = r[m][bj][n] + acc[ai][bj][m][n];
                        u32x2 w; w.x = cvt_pk_bf16(o[0], o[1]); w.y = cvt_pk_bf16(o[2], o[3]); *(u32x2*)(XB + ro + bj * 128 + n * 16) = w;
                        ss += (o[0] * o[0] + o[1] * o[1]) + (o[2] * o[2] + o[3] * o[3]); }
                { const auto a = __builtin_amdgcn_permlane16_swap(__float_as_uint(ss), __float_as_uint(ss), false, false); ss = __uint_as_float(a[0]) + __uint_as_float(a[1]); }
                { const auto b = __builtin_amdgcn_permlane32_swap(__float_as_uint(ss), __float_as_uint(ss), false, false); ss = __uint_as_float(b[0]) + __uint_as_float(b[1]); }
                if (fq == 0) atomicAdd(SS + row, ss); } }
    }
};
struct EpiPQ {
    static constexpr bool PERM = true, AFTER_DRAIN = false;
    bf16* O; const float* SS;
    __device__ __forceinline__ void operator()(const f32x4 (&acc)[2][2][4][2], const pg8::Unit& u, int wr, int wc, int fr, int fq) const {
        const int row0 = u.pm * 256 + wr * 64 + fr, col0 = u.pn * 256 + wc * 32 + 8 * fq;
#pragma unroll
        for (int ai = 0; ai < 2; ++ai)
#pragma unroll
            for (int m = 0; m < 4; ++m) { const int row = row0 + ai * 128 + m * 16; const float rs = 1.0f / sqrtf(SS[row] * (1.f / 1024.f) + EPS); bf16* rowp = O + (size_t)row * 2048 + col0;
#pragma unroll
                for (int bj = 0; bj < 2; ++bj) *(u32x4*)(rowp + bj * 128) = pack8(acc[ai][bj][m][0] * rs, acc[ai][bj][m][1] * rs); }
    }
};

__device__ __forceinline__ void transpose_item(const float* W, int ldw, int src0, int ncols, bf16* WT, int dst0, LAS float* scr, int item, int lane, const float* kgain = nullptr) {
    const int nblk = (ncols + 31) >> 5, kb = item / nblk, nb = item - kb * nblk, k0 = 64 * kb, n0 = 32 * nb;
    const int nn = n0 + (lane & 31);
#pragma unroll 8
    for (int i = 0; i < 32; ++i) { const int kk = 2 * i + (lane >> 5); const float gk = kgain ? kgain[k0 + kk] : 1.0f; scr[kk * 33 + (lane & 31)] = (nn < ncols) ? W[(size_t)(k0 + kk) * ldw + src0 + nn] * gk : 0.f; }
    LDS_WAIT(); asm volatile("" ::: "memory");
    const int c = lane & 7;
#pragma unroll
    for (int j = 0; j < 4; ++j) { const int n = (lane >> 3) + 8 * j; const LAS float* s = scr + (8 * c) * 33 + n;
        u32x4 o; o.x = cvt_pk_bf16(s[0 * 33], s[1 * 33]); o.y = cvt_pk_bf16(s[2 * 33], s[3 * 33]); o.z = cvt_pk_bf16(s[4 * 33], s[5 * 33]); o.w = cvt_pk_bf16(s[6 * 33], s[7 * 33]);
        if (n0 + n < ncols) *(u32x4*)(WT + (size_t)(dst0 + n0 + n) * 1024 + k0 + 8 * c) = o; }
    LDS_WAIT(); asm volatile("" ::: "memory");
}
__device__ __forceinline__ int titems(int ncols) { return 16 * ((ncols + 31) >> 5); }
__device__ __forceinline__ void rms_row_to_bf16(const float* xrow, const float* g, bf16* orow, int lane) {
    const f32x4* xr = (const f32x4*)xrow + lane; const f32x4* gr = (const f32x4*)g + lane;
    f32x4 v[4]; float s = 0.f;
#pragma unroll
    for (int j = 0; j < 4; ++j) { v[j] = xr[64 * j]; s += (v[j].x * v[j].x + v[j].y * v[j].y) + (v[j].z * v[j].z + v[j].w * v[j].w); }
    const float rstd = 1.0f / sqrtf(wave_sum(s) * (1.f / 1024.f) + EPS);
    u32x2* o8 = (u32x2*)orow + lane;
#pragma unroll
    for (int j = 0; j < 4; ++j) { const f32x4 gg = gr[64 * j]; u32x2 o; o.x = cvt_pk_bf16(v[j].x * rstd * gg.x, v[j].y * rstd * gg.y); o.y = cvt_pk_bf16(v[j].z * rstd * gg.z, v[j].w * rstd * gg.w); o8[64 * j] = o; }
}
__device__ __forceinline__ void rms_rows4_to_bf16(const float* x0, size_t rstride, const float* g, bf16* o0, int lane) {
    f32x4 v[4][4];
#pragma unroll
    for (int i = 0; i < 4; ++i) { const f32x4* xr = (const f32x4*)(x0 + (size_t)i * rstride) + lane;
#pragma unroll
        for (int j = 0; j < 4; ++j) v[i][j] = xr[64 * j]; }
    const f32x4* gr = (const f32x4*)g + lane;
#pragma unroll
    for (int i = 0; i < 4; ++i) { float s = 0.f;
#pragma unroll
        for (int j = 0; j < 4; ++j) s += (v[i][j].x * v[i][j].x + v[i][j].y * v[i][j].y) + (v[i][j].z * v[i][j].z + v[i][j].w * v[i][j].w);
        const float rstd = 1.0f / sqrtf(wave_sum(s) * (1.f / 1024.f) + EPS);
        u32x2* o8 = (u32x2*)(o0 + (size_t)i * rstride) + lane;
#pragma unroll
        for (int j = 0; j < 4; ++j) { const f32x4 gg = gr[64 * j]; u32x2 o; o.x = cvt_pk_bf16(v[i][j].x * rstd * gg.x, v[i][j].y * rstd * gg.y); o.y = cvt_pk_bf16(v[i][j].z * rstd * gg.z, v[i][j].w * rstd * gg.w); o8[64 * j] = o; } }
}
__device__ __forceinline__ void rms_row_to_f32(const float* xrow, const float* g, float* orow, int lane) {
    const f32x4* xr = (const f32x4*)xrow + lane; const f32x4* gr = (const f32x4*)g + lane;
    f32x4 v[4]; float s = 0.f;
#pragma unroll
    for (int j = 0; j < 4; ++j) { v[j] = xr[64 * j]; s += (v[j].x * v[j].x + v[j].y * v[j].y) + (v[j].z * v[j].z + v[j].w * v[j].w); }
    const float rstd = 1.0f / sqrtf(wave_sum(s) * (1.f / 1024.f) + EPS);
    f32x4* o = (f32x4*)orow + lane;
#pragma unroll
    for (int j = 0; j < 4; ++j) { const f32x4 gg = gr[64 * j]; o[64 * j] = v[j] * rstd * gg; }
}
__device__ __forceinline__ void cvt_stream(const float* src, bf16* dst, size_t n, size_t gtid, size_t gthreads) {
    for (size_t i = gtid * 8; i < n; i += gthreads * 8) { const f32x4 a = *(const f32x4*)(src + i), b = *(const f32x4*)(src + i + 4); *(u32x4*)(dst + i) = pack8(a, b); }
}

__device__ __forceinline__ void memattn_unit(LAS unsigned char* lds, int unit, int layer, const bf16* KV, const bf16* QMEM, bf16* MIX, int tid, int wave, int lane) {
    const int b = unit >> 6, qb = (unit >> 2) & 15, hd = unit & 3;
    const bf16* kvb = KV + (size_t)(b * 256) * 1024 + layer * 512 + hd * 64;
    LAS unsigned char* Ks = lds; LAS unsigned char* Vt = lds + 36864;
    for (int idx = tid; idx < 2048; idx += NTHR) { const int key = idx >> 3, ch = idx & 7;
        const u32x4 kk = *(const u32x4*)(kvb + (size_t)key * 1024 + ch * 8);
        *(LAS u32x4*)(Ks + key * 144 + ch * 16) = kk;
        const u32x4 vv = *(const u32x4*)(kvb + 256 + (size_t)key * 1024 + ch * 8);
#pragma unroll
        for (int e = 0; e < 4; ++e) { const unsigned w = vv[e];
            *(LAS unsigned short*)(Vt + (ch * 8 + 2 * e) * 520 + key * 2) = (unsigned short)(w & 0xffffu);
            *(LAS unsigned short*)(Vt + (ch * 8 + 2 * e + 1) * 520 + key * 2) = (unsigned short)(w >> 16); } }
    __syncthreads();
    const int q = lane & 31, hh = lane >> 5;
    const size_t t = (size_t)b * SEQ + qb * 256 + wave * 32 + q;
    bf16x8 qf[4];
#pragma unroll
    for (int ks = 0; ks < 4; ++ks) qf[ks] = *(const bf16x8*)(QMEM + t * 256 + hd * 64 + ks * 16 + hh * 8);
    f32x16 s[8];
#pragma unroll
    for (int kt = 0; kt < 8; ++kt) {
#pragma unroll
        for (int r = 0; r < 16; ++r) s[kt][r] = 0.f;
#pragma unroll
        for (int ks = 0; ks < 4; ++ks) { const bf16x8 a = *(const LAS bf16x8*)(Ks + (kt * 32 + q) * 144 + (ks * 16 + hh * 8) * 2);
            s[kt] = __builtin_amdgcn_mfma_f32_32x32x16_bf16(a, qf[ks], s[kt], 0, 0, 0); } }
    float mx = -3.0e38f;
#pragma unroll
    for (int kt = 0; kt < 8; ++kt)
#pragma unroll
        for (int r = 0; r < 16; ++r) mx = fmaxf(mx, s[kt][r]);
    mx = fmaxf(mx, __shfl_xor(mx, 32));
    float l = 0.f;
#pragma unroll
    for (int kt = 0; kt < 8; ++kt)
#pragma unroll
        for (int r = 0; r < 16; ++r) { const float p = __expf((s[kt][r] - mx) * 0.125f); s[kt][r] = p; l += p; }
    l += __shfl_xor(l, 32);
    f32x16 o[2];
#pragma unroll
    for (int dt = 0; dt < 2; ++dt)
#pragma unroll
        for (int r = 0; r < 16; ++r) o[dt][r] = 0.f;
#pragma unroll
    for (int kt = 0; kt < 8; ++kt)
#pragma unroll
        for (int si = 0; si < 2; ++si) {
            union { bf16x8 v; unsigned u[4]; } pb;
#pragma unroll
            for (int e = 0; e < 4; ++e) pb.u[e] = cvt_pk_bf16(s[kt][8 * si + 2 * e], s[kt][8 * si + 2 * e + 1]);
#pragma unroll
            for (int dt = 0; dt < 2; ++dt) { const LAS unsigned char* vp = Vt + (dt * 32 + q) * 520 + (kt * 32 + 16 * si + 4 * hh) * 2;
                union { bf16x8 v; u32x2 h[2]; } va; va.h[0] = *(const LAS u32x2*)vp; va.h[1] = *(const LAS u32x2*)(vp + 16);
                o[dt] = __builtin_amdgcn_mfma_f32_32x32x16_bf16(va.v, pb.v, o[dt], 0, 0, 0); } }
    const float inv = 1.0f / l;
#pragma unroll
    for (int dt = 0; dt < 2; ++dt)
#pragma unroll
        for (int g = 0; g < 4; ++g) { u32x2 w; w.x = cvt_pk_bf16(o[dt][4 * g] * inv, o[dt][4 * g + 1] * inv); w.y = cvt_pk_bf16(o[dt][4 * g + 2] * inv, o[dt][4 * g + 3] * inv);
            *(u32x2*)(MIX + t * 1024 + 768 + hd * 64 + dt * 32 + 8 * g + 4 * hh) = w; }
    __syncthreads();
}

constexpr int SS_ACS = 0, SS_DTV = 6144, SS_WW = 12288, SS_XS = 18432;
constexpr int SS_BT = SS_XS + 6 * 64 * 272;
static_assert(SS_BT + 128 * 272 <= LDS_SCR_BYTES, "SSD LDS map");

__device__ __forceinline__ float softplus_f(float x) { return fmaxf(x, 0.f) + log1pf(__expf(-fabsf(x))); }
__device__ __forceinline__ float silu_f(float v) { return v / (1.0f + __expf(-v)); }

__device__ __forceinline__ void ssd_chunk_scalars(LAS unsigned char* lds, const float* DT, size_t t0, const float* dt_bias, const float* a_log, float* dec, int wave, int lane) {
    LAS float* ACS = (LAS float*)(lds + SS_ACS); LAS float* DTV = (LAS float*)(lds + SS_DTV); LAS float* WW = (LAS float*)(lds + SS_WW);
    for (int h = wave; h < 12; h += NWAVES) {
        const float bias = dt_bias[h], a = -__expf(a_log[h]);
        const float d0 = softplus_f(DT[(t0 + 2 * lane) * 16 + h] + bias), d1 = softplus_f(DT[(t0 + 2 * lane + 1) * 16 + h] + bias);
        const float da0 = d0 * a, da1 = d1 * a;
        float v = da0 + da1;
#pragma unroll
        for (int o = 1; o < 64; o <<= 1) { const float t = __shfl_up(v, o); if (lane >= o) v += t; }
        const float total = __shfl(v, 63);
        const float c1 = v, c0 = v - da1;
        ACS[h * 128 + 2 * lane] = c0; ACS[h * 128 + 2 * lane + 1] = c1;
        DTV[h * 128 + 2 * lane] = d0; DTV[h * 128 + 2 * lane + 1] = d1;
        WW[h * 128 + 2 * lane] = __expf(total - c0) * d0; WW[h * 128 + 2 * lane + 1] = __expf(total - c1) * d1;
        if (dec != nullptr && lane == 0) dec[h] = __expf(total);
    }
}

__device__ __forceinline__ void ssd_states_unit(LAS unsigned char* lds, int unit, const bf16* XBC, const float* DT, const float* conv_w, const float* conv_b,
                                                const float* dt_bias, const float* a_log, bf16* XC, bf16* STATES, float* DEC, int tid, int wave, int lane) {
    const int b = unit >> 5, c = unit & 31; const size_t t0 = (size_t)b * SEQ + c * 128;
    __syncthreads();
    ssd_chunk_scalars(lds, DT, t0, dt_bias, a_log, DEC + (size_t)unit * 12, wave, lane);
    __syncthreads();
    const LAS float* WW = (const LAS float*)(lds + SS_WW);
    const int q = lane & 31, hh = lane >> 5;
    for (int g = 0; g < 2; ++g) {
        for (int idx = tid; idx < 1280; idx += NTHR) {
            const int cg = idx % 80, tg = idx / 80;
            const int col = cg < 48 ? g * 384 + cg * 8 : (cg < 64 ? 768 + g * 128 + (cg - 48) * 8 : 1024 + g * 128 + (cg - 64) * 8);
            float w[4][8], bs[8];
#pragma unroll
            for (int j = 0; j < 4; ++j) { const f32x4 a = *(const f32x4*)(conv_w + j * 1280 + col), bb = *(const f32x4*)(conv_w + j * 1280 + col + 4);
                w[j][0] = a.x; w[j][1] = a.y; w[j][2] = a.z; w[j][3] = a.w; w[j][4] = bb.x; w[j][5] = bb.y; w[j][6] = bb.z; w[j][7] = bb.w; }
            { const f32x4 a = *(const f32x4*)(conv_b + col), bb = *(const f32x4*)(conv_b + col + 4); bs[0] = a.x; bs[1] = a.y; bs[2] = a.z; bs[3] = a.w; bs[4] = bb.x; bs[5] = bb.y; bs[6] = bb.z; bs[7] = bb.w; }
            u32x4 rows[11];
#pragma unroll
            for (int i = 0; i < 11; ++i) { const int lt = tg * 8 - 3 + i;
                rows[i] = (c * 128 + lt >= 0) ? *(const u32x4*)(XBC + (t0 + lt) * 1280 + col) : (u32x4){0u, 0u, 0u, 0u}; }
            float o[8][8];
#pragma unroll
            for (int tt = 0; tt < 8; ++tt)
#pragma unroll
                for (int e = 0; e < 8; ++e) { float acc = bs[e];
#pragma unroll
                    for (int j = 0; j < 4; ++j) { const unsigned wd = rows[tt + j][e >> 1]; const float xv = (e & 1) ? __uint_as_float(wd & 0xffff0000u) : __uint_as_float(wd << 16); acc += w[j][e] * xv; }
                    o[tt][e] = silu_f(acc); }
#pragma unroll
            for (int tt = 0; tt < 8; ++tt) { u32x4 pk; pk.x = pg8::cvt_pk_bf16(o[tt][0], o[tt][1]); pk.y = pg8::cvt_pk_bf16(o[tt][2], o[tt][3]); pk.z = pg8::cvt_pk_bf16(o[tt][4], o[tt][5]); pk.w = pg8::cvt_pk_bf16(o[tt][6], o[tt][7]);
                *(u32x4*)(XC + (t0 + tg * 8 + tt) * 1280 + col) = pk; }
            if (cg < 48) {
                const int hl = cg >> 3, h = g * 6 + hl;
                float ws8[8];
#pragma unroll
                for (int tt = 0; tt < 8; ++tt) ws8[tt] = WW[h * 128 + tg * 8 + tt];
#pragma unroll
                for (int e = 0; e < 8; ++e) { u32x4 pk; pk.x = pg8::cvt_pk_bf16(o[0][e] * ws8[0], o[1][e] * ws8[1]); pk.y = pg8::cvt_pk_bf16(o[2][e] * ws8[2], o[3][e] * ws8[3]);
                    pk.z = pg8::cvt_pk_bf16(o[4][e] * ws8[4], o[5][e] * ws8[5]); pk.w = pg8::cvt_pk_bf16(o[6][e] * ws8[6], o[7][e] * ws8[7]);
                    *(LAS u32x4*)(lds + SS_XS + (cg * 8 + e) * 272 + tg * 16) = pk; }
            } else if (cg < 64) {
#pragma unroll
                for (int e = 0; e < 8; ++e) { u32x4 pk; pk.x = pg8::cvt_pk_bf16(o[0][e], o[1][e]); pk.y = pg8::cvt_pk_bf16(o[2][e], o[3][e]); pk.z = pg8::cvt_pk_bf16(o[4][e], o[5][e]); pk.w = pg8::cvt_pk_bf16(o[6][e], o[7][e]);
                    *(LAS u32x4*)(lds + SS_BT + ((cg - 48) * 8 + e) * 272 + tg * 16) = pk; }
            }
        }
        __syncthreads();
        const int pt = wave >> 2, nt = wave & 3;
#pragma unroll 1
        for (int hl = 0; hl < 6; ++hl) {
            f32x16 acc;
#pragma unroll
            for (int r = 0; r < 16; ++r) acc[r] = 0.f;
#pragma unroll
            for (int ks = 0; ks < 8; ++ks) {
                const bf16x8 a = *(const LAS bf16x8*)(lds + SS_XS + (hl * 64 + pt * 32 + q) * 272 + (ks * 16 + hh * 8) * 2);
                const bf16x8 bb = *(const LAS bf16x8*)(lds + SS_BT + (nt * 32 + q) * 272 + (ks * 16 + hh * 8) * 2);
                acc = __builtin_amdgcn_mfma_f32_32x32x16_bf16(a, bb, acc, 0, 0, 0); }
            bf16* st = STATES + ((size_t)unit * 12 + g * 6 + hl) * 8192 + nt * 32 + q;
#pragma unroll
            for (int r = 0; r < 16; ++r) { const int p = pt * 32 + (r & 3) + 8 * (r >> 2) + 4 * hh; st[p * 128] = (bf16)(cvt_pk_bf16(acc[r], 0.f) & 0xffffu); }
        }
        __syncthreads();
    }
}

__device__ __forceinline__ void ssd_scan(bf16* STATES, const float* DEC, size_t gtid, size_t gthreads) {
    for (size_t i = gtid; i < (size_t)BATCH * 12 * 64 * 16; i += gthreads) {
        const int b = (int)(i / (12 * 64 * 16)); const int rem = (int)(i - (size_t)b * (12 * 64 * 16)); const int h = rem / 1024, pn = rem - h * 1024;
        float hs[8];
#pragma unroll
        for (int e = 0; e < 8; ++e) hs[e] = 0.f;
        bf16* base = STATES + ((size_t)b * 32 * 12 + h) * 8192 + (size_t)pn * 8;
#pragma unroll 4
        for (int c = 0; c < 32; ++c) {
            bf16* p = base + (size_t)c * 12 * 8192;
            const u32x4 sv = *(const u32x4*)p; const float dc = DEC[(b * 32 + c) * 12 + h];
            u32x4 ov; ov.x = cvt_pk_bf16(hs[0], hs[1]); ov.y = cvt_pk_bf16(hs[2], hs[3]); ov.z = cvt_pk_bf16(hs[4], hs[5]); ov.w = cvt_pk_bf16(hs[6], hs[7]);
            *(u32x4*)p = ov;
#pragma unroll
            for (int e = 0; e < 4; ++e) { hs[2 * e] = hs[2 * e] * dc + __uint_as_float(sv[e] << 16); hs[2 * e + 1] = hs[2 * e + 1] * dc + __uint_as_float(sv[e] & 0xffff0000u); }
        }
    }
}

__device__ __forceinline__ void ssd_out_unit(LAS unsigned char* lds, int unit, const bf16* XC, const float* DT, const bf16* Z, const bf16* HPREV, const float* dt_bias, const float* a_log,
                                             const float* d_skip, const float* out_norm, bf16* Y, bf16* MIX, int tid, int wave, int lane) {
    const int b = unit >> 5, c = unit & 31; const size_t t0 = (size_t)b * SEQ + c * 128;
    __syncthreads();
    ssd_chunk_scalars(lds, DT, t0, dt_bias, a_log, nullptr, wave, lane);
    const LAS float* ACS = (const LAS float*)(lds + SS_ACS); const LAS float* DTV = (const LAS float*)(lds + SS_DTV);
    const int q = lane & 31, hh = lane >> 5, lt = wave >> 1, pt = wave & 1;
    const bf16* hp = HPREV + (size_t)unit * 12 * 8192;
    unsigned dmask = 0u;
#pragma unroll
    for (int r = 0; r < 16; ++r) dmask |= (((r & 3) + 8 * (r >> 2) + 4 * hh) <= q) ? (1u << r) : 0u;
    for (int g = 0; g < 2; ++g) {
        __syncthreads();
        for (int idx = tid; idx < 768; idx += NTHR) { const int cg = idx % 48, tg = idx / 48;
            u32x4 rows[8];
#pragma unroll
            for (int i = 0; i < 8; ++i) rows[i] = *(const u32x4*)(XC + (t0 + tg * 8 + i) * 1280 + g * 384 + cg * 8);
#pragma unroll
            for (int e = 0; e < 8; ++e) { u32x4 pk;
#pragma unroll
                for (int k2 = 0; k2 < 4; ++k2) { const unsigned lo = rows[2 * k2][e >> 1], hi2 = rows[2 * k2 + 1][e >> 1];
                    pk[k2] = (e & 1) ? ((lo >> 16) | (hi2 & 0xffff0000u)) : ((lo & 0xffffu) | (hi2 << 16)); }
                *(LAS u32x4*)(lds + SS_XS + (cg * 8 + e) * 272 + tg * 16) = pk; } }
        bf16x8 cf[8];
#pragma unroll
        for (int ks = 0; ks < 8; ++ks) cf[ks] = *(const bf16x8*)(XC + (t0 + lt * 32 + q) * 1280 + 1024 + g * 128 + ks * 16 + hh * 8);
        f32x16 cb[4];
#pragma unroll
        for (int st = 0; st < 4; ++st) {
#pragma unroll
            for (int r = 0; r < 16; ++r) cb[st][r] = 0.f;
            if (st <= lt) {
#pragma unroll
                for (int ks = 0; ks < 8; ++ks) { const bf16x8 a = *(const bf16x8*)(XC + (t0 + st * 32 + q) * 1280 + 768 + g * 128 + ks * 16 + hh * 8);
                    cb[st] = __builtin_amdgcn_mfma_f32_32x32x16_bf16(a, cf[ks], cb[st], 0, 0, 0); } } }
        __syncthreads();
#pragma unroll 1
        for (int hl = 0; hl < 6; ++hl) {
            const int h = g * 6 + hl;
            f32x16 yd, yo;
#pragma unroll
            for (int r = 0; r < 16; ++r) { yd[r] = 0.f; yo[r] = 0.f; }
            const int l = lt * 32 + q; const float al = ACS[h * 128 + l];
#pragma unroll
            for (int st = 0; st < 4; ++st) {
                if (st <= lt) {
                    float mm[16];
#pragma unroll
                    for (int r = 0; r < 16; ++r) { const int s = st * 32 + (r & 3) + 8 * (r >> 2) + 4 * hh;
                        const float v = cb[st][r] * __expf(al - ACS[h * 128 + s]) * DTV[h * 128 + s]; mm[r] = (st < lt || ((dmask >> r) & 1u)) ? v : 0.f; }
#pragma unroll
                    for (int si = 0; si < 2; ++si) {
                        union { bf16x8 v; unsigned u[4]; } af;
#pragma unroll
                        for (int e = 0; e < 4; ++e) af.u[e] = cvt_pk_bf16(mm[8 * si + 2 * e], mm[8 * si + 2 * e + 1]);
                        const LAS unsigned char* xp = lds + SS_XS + (hl * 64 + pt * 32 + q) * 272 + (st * 32 + 16 * si + 4 * hh) * 2;
                        union { bf16x8 v; u32x2 hv[2]; } xb; xb.hv[0] = *(const LAS u32x2*)xp; xb.hv[1] = *(const LAS u32x2*)(xp + 16);
                        yd = __builtin_amdgcn_mfma_f32_32x32x16_bf16(af.v, xb.v, yd, 0, 0, 0); } } }
#pragma unroll
            for (int ks = 0; ks < 8; ++ks) { const bf16x8 hb = *(const bf16x8*)(hp + (size_t)h * 8192 + (pt * 32 + q) * 128 + ks * 16 + hh * 8);
                yo = __builtin_amdgcn_mfma_f32_32x32x16_bf16(cf[ks], hb, yo, 0, 0, 0); }
            const float dsk = d_skip[h];
#pragma unroll
            for (int qd = 0; qd < 4; ++qd) { const int l0 = lt * 32 + 8 * qd + 4 * hh;
                const u32x2 xv = *(const LAS u32x2*)(lds + SS_XS + (hl * 64 + pt * 32 + q) * 272 + l0 * 2);
#pragma unroll
                for (int e = 0; e < 4; ++e) { const int r = 4 * qd + e; const unsigned wd = xv[e >> 1]; const float xs = (e & 1) ? __uint_as_float(wd & 0xffff0000u) : __uint_as_float(wd << 16);
                    const float yv = yd[r] + __expf(ACS[h * 128 + l0 + e]) * yo[r] + xs * dsk;
                    Y[(t0 + l0 + e) * 768 + h * 64 + pt * 32 + q] = (bf16)(cvt_pk_bf16(yv, 0.f) & 0xffffu); } }
        }
    }
    VM_WAIT(); __syncthreads();
    __builtin_amdgcn_fence(__ATOMIC_ACQUIRE, "agent"); VM_WAIT();
    for (int t4 = wave * 16; t4 < wave * 16 + 16; t4 += 4) {
        u32x2 yv[4][3], zv[4][3];
#pragma unroll
        for (int k = 0; k < 4; ++k)
#pragma unroll
            for (int j = 0; j < 3; ++j) { const size_t t = t0 + t4 + k; yv[k][j] = *(const u32x2*)(Y + t * 768 + j * 256 + lane * 4); zv[k][j] = *(const u32x2*)(Z + t * 768 + j * 256 + lane * 4); }
#pragma unroll
        for (int k = 0; k < 4; ++k) { const size_t t = t0 + t4 + k;
            float v[12]; float ss = 0.f;
#pragma unroll
            for (int j = 0; j < 3; ++j)
#pragma unroll
                for (int e = 0; e < 4; ++e) { const unsigned yw = yv[k][j][e >> 1], zw = zv[k][j][e >> 1];
                    const float yy = (e & 1) ? __uint_as_float(yw & 0xffff0000u) : __uint_as_float(yw << 16), zz = (e & 1) ? __uint_as_float(zw & 0xffff0000u) : __uint_as_float(zw << 16);
                    const float x = yy * silu_f(zz); v[4 * j + e] = x; ss += x * x; }
            const float rstd = 1.0f / sqrtf(wave_sum(ss) * (1.f / 768.f) + EPS);
#pragma unroll
            for (int j = 0; j < 3; ++j) { const f32x4 gg = *(const f32x4*)(out_norm + j * 256 + lane * 4);
                u32x2 o; o.x = cvt_pk_bf16(v[4 * j] * rstd * gg.x, v[4 * j + 1] * rstd * gg.y); o.y = cvt_pk_bf16(v[4 * j + 2] * rstd * gg.z, v[4 * j + 3] * rstd * gg.w);
                *(u32x2*)(MIX + t * 1024 + j * 256 + lane * 4) = o; } } }
}

constexpr int DS_IKL = 145408;
constexpr int DS_SC = 0, DS_IMG = 0, DS_IMG_W = 32 * 528, DS_QL = 0, DS_SEL = 8 * DS_IMG_W, DS_RB = DS_SEL + 8192, DS_END = DS_RB + 2048;
static_assert(DS_SEL >= 8 * 4096 * 4 && DS_END <= DS_IKL && DS_IKL + 16384 <= LDS_SCR_BYTES, "DSA LDS map");
typedef short s16x4 __attribute__((ext_vector_type(4)));

__device__ __forceinline__ int t5_bucket(int n) {
    if (n < 16) return n;
    const float v = logf((float)n / 16.0f) / 2.0794415416798357f * 16.0f;
    const int l = 16 + (int)v; return l < 31 ? l : 31;
}
__device__ __forceinline__ unsigned sortable_u32(float f) { const unsigned b = __float_as_uint(f); return b ^ ((unsigned)((int)b >> 31) | 0x80000000u); }
__device__ __forceinline__ unsigned mbcnt64(unsigned long long m) { return __builtin_amdgcn_mbcnt_hi((unsigned)(m >> 32), __builtin_amdgcn_mbcnt_lo((unsigned)m, 0u)); }
__device__ __forceinline__ unsigned wave_sum_u32(unsigned x) {
    x += (unsigned)__builtin_amdgcn_update_dpp(0, (int)x, 0xB1, 0xf, 0xf, false);
    x += (unsigned)__builtin_amdgcn_update_dpp(0, (int)x, 0x4E, 0xf, 0xf, false);
    x += (unsigned)__builtin_amdgcn_update_dpp(0, (int)x, 0x141, 0xf, 0xf, false);
    x += (unsigned)__builtin_amdgcn_update_dpp(0, (int)x, 0x140, 0xf, 0xf, false);
    { const auto a = __builtin_amdgcn_permlane16_swap(x, x, false, false); x = a[0] + a[1]; }
    { const auto b = __builtin_amdgcn_permlane32_swap(x, x, false, false); x = b[0] + b[1]; }
    return x;
}
__device__ __forceinline__ float kg_max(float v) {
    { const auto a = __builtin_amdgcn_permlane16_swap(__float_as_uint(v), __float_as_uint(v), false, false); v = fmaxf(__uint_as_float(a[0]), __uint_as_float(a[1])); }
    { const auto b = __builtin_amdgcn_permlane32_swap(__float_as_uint(v), __float_as_uint(v), false, false); v = fmaxf(__uint_as_float(b[0]), __uint_as_float(b[1])); }
    return v;
}
#define CNT_GE(cnt, uu, cand) asm volatile("v_cmp_ge_u32 vcc, %1, %2\n\tv_addc_co_u32 %0, vcc, 0, %0, vcc" : "+v"(cnt) : "v"(uu), "v"(cand) : "vcc")
#define CNT_GT(cnt, uu, cand) asm volatile("v_cmp_gt_u32 vcc, %1, %2\n\tv_addc_co_u32 %0, vcc, 0, %0, vcc" : "+v"(cnt) : "v"(uu), "v"(cand) : "vcc")
__device__ __forceinline__ float wave_min_f32(float x) {
    x = fminf(x, __uint_as_float((unsigned)__builtin_amdgcn_update_dpp(0, (int)__float_as_uint(x), 0xB1, 0xf, 0xf, false)));
    x = fminf(x, __uint_as_float((unsigned)__builtin_amdgcn_update_dpp(0, (int)__float_as_uint(x), 0x4E, 0xf, 0xf, false)));
    x = fminf(x, __uint_as_float((unsigned)__builtin_amdgcn_update_dpp(0, (int)__float_as_uint(x), 0x141, 0xf, 0xf, false)));
    x = fminf(x, __uint_as_float((unsigned)__builtin_amdgcn_update_dpp(0, (int)__float_as_uint(x), 0x140, 0xf, 0xf, false)));
    { const auto a = __builtin_amdgcn_permlane16_swap(__float_as_uint(x), __float_as_uint(x), false, false); x = fminf(__uint_as_float(a[0]), __uint_as_float(a[1])); }
    { const auto b = __builtin_amdgcn_permlane32_swap(__float_as_uint(x), __float_as_uint(x), false, false); x = fminf(__uint_as_float(b[0]), __uint_as_float(b[1])); }
    return x;
}
__device__ __forceinline__ float wave_max_f32(float x) {
    x = fmaxf(x, __uint_as_float((unsigned)__builtin_amdgcn_update_dpp(0, (int)__float_as_uint(x), 0xB1, 0xf, 0xf, false)));
    x = fmaxf(x, __uint_as_float((unsigned)__builtin_amdgcn_update_dpp(0, (int)__float_as_uint(x), 0x4E, 0xf, 0xf, false)));
    x = fmaxf(x, __uint_as_float((unsigned)__builtin_amdgcn_update_dpp(0, (int)__float_as_uint(x), 0x141, 0xf, 0xf, false)));
    x = fmaxf(x, __uint_as_float((unsigned)__builtin_amdgcn_update_dpp(0, (int)__float_as_uint(x), 0x140, 0xf, 0xf, false)));
    { const auto a = __builtin_amdgcn_permlane16_swap(__float_as_uint(x), __float_as_uint(x), false, false); x = fmaxf(__uint_as_float(a[0]), __uint_as_float(a[1])); }
    { const auto b = __builtin_amdgcn_permlane32_swap(__float_as_uint(x), __float_as_uint(x), false, false); x = fmaxf(__uint_as_float(b[0]), __uint_as_float(b[1])); }
    return x;
}
__device__ __forceinline__ f32x4 mfma16(bf16x8 a, bf16x8 b, f32x4 c) { return __builtin_amdgcn_mfma_f32_16x16x32_bf16(a, b, c, 0, 0, 0); }

__device__ __forceinline__ void dsa_unit(LAS unsigned char* lds, int unit, bf16* QL, const bf16* CKV, const bf16* IQ, const bf16* IK, const float* IW, int tid, int wave, int lane_in) {
    const int lane = lane_in;
    const int b = unit & 7, qb = unit >> 3, t0 = qb * 8; const size_t tok0 = (size_t)b * SEQ + t0;
    LAS float* SC = (LAS float*)(lds + DS_SC); LAS unsigned* SEL = (LAS unsigned*)(lds + DS_SEL); const LAS float* RB = (const LAS float*)(lds + DS_RB);
    __syncthreads();
    for (int _ra = 0; _ra <= (DSA_PROBE & 1); ++_ra) {
        int lnA = lane; asm volatile("" : "+v"(lnA));
        int tid_a = tid; asm volatile("" : "+v"(tid_a));
        const int mt = wave & 1, q = lnA & 31, hh = lnA >> 5;
        const int qi = 4 * mt + 2 * ((q >> 2) & 1) + (q >> 4), hi = ((q >> 3) & 1) * 4 + (q & 3);
        bf16x8 af[4];
#pragma unroll
        for (int ks = 0; ks < 4; ++ks) af[ks] = *(const bf16x8*)(IQ + (tok0 + qi) * 512 + hi * 64 + ks * 16 + hh * 8);
        float wv[16];
        { const f32x4 a0 = *(const f32x4*)(IW + (tok0 + 4 * mt + 2 * hh) * 8), a1 = *(const f32x4*)(IW + (tok0 + 4 * mt + 2 * hh) * 8 + 4);
          const f32x4 b0 = *(const f32x4*)(IW + (tok0 + 4 * mt + 2 * hh + 1) * 8), b1 = *(const f32x4*)(IW + (tok0 + 4 * mt + 2 * hh + 1) * 8 + 4);
#pragma unroll
          for (int e = 0; e < 4; ++e) { wv[e] = a0[e]; wv[4 + e] = a1[e]; wv[8 + e] = b0[e]; wv[12 + e] = b1[e]; } }
        const int nkt = (t0 + 8 + 31) >> 5, ngr = (nkt + 3) >> 2;
        LAS unsigned char* IKL = lds + DS_IKL;
        const u32x4* ikg = (const u32x4*)(IK + (size_t)b * SEQ * 64) + tid_a;
        const int st0 = (tid_a >> 3) * 128 + (((tid_a & 7) ^ ((tid_a >> 3) & 7)) << 4), st1 = st0 + 64 * 128;
        const int jt = wave >> 1;
        const int rd0 = (jt * 32 + q) * 128; const int rx = (jt * 32 + q) & 7;
        u32x4 g0 = ikg[0], g1 = ikg[512];
#pragma unroll 1
        for (int g = 0; g < ngr; ++g) {
            __syncthreads();
            *(LAS u32x4*)(IKL + st0) = g0; *(LAS u32x4*)(IKL + st1) = g1;
            __syncthreads();
            if (g + 1 < ngr) { g0 = ikg[(size_t)(g + 1) * 1024]; g1 = ikg[(size_t)(g + 1) * 1024 + 512]; }
            const int kt = g * 4 + jt;
            if (kt < nkt) {
                f32x16 acc;
#pragma unroll
                for (int r = 0; r < 16; ++r) acc[r] = 0.f;
#pragma unroll
                for (int ks = 0; ks < 4; ++ks) { const bf16x8 bf = *(const LAS bf16x8*)(IKL + rd0 + (((2 * ks + hh) ^ rx) << 4)); acc = __builtin_amdgcn_mfma_f32_32x32x16_bf16(af[ks], bf, acc, 0, 0, 0); }
                float s0 = 0.f, s1 = 0.f;
#pragma unroll
                for (int r = 0; r < 8; ++r) { s0 += wv[r] * fmaxf(acc[r], 0.f); s1 += wv[8 + r] * fmaxf(acc[8 + r], 0.f); }
                const int key = kt * 32 + q;
                SC[(4 * mt + 2 * hh) * 4096 + key] = s0; SC[(4 * mt + 2 * hh + 1) * 4096 + key] = s1; }
        }
    }
    __syncthreads();
    int lnD = lane_in; asm volatile("" : "+v"(lnD));
    const int fr = lnD & 15, kg = lnD >> 4;
    bf16x8 ql[8];
#pragma unroll
    for (int ks = 0; ks < 8; ++ks) ql[ks] = (fr < 12) ? *(const bf16x8*)(QL + ((tok0 + wave) * 12 + fr) * 256 + ks * 32 + kg * 8) : (bf16x8){0, 0, 0, 0, 0, 0, 0, 0};
    const int t = t0 + wave, n = t + 1; const int nsel = n < 256 ? n : 256;
    for (int _rb = 0; _rb <= ((DSA_PROBE >> 1) & 1); ++_rb) {
        int lane = lane_in; asm volatile("" : "+v"(lane));
        LAS unsigned* selw = SEL + wave * 256;
        if (n <= 256) {
            for (int i = lane; i < n; i += 64) selw[i] = (unsigned)i | ((unsigned)t5_bucket(t - i) << 16);
        } else {
            const LAS float* sc = SC + wave * 4096;
            const int ni = (n + 63) >> 6;
            float f[64];
#pragma unroll
            for (int i = 0; i < 64; ++i) { const int s = 64 * i + lane; f[i] = (s < n) ? sc[s] + 0.f : -3.0e38f; }
            float lo, hi, T = 0.f; bool conv = false;
            { float m0 = -3.0e38f, m1 = -3.0e38f, m2 = -3.0e38f, m3 = -3.0e38f;
#pragma unroll
              for (int g4 = 0; g4 < 4; ++g4) if (ni > 16 * g4) {
#pragma unroll
                  for (int i = 16 * g4; i < 16 * g4 + 16; i += 4) { m0 = fmaxf(m0, f[i]); m1 = fmaxf(m1, f[i + 1]); m2 = fmaxf(m2, f[i + 2]); m3 = fmaxf(m3, f[i + 3]); } }
              lo = wave_min_f32(fminf(fminf(m0, m1), fminf(m2, m3))); hi = wave_max_f32(fmaxf(fmaxf(m0, m1), fmaxf(m2, m3))); }
#pragma unroll 1
            for (int it = 0; it < 26; ++it) {
                const float mid = 0.5f * lo + 0.5f * hi; unsigned cl = 0u;
#pragma unroll
                for (int g4 = 0; g4 < 4; ++g4) if (ni > 16 * g4) {
#pragma unroll
                    for (int i = 16 * g4; i < 16 * g4 + 16; ++i) asm volatile("v_cmp_ge_f32 vcc, %1, %2\n\tv_addc_co_u32 %0, vcc, 0, %0, vcc" : "+v"(cl) : "v"(f[i]), "v"(mid) : "vcc"); }
                asm volatile("s_nop 1" ::: "memory");
                const unsigned cnt = (unsigned)__builtin_amdgcn_readfirstlane((int)wave_sum_u32(cl));
                if (cnt == 256u) { T = mid; conv = true; break; }
                if (cnt > 256u) lo = mid; else hi = mid;
            }
            if (!conv) {
                unsigned Tu = 0u;
#pragma unroll 1
                for (int bit = 31; bit >= 0; --bit) {
                    const unsigned cand = Tu | (1u << bit); unsigned cl = 0u;
#pragma unroll
                    for (int g4 = 0; g4 < 4; ++g4) if (ni > 16 * g4) {
#pragma unroll
                        for (int i = 16 * g4; i < 16 * g4 + 16; ++i) { const unsigned uu = (f[i] == -3.0e38f) ? 0u : sortable_u32(f[i]); CNT_GE(cl, uu, cand); } }
                    asm volatile("s_nop 1" ::: "memory");
                    const unsigned cnt = (unsigned)__builtin_amdgcn_readfirstlane((int)wave_sum_u32(cl));
                    if (cnt >= 256u) Tu = cand;
                    if (cnt == 256u) break;
                }
                T = __uint_as_float((Tu & 0x80000000u) ? (Tu ^ 0x80000000u) : ~Tu);
            }
            unsigned G;
            { unsigned gl = 0u;
#pragma unroll
              for (int g4 = 0; g4 < 4; ++g4) if (ni > 16 * g4) {
#pragma unroll
                  for (int i = 16 * g4; i < 16 * g4 + 16; ++i) asm volatile("v_cmp_gt_f32 vcc, %1, %2\n\tv_addc_co_u32 %0, vcc, 0, %0, vcc" : "+v"(gl) : "v"(f[i]), "v"(T) : "vcc"); }
              asm volatile("s_nop 1" ::: "memory");
              G = (unsigned)__builtin_amdgcn_readfirstlane((int)wave_sum_u32(gl)); }
            const unsigned need_eq = 256u - G;
            unsigned pos = 0u, eq_used = 0u;
#pragma unroll
            for (int g4 = 0; g4 < 4; ++g4) if (ni > 16 * g4) {
#pragma unroll
                for (int i = 16 * g4; i < 16 * g4 + 16; ++i) {
                    const bool gt = f[i] > T, eq = f[i] == T;
                    const unsigned long long meq = __ballot(eq);
                    const bool sl = gt || (eq && (eq_used + mbcnt64(meq) < need_eq));
                    const unsigned long long msl = __ballot(sl);
                    if (sl) selw[pos + mbcnt64(msl)] = (unsigned)(64 * i + lane);
                    pos += (unsigned)__popcll(msl); eq_used += (unsigned)__popcll(meq); } }
#pragma unroll 1
            for (int i = lane; i < 256; i += 64) { const unsigned s = selw[i]; selw[i] = s | ((unsigned)t5_bucket(t - (int)s) << 16); }
        }
    }
    __syncthreads();
    f32x4 O[16];
#pragma unroll
    for (int ct = 0; ct < 16; ++ct) O[ct] = (f32x4){0.f, 0.f, 0.f, 0.f};
    float mrun = -3.0e38f, lrun = 0.f;
    for (int _rd = 0; _rd <= ((DSA_PROBE >> 3) & 1); ++_rd) {
        const unsigned rowmask = ((DSA_PROBE & 32) && _rd == 0) ? 0x7ffu : 0xffffu;
        if (_rd) { mrun = -3.0e38f; lrun = 0.f;
_Pragma("unroll") for (int ct = 0; ct < 16; ++ct) O[ct] = (f32x4){0.f, 0.f, 0.f, 0.f}; }
        const LAS unsigned* selw = SEL + wave * 256;
        LAS unsigned char* img = lds + DS_IMG + wave * DS_IMG_W;
        const int nsteps = (nsel + 31) >> 5;
        const int hh2 = lnD >> 5, c32 = lnD & 31; const bf16* ckr = CKV + (size_t)b * SEQ * 256 + c32 * 8;
        bf16x8 b0[8], b1[8], b2[8];
#pragma unroll
        for (int ks = 0; ks < 8; ++ks) { b0[ks] = (bf16x8){0, 0, 0, 0, 0, 0, 0, 0}; b1[ks] = b0[ks]; b2[ks] = b0[ks]; }
        const int ntiles = 2 * nsteps;
#define DSA_GATHER(X, tile) do { _Pragma("unroll") for (int j = 0; j < 8; ++j) { const int k_ = (tile) * 16 + 2 * j + hh2; const unsigned e_ = selw[k_ < nsel ? k_ : nsel - 1]; \
            if (!((DSA_PROBE & 128) && _rd == 0)) X[j] = *(const bf16x8*)(ckr + (size_t)(e_ & rowmask) * 256); } } while (0)
#define DSA_STEP(X0, X1, st) do { \
            f32x4 d0 = {0.f, 0.f, 0.f, 0.f}, d1 = {0.f, 0.f, 0.f, 0.f}; \
            _Pragma("unroll") for (int j = 0; j < 8; ++j) *(LAS bf16x8*)(img + (2 * j + hh2) * 528 + c32 * 16) = X0[j]; \
            if (2 * (st) + 3 < ntiles) DSA_GATHER(X0, 2 * (st) + 3);                \
            _Pragma("unroll") for (int j = 0; j < 8; ++j) *(LAS bf16x8*)(img + (16 + 2 * j + hh2) * 528 + c32 * 16) = X1[j]; \
            if (2 * (st) + 4 < ntiles) DSA_GATHER(X1, 2 * (st) + 4); \
            _Pragma("unroll") for (int k4 = 0; k4 < 8; k4 += 2) { bf16x8 fa[2], fb[2]; \
                _Pragma("unroll") for (int ks = 0; ks < 2; ++ks) { fa[ks] = *(const LAS bf16x8*)(img + fr * 528 + ((k4 + ks) * 32 + kg * 8) * 2); fb[ks] = *(const LAS bf16x8*)(img + (16 + fr) * 528 + ((k4 + ks) * 32 + kg * 8) * 2); } \
                _Pragma("unroll") for (int ks = 0; ks < 2; ++ks) { d0 = mfma16(fa[ks], ql[k4 + ks], d0); d1 = mfma16(fb[ks], ql[k4 + ks], d1); } } \
            const u32x4 s0 = *(const LAS u32x4*)(selw + (st) * 32 + kg * 4), s1 = *(const LAS u32x4*)(selw + (st) * 32 + 16 + kg * 4); \
            float lg[8]; float mloc = -3.0e38f; \
            _Pragma("unroll") for (int r = 0; r < 4; ++r) { \
                const float v0 = d0[r] + RB[((s0[r] >> 16) & 31u) * 16 + fr], v1 = d1[r] + RB[((s1[r] >> 16) & 31u) * 16 + fr]; \
                lg[r] = ((st) * 32 + kg * 4 + r < nsel) ? v0 : -3.0e38f; lg[4 + r] = ((st) * 32 + 16 + kg * 4 + r < nsel) ? v1 : -3.0e38f; \
                mloc = fmaxf(mloc, fmaxf(lg[r], lg[4 + r])); } \
            if (__any(mloc > mrun + 16.0f)) {                                       \
                mloc = kg_max(mloc); \
                const float mnew = fmaxf(mrun, mloc); \
                const float alpha = __expf(mrun - mnew); lrun *= alpha; \
                float ar[4]; \
                _Pragma("unroll") for (int r = 0; r < 4; ++r) ar[r] = __shfl(alpha, kg * 4 + r); \
                _Pragma("unroll") for (int ct = 0; ct < 16; ++ct) _Pragma("unroll") for (int r = 0; r < 4; ++r) O[ct][r] *= ar[r]; \
                mrun = mnew; } \
            float p[8]; \
            _Pragma("unroll") for (int r = 0; r < 8; ++r) { p[r] = (lg[r] > -1.0e38f) ? __expf(lg[r] - mrun) : 0.f; lrun += p[r]; } \
            union { bf16x8 v; unsigned w[4]; } pa; \
            pa.w[0] = cvt_pk_bf16(p[0], p[1]); pa.w[1] = cvt_pk_bf16(p[2], p[3]); pa.w[2] = cvt_pk_bf16(p[4], p[5]); pa.w[3] = cvt_pk_bf16(p[6], p[7]); \
            const LAS unsigned char* tb = img + (kg * 4 + (fr >> 2)) * 528 + (fr & 3) * 8; \
            if (!((DSA_PROBE & 64) && _rd == 0)) { \
            _Pragma("unroll") for (int c8 = 0; c8 < 16; c8 += 4) { \
                union { bf16x8 v; s16x4 h[2]; } bb[4]; \
                _Pragma("unroll") for (int cj = 0; cj < 4; ++cj) { bb[cj].h[0] = __builtin_amdgcn_ds_read_tr16_b64_v4i16((LAS s16x4*)(tb + (c8 + cj) * 32)); \
                    bb[cj].h[1] = __builtin_amdgcn_ds_read_tr16_b64_v4i16((LAS s16x4*)(tb + 16 * 528 + (c8 + cj) * 32)); } \
                _Pragma("unroll") for (int cj = 0; cj < 4; ++cj) O[c8 + cj] = mfma16(pa.v, bb[cj].v, O[c8 + cj]); } } } while (0)
        DSA_GATHER(b0, 0); DSA_GATHER(b1, 1); if (ntiles > 2) DSA_GATHER(b2, 2);
        for (int st = 0; st < nsteps; st += 3) {
            DSA_STEP(b0, b1, st);
            if (st + 1 < nsteps) DSA_STEP(b2, b0, st + 1);
            if (st + 2 < nsteps) DSA_STEP(b1, b2, st + 2);
        }
    }
#undef DSA_GATHER
#undef DSA_STEP
    lrun += __shfl_xor(lrun, 16); lrun += __shfl_xor(lrun, 32);
    const float inv = 1.0f / lrun;
    float ir[4];
#pragma unroll
    for (int r = 0; r < 4; ++r) ir[r] = __shfl(inv, kg * 4 + r);
    __syncthreads();
    if (kg < 3) {
#pragma unroll
        for (int ct = 0; ct < 16; ++ct)
#pragma unroll
            for (int r = 0; r < 4; ++r) *(LAS unsigned short*)(lds + DS_QL + ((wave * 12 + kg * 4 + r) * 256 + ct * 16 + fr) * 2) = (unsigned short)(cvt_pk_bf16(O[ct][r] * ir[r], 0.f) & 0xffffu);
    }
    __syncthreads();
    { const LAS u32x4* src = (const LAS u32x4*)(lds + DS_QL + wave * 12 * 256 * 2); u32x4* dst = (u32x4*)(QL + (tok0 + wave) * 12 * 256);
#pragma unroll
      for (int j = 0; j < 6; ++j) dst[j * 64 + lnD] = src[j * 64 + lnD]; }
}

__device__ __forceinline__ void qlat_phase(LAS unsigned char* lds, int u0, int ustep, int nunits, const bf16* Q, const bf16* UK, bf16* QL, int tid, int wave, int lane_in) {
    int lane = lane_in; asm volatile("" : "+v"(lane));
    const int q = lane & 31, hh = lane >> 5;
    u32x4 pre[2]; bf16x8 af[4];
#define QL_LOAD(unit) do { const int tb_ = (unit) / 12, h_ = (unit) - tb_ * 12; \
        _Pragma("unroll") for (int i = 0; i < 2; ++i) { const int idx = tid + i * NTHR, row = idx >> 3, ch = idx & 7; pre[i] = *(const u32x4*)(Q + ((size_t)tb_ * 128 + row) * 768 + h_ * 64 + ch * 8); } \
        _Pragma("unroll") for (int ks = 0; ks < 4; ++ks) af[ks] = *(const bf16x8*)(UK + ((size_t)h_ * 256 + wave * 32 + q) * 64 + ks * 16 + hh * 8); } while (0)
    if (u0 < nunits) QL_LOAD(u0);
    for (int unit = u0; unit < nunits; unit += ustep) {
        const int tb = unit / 12, h = unit - tb * 12; const size_t tok0 = (size_t)tb * 128;
        __syncthreads();
#pragma unroll
        for (int i = 0; i < 2; ++i) { const int idx = tid + i * NTHR, row = idx >> 3, ch = idx & 7; *(LAS u32x4*)(lds + row * 144 + ch * 16) = pre[i]; }
        bf16x8 afc[4];
#pragma unroll
        for (int ks = 0; ks < 4; ++ks) afc[ks] = af[ks];
        __syncthreads();
        if (unit + ustep < nunits) QL_LOAD(unit + ustep);
#pragma unroll
        for (int nt = 0; nt < 4; ++nt) {
            f32x16 acc;
#pragma unroll
            for (int r = 0; r < 16; ++r) acc[r] = 0.f;
#pragma unroll
            for (int ks = 0; ks < 4; ++ks) { const bf16x8 bq = *(const LAS bf16x8*)(lds + (nt * 32 + q) * 144 + (ks * 16 + hh * 8) * 2); acc = __builtin_amdgcn_mfma_f32_32x32x16_bf16(afc[ks], bq, acc, 0, 0, 0); }
#pragma unroll
            for (int g = 0; g < 4; ++g) { u32x2 w; w.x = cvt_pk_bf16(acc[4 * g] * 0.125f, acc[4 * g + 1] * 0.125f); w.y = cvt_pk_bf16(acc[4 * g + 2] * 0.125f, acc[4 * g + 3] * 0.125f);
                *(LAS u32x2*)(lds + 18432 + (nt * 32 + q) * 528 + (wave * 32 + 8 * g + 4 * hh) * 2) = w; }
        }
        __syncthreads();
        for (int idx = tid; idx < 4096; idx += NTHR) { const int row = idx >> 5, ch = idx & 31;
            *(u32x4*)(QL + ((tok0 + row) * 12 + h) * 256 + ch * 8) = *(const LAS u32x4*)(lds + 18432 + row * 528 + ch * 16); }
    }
#undef QL_LOAD
}
__device__ __forceinline__ void uv_phase(LAS unsigned char* lds, int u0, int ustep, int nunits, const bf16* QL, const bf16* UVT, bf16* MIX, int tid, int wave, int lane_in) {
    int lane = lane_in; asm volatile("" : "+v"(lane));
    const int q = lane & 31, hh = lane >> 5, mt = wave >> 1, nt = wave & 1;
    u32x4 pre[8];
#define UV_LOAD(unit) do { const int tb_ = (unit) / 12, h_ = (unit) - tb_ * 12; _Pragma("unroll") for (int i = 0; i < 8; ++i) { const int idx = tid + i * NTHR, row = idx >> 5, ch = idx & 31; \
        pre[i] = *(const u32x4*)(QL + (((size_t)tb_ * 128 + row) * 12 + h_) * 256 + ch * 8); } } while (0)
    if (u0 < nunits) UV_LOAD(u0);
    for (int unit = u0; unit < nunits; unit += ustep) {
        const int tb = unit / 12, h = unit - tb * 12; const size_t tok0 = (size_t)tb * 128;
        __syncthreads();
#pragma unroll
        for (int i = 0; i < 8; ++i) { const int idx = tid + i * NTHR, row = idx >> 5, ch = idx & 31; *(LAS u32x4*)(lds + row * 528 + ch * 16) = pre[i]; }
        const bf16* bp = UVT + ((size_t)h * 64 + nt * 32 + q) * 256 + hh * 8;
        bf16x8 bw[16];
#pragma unroll
        for (int ks = 0; ks < 16; ++ks) bw[ks] = *(const bf16x8*)(bp + ks * 16);
        __syncthreads();
        if (unit + ustep < nunits) UV_LOAD(unit + ustep);
        f32x16 acc;
#pragma unroll
        for (int r = 0; r < 16; ++r) acc[r] = 0.f;
#pragma unroll
        for (int ks = 0; ks < 16; ++ks) { const bf16x8 a = *(const LAS bf16x8*)(lds + (mt * 32 + q) * 528 + (ks * 16 + hh * 8) * 2); acc = __builtin_amdgcn_mfma_f32_32x32x16_bf16(a, bw[ks], acc, 0, 0, 0); }
#pragma unroll
        for (int r = 0; r < 16; ++r) *(LAS unsigned short*)(lds + 67584 + (mt * 32 + (r & 3) + 8 * (r >> 2) + 4 * hh) * 144 + (nt * 32 + q) * 2) = (unsigned short)(cvt_pk_bf16(acc[r], 0.f) & 0xffffu);
        __syncthreads();
        for (int idx = tid; idx < 1024; idx += NTHR) { const int row = idx >> 3, ch = idx & 7;
            *(u32x4*)(MIX + (tok0 + row) * 1024 + h * 64 + ch * 8) = *(const LAS u32x4*)(lds + 67584 + row * 144 + ch * 16); }
    }
#undef UV_LOAD
}

typedef __bf16 bf16v2_tt __attribute__((ext_vector_type(2)));
typedef float f32x2 __attribute__((ext_vector_type(2)));
__device__ __forceinline__ float dot2bf(unsigned a, unsigned b, float c) { return __builtin_amdgcn_fdot2_f32_bf16(__builtin_bit_cast(bf16v2_tt, a), __builtin_bit_cast(bf16v2_tt, b), c, false); }
__device__ __forceinline__ float unsortable_f32(unsigned u) { return __uint_as_float((u & 0x80000000u) ? (u ^ 0x80000000u) : ~u); }

constexpr int PA_SK = 0, PA_WB = 2 * 128 * 272, PA_WBYTES = 32 * 272;
static_assert(PA_WB + 8 * PA_WBYTES <= LDS_SCR_BYTES, "PEER-A LDS map");
__device__ __forceinline__ unsigned wave_max_u32(unsigned x) {
    { const unsigned t = (unsigned)__builtin_amdgcn_update_dpp(0, (int)x, 0xB1, 0xf, 0xf, false); x = t > x ? t : x; }
    { const unsigned t = (unsigned)__builtin_amdgcn_update_dpp(0, (int)x, 0x4E, 0xf, 0xf, false); x = t > x ? t : x; }
    { const unsigned t = (unsigned)__builtin_amdgcn_update_dpp(0, (int)x, 0x141, 0xf, 0xf, false); x = t > x ? t : x; }
    { const unsigned t = (unsigned)__builtin_amdgcn_update_dpp(0, (int)x, 0x140, 0xf, 0xf, false); x = t > x ? t : x; }
    { const auto a = __builtin_amdgcn_permlane16_swap(x, x, false, false); x = a[0] > a[1] ? a[0] : a[1]; }
    { const auto b = __builtin_amdgcn_permlane32_swap(x, x, false, false); x = b[0] > b[1] ? b[0] : b[1]; }
    return (unsigned)__builtin_amdgcn_readfirstlane((int)x);
}
__device__ __forceinline__ void peer_topk_load_sk(LAS unsigned char* lds, const bf16* SK, int tid) {
    __syncthreads();
    for (int idx = tid; idx < 4096; idx += NTHR) { const int row = idx >> 4, ch = idx & 15;
        *(LAS u32x4*)(lds + PA_SK + row * 272 + ch * 16) = *(const u32x4*)(SK + (size_t)row * 128 + ch * 8); }
    __syncthreads();
}
__device__ __forceinline__ void peer_topk_task(LAS unsigned char* lds, int task, const bf16* PQ, u32x2* TOPK, int wave, int lane_in) {
    int lane = lane_in; asm volatile("" : "+v"(lane));
    const int tg = task >> 4, sl = task & 15, half = sl & 1, q = lane & 31, hh = lane >> 5;
    LAS unsigned char* wb = lds + PA_WB + wave * PA_WBYTES;
#pragma unroll
    for (int j = 0; j < 8; ++j) { const int row = 4 * j + (lane >> 4), ch = lane & 15;
        *(LAS u32x4*)(wb + row * 272 + ch * 16) = *(const u32x4*)(PQ + ((size_t)tg * 32 + row) * 2048 + sl * 128 + ch * 8); }
    bf16x8 bq[8];
#pragma unroll
    for (int ks = 0; ks < 8; ++ks) bq[ks] = *(const LAS bf16x8*)(wb + q * 272 + (ks * 16 + hh * 8) * 2);
    float f[64];
    const LAS unsigned char* skp = lds + PA_SK + (half * 128 + q) * 272 + hh * 16;
#pragma unroll
    for (int kt = 0; kt < 4; ++kt) {
        f32x16 acc;
#pragma unroll
        for (int r = 0; r < 16; ++r) acc[r] = 0.f;
#pragma unroll
        for (int ks = 0; ks < 8; ++ks) { const bf16x8 a = *(const LAS bf16x8*)(skp + kt * 32 * 272 + ks * 32); acc = __builtin_amdgcn_mfma_f32_32x32x16_bf16(a, bq[ks], acc, 0, 0, 0); }
#pragma unroll
        for (int r = 0; r < 16; ++r) f[kt * 16 + r] = acc[r] + 0.f;
    }
    float lo, hi, T = 0.f;
    { float mn = 3.0e38f, mx = -3.0e38f;
#pragma unroll
      for (int g = 0; g < 8; ++g) { float m = f[8 * g];
#pragma unroll
          for (int i = 1; i < 8; ++i) m = fmaxf(m, f[8 * g + i]);
          mn = fminf(mn, m); mx = fmaxf(mx, m); }
      { const auto a2 = __builtin_amdgcn_permlane32_swap(__float_as_uint(mn), __float_as_uint(mn), false, false); mn = fminf(__uint_as_float(a2[0]), __uint_as_float(a2[1]));
        const auto b2 = __builtin_amdgcn_permlane32_swap(__float_as_uint(mx), __float_as_uint(mx), false, false); mx = fmaxf(__uint_as_float(b2[0]), __uint_as_float(b2[1])); }
      lo = mn; hi = mx; }
    bool done = false;
#pragma unroll 1
    for (int it = 0; it < 22; ++it) {
        const float mid = 0.5f * lo + 0.5f * hi; unsigned cnt = 0u;
#pragma unroll
        for (int i = 0; i < 64; ++i) asm volatile("v_cmp_ge_f32 vcc, %1, %2\n\tv_addc_co_u32 %0, vcc, 0, %0, vcc" : "+v"(cnt) : "v"(f[i]), "v"(mid) : "vcc");
        asm volatile("s_nop 1" ::: "memory");
        const auto sw = __builtin_amdgcn_permlane32_swap(cnt, cnt, false, false);
        const unsigned tot = sw[0] + sw[1];
        if (!done) { if (tot >= 16u) lo = mid; else hi = mid; if (tot == 16u) { T = mid; done = true; } }
        if (__all(done)) break;
    }
    if (!__all(done)) {
        unsigned Tu = 0u;
#pragma unroll 1
        for (int bit = 31; bit >= 0; --bit) {
            const unsigned cand = Tu | (1u << bit); unsigned cnt = 0u;
#pragma unroll
            for (int i = 0; i < 64; ++i) { const unsigned uu = sortable_u32(f[i]); CNT_GE(cnt, uu, cand); }
            asm volatile("s_nop 1" ::: "memory");
            const auto sw = __builtin_amdgcn_permlane32_swap(cnt, cnt, false, false);
            if (sw[0] + sw[1] >= 16u) Tu = cand;
        }
        if (!done) T = unsortable_f32(Tu);
    }
    unsigned gtc = 0u, eqc = 0u;
#pragma unroll
    for (int i = 0; i < 64; ++i) { asm volatile("v_cmp_gt_f32 vcc, %1, %2\n\tv_addc_co_u32 %0, vcc, 0, %0, vcc" : "+v"(gtc) : "v"(f[i]), "v"(T) : "vcc");
        asm volatile("v_cmp_eq_f32 vcc, %1, %2\n\tv_addc_co_u32 %0, vcc, 0, %0, vcc" : "+v"(eqc) : "v"(f[i]), "v"(T) : "vcc"); }
    asm volatile("s_nop 1" ::: "memory");
    unsigned pg, pe;
    { const auto a = __builtin_amdgcn_permlane32_swap(gtc, gtc, false, false); pg = a[0] + a[1] - gtc; const auto e = __builtin_amdgcn_permlane32_swap(eqc, eqc, false, false); pe = e[0] + e[1] - eqc; }
    const unsigned need_eq = 16u - (gtc + pg);
    const unsigned take0 = hh ? (pe < need_eq ? pe : need_eq) : (eqc < need_eq ? eqc : need_eq);
    const unsigned my_take = hh ? need_eq - take0 : take0;
    unsigned pos = hh ? (pg + take0) : 0u, eq_seen = 0u;
    LAS u32x2* stg = (LAS u32x2*)wb + q * 16;
#pragma unroll
    for (int i = 0; i < 64; ++i) {
        const bool eq = (f[i] == T); const bool sel = (f[i] > T) || (eq && eq_seen < my_take);
        if (sel) { u32x2 e; e.x = __float_as_uint(f[i]); e.y = (unsigned)((i >> 4) * 32 + (i & 3) + 8 * ((i >> 2) & 3) + 4 * hh); stg[pos] = e; pos += 1u; }
        eq_seen += eq ? 1u : 0u;
    }
#pragma unroll
    for (int j = 0; j < 4; ++j) { const int tk = 8 * j + (lane >> 3), ch = lane & 7;
        *(u32x4*)((unsigned char*)(TOPK + (((size_t)tg * 32 + tk) * 16 + sl) * 16) + ch * 16) = *(const LAS u32x4*)(wb + tk * 128 + ch * 16); }
}

template <bool LAST>
__device__ __forceinline__ void peer_tok(LAS unsigned char* lds_w, size_t tok, const u32x2* TOPK, const unsigned char* TABU, const unsigned char* TABV, const float* TSU, const float* TSV, bf16* HB, const float* SS, const float* gffn, float* xres, const float* gnext, int lane_in) {
    int lane = lane_in; asm volatile("" : "+v"(lane));
    LAS u32x2* EL = (LAS u32x2*)lds_w;
    LAS u32x4* EG = (LAS u32x4*)(lds_w + 1024);
    for (int _rp = 0; _rp <= (PEER_PROBE & 1); ++_rp)
#pragma unroll 1
    for (int head = 0; head < 8; ++head) {
        const u32x2* base = TOPK + (tok * 16 + head * 2) * 16;
        const u32x2 e0 = base[lane >> 2];
        const u32x4 e1a = *(const u32x4*)(base + 16 + 4 * (lane & 3)), e1b = *(const u32x4*)(base + 16 + 4 * (lane & 3) + 2);
        const float s0 = __uint_as_float(e0.x);
        float cs[4]; unsigned ck[4], u[4];
        cs[0] = s0 + __uint_as_float(e1a.x); ck[0] = e0.y * 128u + e1a.y; cs[1] = s0 + __uint_as_float(e1a.z); ck[1] = e0.y * 128u + e1a.w;
        cs[2] = s0 + __uint_as_float(e1b.x); ck[2] = e0.y * 128u + e1b.y; cs[3] = s0 + __uint_as_float(e1b.z); ck[3] = e0.y * 128u + e1b.w;
#pragma unroll
        for (int m = 0; m < 4; ++m) u[m] = sortable_u32(cs[m]);
        unsigned T = 0u;
#pragma unroll 1
        for (int bit = 31; bit >= 0; --bit) {
            const unsigned cand = T | (1u << bit); unsigned cnt = 0u;
#pragma unroll
            for (int m = 0; m < 4; ++m) cnt += (unsigned)__popcll(__ballot(u[m] >= cand));
            if (cnt >= 16u) T = cand;
            if (cnt == 16u) break;
        }
        unsigned G = 0u;
#pragma unroll
        for (int m = 0; m < 4; ++m) G += (unsigned)__popcll(__ballot(u[m] > T));
        const unsigned need_eq = 16u - G; unsigned pos = 0u, eq_used = 0u;
#pragma unroll
        for (int m = 0; m < 4; ++m) {
            const bool gt = u[m] > T, eq = u[m] == T;
            const unsigned long long meq = __ballot(eq);
            const bool sl = gt || (eq && (eq_used + mbcnt64(meq) < need_eq));
            const unsigned long long msl = __ballot(sl);
            if (sl) { u32x2 e; e.x = ck[m]; e.y = __float_as_uint(cs[m]); EL[head * 16 + pos + mbcnt64(msl)] = e; }
            pos += (unsigned)__popcll(msl); eq_used += (unsigned)__popcll(meq); }
    }
#pragma unroll
    for (int rep = 0; rep < 2; ++rep) { const int e = lane + 64 * rep; const u32x2 ent = EL[e]; const float sc = __uint_as_float(ent.y);
        const float su = TSU[ent.x], sv = TSV[ent.x];
        float mx = sc;
#pragma unroll
        for (int o = 1; o < 16; o <<= 1) mx = fmaxf(mx, __shfl_xor(mx, o));
        const float p = __expf(sc - mx); float sm = p;
#pragma unroll
        for (int o = 1; o < 16; o <<= 1) sm += __shfl_xor(sm, o);
        u32x4 w; w.x = ent.x; w.y = __float_as_uint(su); w.z = __float_as_uint(p / sm * sv); w.w = 0u; EG[e] = w; }
    int xq[4]; float sx;
    { const u32x4* hp = (const u32x4*)(HB + tok * 1024 + lane * 16); const u32x4 qa = hp[0], qb = hp[1]; float f[16]; float am = 0.f;
#pragma unroll
      for (int e = 0; e < 4; ++e) { f[2 * e] = __uint_as_float(qa[e] << 16); f[2 * e + 1] = __uint_as_float(qa[e] & 0xffff0000u); f[8 + 2 * e] = __uint_as_float(qb[e] << 16); f[8 + 2 * e + 1] = __uint_as_float(qb[e] & 0xffff0000u); }
      { const float rs_ = 1.0f / sqrtf(SS[tok] * (1.f / 1024.f) + EPS);
#pragma unroll
        for (int j = 0; j < 4; ++j) { const f32x4 gg = *(const f32x4*)(gffn + lane * 16 + 4 * j); f[4 * j] *= rs_ * gg[0]; f[4 * j + 1] *= rs_ * gg[1]; f[4 * j + 2] *= rs_ * gg[2]; f[4 * j + 3] *= rs_ * gg[3]; } }
#pragma unroll
      for (int c = 0; c < 16; ++c) am = fmaxf(am, fabsf(f[c]));
      am = wave_max(am); sx = am > 0.f ? am * (1.0f / 127.0f) : 1.0f; const float inv = 1.0f / sx;
#pragma unroll
      for (int e = 0; e < 4; ++e) { const int q0 = (int)rintf(f[4 * e] * inv), q1 = (int)rintf(f[4 * e + 1] * inv), q2 = (int)rintf(f[4 * e + 2] * inv), q3 = (int)rintf(f[4 * e + 3] * inv);
          xq[e] = (q0 & 0xff) | ((q1 & 0xff) << 8) | ((q2 & 0xff) << 16) | ((q3 & 0xff) << 24); } }
    f32x2 out2[8];
#pragma unroll
    for (int c = 0; c < 8; ++c) out2[c] = (f32x2){0.f, 0.f};
    const unsigned char* ubase = TABU + lane * 16; const unsigned char* vbase = TABV + lane * 16;
#define PT_LOAD(UB, VB, BT) do { _Pragma("unroll") for (int k = 0; k < 8; ++k) { const size_t ro = (size_t)EG[(BT) * 8 + k].x << 10; UB[k] = *(const u32x4*)(ubase + ro); VB[k] = *(const u32x4*)(vbase + ro); } } while (0)
#define PT_COMPUTE(UB, VB, BT) do { int di[8]; \
        _Pragma("unroll") for (int k = 0; k < 8; ++k) { int a0 = 0; \
            _Pragma("unroll") for (int e = 0; e < 4; ++e) a0 = __builtin_amdgcn_sdot4((int)UB[k][e], xq[e], a0, false); di[k] = a0; } \
        int r4[4], r2[2], v1; \
        { const bool h32 = (lane & 32) != 0; \
          _Pragma("unroll") for (int j = 0; j < 4; ++j) { const int send = h32 ? di[j] : di[j + 4], keep = h32 ? di[j + 4] : di[j]; r4[j] = keep + __shfl_xor(send, 32); } \
          const bool h16 = (lane & 16) != 0; \
          _Pragma("unroll") for (int j = 0; j < 2; ++j) { const int send = h16 ? r4[j] : r4[j + 2], keep = h16 ? r4[j + 2] : r4[j]; r2[j] = keep + __shfl_xor(send, 16); } \
          const bool h8 = (lane & 8) != 0; \
          { const int send = h8 ? r2[0] : r2[1], keep = h8 ? r2[1] : r2[0]; v1 = keep + __shfl_xor(send, 8); } \
          v1 += __shfl_xor(v1, 4); v1 += __shfl_xor(v1, 2); v1 += __shfl_xor(v1, 1); } \
        float act; { const u32x4 eg = EG[(BT) * 8 + (lane >> 3)]; const float v = (float)v1 * (__uint_as_float(eg.y) * sx); \
          const float t = __builtin_amdgcn_rcpf(fabsf(v) * 0.2316418882f + 1.0f); \
          float q = t * 0.5307027145f + (-0.7265760135f); q = q * t + 0.7107068705f; q = q * t + (-0.142248368f); q = q * t + 0.127414796f; q = q * t; \
          const float m = v * (q * __builtin_amdgcn_exp2f(v * v * (-0.72134752044f))); \
          act = (v < 0.f ? m : v - m) * __uint_as_float(eg.z); }                        \
        _Pragma("unroll") for (int k = 0; k < 8; ++k) { const float a = __uint_as_float(__builtin_amdgcn_readlane((int)__float_as_uint(act), 8 * k)); \
            _Pragma("unroll") for (int e = 0; e < 4; ++e) { out2[2 * e] += __builtin_amdgcn_cvt_pk_f32_fp8((int)VB[k][e], false) * a; out2[2 * e + 1] += __builtin_amdgcn_cvt_pk_f32_fp8((int)VB[k][e], true) * a; } } } while (0)
    {
        u32x4 ubA[8], vbA[8], ubB[8], vbB[8], ubC[8], vbC[8];
        PT_LOAD(ubA, vbA, 0); PT_LOAD(ubB, vbB, 1);
#pragma unroll 1
        for (int bt = 0; bt < 16; bt += 3) {
            { const int n2 = (bt + 2 < 16) ? bt + 2 : 15; PT_LOAD(ubC, vbC, n2); }
            PT_COMPUTE(ubA, vbA, bt);
            if (bt + 1 < 16) {
                { const int n3 = (bt + 3 < 16) ? bt + 3 : 15; PT_LOAD(ubA, vbA, n3); }
                PT_COMPUTE(ubB, vbB, bt + 1);
                { const int n4 = (bt + 4 < 16) ? bt + 4 : 15; PT_LOAD(ubB, vbB, n4); }
                PT_COMPUTE(ubC, vbC, bt + 2);
            }
        }
    }
#undef PT_LOAD
#undef PT_COMPUTE
    f32x4 xr[4]; float ss = 0.f;
    float* xq4 = xres + tok * 1024 + lane * 16;
#pragma unroll
    for (int j = 0; j < 4; ++j) { xr[j] = *(const f32x4*)(xq4 + 4 * j);
        xr[j][0] += out2[2 * j].x; xr[j][1] += out2[2 * j].y; xr[j][2] += out2[2 * j + 1].x; xr[j][3] += out2[2 * j + 1].y;
#pragma unroll
        for (int e = 0; e < 4; ++e) ss += xr[j][e] * xr[j][e]; }
    const float rstd = 1.0f / sqrtf(wave_sum(ss) * (1.f / 1024.f) + EPS);
    if (LAST) {
#pragma unroll
        for (int j = 0; j < 4; ++j) { const f32x4 gg = *(const f32x4*)(gnext + lane * 16 + 4 * j); *(f32x4*)(xq4 + 4 * j) = xr[j] * rstd * gg; }
    } else {
        u32x4 o0, o1;
#pragma unroll
        for (int j = 0; j < 4; ++j) { *(f32x4*)(xq4 + 4 * j) = xr[j]; const f32x4 gg = *(const f32x4*)(gnext + lane * 16 + 4 * j);
            const unsigned lo = cvt_pk_bf16(xr[j][0] * rstd * gg[0], xr[j][1] * rstd * gg[1]), hi = cvt_pk_bf16(xr[j][2] * rstd * gg[2], xr[j][3] * rstd * gg[3]);
            if (j < 2) { o0[2 * j] = lo; o0[2 * j + 1] = hi; } else { o1[2 * (j - 2)] = lo; o1[2 * (j - 2) + 1] = hi; } }
        u32x4* hq = (u32x4*)(HB + tok * 1024 + lane * 16); hq[0] = o0; hq[1] = o1;
    }
}

template <int R> __device__ __forceinline__ void rank_step(unsigned long long key, unsigned& rank) {
    const unsigned lo = (unsigned)__builtin_amdgcn_update_dpp(0, (int)(unsigned)key, 0x120 + R, 0xf, 0xf, false);
    const unsigned hi = (unsigned)__builtin_amdgcn_update_dpp(0, (int)(unsigned)(key >> 32), 0x120 + R, 0xf, 0xf, false);
    rank += ((((unsigned long long)hi << 32) | lo) > key) ? 1u : 0u;
    if constexpr (R < 15) rank_step<R + 1>(key, rank);
}
__device__ __forceinline__ void xcc_sync(unsigned* ctr, unsigned nloc, unsigned target);
constexpr int PW_SET = 6144, PW_HIST = 2 * PW_SET, PW_SL = PW_HIST + 1024, PW_BYTES = PW_SL + 512;
template <bool LAST>
__device__ __forceinline__ void peer_wave(LAS unsigned char* lds_w, int m0, int mstep, int mcount, const u32x2* TOPK, const unsigned char* TABU, const unsigned char* TABV, const float* TSU, const float* TSV,
                                          bf16* HB, const float* SS, const float* gffn, float* xres, const float* gnext, int lane_in, unsigned* xctr, unsigned nloc, unsigned xbase) {
    int lane = lane_in; asm volatile("" : "+v"(lane));
    LAS unsigned* HIST = (LAS unsigned*)(lds_w + PW_HIST);
    LAS u32x2* SLs = (LAS u32x2*)(lds_w + PW_SL);
    int ri, rj;
    { const int L = lane;
      if (L < 16) { ri = 0; rj = L; } else if (L < 24) { ri = 1; rj = L - 16; } else if (L < 29) { ri = 2; rj = L - 24; } else if (L < 33) { ri = 3; rj = L - 29; }
      else if (L < 36) { ri = 4; rj = L - 33; } else if (L < 38) { ri = 5; rj = L - 36; } else if (L < 40) { ri = 6; rj = L - 38; } else if (L < 42) { ri = 7; rj = L - 40; }
      else if (L < 50) { ri = L - 34; rj = 0; } else { ri = 0; rj = 0; } }
#define PW_CAND(tokC, head, ELc) do { \
        const u32x2 ent = TOPK[((tokC + (lane >> 5)) * 16 + head * 2) * 16 + (lane & 31)]; \
        const unsigned long long key = ((unsigned long long)sortable_u32(__uint_as_float(ent.x)) << 32) | (unsigned)(15 - (lane & 15)); \
        unsigned rank = 0u; rank_step<1>(key, rank); \
        SLs[(lane >> 4) * 16 + rank] = ent; \
_Pragma("unroll 1") \
        for (int tk = 0; tk < 2; ++tk) { \
            const u32x2 ea = SLs[(tk * 2) * 16 + ri], eb = SLs[(tk * 2 + 1) * 16 + rj]; \
            const float cs = __uint_as_float(ea.x) + __uint_as_float(eb.x); const unsigned ck = ea.y * 128u + eb.y; \
            const bool vld = lane < 50; \
              \
            float lo = wave_min_f32(vld ? cs : 3.0e38f), hi = wave_max_f32(vld ? cs : -3.0e38f); bool sl = false; bool conv = false; \
            _Pragma("unroll 1") for (int it = 0; it < 24; ++it) { \
                const float mid = 0.5f * lo + 0.5f * hi; const bool ge = vld && (cs >= mid); const unsigned cnt = (unsigned)__popcll(__ballot(ge)); \
                if (cnt == 16u) { sl = ge; conv = true; break; } \
                if (cnt > 16u) lo = mid; else hi = mid; } \
            if (!conv) {                                                                \
                const unsigned u = vld ? sortable_u32(cs) : 0u; \
                unsigned T = 0u; \
                _Pragma("unroll 1") for (int bit = 31; bit >= 0; --bit) { \
                    const unsigned cand = T | (1u << bit); const unsigned cnt = (unsigned)__popcll(__ballot(u >= cand)); \
                    if (cnt >= 16u) T = cand; \
                    if (cnt == 16u) break; \
                } \
                const unsigned G = (unsigned)__popcll(__ballot(u > T)); const unsigned need_eq = 16u - G; \
                const bool gt = u > T, eq = u == T; \
                const unsigned long long meq = __ballot(eq); \
                sl = gt || (eq && (mbcnt64(meq) < need_eq)); } \
            const unsigned long long msl = __ballot(sl); \
            if (sl) { u32x2 e; e.x = ck; e.y = __float_as_uint(cs); ELc[(tk * 8 + head) * 16 + mbcnt64(msl)] = e; } \
        } \
        } while (0)
    if (m0 >= mcount) return;
    {
        LAS u32x2* ELc = (LAS u32x2*)lds_w; LAS u32x4* EGc = (LAS u32x4*)(lds_w + 2048); const size_t tokC = (size_t)m0 * 2;
        HIST[lane] = 0u; HIST[64 + lane] = 0u;
        for (int _rp = 0; _rp <= (PEER_PROBE & 1); ++_rp)
#pragma unroll 1
        for (int head = 0; head < 8; ++head) PW_CAND(tokC, head, ELc);
    u32x4 ent4[4]; unsigned rk[4];
#pragma unroll
    for (int rep = 0; rep < 4; ++rep) { const int e = lane + 64 * rep; const u32x2 ent = ELc[e]; const float sc = __uint_as_float(ent.y);
        const float su = TSU[ent.x], sv = TSV[ent.x];
        float mx = sc;
#pragma unroll
        for (int o = 1; o < 16; o <<= 1) mx = fmaxf(mx, __shfl_xor(mx, o));
        const float p = __expf(sc - mx); float sm = p;
#pragma unroll
        for (int o = 1; o < 16; o <<= 1) sm += __shfl_xor(sm, o);
        ent4[rep].x = ent.x; ent4[rep].y = __float_as_uint(su); ent4[rep].z = __float_as_uint(p / sm * sv); ent4[rep].w = (unsigned)(rep >> 1);
        rk[rep] = atomicAdd((unsigned*)&HIST[ent.x >> 7], 1u); }
    { const unsigned c0 = HIST[2 * lane], c1 = HIST[2 * lane + 1]; unsigned inc = c0 + c1;
_Pragma("unroll")
      for (int o = 1; o < 64; o <<= 1) { const unsigned t = (unsigned)__shfl_up((int)inc, o); if (lane >= o) inc += t; }
      HIST[128 + 2 * lane] = inc - c0 - c1; HIST[128 + 2 * lane + 1] = inc - c1; }
#pragma unroll
    for (int rep = 0; rep < 4; ++rep) EGc[HIST[128 + (ent4[rep].x >> 7)] + rk[rep]] = ent4[rep];
    }
    int par = 0;
#pragma unroll 1
    for (int m = m0; m < mcount; m += mstep, par ^= 1) {
        const size_t tok0 = (size_t)m * 2; const bool has_next = (m + mstep) < mcount; const size_t tokC = (size_t)(m + mstep) * 2;
        if (PEER_WGSYNC == 1 || PEER_WGSYNC == 3) __syncthreads();
        if (PEER_WGSYNC == 2) xcc_sync(xctr, nloc, xbase + (unsigned)((m - m0) / mstep) + 1u);
        LAS u32x4* EGg = (LAS u32x4*)(lds_w + par * PW_SET + 2048);
        LAS u32x2* ELc = (LAS u32x2*)(lds_w + (par ^ 1) * PW_SET); LAS u32x4* EGc = (LAS u32x4*)(lds_w + (par ^ 1) * PW_SET + 2048);
        int x0q[4], x1q[4]; float sx0, sx1;
        {
    float gf[16];
#pragma unroll
    for (int j = 0; j < 4; ++j) { const f32x4 gg = *(const f32x4*)(gffn + lane * 16 + 4 * j); gf[4 * j] = gg[0]; gf[4 * j + 1] = gg[1]; gf[4 * j + 2] = gg[2]; gf[4 * j + 3] = gg[3]; }

#define PP_QUANT(xq, sx, tk) do { const u32x4* hp = (const u32x4*)(HB + (tok0 + (tk)) * 1024 + lane * 16); const u32x4 qa = hp[0], qb = hp[1]; float f[16]; float am = 0.f; \
        const float rs_ = 1.0f / sqrtf(SS[tok0 + (tk)] * (1.f / 1024.f) + EPS); \
        _Pragma("unroll") for (int e = 0; e < 4; ++e) { f[2 * e] = __uint_as_float(qa[e] << 16); f[2 * e + 1] = __uint_as_float(qa[e] & 0xffff0000u); f[8 + 2 * e] = __uint_as_float(qb[e] << 16); f[8 + 2 * e + 1] = __uint_as_float(qb[e] & 0xffff0000u); } \
        _Pragma("unroll") for (int c = 0; c < 16; ++c) f[c] *= rs_ * gf[c]; \
        _Pragma("unroll") for (int c = 0; c < 16; ++c) am = fmaxf(am, fabsf(f[c])); \
        am = wave_max(am); sx = am > 0.f ? am * (1.0f / 127.0f) : 1.0f; const float inv = 1.0f / sx; \
        _Pragma("unroll") for (int e = 0; e < 4; ++e) { const int q0 = (int)rintf(f[4 * e] * inv), q1 = (int)rintf(f[4 * e + 1] * inv), q2 = (int)rintf(f[4 * e + 2] * inv), q3 = (int)rintf(f[4 * e + 3] * inv); \
            xq[e] = (q0 & 0xff) | ((q1 & 0xff) << 8) | ((q2 & 0xff) << 16) | ((q3 & 0xff) << 24); } } while (0)
        PP_QUANT(x0q, sx0, 0); PP_QUANT(x1q, sx1, 1);
#undef PP_QUANT
        }
        f32x2 out0[8], out1[8];
#pragma unroll
        for (int c = 0; c < 8; ++c) { out0[c] = (f32x2){0.f, 0.f}; out1[c] = (f32x2){0.f, 0.f}; }
#define PP_LOAD(UB, VB, BT) do { _Pragma("unroll") for (int k = 0; k < 8; ++k) { const unsigned id = EGg[(BT) * 8 + k].x; UB[k] = *(const u32x4*)(TABU + (size_t)id * 2048 + lane * 16); VB[k] = *(const u32x4*)(TABV + (size_t)id * 2048 + lane * 16); } } while (0)
#define PP_COMPUTE(UB, VB, BT) do { int di[8]; \
        _Pragma("unroll") for (int k = 0; k < 8; ++k) { int a0 = 0; \
            const unsigned tkk = (unsigned)__builtin_amdgcn_readfirstlane((int)EGg[(BT) * 8 + k].w); \
            if (tkk) { _Pragma("unroll") for (int e = 0; e < 4; ++e) a0 = __builtin_amdgcn_sdot4((int)UB[k][e], x1q[e], a0, false); } \
            else     { _Pragma("unroll") for (int e = 0; e < 4; ++e) a0 = __builtin_amdgcn_sdot4((int)UB[k][e], x0q[e], a0, false); } \
            di[k] = a0; } \
        int r4[4], r2[2], v1; \
        { const bool h32 = (lane & 32) != 0; \
          _Pragma("unroll") for (int j = 0; j < 4; ++j) { const int send = h32 ? di[j] : di[j + 4], keep = h32 ? di[j + 4] : di[j]; r4[j] = keep + __shfl_xor(send, 32); } \
          const bool h16 = (lane & 16) != 0; \
          _Pragma("unroll") for (int j = 0; j < 2; ++j) { const int send = h16 ? r4[j] : r4[j + 2], keep = h16 ? r4[j + 2] : r4[j]; r2[j] = keep + __shfl_xor(send, 16); } \
          const bool h8 = (lane & 8) != 0; \
          { const int send = h8 ? r2[0] : r2[1], keep = h8 ? r2[1] : r2[0]; v1 = keep + __shfl_xor(send, 8); } \
          v1 += __shfl_xor(v1, 4); v1 += __shfl_xor(v1, 2); v1 += __shfl_xor(v1, 1); } \
        float act; { const u32x4 eg = EGg[(BT) * 8 + (lane >> 3)]; const float v = (float)v1 * __uint_as_float(eg.y) * (eg.w ? sx1 : sx0); \
          const float t = __builtin_amdgcn_rcpf(fabsf(v) * 0.2316418882f + 1.0f); \
          float q = t * 0.5307027145f + (-0.7265760135f); q = q * t + 0.7107068705f; q = q * t + (-0.142248368f); q = q * t + 0.127414796f; q = q * t; \
          const float m = v * (q * __builtin_amdgcn_exp2f(v * v * (-0.72134752044f))); \
          act = (v < 0.f ? m : v - m) * __uint_as_float(eg.z); } \
        _Pragma("unroll") for (int k = 0; k < 8; ++k) { const float a = __uint_as_float(__builtin_amdgcn_readlane((int)__float_as_uint(act), 8 * k)); \
            const unsigned tkk = (unsigned)__builtin_amdgcn_readfirstlane((int)EGg[(BT) * 8 + k].w); \
            if (tkk) { _Pragma("unroll") for (int e = 0; e < 4; ++e) { out1[2 * e] += __builtin_amdgcn_cvt_pk_f32_fp8((int)VB[k][e], false) * a; out1[2 * e + 1] += __builtin_amdgcn_cvt_pk_f32_fp8((int)VB[k][e], true) * a; } } \
            else     { _Pragma("unroll") for (int e = 0; e < 4; ++e) { out0[2 * e] += __builtin_amdgcn_cvt_pk_f32_fp8((int)VB[k][e], false) * a; out0[2 * e + 1] += __builtin_amdgcn_cvt_pk_f32_fp8((int)VB[k][e], true) * a; } } } } while (0)
        {
            u32x4 ubA[8], vbA[8], ubB[8], vbB[8];
            PP_LOAD(ubA, vbA, 0);
#pragma unroll 1
            for (int bt = 0; bt < 32; bt += 2) {
                if (PEER_WGSYNC == 3 && (bt & 7) == 0) __syncthreads();
                PP_LOAD(ubB, vbB, bt + 1);
                PP_COMPUTE(ubA, vbA, bt);
                const int nb = (bt + 2 < 32) ? bt + 2 : 31;
                if (has_next && (bt & 3) == 0) { const int head = bt >> 2; PW_CAND(tokC, head, ELc); }
                PP_LOAD(ubA, vbA, nb);
                PP_COMPUTE(ubB, vbB, bt + 1);
            }
        }
#undef PP_LOAD
#undef PP_COMPUTE
        if (has_next) {
            HIST[lane] = 0u; HIST[64 + lane] = 0u;
        u32x4 ent4[4]; unsigned rk[4];
#pragma unroll
        for (int rep = 0; rep < 4; ++rep) { const int e = lane + 64 * rep; const u32x2 ent = ELc[e]; const float sc = __uint_as_float(ent.y);
            const float su = TSU[ent.x], sv = TSV[ent.x];
            float mx = sc;
#pragma unroll
            for (int o = 1; o < 16; o <<= 1) mx = fmaxf(mx, __shfl_xor(mx, o));
            const float p = __expf(sc - mx); float sm = p;
#pragma unroll
            for (int o = 1; o < 16; o <<= 1) sm += __shfl_xor(sm, o);
            ent4[rep].x = ent.x; ent4[rep].y = __float_as_uint(su); ent4[rep].z = __float_as_uint(p / sm * sv); ent4[rep].w = (unsigned)(rep >> 1);
            rk[rep] = atomicAdd((unsigned*)&HIST[ent.x >> 7], 1u); }
        { const unsigned c0 = HIST[2 * lane], c1 = HIST[2 * lane + 1]; unsigned inc = c0 + c1;
_Pragma("unroll")
      for (int o = 1; o < 64; o <<= 1) { const unsigned t = (unsigned)__shfl_up((int)inc, o); if (lane >= o) inc += t; }
      HIST[128 + 2 * lane] = inc - c0 - c1; HIST[128 + 2 * lane + 1] = inc - c1; }
#pragma unroll
        for (int rep = 0; rep < 4; ++rep) EGc[HIST[128 + (ent4[rep].x >> 7)] + rk[rep]] = ent4[rep];
        }
#pragma unroll
        for (int tk = 0; tk < 2; ++tk) {
            float xr[16]; float ss = 0.f;
            { const u32x4* hp = (const u32x4*)(HB + (tok0 + tk) * 1024 + lane * 16); const u32x4 qa = hp[0], qb = hp[1];
#pragma unroll
              for (int e = 0; e < 4; ++e) { xr[2 * e] = __uint_as_float(qa[e] << 16); xr[2 * e + 1] = __uint_as_float(qa[e] & 0xffff0000u); xr[8 + 2 * e] = __uint_as_float(qb[e] << 16); xr[8 + 2 * e + 1] = __uint_as_float(qb[e] & 0xffff0000u); } }
#pragma unroll
            for (int c = 0; c < 16; ++c) { const f32x2 o2 = tk ? out1[c >> 1] : out0[c >> 1]; xr[c] += (c & 1) ? o2.y : o2.x; ss += xr[c] * xr[c]; }
            const float rstd = 1.0f / sqrtf(wave_sum(ss) * (1.f / 1024.f) + EPS);
            if (LAST) {
                float* xq = xres + (tok0 + tk) * 1024 + lane * 16;
#pragma unroll
                for (int j = 0; j < 4; ++j) { const f32x4 gg = *(const f32x4*)(gnext + lane * 16 + 4 * j); *(f32x4*)(xq + 4 * j) = (f32x4){xr[4 * j] * rstd * gg[0], xr[4 * j + 1] * rstd * gg[1], xr[4 * j + 2] * rstd * gg[2], xr[4 * j + 3] * rstd * gg[3]}; }
            } else {
                u32x4 o0, o1, r0, r1;
#pragma unroll
                for (int j = 0; j < 4; ++j) { const f32x4 gg = *(const f32x4*)(gnext + lane * 16 + 4 * j);
                    const unsigned lo = cvt_pk_bf16(xr[4 * j] * rstd * gg[0], xr[4 * j + 1] * rstd * gg[1]), hi = cvt_pk_bf16(xr[4 * j + 2] * rstd * gg[2], xr[4 * j + 3] * rstd * gg[3]);
                    const unsigned rl = cvt_pk_bf16(xr[4 * j], xr[4 * j + 1]), rh = cvt_pk_bf16(xr[4 * j + 2], xr[4 * j + 3]);
                    if (j < 2) { o0[2 * j] = lo; o0[2 * j + 1] = hi; r0[2 * j] = rl; r0[2 * j + 1] = rh; } else { o1[2 * (j - 2)] = lo; o1[2 * (j - 2) + 1] = hi; r1[2 * (j - 2)] = rl; r1[2 * (j - 2) + 1] = rh; } }
                u32x4* hq = (u32x4*)(HB + (tok0 + tk) * 1024 + lane * 16); hq[0] = o0; hq[1] = o1;
                u32x4* xq2 = (u32x4*)((bf16*)xres + (tok0 + tk) * 1024 + lane * 16); xq2[0] = r0; xq2[1] = r1;
            }
        }
    }
#undef PW_CAND
}

template <bool LAST>
__device__ __forceinline__ void peer_pair(LAS unsigned char* lds_w, size_t tok0, const u32x2* TOPK, const unsigned char* TABU, const unsigned char* TABV, const float* TSU, const float* TSV, bf16* HB, const float* SS, const float* gffn, float* xres, const float* gnext, int lane_in) {
    int lane = lane_in; asm volatile("" : "+v"(lane));
    LAS u32x2* EL = (LAS u32x2*)lds_w;
    LAS u32x4* EG = (LAS u32x4*)(lds_w + 2048);
    LAS unsigned* HIST = (LAS unsigned*)(lds_w + 2048 + 4096);
    if (lane < 32) HIST[lane] = 0u;
    int ri, rj;
    { const int L = lane;
      if (L < 16) { ri = 0; rj = L; } else if (L < 24) { ri = 1; rj = L - 16; } else if (L < 29) { ri = 2; rj = L - 24; } else if (L < 33) { ri = 3; rj = L - 29; }
      else if (L < 36) { ri = 4; rj = L - 33; } else if (L < 38) { ri = 5; rj = L - 36; } else if (L < 40) { ri = 6; rj = L - 38; } else if (L < 42) { ri = 7; rj = L - 40; }
      else if (L < 50) { ri = L - 34; rj = 0; } else { ri = 0; rj = 0; } }
    LAS u32x2* SLs = (LAS u32x2*)(lds_w + 6400);
    for (int _rp = 0; _rp <= (PEER_PROBE & 1); ++_rp)
#pragma unroll 1
    for (int head = 0; head < 8; ++head) {
        const u32x2 ent = TOPK[((tok0 + (lane >> 5)) * 16 + head * 2) * 16 + (lane & 31)];
        const unsigned long long key = ((unsigned long long)sortable_u32(__uint_as_float(ent.x)) << 32) | (unsigned)(15 - (lane & 15));
        unsigned rank = 0u; rank_step<1>(key, rank);
        SLs[(lane >> 4) * 16 + rank] = ent;
#pragma unroll 1
        for (int tk = 0; tk < 2; ++tk) {
            const u32x2 ea = SLs[(tk * 2) * 16 + ri], eb = SLs[(tk * 2 + 1) * 16 + rj];
            const float cs = __uint_as_float(ea.x) + __uint_as_float(eb.x); const unsigned ck = ea.y * 128u + eb.y;
            const unsigned u = (lane < 50) ? sortable_u32(cs) : 0u;
            unsigned T = 0u;
#pragma unroll 1
            for (int bit = 31; bit >= 0; --bit) {
                const unsigned cand = T | (1u << bit); const unsigned cnt = (unsigned)__popcll(__ballot(u >= cand));
                if (cnt >= 16u) T = cand;
                if (cnt == 16u) break;
            }
            const unsigned G = (unsigned)__popcll(__ballot(u > T)); const unsigned need_eq = 16u - G;
            const bool gt = u > T, eq = u == T;
            const unsigned long long meq = __ballot(eq);
            const bool sl = gt || (eq && (mbcnt64(meq) < need_eq));
            const unsigned long long msl = __ballot(sl);
            if (sl) { u32x2 e; e.x = ck; e.y = __float_as_uint(cs); EL[(tk * 8 + head) * 16 + mbcnt64(msl)] = e; }
        }
    }
    u32x4 ent4[4]; unsigned rk[4];
#pragma unroll
    for (int rep = 0; rep < 4; ++rep) { const int e = lane + 64 * rep; const u32x2 ent = EL[e]; const float sc = __uint_as_float(ent.y);
        const float su = TSU[ent.x], sv = TSV[ent.x];
        float mx = sc;
#pragma unroll
        for (int o = 1; o < 16; o <<= 1) mx = fmaxf(mx, __shfl_xor(mx, o));
        const float p = __expf(sc - mx); float sm = p;
#pragma unroll
        for (int o = 1; o < 16; o <<= 1) sm += __shfl_xor(sm, o);
        ent4[rep].x = ent.x; ent4[rep].y = __float_as_uint(su); ent4[rep].z = __float_as_uint(p / sm * sv); ent4[rep].w = (unsigned)(rep >> 1);
        rk[rep] = atomicAdd((unsigned*)&HIST[ent.x >> 9], 1u); }
    { unsigned c = (lane < 32) ? HIST[lane] : 0u, inc = c;
#pragma unroll
      for (int o = 1; o < 32; o <<= 1) { const unsigned t = (unsigned)__shfl_up((int)inc, o); if ((lane & 31) >= o) inc += t; }
      if (lane < 32) HIST[32 + lane] = inc - c; }
#pragma unroll
    for (int rep = 0; rep < 4; ++rep) EG[HIST[32 + (ent4[rep].x >> 9)] + rk[rep]] = ent4[rep];
    int x0q[4], x1q[4]; float sx0, sx1;
    float gf[16];
#pragma unroll
    for (int j = 0; j < 4; ++j) { const f32x4 gg = *(const f32x4*)(gffn + lane * 16 + 4 * j); gf[4 * j] = gg[0]; gf[4 * j + 1] = gg[1]; gf[4 * j + 2] = gg[2]; gf[4 * j + 3] = gg[3]; }
#define PP_QUANT(xq, sx, tk) do { const u32x4* hp = (const u32x4*)(HB + (tok0 + (tk)) * 1024 + lane * 16); const u32x4 qa = hp[0], qb = hp[1]; float f[16]; float am = 0.f; \
        const float rs_ = 1.0f / sqrtf(SS[tok0 + (tk)] * (1.f / 1024.f) + EPS); \
        _Pragma("unroll") for (int e = 0; e < 4; ++e) { f[2 * e] = __uint_as_float(qa[e] << 16); f[2 * e + 1] = __uint_as_float(qa[e] & 0xffff0000u); f[8 + 2 * e] = __uint_as_float(qb[e] << 16); f[8 + 2 * e + 1] = __uint_as_float(qb[e] & 0xffff0000u); } \
        _Pragma("unroll") for (int c = 0; c < 16; ++c) f[c] *= rs_ * gf[c]; \
        _Pragma("unroll") for (int c = 0; c < 16; ++c) am = fmaxf(am, fabsf(f[c])); \
        am = wave_max(am); sx = am > 0.f ? am * (1.0f / 127.0f) : 1.0f; const float inv = 1.0f / sx; \
        _Pragma("unroll") for (int e = 0; e < 4; ++e) { const int q0 = (int)rintf(f[4 * e] * inv), q1 = (int)rintf(f[4 * e + 1] * inv), q2 = (int)rintf(f[4 * e + 2] * inv), q3 = (int)rintf(f[4 * e + 3] * inv); \
            xq[e] = (q0 & 0xff) | ((q1 & 0xff) << 8) | ((q2 & 0xff) << 16) | ((q3 & 0xff) << 24); } } while (0)
    PP_QUANT(x0q, sx0, 0); PP_QUANT(x1q, sx1, 1);
#undef PP_QUANT
    f32x2 outp[16];
#pragma unroll
    for (int c = 0; c < 16; ++c) outp[c] = (f32x2){0.f, 0.f};
#define PP_LOAD(UB, VB, BT) do { _Pragma("unroll") for (int k = 0; k < 8; ++k) { const unsigned id = EG[(BT) * 8 + k].x; UB[k] = *(const u32x4*)(TABU + (size_t)id * 1024 + lane * 16); VB[k] = *(const u32x4*)(TABV + (size_t)id * 1024 + lane * 16); } } while (0)
#define PP_COMPUTE(UB, VB, BT) do { int di[8]; \
        _Pragma("unroll") for (int k = 0; k < 8; ++k) { int a0 = 0, a1 = 0; \
            _Pragma("unroll") for (int e = 0; e < 4; ++e) { a0 = __builtin_amdgcn_sdot4((int)UB[k][e], x0q[e], a0, false); a1 = __builtin_amdgcn_sdot4((int)UB[k][e], x1q[e], a1, false); } \
            const unsigned tkk = (unsigned)__builtin_amdgcn_readfirstlane((int)EG[(BT) * 8 + k].w); di[k] = tkk ? a1 : a0; } \
        int r4[4], r2[2], v1; \
        { const bool h32 = (lane & 32) != 0; \
          _Pragma("unroll") for (int j = 0; j < 4; ++j) { const int send = h32 ? di[j] : di[j + 4], keep = h32 ? di[j + 4] : di[j]; r4[j] = keep + __shfl_xor(send, 32); } \
          const bool h16 = (lane & 16) != 0; \
          _Pragma("unroll") for (int j = 0; j < 2; ++j) { const int send = h16 ? r4[j] : r4[j + 2], keep = h16 ? r4[j + 2] : r4[j]; r2[j] = keep + __shfl_xor(send, 16); } \
          const bool h8 = (lane & 8) != 0; \
          { const int send = h8 ? r2[0] : r2[1], keep = h8 ? r2[1] : r2[0]; v1 = keep + __shfl_xor(send, 8); } \
          v1 += __shfl_xor(v1, 4); v1 += __shfl_xor(v1, 2); v1 += __shfl_xor(v1, 1); } \
        float act; { const u32x4 eg = EG[(BT) * 8 + (lane >> 3)]; const float v = (float)v1 * __uint_as_float(eg.y) * (eg.w ? sx1 : sx0); \
          const float t = __builtin_amdgcn_rcpf(fabsf(v) * 0.2316418882f + 1.0f); \
          float q = t * 0.5307027145f + (-0.7265760135f); q = q * t + 0.7107068705f; q = q * t + (-0.142248368f); q = q * t + 0.127414796f; q = q * t; \
          const float m = v * (q * __builtin_amdgcn_exp2f(v * v * (-0.72134752044f))); \
          act = (v < 0.f ? m : v - m) * __uint_as_float(eg.z); }                        \
        _Pragma("unroll") for (int k = 0; k < 8; ++k) { const float a = __uint_as_float(__builtin_amdgcn_readlane((int)__float_as_uint(act), 8 * k)); \
            const unsigned tkk = (unsigned)__builtin_amdgcn_readfirstlane((int)EG[(BT) * 8 + k].w); \
            const f32x2 a2 = tkk ? (f32x2){0.f, a} : (f32x2){a, 0.f}; \
            _Pragma("unroll") for (int e = 0; e < 4; ++e) { const f32x2 lo = __builtin_amdgcn_cvt_pk_f32_fp8((int)VB[k][e], false), hi = __builtin_amdgcn_cvt_pk_f32_fp8((int)VB[k][e], true); \
                outp[4 * e] += a2 * lo.x; outp[4 * e + 1] += a2 * lo.y; outp[4 * e + 2] += a2 * hi.x; outp[4 * e + 3] += a2 * hi.y; } } } while (0)
    for (int _rg = ((PEER_PROBE & 6) ? 0 : 1); _rg < 2; ++_rg) {
        const bool noload = (PEER_PROBE & 4) && _rg == 0;
#pragma unroll
        for (int c = 0; c < 16; ++c) outp[c] = (f32x2){0.f, 0.f};
        u32x4 ubA[8], vbA[8], ubB[8], vbB[8];
#pragma unroll
        for (int k = 0; k < 8; ++k) { ubA[k] = (u32x4){0u, 0u, 0u, 0u}; vbA[k] = ubA[k]; ubB[k] = ubA[k]; vbB[k] = ubA[k]; }
        if (!noload) PP_LOAD(ubA, vbA, 0);
#pragma unroll 1
        for (int bt = 0; bt < 32; bt += 2) {
            if (!noload) PP_LOAD(ubB, vbB, bt + 1);
            PP_COMPUTE(ubA, vbA, bt);
            const int nb = (bt + 2 < 32) ? bt + 2 : 31;
            if (!noload) PP_LOAD(ubA, vbA, nb);
            PP_COMPUTE(ubB, vbB, bt + 1);
        }
    }
#undef PP_LOAD
#undef PP_COMPUTE
#pragma unroll
    for (int tk = 0; tk < 2; ++tk) {
        f32x4 xr[4]; float ss = 0.f;
        float* xq = xres + (tok0 + tk) * 1024 + lane * 16;
#pragma unroll
        for (int j = 0; j < 4; ++j) { xr[j] = *(const f32x4*)(xq + 4 * j);
#pragma unroll
            for (int e = 0; e < 4; ++e) { xr[j][e] += tk ? outp[4 * j + e].y : outp[4 * j + e].x; ss += xr[j][e] * xr[j][e]; } }
        const float rstd = 1.0f / sqrtf(wave_sum(ss) * (1.f / 1024.f) + EPS);
        if (LAST) {
#pragma unroll
            for (int j = 0; j < 4; ++j) { const f32x4 gg = *(const f32x4*)(gnext + lane * 16 + 4 * j); *(f32x4*)(xq + 4 * j) = xr[j] * rstd * gg; }
        } else {
            u32x4 o0, o1;
#pragma unroll
            for (int j = 0; j < 4; ++j) { *(f32x4*)(xq + 4 * j) = xr[j]; const f32x4 gg = *(const f32x4*)(gnext + lane * 16 + 4 * j);
                const unsigned lo = cvt_pk_bf16(xr[j][0] * rstd * gg[0], xr[j][1] * rstd * gg[1]), hi = cvt_pk_bf16(xr[j][2] * rstd * gg[2], xr[j][3] * rstd * gg[3]);
                if (j < 2) { o0[2 * j] = lo; o0[2 * j + 1] = hi; } else { o1[2 * (j - 2)] = lo; o1[2 * (j - 2) + 1] = hi; } }
            u32x4* hq = (u32x4*)(HB + (tok0 + tk) * 1024 + lane * 16); hq[0] = o0; hq[1] = o1;
        }
    }
}

__device__ __forceinline__ void pair_prepare(LAS unsigned char* lds_w, size_t tok0, const u32x2* TOPK, const float* TSU, const float* TSV, int lane_in) {
    int lane = lane_in; asm volatile("" : "+v"(lane));
    LAS u32x2* EL = (LAS u32x2*)lds_w;
    LAS u32x4* EG = (LAS u32x4*)(lds_w + 2048);
    LAS unsigned* HIST = (LAS unsigned*)(lds_w + 2048 + 4096);
    if (lane < 32) HIST[lane] = 0u;
    for (int _rp = 0; _rp <= (PEER_PROBE & 1); ++_rp)
#pragma unroll 1
    for (int th = 0; th < 16; ++th) { const int tk = th >> 3, head = th & 7;
        const u32x2* base = TOPK + ((tok0 + tk) * 16 + head * 2) * 16;
        const u32x2 e0 = base[lane >> 2];
        const u32x4 e1a = *(const u32x4*)(base + 16 + 4 * (lane & 3)), e1b = *(const u32x4*)(base + 16 + 4 * (lane & 3) + 2);
        const float s0 = __uint_as_float(e0.x);
        float cs[4]; unsigned ck[4], u[4];
        cs[0] = s0 + __uint_as_float(e1a.x); ck[0] = e0.y * 128u + e1a.y; cs[1] = s0 + __uint_as_float(e1a.z); ck[1] = e0.y * 128u + e1a.w;
        cs[2] = s0 + __uint_as_float(e1b.x); ck[2] = e0.y * 128u + e1b.y; cs[3] = s0 + __uint_as_float(e1b.z); ck[3] = e0.y * 128u + e1b.w;
#pragma unroll
        for (int m = 0; m < 4; ++m) u[m] = sortable_u32(cs[m]);
        unsigned T = 0u;
#pragma unroll 1
        for (int bit = 31; bit >= 0; --bit) {
            const unsigned cand = T | (1u << bit); unsigned cnt = 0u;
#pragma unroll
            for (int m = 0; m < 4; ++m) cnt += (unsigned)__popcll(__ballot(u[m] >= cand));
            if (cnt >= 16u) T = cand;
            if (cnt == 16u) break;
        }
        unsigned G = 0u;
#pragma unroll
        for (int m = 0; m < 4; ++m) G += (unsigned)__popcll(__ballot(u[m] > T));
        const unsigned need_eq = 16u - G; unsigned pos = 0u, eq_used = 0u;
#pragma unroll
        for (int m = 0; m < 4; ++m) {
            const bool gt = u[m] > T, eq = u[m] == T;
            const unsigned long long meq = __ballot(eq);
            const bool sl = gt || (eq && (eq_used + mbcnt64(meq) < need_eq));
            const unsigned long long msl = __ballot(sl);
            if (sl) { u32x2 e; e.x = ck[m]; e.y = __float_as_uint(cs[m]); EL[th * 16 + pos + mbcnt64(msl)] = e; }
            pos += (unsigned)__popcll(msl); eq_used += (unsigned)__popcll(meq); }
    }
    u32x4 ent4[4]; unsigned rk[4];
#pragma unroll
    for (int rep = 0; rep < 4; ++rep) { const int e = lane + 64 * rep; const u32x2 ent = EL[e]; const float sc = __uint_as_float(ent.y);
        const float su = TSU[ent.x], sv = TSV[ent.x];
        float mx = sc;
#pragma unroll
        for (int o = 1; o < 16; o <<= 1) mx = fmaxf(mx, __shfl_xor(mx, o));
        const float p = __expf(sc - mx); float sm = p;
#pragma unroll
        for (int o = 1; o < 16; o <<= 1) sm += __shfl_xor(sm, o);
        ent4[rep].x = ent.x; ent4[rep].y = __float_as_uint(su); ent4[rep].z = __float_as_uint(p / sm * sv); ent4[rep].w = (unsigned)(rep >> 1);
        rk[rep] = atomicAdd((unsigned*)&HIST[ent.x >> 9], 1u); }
    { unsigned c = (lane < 32) ? HIST[lane] : 0u, inc = c;
#pragma unroll
      for (int o = 1; o < 32; o <<= 1) { const unsigned t = (unsigned)__shfl_up((int)inc, o); if ((lane & 31) >= o) inc += t; }
      if (lane < 32) HIST[32 + lane] = inc - c; }
#pragma unroll
    for (int rep = 0; rep < 4; ++rep) EG[HIST[32 + (ent4[rep].x >> 9)] + rk[rep]] = ent4[rep];
}
__device__ __forceinline__ void pair_pass1(LAS unsigned char* lds_w, size_t tok0, const unsigned char* TABU, const bf16* HB, int lane_in) {
    int lane = lane_in; asm volatile("" : "+v"(lane));
    LAS u32x4* EG = (LAS u32x4*)(lds_w + 2048);
    f32x2 xp[16];
    { const u32x4* h0 = (const u32x4*)(HB + tok0 * 1024 + lane * 16); const u32x4* h1 = (const u32x4*)(HB + (tok0 + 1) * 1024 + lane * 16);
      const u32x4 a0 = h0[0], b0 = h0[1], a1 = h1[0], b1 = h1[1];
#pragma unroll
      for (int e = 0; e < 4; ++e) { xp[2 * e] = (f32x2){__uint_as_float(a0[e] << 16), __uint_as_float(a1[e] << 16)}; xp[2 * e + 1] = (f32x2){__uint_as_float(a0[e] & 0xffff0000u), __uint_as_float(a1[e] & 0xffff0000u)};
          xp[8 + 2 * e] = (f32x2){__uint_as_float(b0[e] << 16), __uint_as_float(b1[e] << 16)}; xp[8 + 2 * e + 1] = (f32x2){__uint_as_float(b0[e] & 0xffff0000u), __uint_as_float(b1[e] & 0xffff0000u)}; } }
    u32x4 ub[8];
#pragma unroll
    for (int k = 0; k < 8; ++k) ub[k] = *(const u32x4*)(TABU + (size_t)EG[k].x * 1024 + lane * 16);
#pragma unroll 1
    for (int bt = 0; bt < 32; ++bt) {
        u32x4 un[8];
        const int nb = (bt + 1 < 32) ? bt + 1 : bt;
#pragma unroll
        for (int k = 0; k < 8; ++k) un[k] = *(const u32x4*)(TABU + (size_t)EG[nb * 8 + k].x * 1024 + lane * 16);
        float d[8];
#pragma unroll
        for (int k = 0; k < 8; ++k) { f32x2 a = {0.f, 0.f};
#pragma unroll
            for (int e = 0; e < 4; ++e) { const f32x2 lo = __builtin_amdgcn_cvt_pk_f32_fp8((int)ub[k][e], false), hi = __builtin_amdgcn_cvt_pk_f32_fp8((int)ub[k][e], true);
                a += xp[4 * e] * lo.x; a += xp[4 * e + 1] * lo.y; a += xp[4 * e + 2] * hi.x; a += xp[4 * e + 3] * hi.y; }
            const unsigned tkk = (unsigned)__builtin_amdgcn_readfirstlane((int)EG[bt * 8 + k].w);
            d[k] = tkk ? a.y : a.x; }
        float r4[4], r2[2], v1;
        { const bool h32 = (lane & 32) != 0;
#pragma unroll
          for (int j = 0; j < 4; ++j) { const float send = h32 ? d[j] : d[j + 4], keep = h32 ? d[j + 4] : d[j]; r4[j] = keep + __shfl_xor(send, 32); }
          const bool h16 = (lane & 16) != 0;
#pragma unroll
          for (int j = 0; j < 2; ++j) { const float send = h16 ? r4[j] : r4[j + 2], keep = h16 ? r4[j + 2] : r4[j]; r2[j] = keep + __shfl_xor(send, 16); }
          const bool h8 = (lane & 8) != 0;
          { const float send = h8 ? r2[0] : r2[1], keep = h8 ? r2[1] : r2[0]; v1 = keep + __shfl_xor(send, 8); }
          v1 += __shfl_xor(v1, 4); v1 += __shfl_xor(v1, 2); v1 += __shfl_xor(v1, 1); }
        { const u32x4 eg = EG[bt * 8 + (lane >> 3)]; const float x = v1 * __uint_as_float(eg.y);
          const float act = 0.5f * x * (1.0f + erff(x * 0.70710678118654752f)) * __uint_as_float(eg.z);
          if ((lane & 7) == 0) *((LAS float*)&EG[bt * 8 + (lane >> 3)] + 1) = act; }
#pragma unroll
        for (int k = 0; k < 8; ++k) ub[k] = un[k];
    }
}
template <bool LAST>
__device__ __forceinline__ void pair_pass2(LAS unsigned char* lds_w, size_t tok0, const unsigned char* TABV, bf16* HB, float* xres, const float* gnext, int lane_in) {
    int lane = lane_in; asm volatile("" : "+v"(lane));
    LAS u32x4* EG = (LAS u32x4*)(lds_w + 2048);
    f32x2 outp[16];
#pragma unroll
    for (int c = 0; c < 16; ++c) outp[c] = (f32x2){0.f, 0.f};
    u32x4 vb[8];
#pragma unroll
    for (int k = 0; k < 8; ++k) vb[k] = *(const u32x4*)(TABV + (size_t)EG[k].x * 1024 + lane * 16);
#pragma unroll 1
    for (int bt = 0; bt < 32; ++bt) {
        u32x4 vn[8];
        const int nb = (bt + 1 < 32) ? bt + 1 : bt;
#pragma unroll
        for (int k = 0; k < 8; ++k) vn[k] = *(const u32x4*)(TABV + (size_t)EG[nb * 8 + k].x * 1024 + lane * 16);
#pragma unroll
        for (int k = 0; k < 8; ++k) { const u32x4 eg = EG[bt * 8 + k];
            const unsigned tkk = (unsigned)__builtin_amdgcn_readfirstlane((int)eg.w); const float a = __uint_as_float((unsigned)__builtin_amdgcn_readfirstlane((int)eg.y));
            const f32x2 a2 = tkk ? (f32x2){0.f, a} : (f32x2){a, 0.f};
#pragma unroll
            for (int e = 0; e < 4; ++e) { const f32x2 lo = __builtin_amdgcn_cvt_pk_f32_fp8((int)vb[k][e], false), hi = __builtin_amdgcn_cvt_pk_f32_fp8((int)vb[k][e], true);
                outp[4 * e] += a2 * lo.x; outp[4 * e + 1] += a2 * lo.y; outp[4 * e + 2] += a2 * hi.x; outp[4 * e + 3] += a2 * hi.y; } }
#pragma unroll
        for (int k = 0; k < 8; ++k) vb[k] = vn[k];
    }
#pragma unroll
    for (int tk = 0; tk < 2; ++tk) {
        f32x4 xr[4]; float ss = 0.f;
        float* xq = xres + (tok0 + tk) * 1024 + lane * 16;
#pragma unroll
        for (int j = 0; j < 4; ++j) { xr[j] = *(const f32x4*)(xq + 4 * j);
#pragma unroll
            for (int e = 0; e < 4; ++e) { xr[j][e] += tk ? outp[4 * j + e].y : outp[4 * j + e].x; ss += xr[j][e] * xr[j][e]; } }
        const float rstd = 1.0f / sqrtf(wave_sum(ss) * (1.f / 1024.f) + EPS);
        if (LAST) {
#pragma unroll
            for (int j = 0; j < 4; ++j) { const f32x4 gg = *(const f32x4*)(gnext + lane * 16 + 4 * j); *(f32x4*)(xq + 4 * j) = xr[j] * rstd * gg; }
        } else {
            u32x4 o0, o1;
#pragma unroll
            for (int j = 0; j < 4; ++j) { *(f32x4*)(xq + 4 * j) = xr[j]; const f32x4 gg = *(const f32x4*)(gnext + lane * 16 + 4 * j);
                const unsigned lo = cvt_pk_bf16(xr[j][0] * rstd * gg[0], xr[j][1] * rstd * gg[1]), hi = cvt_pk_bf16(xr[j][2] * rstd * gg[2], xr[j][3] * rstd * gg[3]);
                if (j < 2) { o0[2 * j] = lo; o0[2 * j + 1] = hi; } else { o1[2 * (j - 2)] = lo; o1[2 * (j - 2) + 1] = hi; } }
            u32x4* hq = (u32x4*)(HB + (tok0 + tk) * 1024 + lane * 16); hq[0] = o0; hq[1] = o1;
        }
    }
}

constexpr int PQ_EL = 0, PQ_EG = 4096, PQ_HIST = 12288, PQ_BYTES = 12800;
__device__ __forceinline__ void quad_prepare(LAS unsigned char* lds_w, size_t tok0, const u32x2* TOPK, const float* TSU, const float* TSV, int lane_in) {
    int lane = lane_in; asm volatile("" : "+v"(lane));
    LAS u32x2* EL = (LAS u32x2*)(lds_w + PQ_EL); LAS u32x4* EG = (LAS u32x4*)(lds_w + PQ_EG); LAS unsigned* HIST = (LAS unsigned*)(lds_w + PQ_HIST);
    if (lane < 32) HIST[lane] = 0u;
    for (int _rp = 0; _rp <= (PEER_PROBE & 1); ++_rp)
#pragma unroll 1
    for (int th = 0; th < 32; ++th) { const int tk = th >> 3, head = th & 7;
        const u32x2* base = TOPK + ((tok0 + tk) * 16 + head * 2) * 16;
        const u32x2 e0 = base[lane >> 2];
        const u32x4 e1a = *(const u32x4*)(base + 16 + 4 * (lane & 3)), e1b = *(const u32x4*)(base + 16 + 4 * (lane & 3) + 2);
        const float s0 = __uint_as_float(e0.x);
        float cs[4]; unsigned ck[4], u[4];
        cs[0] = s0 + __uint_as_float(e1a.x); ck[0] = e0.y * 128u + e1a.y; cs[1] = s0 + __uint_as_float(e1a.z); ck[1] = e0.y * 128u + e1a.w;
        cs[2] = s0 + __uint_as_float(e1b.x); ck[2] = e0.y * 128u + e1b.y; cs[3] = s0 + __uint_as_float(e1b.z); ck[3] = e0.y * 128u + e1b.w;
#pragma unroll
        for (int m = 0; m < 4; ++m) u[m] = sortable_u32(cs[m]);
        unsigned T = 0u;
#pragma unroll 1
        for (int bit = 31; bit >= 0; --bit) {
            const unsigned cand = T | (1u << bit); unsigned cnt = 0u;
#pragma unroll
            for (int m = 0; m < 4; ++m) cnt += (unsigned)__popcll(__ballot(u[m] >= cand));
            if (cnt >= 16u) T = cand;
            if (cnt == 16u) break;
        }
        unsigned G = 0u;
#pragma unroll
        for (int m = 0; m < 4; ++m) G += (unsigned)__popcll(__ballot(u[m] > T));
        const unsigned need_eq = 16u - G; unsigned pos = 0u, eq_used = 0u;
#pragma unroll
        for (int m = 0; m < 4; ++m) {
            const bool gt = u[m] > T, eq = u[m] == T;
            const unsigned long long meq = __ballot(eq);
            const bool sl = gt || (eq && (eq_used + mbcnt64(meq) < need_eq));
            const unsigned long long msl = __ballot(sl);
            if (sl) { u32x2 e; e.x = ck[m]; e.y = __float_as_uint(cs[m]); EL[th * 16 + pos + mbcnt64(msl)] = e; }
            pos += (unsigned)__popcll(msl); eq_used += (unsigned)__popcll(meq); }
    }
    u32x4 ent8[8]; unsigned rk[8];
#pragma unroll
    for (int rep = 0; rep < 8; ++rep) { const int e = lane + 64 * rep; const u32x2 ent = EL[e]; const float sc = __uint_as_float(ent.y);
        const float su = TSU[ent.x], sv = TSV[ent.x];
        float mx = sc;
#pragma unroll
        for (int o = 1; o < 16; o <<= 1) mx = fmaxf(mx, __shfl_xor(mx, o));
        const float p = __expf(sc - mx); float sm = p;
#pragma unroll
        for (int o = 1; o < 16; o <<= 1) sm += __shfl_xor(sm, o);
        ent8[rep].x = ent.x; ent8[rep].y = __float_as_uint(su); ent8[rep].z = __float_as_uint(p / sm * sv); ent8[rep].w = (unsigned)(rep >> 1);
        rk[rep] = atomicAdd((unsigned*)&HIST[ent.x >> 9], 1u); }
    { unsigned c = (lane < 32) ? HIST[lane] : 0u, inc = c;
#pragma unroll
      for (int o = 1; o < 32; o <<= 1) { const unsigned t = (unsigned)__shfl_up((int)inc, o); if ((lane & 31) >= o) inc += t; }
      if (lane < 32) HIST[32 + lane] = inc - c; }
#pragma unroll
    for (int rep = 0; rep < 8; ++rep) EG[HIST[32 + (ent8[rep].x >> 9)] + rk[rep]] = ent8[rep];
}
__device__ __forceinline__ void quad_pass1(LAS unsigned char* lds_w, size_t tok0, const unsigned char* TABU, const bf16* HB, int lane_in) {
    int lane = lane_in; asm volatile("" : "+v"(lane));
    LAS u32x4* EG = (LAS u32x4*)(lds_w + PQ_EG);
    float x0[16], x1[16], x2[16], x3[16];
#define PQ_LOADX(xx, tk) do { const u32x4* hp = (const u32x4*)(HB + (tok0 + (tk)) * 1024 + lane * 16); const u32x4 a = hp[0], b = hp[1]; \
        _Pragma("unroll") for (int e = 0; e < 4; ++e) { xx[2 * e] = __uint_as_float(a[e] << 16); xx[2 * e + 1] = __uint_as_float(a[e] & 0xffff0000u); xx[8 + 2 * e] = __uint_as_float(b[e] << 16); xx[8 + 2 * e + 1] = __uint_as_float(b[e] & 0xffff0000u); } } while (0)
    PQ_LOADX(x0, 0); PQ_LOADX(x1, 1); PQ_LOADX(x2, 2); PQ_LOADX(x3, 3);
#undef PQ_LOADX
    u32x4 ub[8];
#pragma unroll
    for (int k = 0; k < 8; ++k) ub[k] = *(const u32x4*)(TABU + (size_t)EG[k].x * 1024 + lane * 16);
#pragma unroll 1
    for (int bt = 0; bt < 64; ++bt) {
        u32x4 un[8];
        const int nb = (bt + 1 < 64) ? bt + 1 : bt;
#pragma unroll
        for (int k = 0; k < 8; ++k) un[k] = *(const u32x4*)(TABU + (size_t)EG[nb * 8 + k].x * 1024 + lane * 16);
        float d[8];
#pragma unroll
        for (int k = 0; k < 8; ++k) {
            float f[16];
#pragma unroll
            for (int e = 0; e < 4; ++e) { const f32x2 lo = __builtin_amdgcn_cvt_pk_f32_fp8((int)ub[k][e], false), hi = __builtin_amdgcn_cvt_pk_f32_fp8((int)ub[k][e], true); f[4 * e] = lo.x; f[4 * e + 1] = lo.y; f[4 * e + 2] = hi.x; f[4 * e + 3] = hi.y; }
            const unsigned tkk = (unsigned)__builtin_amdgcn_readfirstlane((int)EG[bt * 8 + k].w);
            float a = 0.f;
            if (tkk == 0u) {
#pragma unroll
                for (int c = 0; c < 16; ++c) a += f[c] * x0[c]; }
            else if (tkk == 1u) {
#pragma unroll
                for (int c = 0; c < 16; ++c) a += f[c] * x1[c]; }
            else if (tkk == 2u) {
#pragma unroll
                for (int c = 0; c < 16; ++c) a += f[c] * x2[c]; }
            else {
#pragma unroll
                for (int c = 0; c < 16; ++c) a += f[c] * x3[c]; }
            d[k] = a; }
        float r4[4], r2[2], v1;
        { const bool h32 = (lane & 32) != 0;
#pragma unroll
          for (int j = 0; j < 4; ++j) { const float send = h32 ? d[j] : d[j + 4], keep = h32 ? d[j + 4] : d[j]; r4[j] = keep + __shfl_xor(send, 32); }
          const bool h16 = (lane & 16) != 0;
#pragma unroll
          for (int j = 0; j < 2; ++j) { const float send = h16 ? r4[j] : r4[j + 2], keep = h16 ? r4[j + 2] : r4[j]; r2[j] = keep + __shfl_xor(send, 16); }
          const bool h8 = (lane & 8) != 0;
          { const float send = h8 ? r2[0] : r2[1], keep = h8 ? r2[1] : r2[0]; v1 = keep + __shfl_xor(send, 8); }
          v1 += __shfl_xor(v1, 4); v1 += __shfl_xor(v1, 2); v1 += __shfl_xor(v1, 1); }
        { const u32x4 eg = EG[bt * 8 + (lane >> 3)]; const float x = v1 * __uint_as_float(eg.y);
          const float act = 0.5f * x * (1.0f + erff(x * 0.70710678118654752f)) * __uint_as_float(eg.z);
          if ((lane & 7) == 0) *((LAS float*)&EG[bt * 8 + (lane >> 3)] + 1) = act; }
#pragma unroll
        for (int k = 0; k < 8; ++k) ub[k] = un[k];
    }
}
template <bool LAST>
__device__ __forceinline__ void quad_pass2(LAS unsigned char* lds_w, size_t tok0, const unsigned char* TABV, bf16* HB, float* xres, const float* gnext, int lane_in) {
    int lane = lane_in; asm volatile("" : "+v"(lane));
    LAS u32x4* EG = (LAS u32x4*)(lds_w + PQ_EG);
    float o0[16], o1[16], o2[16], o3[16];
#pragma unroll
    for (int c = 0; c < 16; ++c) { o0[c] = 0.f; o1[c] = 0.f; o2[c] = 0.f; o3[c] = 0.f; }
    u32x4 vb[8];
#pragma unroll
    for (int k = 0; k < 8; ++k) vb[k] = *(const u32x4*)(TABV + (size_t)EG[k].x * 1024 + lane * 16);
#pragma unroll 1
    for (int bt = 0; bt < 64; ++bt) {
        u32x4 vn[8];
        const int nb = (bt + 1 < 64) ? bt + 1 : bt;
#pragma unroll
        for (int k = 0; k < 8; ++k) vn[k] = *(const u32x4*)(TABV + (size_t)EG[nb * 8 + k].x * 1024 + lane * 16);
#pragma unroll
        for (int k = 0; k < 8; ++k) {
            float f[16];
#pragma unroll
            for (int e = 0; e < 4; ++e) { const f32x2 lo = __builtin_amdgcn_cvt_pk_f32_fp8((int)vb[k][e], false), hi = __builtin_amdgcn_cvt_pk_f32_fp8((int)vb[k][e], true); f[4 * e] = lo.x; f[4 * e + 1] = lo.y; f[4 * e + 2] = hi.x; f[4 * e + 3] = hi.y; }
            const u32x4 eg = EG[bt * 8 + k];
            const unsigned tkk = (unsigned)__builtin_amdgcn_readfirstlane((int)eg.w); const float a = __uint_as_float((unsigned)__builtin_amdgcn_readfirstlane((int)eg.y));
            if (tkk == 0u) {
#pragma unroll
                for (int c = 0; c < 16; ++c) o0[c] += a * f[c]; }
            else if (tkk == 1u) {
#pragma unroll
                for (int c = 0; c < 16; ++c) o1[c] += a * f[c]; }
            else if (tkk == 2u) {
#pragma unroll
                for (int c = 0; c < 16; ++c) o2[c] += a * f[c]; }
            else {
#pragma unroll
                for (int c = 0; c < 16; ++c) o3[c] += a * f[c]; } }
#pragma unroll
        for (int k = 0; k < 8; ++k) vb[k] = vn[k];
    }
#define PQ_FINAL(oo, tk) do { f32x4 xr[4]; float ss = 0.f; float* xq = xres + (tok0 + (tk)) * 1024 + lane * 16; \
        _Pragma("unroll") for (int j = 0; j < 4; ++j) { xr[j] = *(const f32x4*)(xq + 4 * j); _Pragma("unroll") for (int e = 0; e < 4; ++e) { xr[j][e] += oo[4 * j + e]; ss += xr[j][e] * xr[j][e]; } } \
        const float rstd = 1.0f / sqrtf(wave_sum(ss) * (1.f / 1024.f) + EPS); \
        if (LAST) { _Pragma("unroll") for (int j = 0; j < 4; ++j) { const f32x4 gg = *(const f32x4*)(gnext + lane * 16 + 4 * j); *(f32x4*)(xq + 4 * j) = xr[j] * rstd * gg; } } \
        else { u32x4 q0, q1; \
            _Pragma("unroll") for (int j = 0; j < 4; ++j) { *(f32x4*)(xq + 4 * j) = xr[j]; const f32x4 gg = *(const f32x4*)(gnext + lane * 16 + 4 * j); \
                const unsigned lo = cvt_pk_bf16(xr[j][0] * rstd * gg[0], xr[j][1] * rstd * gg[1]), hi = cvt_pk_bf16(xr[j][2] * rstd * gg[2], xr[j][3] * rstd * gg[3]); \
                if (j < 2) { q0[2 * j] = lo; q0[2 * j + 1] = hi; } else { q1[2 * (j - 2)] = lo; q1[2 * (j - 2) + 1] = hi; } } \
            u32x4* hq = (u32x4*)(HB + (tok0 + (tk)) * 1024 + lane * 16); hq[0] = q0; hq[1] = q1; } } while (0)
    PQ_FINAL(o0, 0); PQ_FINAL(o1, 1); PQ_FINAL(o2, 2); PQ_FINAL(o3, 3);
#undef PQ_FINAL
}
__device__ __forceinline__ void xcc_sync(unsigned* ctr, unsigned nloc, unsigned target) {
    __syncthreads();
    if (threadIdx.x == 0 && nloc > 0u) {
        __hip_atomic_fetch_add(ctr, 1u, __ATOMIC_RELAXED, __HIP_MEMORY_SCOPE_AGENT);
        unsigned sp = 0u;
        while (__hip_atomic_load(ctr, __ATOMIC_RELAXED, __HIP_MEMORY_SCOPE_AGENT) < nloc * target) { __builtin_amdgcn_s_sleep(1); if (++sp > (1u << 16)) break; }
    }
    __syncthreads();
}

__device__ __forceinline__ void row_to_fp8(const float* src, unsigned char* dst, float* scale, int lane) {
    const f32x4* sp = (const f32x4*)(src + lane * 16); f32x4 v[4]; float am = 0.f;
#pragma unroll
    for (int j = 0; j < 4; ++j) { v[j] = sp[j]; am = fmaxf(am, fmaxf(fmaxf(fabsf(v[j].x), fabsf(v[j].y)), fmaxf(fabsf(v[j].z), fabsf(v[j].w)))); }
    am = wave_max(am);
    const float sc = am > 0.f ? am * (1.0f / 448.0f) : 1.0f, inv = 1.0f / sc;
    u32x4 o;
#pragma unroll
    for (int j = 0; j < 4; ++j) { int w = 0; w = __builtin_amdgcn_cvt_pk_fp8_f32(v[j].x * inv, v[j].y * inv, w, false); w = __builtin_amdgcn_cvt_pk_fp8_f32(v[j].z * inv, v[j].w * inv, w, true); o[j] = (unsigned)w; }
    *(u32x4*)(dst + lane * 16) = o;
    if (lane == 0) *scale = sc;
}

__device__ __forceinline__ void row_to_int8(const float* src, unsigned char* dst, float* scale, int lane) {
    const f32x4* sp = (const f32x4*)(src + lane * 16); f32x4 v[4]; float am = 0.f;
#pragma unroll
    for (int j = 0; j < 4; ++j) { v[j] = sp[j]; am = fmaxf(am, fmaxf(fmaxf(fabsf(v[j].x), fabsf(v[j].y)), fmaxf(fabsf(v[j].z), fabsf(v[j].w)))); }
    am = wave_max(am);
    const float sc = am > 0.f ? am * (1.0f / 127.0f) : 1.0f, inv = 1.0f / sc;
    u32x4 o;
#pragma unroll
    for (int j = 0; j < 4; ++j) { const int q0 = (int)rintf(v[j].x * inv), q1 = (int)rintf(v[j].y * inv), q2 = (int)rintf(v[j].z * inv), q3 = (int)rintf(v[j].w * inv);
        o[j] = (unsigned)((q0 & 0xff) | ((q1 & 0xff) << 8) | ((q2 & 0xff) << 16) | ((q3 & 0xff) << 24)); }
    *(u32x4*)(dst + lane * 16) = o;
    if (lane == 0) *scale = sc;
}

template <bool FP8>
__device__ __forceinline__ void rows4_to_q8(const float* src, size_t rstride_f, unsigned char* dst, size_t rstride_b, float* scale, size_t sstride, int lane) {
    f32x4 v[4][4];
#pragma unroll
    for (int i = 0; i < 4; ++i) { const f32x4* sp = (const f32x4*)(src + (size_t)i * rstride_f + lane * 16);
#pragma unroll
        for (int j = 0; j < 4; ++j) v[i][j] = sp[j]; }
#pragma unroll
    for (int i = 0; i < 4; ++i) { float am = 0.f;
#pragma unroll
        for (int j = 0; j < 4; ++j) am = fmaxf(am, fmaxf(fmaxf(fabsf(v[i][j].x), fabsf(v[i][j].y)), fmaxf(fabsf(v[i][j].z), fabsf(v[i][j].w))));
        am = wave_max(am);
        const float sc = am > 0.f ? am * (FP8 ? (1.0f / 448.0f) : (1.0f / 127.0f)) : 1.0f, inv = 1.0f / sc;
        u32x4 o;
#pragma unroll
        for (int j = 0; j < 4; ++j) {
            if (FP8) { int w = 0; w = __builtin_amdgcn_cvt_pk_fp8_f32(v[i][j].x * inv, v[i][j].y * inv, w, false); w = __builtin_amdgcn_cvt_pk_fp8_f32(v[i][j].z * inv, v[i][j].w * inv, w, true); o[j] = (unsigned)w; }
            else { const int q0 = (int)rintf(v[i][j].x * inv), q1 = (int)rintf(v[i][j].y * inv), q2 = (int)rintf(v[i][j].z * inv), q3 = (int)rintf(v[i][j].w * inv);
                o[j] = (unsigned)((q0 & 0xff) | ((q1 & 0xff) << 8) | ((q2 & 0xff) << 16) | ((q3 & 0xff) << 24)); } }
        *(u32x4*)(dst + (size_t)i * rstride_b + lane * 16) = o;
        if (lane == 0) scale[(size_t)i * sstride] = sc; }
}

__global__ void __launch_bounds__(NTHR, 2) trunk_fwd(Args args) {
    extern __shared__ __attribute__((aligned(16))) unsigned char lds_raw[];
    LAS unsigned char* lds = (LAS unsigned char*)lds_raw;
    const int tid = threadIdx.x, lane = tid & 63, wave = __builtin_amdgcn_readfirstlane(tid >> 6);
    const int G = gridDim.x, bx = blockIdx.x;
    unsigned char* ws = args.ws;
    unsigned* ctl = (unsigned*)(ws + WS_CTL);
    volatile LAS unsigned* LCTL = (volatile LAS unsigned*)(lds + LDS_CTL);
    for (int u = tid; u < 512; u += NTHR) LCTL[u] = 0u;
    __syncthreads();
    XcdBarrier bar; bar.bar = ctl + CW_BAR; bar.x = 0; bar.st = nullptr;
    if (!MK_PER_PHASE) bar = xcd_barrier_post(ctl + CW_BAR, LCTL + 8);
    const int lo = args.ph_lo, hi = args.ph_hi;
#define IN(k) (lo <= (k) && (k) < hi)
#define SEAM(k) do { if (IN(k) && IN((k) + 1)) xcd_barrier(bar); } while (0)
#define SEAM2(k) do { if (IN(k) && IN((k) + 2)) xcd_barrier(bar); } while (0)
#define REP(k) for (int _r = 0; _r <= ((PROBE_MASK >> (k)) & 1); ++_r)
    const size_t gtid = (size_t)bx * NTHR + tid, gthreads = (size_t)G * NTHR;
    const int gw = bx * NWAVES + wave, NGW = G * NWAVES;

    const float* x_in = args.in[I_X];
    float* xres = args.out;
    bf16* WA = (bf16*)(ws + WS_WA); bf16* WB = (bf16*)(ws + WS_WB); bf16* WO = (bf16*)(ws + WS_WO); bf16* WKV = (bf16*)(ws + WS_WKV); bf16* WQ = (bf16*)(ws + WS_WQ);
    bf16* MEMN = (bf16*)(ws + WS_MEMN); bf16* KV = (bf16*)(ws + WS_KV); bf16* HB = (bf16*)(ws + WS_HB); bf16* MIX = (bf16*)(ws + WS_MIX);
    unsigned char* TAB8 = ws + WS_TAB;
    float* TSC = (float*)(ws + WS_TSC);
    unsigned char* AR = ws + WS_AR;
    bf16* QMEM = (bf16*)(AR + AR_QMEM);
    bf16* Qb = (bf16*)args.out; bf16* QMEM0 = (bf16*)args.out + (size_t)M * 768;
    bf16* QLb = (bf16*)(AR + AR_QL);
    bf16* Zb = (bf16*)(AR + AR_Z); bf16* XBC = (bf16*)(AR + AR_XBC); float* DTb = (float*)(AR + AR_DT); bf16* XC = (bf16*)(AR + AR_XC); bf16* STATES = (bf16*)(AR + AR_ST); bf16* Yb = (bf16*)(AR + AR_Y);
    float* DEC = (float*)(ws + WS_DEC); float* SSb = (float*)(ws + WS_SS);
    bf16* UKb = (bf16*)(ws + WS_UK); bf16* UVTb = (bf16*)(ws + WS_UVT); bf16* SUBKb = (bf16*)(ws + WS_SUBK);
    bf16* PQb = (bf16*)(AR + AR_PQ); u32x2* TOPK = (u32x2*)(AR + AR_TOPK);

    if (IN(0)) REP(0) {
        LAS float* scr = (LAS float*)(lds + LDS_SCR + wave * 8704);
        const float* awin = args.in[I_AWIN]; const float* bwin = args.in[I_BWIN];
        const int nA0 = titems(1536), nA1 = titems(256), nA2 = titems(64), nA3 = titems(8);
        const int nB0 = titems(2048), nB1 = titems(256), nB2 = titems(12);
        const int nO = titems(1024), nKV = titems(512), nQ = titems(2048);
        const int NIT = nA0 + nA1 + nA2 + nA3 + nB0 + nB1 + nB2 + 2 * nO + 2 * nKV + 2 * nQ;
        for (int it = gw; it < NIT; it += NGW) {
            int r = it;
            if (r < nA0) { transpose_item(awin, 1864, 0, 1536, WA, 0, scr, r, lane); continue; } r -= nA0;
            if (r < nA1) { transpose_item(awin, 1864, 1608, 256, WA, 1536, scr, r, lane); continue; } r -= nA1;
            if (r < nA2) { transpose_item(awin, 1864, 1536, 64, WA, 1792, scr, r, lane); continue; } r -= nA2;
            if (r < nA3) { transpose_item(awin, 1864, 1600, 8, WA, 1856, scr, r, lane); continue; } r -= nA3;
            if (r < nB0) { transpose_item(bwin, 2316, 0, 2048, WB, 0, scr, r, lane); continue; } r -= nB0;
            if (r < nB1) { transpose_item(bwin, 2316, 2060, 256, WB, 2048, scr, r, lane); continue; } r -= nB1;
            if (r < nB2) { transpose_item(bwin, 2316, 2048, 12, WB, 2304, scr, r, lane); continue; } r -= nB2;
            if (r < 2 * nO) { const int l = r / nO; transpose_item(args.in[I_WO] + (size_t)l * 1024 * 1024, 1024, 0, 1024, WO, l * 1024, scr, r - l * nO, lane); continue; } r -= 2 * nO;
            if (r < 2 * nKV) { const int l = r / nKV; transpose_item(args.in[I_WMEMKV] + (size_t)l * 1024 * 512, 512, 0, 512, WKV, l * 512, scr, r - l * nKV, lane); continue; } r -= 2 * nKV;
            { const int l = r / nQ; transpose_item(args.in[I_PWQ] + (size_t)l * 1024 * 2048, 2048, 0, 2048, WQ, l * 2048, scr, r - l * nQ, lane, args.in[I_FFNNORM] + l * D); }
        }
        for (size_t i = gtid; i < (size_t)(2048 - 1864) * 128; i += gthreads) *((u32x4*)(WA + (size_t)1864 * 1024) + i) = (u32x4){0u, 0u, 0u, 0u};
        for (size_t i = gtid; i < (size_t)(2560 - 2316) * 128; i += gthreads) *((u32x4*)(WB + (size_t)2316 * 1024) + i) = (u32x4){0u, 0u, 0u, 0u};
        for (size_t i = gtid; i < (size_t)2 * M; i += gthreads) SSb[i] = 0.f;
        for (int m = gw; m < BATCH * MEMLEN; m += NGW) rms_row_to_bf16(args.in[I_MEM] + (size_t)m * D, args.in[I_MEMNORM], MEMN + (size_t)m * D, lane);
        for (int m = gw; m < M; m += 4 * NGW) rms_rows4_to_bf16(x_in + (size_t)m * D, (size_t)NGW * D, args.in[I_MIXNORM], HB + (size_t)m * D, lane);
        cvt_stream(args.in[I_AWUK], UKb, (size_t)12 * 256 * 64, gtid, gthreads);
        for (size_t i = gtid; i < (size_t)12 * 64 * 256; i += gthreads) { const int h = (int)(i >> 14), d = (int)((i >> 8) & 63), c = (int)(i & 255);
            UVTb[i] = (bf16)(cvt_pk_bf16(args.in[I_AWUV][((size_t)h * 256 + c) * 64 + d], 0.f) & 0xffffu); }
        cvt_stream(args.in[I_PSUBK], SUBKb, (size_t)2 * 2 * 128 * 128, gtid, gthreads);
        for (int tbl = 0; tbl < 2; ++tbl) { const int l = tbl >> 1, tv = tbl & 1;
            const float* srcb = args.in[tv ? I_PV : I_PU] + (size_t)l * 16384 * 1024; unsigned char* dstb = TAB8 + (size_t)l * 32 * MiB + (size_t)tv * 1024; float* scb = TSC + (l * 2 + tv) * 16384;
            for (int e = gw; e < 16384; e += 4 * NGW) {
                if (tv) rows4_to_q8<true>(srcb + (size_t)e * 1024, (size_t)NGW * 1024, dstb + (size_t)e * 2048, (size_t)NGW * 2048, scb + e, NGW, lane);
                else rows4_to_q8<false>(srcb + (size_t)e * 1024, (size_t)NGW * 1024, dstb + (size_t)e * 2048, (size_t)NGW * 2048, scb + e, NGW, lane); } }
    }
    SEAM(0);
    if (IN(1)) REP(1) {
        { pg8::Gemm g{HB, WA, M, NA, D}; pg8::StaticOrder S; S.init(M, NA, G, bx);
          EpiInA E{Qb, (float*)(AR + AR_CKV32), (bf16*)(AR + AR_IQ), QMEM0, (bf16*)(AR + AR_IK), (float*)(AR + AR_IW)};
          pg8::gemm_phase<EpiInA, pg8::StaticOrder, true, true>(lds + LDS_SCR, g, S, E); }
        { pg8::Gemm g{MEMN, WKV, BATCH * MEMLEN, 1024, D}; pg8::StaticOrder S; S.init(BATCH * MEMLEN, 1024, G, bx);
          EpiPlain E{KV, 1024};
          pg8::gemm_phase<EpiPlain, pg8::StaticOrder, true, true>(lds + LDS_SCR, g, S, E); }
        if (bx >= 32) { const int gw2 = (bx - 32) * NWAVES + wave, NGW2 = (G - 32) * NWAVES;
            for (int tv = 0; tv < 2; ++tv) {
                const float* srcb = args.in[tv ? I_PV : I_PU] + (size_t)16384 * 1024; unsigned char* dstb = TAB8 + (size_t)32 * MiB + (size_t)tv * 1024; float* scb = TSC + (2 + tv) * 16384;
                for (int e = gw2; e < 4096; e += NGW2) {
                    if (tv) rows4_to_q8<true>(srcb + (size_t)e * 1024, (size_t)4096 * 1024, dstb + (size_t)e * 2048, (size_t)4096 * 2048, scb + e, 4096, lane);
                    else rows4_to_q8<false>(srcb + (size_t)e * 1024, (size_t)4096 * 1024, dstb + (size_t)e * 2048, (size_t)4096 * 2048, scb + e, 4096, lane); } } }
    }
    SEAM(1);
    if (IN(2)) REP(2) {
        { const float* src = (const float*)(AR + AR_CKV32); bf16* dst = (bf16*)(AR + AR_CKV); const f32x4 gg = *((const f32x4*)args.in[I_AKVNORM] + lane);
          for (int m = gw; m < M; m += 4 * NGW) {
              f32x4 v[4];
#pragma unroll
              for (int i = 0; i < 4; ++i) v[i] = *((const f32x4*)(src + (size_t)(m + i * NGW) * 256) + lane);
#pragma unroll
              for (int i = 0; i < 4; ++i) { const float ss = wave_sum((v[i].x * v[i].x + v[i].y * v[i].y) + (v[i].z * v[i].z + v[i].w * v[i].w)); const float rstd = 1.0f / sqrtf(ss * (1.f / 256.f) + EPS);
                  u32x2 o; o.x = cvt_pk_bf16(v[i].x * rstd * gg.x, v[i].y * rstd * gg.y); o.y = cvt_pk_bf16(v[i].z * rstd * gg.z, v[i].w * rstd * gg.w);
                  *((u32x2*)(dst + (size_t)(m + i * NGW) * 256) + lane) = o; } } }
        for (int u = bx; u < 512; u += G) memattn_unit(lds + LDS_SCR, u, 0, KV, QMEM0, MIX, tid, wave, lane);
        qlat_phase(lds + LDS_SCR, bx, G, 3072, Qb, UKb, QLb, tid, wave, lane);
    }
    SEAM(2);
    if (IN(3)) REP(3) {
        { LAS float* RB = (LAS float*)(lds + LDS_SCR + DS_RB); const float* rbias = args.in[I_RELBIAS];
          for (int i = tid; i < 512; i += NTHR) { const int bk = i >> 4, h = i & 15; RB[i] = h < 12 ? rbias[bk * 12 + h] : 0.f; } }
        for (int u = bx; u < 4096; u += G) dsa_unit(lds + LDS_SCR, u, QLb, (const bf16*)(AR + AR_CKV), (const bf16*)(AR + AR_IQ), (const bf16*)(AR + AR_IK), (const float*)(AR + AR_IW), tid, wave, lane);
    }
    SEAM(3);
    if (IN(4)) REP(4) { uv_phase(lds + LDS_SCR, bx, G, 3072, QLb, UVTb, MIX, tid, wave, lane); }
    SEAM(4);
    if (IN(5)) REP(5) {
        pg8::Gemm g{MIX, WO, M, D, D}; pg8::StaticOrder S; S.init(M, D, G, bx);
        EpiResid<false> E{x_in, HB, SSb};
        pg8::gemm_phase<EpiResid<false>, pg8::StaticOrder, true, true>(lds + LDS_SCR, g, S, E);
    }
    SEAM2(5);
    if (IN(7)) REP(7) {
        pg8::Gemm g{HB, WQ, M, 2048, D}; pg8::StaticOrder S; S.init(M, 2048, G, bx);
        EpiPQ E{PQb, SSb};
        pg8::gemm_phase<EpiPQ, pg8::StaticOrder, true, true>(lds + LDS_SCR, g, S, E);
    }
    SEAM(7);
    if (IN(8)) REP(8) { peer_topk_load_sk(lds + LDS_SCR, SUBKb, tid); for (int task = gw; task < 16384; task += NGW) peer_topk_task(lds + LDS_SCR, task, PQb, TOPK, wave, lane); }
    SEAM(8);
    if (IN(9)) { peer_wave<false>(lds + LDS_SCR + wave * PW_BYTES, gw, NGW, M / 2, TOPK, TAB8, TAB8 + 1024, TSC, TSC + 16384, HB, SSb, args.in[I_FFNNORM], xres, args.in[I_MIXNORM] + D, lane, ctl + CW_XS + 64 * xb_xcc_id(), MK_PER_PHASE ? 0u : LCTL[8], 0u); }
    SEAM(9);
    if (IN(10)) REP(10) {
        pg8::Gemm g{HB, WB, M, NB, D}; pg8::StaticOrder S; S.init(M, NB, G, bx);
        EpiInB E{(bf16*)(AR + AR_Z), (bf16*)(AR + AR_XBC), QMEM, (float*)(AR + AR_DT)};
        pg8::gemm_phase<EpiInB, pg8::StaticOrder, true, true>(lds + LDS_SCR, g, S, E);
    }
    SEAM(10);
    if (IN(11)) REP(11) {
        for (int u = bx; u < 512; u += G) memattn_unit(lds + LDS_SCR, u, 1, KV, QMEM, MIX, tid, wave, lane);
        for (int u = bx; u < 256; u += G) ssd_states_unit(lds + LDS_SCR, u, XBC, DTb, args.in[I_BCONVW], args.in[I_BCONVB], args.in[I_BDTBIAS], args.in[I_BALOG], XC, STATES, DEC, tid, wave, lane);
    }
    SEAM(11);
    if (IN(12)) { ssd_scan(STATES, DEC, gtid, gthreads); }
    SEAM(12);
    if (IN(13)) REP(13) { for (int u = bx; u < 256; u += G) ssd_out_unit(lds + LDS_SCR, u, XC, DTb, Zb, STATES, args.in[I_BDTBIAS], args.in[I_BALOG], args.in[I_BDSKIP], args.in[I_BOUTNORM], Yb, MIX, tid, wave, lane); }
    SEAM(13);
    if (IN(14)) {
        pg8::Gemm g{MIX, WO + (size_t)1024 * 1024, M, D, D}; pg8::StaticOrder S; S.init(M, D, G, bx);
        EpiResid<true> E{(const bf16*)xres, HB, SSb + M};
        pg8::gemm_phase<EpiResid<true>, pg8::StaticOrder, true, true>(lds + LDS_SCR, g, S, E);
    }
    SEAM2(14);
    if (IN(16)) REP(16) {
        pg8::Gemm g{HB, WQ + (size_t)2048 * 1024, M, 2048, D}; pg8::StaticOrder S; S.init(M, 2048, G, bx);
        EpiPQ E{PQb, SSb + M};
        pg8::gemm_phase<EpiPQ, pg8::StaticOrder, true, true>(lds + LDS_SCR, g, S, E);
    }
    SEAM(16);
    if (IN(17)) REP(17) { peer_topk_load_sk(lds + LDS_SCR, SUBKb + 32768, tid); for (int task = gw; task < 16384; task += NGW) peer_topk_task(lds + LDS_SCR, task, PQb, TOPK, wave, lane); }
    SEAM(17);
    if (IN(18)) { peer_wave<true>(lds + LDS_SCR + wave * PW_BYTES, gw, NGW, M / 2, TOPK, TAB8 + 32 * MiB, TAB8 + 32 * MiB + 1024, TSC + 32768, TSC + 49152, HB, SSb + M, args.in[I_FFNNORM] + D, xres, args.in[I_FINALNORM], lane, ctl + CW_XS + 64 * xb_xcc_id(), MK_PER_PHASE ? 0u : LCTL[8], 8u); }
#undef IN
#undef SEAM
#undef SEAM2
#undef REP
}

extern "C" void kernel_launch(void* const* d_in, const int* in_sizes, int n_in, void* d_out, int out_size, void* d_ws, size_t ws_size, hipStream_t stream) {
    static int grid = 0;
    if (grid == 0) {
        if (n_in != 24 || in_sizes[0] != M * D || out_size != M * D || ws_size < WS_END) { fprintf(stderr, "kernel_launch: unexpected shapes (n_in %d, ws %zu); nothing launched\n", n_in, ws_size); grid = -1; return; }
        int dev = 0, cus = 0, per_cu = 0;
        if (hipGetDevice(&dev) != hipSuccess || hipDeviceGetAttribute(&cus, hipDeviceAttributeMultiprocessorCount, dev) != hipSuccess) { grid = -1; return; }
        if (hipFuncSetAttribute((const void*)trunk_fwd, hipFuncAttributeMaxDynamicSharedMemorySize, LDS_BYTES) != hipSuccess) { fprintf(stderr, "kernel_launch: hipFuncSetAttribute failed\n"); grid = -1; return; }
        if (hipOccupancyMaxActiveBlocksPerMultiprocessor(&per_cu, (const void*)trunk_fwd, NTHR, LDS_BYTES) != hipSuccess || per_cu < 1) { fprintf(stderr, "kernel_launch: occupancy query says %d\n", per_cu); }
        (void)hipGetLastError();
        grid = cus;
    }
    if (grid < 0) return;
    if (hipMemsetAsync((char*)d_ws + WS_CTL, 0, CTL_ZERO_BYTES, stream) != hipSuccess) return;
    Args a{};
    for (int i = 0; i < 24; ++i) a.in[i] = (const float*)d_in[i];
    a.out = (float*)d_out; a.ws = (unsigned char*)d_ws;
#if MK_PER_PHASE
    for (int p = 0; p < NPHASE; ++p) { a.ph_lo = p; a.ph_hi = p + 1; hipLaunchKernelGGL(trunk_fwd, dim3(grid), dim3(NTHR), LDS_BYTES, stream, a); }
#else
    a.ph_lo = 0; a.ph_hi = NPHASE;
    hipLaunchKernelGGL(trunk_fwd, dim3(grid), dim3(NTHR), LDS_BYTES, stream, a);
#endif
}
```

```cpp
#include <hip/hip_runtime.h>
#include <cstdio>
#include <cstdint>
#ifndef PROBE_MASK
#define PROBE_MASK 0
#endif
#ifndef DSA_PROBE
#define DSA_PROBE 0
#endif
#ifndef PEER_PROBE
#define PEER_PROBE 0
#endif
#ifndef PEER_WGSYNC
#define PEER_WGSYNC 4
#endif
#ifndef MK_PER_PHASE
#define MK_PER_PHASE 0
#endif
namespace pg8 {
#define PG8_LAS __attribute__((address_space(3)))
typedef unsigned short bf16_t;
typedef short bf16x8 __attribute__((ext_vector_type(8)));
typedef float f32x4 __attribute__((ext_vector_type(4)));
typedef unsigned u32x4 __attribute__((ext_vector_type(4)));
constexpr int BM = 256, BK = 64, HALF = 128, HTB = HALF * BK * 2  , STAGE_BYTES = 8 * HTB, NXCD = 8, WGM = 8;

__host__ __device__ __forceinline__ int lds_byte(int r, int c) { const int st = (r >> 4) * 2 + (c >> 5), rr = r & 15, cc = c & 31, ob = rr * 64 + cc * 2; return st * 1024 + (ob ^ (((ob >> 9) & 1) << 5)); }
__host__ __device__ __forceinline__ void stage_rc(int b, int& R, int& C) { const int st = b / 1024, sb = b % 1024, swz = sb ^ (((sb >> 9) & 1) << 5); R = (st >> 1) * 16 + swz / 64; C = (st & 1) * 32 + (swz % 64) / 2; }
__host__ __device__ __forceinline__ int perm32(int rho) { const int n = rho >> 4, i = rho & 15; return 8 * (i >> 2) + 4 * n + (i & 3); }

struct Unit { int pm, pn; };
struct Gemm { const bf16_t* A; const bf16_t* Bt; int M, N, K; };

struct StaticOrder {
    int nM, nN, nwg, G, c;
    __host__ __device__ void init(int M, int N, int G_, int c_) { nM = M / BM; nN = N / BM; nwg = nM * nN; G = G_; c = c_; }
    __host__ __device__ bool next(int i, Unit& u) const {
        const long L = (long)i * G + c; if (L >= nwg) return false;
        int wgid = (int)L; { const int q = nwg / NXCD, r = nwg % NXCD, xcd = wgid % NXCD, off = wgid / NXCD; wgid = (xcd < r ? xcd * (q + 1) : r * (q + 1) + (xcd - r) * q) + off; }
        const int nig = WGM * nN, gid = wgid / nig, fm = gid * WGM, gsz = (nM - fm) < WGM ? (nM - fm) : WGM;
        u.pm = fm + ((wgid % nig) % gsz); u.pn = (wgid % nig) / gsz; return true;
    }
    __device__ __forceinline__ void a_ready(const Unit&) const {}
    __device__ __forceinline__ void done(const Unit&) const {}
};
__device__ __forceinline__ unsigned cvt_pk_bf16(float lo, float hi) { unsigned r; asm volatile("v_cvt_pk_bf16_f32 %0, %1, %2" : "=v"(r) : "v"(lo), "v"(hi)); return r; }
template <class Epi, class Sched, bool ALIGN_EPI = false, bool SP2 = false>
__device__ __forceinline__ void gemm_phase(PG8_LAS unsigned char* lds, const Gemm g, const Sched& S, const Epi& E) {
    const int tid = threadIdx.x, wid = __builtin_amdgcn_readfirstlane(tid >> 6), lane = tid & 63, wr = wid >> 2, wc = wid & 3, fr = lane & 15, fq = lane >> 4;
    const int K = g.K, nt = K / BK;
    unsigned voffA[2], voffB[2];
#pragma unroll
    for (int i = 0; i < 2; ++i) { int R, C; stage_rc(tid * 16 + i * 8192, R, C); const int Rb = Epi::PERM ? ((R & ~31) + perm32(R & 31)) : R;
        voffA[i] = (unsigned)(R * K + C) * 2u; voffB[i] = (unsigned)(Rb * K + C) * 2u; }
    const size_t kstep = (size_t)(BK * 2);
    const size_t hstep = (size_t)HALF * K * 2;
    const size_t tstep = 2 * hstep;
    const unsigned ldsw = (unsigned)wid * 1024u;
    const int aoff = lds_byte(wr * 64 + fr, fq * 8), boff = lds_byte(wc * 32 + fr, fq * 8);
#define PG8_SA(b, h) (((b) * 2 + (h)) * HTB)
#define PG8_SB(b, h) ((4 + (b) * 2 + (h)) * HTB)
#define PG8_STAGE(bufoff, gbase, voff) do { _Pragma("unroll") for (int _i = 0; _i < 2; ++_i) \
        __builtin_amdgcn_global_load_lds((const unsigned*)((const char*)(gbase) + (voff)[_i]), (PG8_LAS unsigned*)(lds + (bufoff) + ldsw + _i * 8192), 16, 0, 0); } while (0)
#define PG8_LDA(dst, b, h) do { _Pragma("unroll") for (int m = 0; m < 4; ++m) _Pragma("unroll") for (int k = 0; k < 2; ++k) dst[m][k] = *(const PG8_LAS bf16x8*)(lds + PG8_SA(b, h) + aoff + m * 2048 + k * 1024); } while (0)
#define PG8_LDB(dst, b, h) do { _Pragma("unroll") for (int n = 0; n < 2; ++n) _Pragma("unroll") for (int k = 0; k < 2; ++k) dst[n][k] = *(const PG8_LAS bf16x8*)(lds + PG8_SB(b, h) + boff + n * 2048 + k * 1024); } while (0)
#define PG8_MMA(ai, bj, At, Bt) do { __builtin_amdgcn_s_setprio(1); _Pragma("unroll") for (int m = 0; m < 4; ++m) _Pragma("unroll") for (int n = 0; n < 2; ++n) _Pragma("unroll") for (int k = 0; k < 2; ++k) \
        acc[ai][bj][m][n] = __builtin_amdgcn_mfma_f32_16x16x32_bf16(Bt[n][k], At[m][k], acc[ai][bj][m][n], 0, 0, 0); __builtin_amdgcn_s_setprio(0); } while (0)
#define PG8_WAIT_V(n) asm volatile("s_waitcnt vmcnt(" #n ")" ::: "memory")
#define PG8_WAIT_L(n) asm volatile("s_waitcnt lgkmcnt(" #n ")" ::: "memory")
#define PG8_BAR __builtin_amdgcn_s_barrier()
#define PG8_SCHED __builtin_amdgcn_sched_barrier(0)
    Unit cur, nxt; int ui = 0;
    if (!S.next(0, cur)) return;
    f32x4 acc[2][2][4][2];
#pragma unroll
    for (int a = 0; a < 2; ++a)
#pragma unroll
        for (int b = 0; b < 2; ++b)
#pragma unroll
            for (int m = 0; m < 4; ++m)
#pragma unroll
                for (int n = 0; n < 2; ++n) acc[a][b][m][n] = (f32x4){0.f, 0.f, 0.f, 0.f};
    bf16x8 At[4][2], B0[2][2], B1[2][2];
    const char* cA = (const char*)g.A + (size_t)cur.pm * tstep; const char* cB = (const char*)g.Bt + (size_t)cur.pn * tstep;
    S.a_ready(cur);
    if constexpr (SP2) {
        PG8_STAGE(PG8_SB(0, 0), cB, voffB); PG8_STAGE(PG8_SB(0, 1), cB + hstep, voffB); PG8_STAGE(PG8_SA(0, 0), cA, voffA); PG8_STAGE(PG8_SA(0, 1), cA + hstep, voffA);
        if (wr == 1) PG8_BAR;
        PG8_WAIT_V(2); PG8_BAR;
        PG8_STAGE(PG8_SB(1, 0), cB + kstep, voffB); PG8_STAGE(PG8_SA(1, 0), cA + kstep, voffA); PG8_STAGE(PG8_SB(1, 1), cB + hstep + kstep, voffB);
        PG8_WAIT_V(6); PG8_BAR;
    } else {
        PG8_STAGE(PG8_SB(0, 0), cB, voffB); PG8_STAGE(PG8_SA(0, 0), cA, voffA); PG8_STAGE(PG8_SB(0, 1), cB + hstep, voffB); PG8_STAGE(PG8_SA(0, 1), cA + hstep, voffA);
        if (wr == 1) PG8_BAR;
        PG8_WAIT_V(4); PG8_BAR;
        PG8_STAGE(PG8_SB(1, 0), cB + kstep, voffB); PG8_STAGE(PG8_SA(1, 0), cA + kstep, voffA); PG8_STAGE(PG8_SB(1, 1), cB + hstep + kstep, voffB);
        PG8_WAIT_V(6); PG8_BAR;
    }
    for (;;) {
        const bool has_next = S.next(ui + 1, nxt);
        const char* nA = has_next ? (const char*)g.A + (size_t)nxt.pm * tstep : cA; const char* nB = has_next ? (const char*)g.Bt + (size_t)nxt.pn * tstep : cB;
        for (int t = 0; t < nt; t += 2) {
            const bool last = (t == nt - 2);
            const char* a1 = cA + (size_t)(t + 1) * kstep;
            const char* a2 = last ? nA : cA + (size_t)(t + 2) * kstep; const char* b2 = last ? nB : cB + (size_t)(t + 2) * kstep;
            const char* a3 = a2 + kstep; const char* b3 = b2 + kstep;
            if (last && has_next) S.a_ready(nxt);
            if constexpr (SP2) {
            PG8_LDB(B0, 0, 0); PG8_LDB(B1, 0, 1); PG8_SCHED; PG8_LDA(At, 0, 0); PG8_STAGE(PG8_SA(1, 1), a1 + hstep, voffA);
            PG8_WAIT_V(8); PG8_WAIT_L(0); PG8_BAR; PG8_MMA(0, 0, At, B0); PG8_MMA(0, 1, At, B1); PG8_BAR; PG8_SCHED;
            PG8_LDA(At, 0, 1); PG8_STAGE(PG8_SB(0, 0), b2, voffB); PG8_STAGE(PG8_SB(0, 1), b2 + hstep, voffB); PG8_STAGE(PG8_SA(0, 0), a2, voffA);
            PG8_WAIT_V(8); PG8_WAIT_L(0); PG8_BAR; PG8_MMA(1, 0, At, B0); PG8_MMA(1, 1, At, B1); PG8_BAR; PG8_SCHED;
            PG8_LDB(B0, 1, 0); PG8_LDB(B1, 1, 1); PG8_SCHED; PG8_LDA(At, 1, 0); PG8_STAGE(PG8_SA(0, 1), a2 + hstep, voffA);
            PG8_WAIT_V(8); PG8_WAIT_L(0); PG8_BAR; PG8_MMA(0, 0, At, B0); PG8_MMA(0, 1, At, B1); PG8_BAR; PG8_SCHED;
            PG8_LDA(At, 1, 1); PG8_STAGE(PG8_SB(1, 0), b3, voffB); PG8_STAGE(PG8_SB(1, 1), b3 + hstep, voffB); PG8_STAGE(PG8_SA(1, 0), a3, voffA);
            PG8_WAIT_V(8); PG8_WAIT_L(0); PG8_BAR; PG8_MMA(1, 0, At, B0); PG8_MMA(1, 1, At, B1); PG8_BAR; PG8_SCHED;
            } else {
            PG8_LDB(B0, 0, 0); PG8_SCHED; PG8_LDA(At, 0, 0); PG8_STAGE(PG8_SA(1, 1), a1 + hstep, voffA);
            PG8_WAIT_L(8); PG8_BAR; PG8_WAIT_L(0); PG8_MMA(0, 0, At, B0); PG8_BAR; PG8_SCHED;
            PG8_LDB(B1, 0, 1); PG8_STAGE(PG8_SB(0, 0), b2, voffB);
            PG8_BAR; PG8_WAIT_L(0); PG8_MMA(0, 1, At, B1); PG8_BAR;
            PG8_LDA(At, 0, 1); PG8_STAGE(PG8_SA(0, 0), a2, voffA);
            PG8_BAR; PG8_WAIT_L(0); PG8_MMA(1, 0, At, B0); PG8_BAR; PG8_SCHED;
            PG8_STAGE(PG8_SB(0, 1), b2 + hstep, voffB);
            PG8_WAIT_V(6); PG8_BAR; PG8_MMA(1, 1, At, B1); PG8_BAR;
            PG8_LDB(B0, 1, 0); PG8_SCHED; PG8_LDA(At, 1, 0); PG8_STAGE(PG8_SA(0, 1), a2 + hstep, voffA);
            PG8_WAIT_L(8); PG8_BAR; PG8_WAIT_L(0); PG8_MMA(0, 0, At, B0); PG8_BAR; PG8_SCHED;
            PG8_LDB(B1, 1, 1); PG8_STAGE(PG8_SB(1, 0), b3, voffB);
            PG8_BAR; PG8_WAIT_L(0); PG8_MMA(0, 1, At, B1); PG8_BAR;
            PG8_LDA(At, 1, 1); PG8_STAGE(PG8_SA(1, 0), a3, voffA);
            PG8_BAR; PG8_WAIT_L(0); PG8_MMA(1, 0, At, B0); PG8_BAR; PG8_SCHED;
            PG8_STAGE(PG8_SB(1, 1), b3 + hstep, voffB);
            PG8_WAIT_V(6); PG8_BAR; PG8_MMA(1, 1, At, B1); PG8_BAR;
            }
        }
        if constexpr (ALIGN_EPI) { if (wr == 0) PG8_BAR; }
        if constexpr (!Epi::AFTER_DRAIN) { E(acc, cur, wr, wc, fr, fq); S.done(cur); }
        if (!has_next) break;
#pragma unroll
        for (int a = 0; a < 2; ++a)
#pragma unroll
            for (int b = 0; b < 2; ++b)
#pragma unroll
                for (int m = 0; m < 4; ++m)
#pragma unroll
                    for (int n = 0; n < 2; ++n) acc[a][b][m][n] = (f32x4){0.f, 0.f, 0.f, 0.f};
        cur = nxt; cA = nA; cB = nB; ++ui;
        if constexpr (ALIGN_EPI) { if (wr == 1) PG8_BAR; }
    }
    PG8_WAIT_V(0);
    if constexpr (!ALIGN_EPI) { if (wr == 0) PG8_BAR; }
    PG8_BAR;
    if constexpr (Epi::AFTER_DRAIN) { E.fused(acc, cur, wr, wc, fr, fq, lds, wid, lane); S.done(cur); }
#undef PG8_SA
#undef PG8_SB
#undef PG8_STAGE
#undef PG8_LDA
#undef PG8_LDB
#undef PG8_MMA
#undef PG8_WAIT_V
#undef PG8_WAIT_L
#undef PG8_BAR
#undef PG8_SCHED
}
}

#define LAS __attribute__((address_space(3)))
typedef unsigned short bf16;
typedef short bf16x8 __attribute__((ext_vector_type(8)));
typedef short bf16x4 __attribute__((ext_vector_type(4)));
typedef float f32x4 __attribute__((ext_vector_type(4)));
typedef float f32x16 __attribute__((ext_vector_type(16)));
typedef unsigned u32x4 __attribute__((ext_vector_type(4)));
typedef unsigned u32x2 __attribute__((ext_vector_type(2)));
typedef __bf16 bf16v2_t __attribute__((ext_vector_type(2)));
__device__ __forceinline__ unsigned cvt_pk_bf16(float lo, float hi) { bf16v2_t v; v.x = (__bf16)lo; v.y = (__bf16)hi; return __builtin_bit_cast(unsigned, v); }

constexpr int NWAVES = 8, NTHR = 512;
constexpr int D = 1024, BATCH = 8, SEQ = 4096, M = BATCH * SEQ, MEMLEN = 256;
constexpr int NA = 2048, NB = 2560;
constexpr float EPS = 1e-6f;
constexpr int NPHASE = 19;

constexpr size_t MiB = 1u << 20;
constexpr size_t WS_CTL = 0, CTL_ZERO_BYTES = 1 * MiB;
constexpr size_t WS_WA = 1 * MiB, WS_WB = 5 * MiB, WS_WO = 10 * MiB, WS_WKV = 14 * MiB, WS_WQ = 16 * MiB;
constexpr size_t WS_DEC = 25 * MiB + 512 * 1024, WS_TSC = 26 * MiB, WS_SS = 27 * MiB;
constexpr size_t WS_UK = 24 * MiB, WS_UVT = 24 * MiB + 512 * 1024, WS_SUBK = 25 * MiB;
constexpr size_t WS_MEMN = 32 * MiB, WS_KV = 36 * MiB, WS_HB = 40 * MiB, WS_MIX = 104 * MiB, WS_TAB = 168 * MiB, WS_AR = 232 * MiB, WS_END = 512 * MiB;
constexpr size_t AR_CKV32 = 0, AR_CKV = 32 * MiB, AR_IQ = 48 * MiB, AR_IK = 80 * MiB, AR_IW = 84 * MiB, AR_QL = 88 * MiB, AR_QMEM = 136 * MiB;
constexpr size_t AR_Z = 0, AR_XBC = 48 * MiB, AR_DT = 128 * MiB, AR_XC = 152 * MiB, AR_ST = 232 * MiB, AR_Y = 48 * MiB;
constexpr size_t AR_PQ = 152 * MiB, AR_TOPK = 0;
constexpr int CW_XS = 8192;
constexpr int CW_BAR = 4096;

constexpr int LDS_BYTES = 163840;
constexpr int LDS_SCR = 0, LDS_SCR_BYTES = 161792;
constexpr int LDS_CTL = 161792;

__device__ __forceinline__ float bf2f(unsigned short b) { return __uint_as_float(((unsigned)b) << 16); }
__device__ __forceinline__ float wave_sum(float v) {
#pragma unroll
    for (int o = 1; o < 64; o <<= 1) v += __shfl_xor(v, o);
    return v;
}
__device__ __forceinline__ float wave_max(float v) {
#pragma unroll
    for (int o = 1; o < 64; o <<= 1) v = fmaxf(v, __shfl_xor(v, o));
    return v;
}
#define LDS_WAIT() asm volatile("s_waitcnt lgkmcnt(0)" ::: "memory")
#define VM_WAIT() asm volatile("s_waitcnt vmcnt(0)" ::: "memory")

#define XB_TMO      128
#define XB_XCNT(j)  (256  + 64 * (j))
#define XB_XSUB(j)  (1280 + 64 * (j))
#define XB_XGEN(j)  (2304 + 64 * (j))
#define XB_TOP      3328
#define XB_TOPGEN   3392
#define XCD_BAR_WORDS 3456
#define XB_SPIN_CAP (1u << 22)

__device__ __forceinline__ unsigned xb_ld(unsigned* p)              { return __hip_atomic_load(p, __ATOMIC_RELAXED, __HIP_MEMORY_SCOPE_AGENT); }
__device__ __forceinline__ unsigned xb_add(unsigned* p, unsigned v) { return __hip_atomic_fetch_add(p, v, __ATOMIC_RELAXED, __HIP_MEMORY_SCOPE_AGENT); }
__device__ __forceinline__ unsigned xb_xcc_id() { return (unsigned)__builtin_amdgcn_s_getreg((3 << 11) | 20) & 0xFu; }
#define XB_SPIN(cond, bar) do { unsigned _sp = 0; while (cond) { __builtin_amdgcn_s_sleep(1); \
    if ((++_sp & 255u) == 0u) { if (xb_ld(&(bar)[XB_TMO])) break; if (_sp > XB_SPIN_CAP) { atomicAdd(&(bar)[XB_TMO], 1u); break; } } } } while (0)

struct XcdBarrier {
    unsigned* bar; unsigned x;
    volatile LAS unsigned* st;
};

__device__ __forceinline__ XcdBarrier xcd_barrier_post(unsigned* bar, volatile LAS unsigned* st) {
    XcdBarrier b; b.bar = bar; b.x = xb_xcc_id(); b.st = st;
    if (threadIdx.x == 0) (void)xb_add(&bar[XB_XCNT(b.x)], 1u);
    return b;
}
__device__ __forceinline__ void xcd_barrier_complete(unsigned* bar, unsigned x, unsigned& nloc, unsigned& nx) {
    const unsigned G = gridDim.x * gridDim.y * gridDim.z;
    unsigned sum, cnt, mine, sp = 0u;
    for (;;) {
        sum = 0u; cnt = 0u; mine = 0u;
#pragma unroll
        for (unsigned j = 0; j < 16; ++j) { const unsigned c = xb_ld(&bar[XB_XCNT(j)]); sum += c; cnt += (c > 0u) ? 1u : 0u; mine = (j == x) ? c : mine; }
        if (sum == G) break;
        __builtin_amdgcn_s_sleep(1);
        if ((++sp & 255u) == 0u) { if (xb_ld(&bar[XB_TMO])) break; if (sp > XB_SPIN_CAP) { atomicAdd(&bar[XB_TMO], 1u); break; } }
    }
    nloc = mine > 0u ? mine : 1u; nx = cnt > 0u ? cnt : 1u;
}

__device__ __forceinline__ void xcd_barrier(const XcdBarrier& b) {
    asm volatile("s_waitcnt vmcnt(0)" ::: "memory");
    __syncthreads();
    if (threadIdx.x == 0) {
        unsigned* bar = b.bar;
        __builtin_amdgcn_s_waitcnt(0);
        unsigned nloc = b.st[0], nx = b.st[1];
        if (nloc == 0u) { xcd_barrier_complete(bar, b.x, nloc, nx); b.st[0] = nloc; b.st[1] = nx; }
        const unsigned old = xb_add(&bar[XB_XSUB(b.x)], 1u);
        const unsigned gen = old / nloc;
        if (old + 1u == (gen + 1u) * nloc) {
            __builtin_amdgcn_fence(__ATOMIC_RELEASE, "agent");
            asm volatile("s_waitcnt vmcnt(0)" ::: "memory");
            const unsigned og = xb_add(&bar[XB_TOP], 1u);
            const unsigned tg = og / nx;
            if (og + 1u == (tg + 1u) * nx) xb_add(&bar[XB_TOPGEN], 1u);
            else XB_SPIN(xb_ld(&bar[XB_TOPGEN]) == tg, bar);
            __builtin_amdgcn_fence(__ATOMIC_ACQUIRE, "agent");
            xb_add(&bar[XB_XGEN(b.x)], 1u);
            asm volatile("s_waitcnt vmcnt(0)" ::: "memory");
        } else {
            XB_SPIN(xb_ld(&bar[XB_XGEN(b.x)]) == gen, bar);
            __builtin_amdgcn_fence(__ATOMIC_ACQUIRE, "agent");
            asm volatile("s_waitcnt vmcnt(0)" ::: "memory");
        }
    }
    __syncthreads();
}

struct Args { const float* in[24]; float* out; unsigned char* ws; int ph_lo, ph_hi; };
enum { I_X = 0, I_MEM, I_MEMNORM, I_RELBIAS, I_MIXNORM, I_FFNNORM, I_FINALNORM, I_WO, I_WMEMKV, I_AWIN, I_AKVNORM, I_AWUK, I_AWUV,
       I_BWIN, I_BCONVW, I_BCONVB, I_BDTBIAS, I_BALOG, I_BDSKIP, I_BOUTNORM, I_PWQ, I_PSUBK, I_PU, I_PV };

__device__ __forceinline__ u32x4 pack8(const f32x4 v0, const f32x4 v1) {
    u32x4 w; w.x = pg8::cvt_pk_bf16(v0[0], v0[1]); w.y = pg8::cvt_pk_bf16(v0[2], v0[3]); w.z = pg8::cvt_pk_bf16(v1[0], v1[1]); w.w = pg8::cvt_pk_bf16(v1[2], v1[3]); return w;
}
struct EpiPlain {
    static constexpr bool PERM = true, AFTER_DRAIN = false;
    bf16* O; int ld;
    __device__ __forceinline__ void operator()(const f32x4 (&acc)[2][2][4][2], const pg8::Unit& u, int wr, int wc, int fr, int fq) const {
        const int row0 = u.pm * 256 + wr * 64 + fr, col0 = u.pn * 256 + wc * 32 + 8 * fq;
#pragma unroll
        for (int ai = 0; ai < 2; ++ai)
#pragma unroll
            for (int m = 0; m < 4; ++m) { bf16* rowp = O + (size_t)(row0 + ai * 128 + m * 16) * ld + col0;
#pragma unroll
                for (int bj = 0; bj < 2; ++bj) *(u32x4*)(rowp + bj * 128) = pack8(acc[ai][bj][m][0], acc[ai][bj][m][1]); }
    }
};
struct EpiInA {
    static constexpr bool PERM = true, AFTER_DRAIN = false;
    bf16* Q; float* CKV32; bf16* IQ; bf16* QMEM; bf16* IK; float* IW;
    __device__ __forceinline__ void operator()(const f32x4 (&acc)[2][2][4][2], const pg8::Unit& u, int wr, int wc, int fr, int fq) const {
        const int row0 = u.pm * 256 + wr * 64 + fr, cb0 = wc * 32 + 8 * fq, pn = u.pn;
#pragma unroll
        for (int ai = 0; ai < 2; ++ai)
#pragma unroll
            for (int m = 0; m < 4; ++m) { const size_t row = (size_t)(row0 + ai * 128 + m * 16);
#pragma unroll
                for (int bj = 0; bj < 2; ++bj) { const int cb = cb0 + bj * 128; const f32x4 v0 = acc[ai][bj][m][0], v1 = acc[ai][bj][m][1];
                    if (pn < 3) *(u32x4*)(Q + row * 768 + pn * 256 + cb) = pack8(v0, v1);
                    else if (pn == 3) { *(f32x4*)(CKV32 + row * 256 + cb) = v0; *(f32x4*)(CKV32 + row * 256 + cb + 4) = v1; }
                    else if (pn < 6) *(u32x4*)(IQ + row * 512 + (pn - 4) * 256 + cb) = pack8(v0, v1);
                    else if (pn == 6) *(u32x4*)(QMEM + row * 256 + cb) = pack8(v0, v1);
                    else { if (cb < 64) *(u32x4*)(IK + row * 64 + cb) = pack8(v0, v1);
                           else if (cb == 64) { *(f32x4*)(IW + row * 8) = v0; *(f32x4*)(IW + row * 8 + 4) = v1; } } } }
    }
};
struct EpiInB {
    static constexpr bool PERM = true, AFTER_DRAIN = false;
    bf16* Z; bf16* XBC; bf16* QMEM; float* DT;
    __device__ __forceinline__ void operator()(const f32x4 (&acc)[2][2][4][2], const pg8::Unit& u, int wr, int wc, int fr, int fq) const {
        const int row0 = u.pm * 256 + wr * 64 + fr, cb0 = wc * 32 + 8 * fq, pn = u.pn;
#pragma unroll
        for (int ai = 0; ai < 2; ++ai)
#pragma unroll
            for (int m = 0; m < 4; ++m) { const size_t row = (size_t)(row0 + ai * 128 + m * 16);
#pragma unroll
                for (int bj = 0; bj < 2; ++bj) { const int cb = cb0 + bj * 128; const f32x4 v0 = acc[ai][bj][m][0], v1 = acc[ai][bj][m][1];
                    if (pn < 3) *(u32x4*)(Z + row * 768 + pn * 256 + cb) = pack8(v0, v1);
                    else if (pn < 8) *(u32x4*)(XBC + row * 1280 + (pn - 3) * 256 + cb) = pack8(v0, v1);
                    else if (pn == 8) *(u32x4*)(QMEM + row * 256 + cb) = pack8(v0, v1);
                    else if (cb < 16) { *(f32x4*)(DT + row * 16 + cb) = v0; *(f32x4*)(DT + row * 16 + cb + 4) = v1; } } }
    }
};
template <bool RES_BF16> struct EpiResid {
    static constexpr bool PERM = false, AFTER_DRAIN = false;
    const void* RES; bf16* XB; float* SS;
    __device__ __forceinline__ void operator()(const f32x4 (&acc)[2][2][4][2], const pg8::Unit& u, int wr, int wc, int fr, int fq) const {
        const int row0 = u.pm * 256 + wr * 64 + fr, col0 = u.pn * 256 + wc * 32 + 4 * fq;
#pragma unroll
        for (int ai = 0; ai < 2; ++ai) {
            f32x4 r[4][2][2];
#pragma unroll
            for (int m = 0; m < 4; ++m) { const size_t ro = (size_t)(row0 + ai * 128 + m * 16) * 1024 + col0;
#pragma unroll
                for (int bj = 0; bj < 2; ++bj)
#pragma unroll
                    for (int n = 0; n < 2; ++n) {
                        if (RES_BF16) { const u32x2 t = *(const u32x2*)((const bf16*)RES + ro + bj * 128 + n * 16);
                            r[m][bj][n] = (f32x4){__uint_as_float(t.x << 16), __uint_as_float(t.x & 0xffff0000u), __uint_as_float(t.y << 16), __uint_as_float(t.y & 0xffff0000u)}; }
                        else r[m][bj][n] = *(const f32x4*)((const float*)RES + ro + bj * 128 + n * 16); } }
#pragma unroll
            for (int m = 0; m < 4; ++m) { const int row = row0 + ai * 128 + m * 16; const size_t ro = (size_t)row * 1024 + col0; float ss = 0.f;
#pragma unroll
                for (int bj = 0; bj < 2; ++bj)
#pragma unroll
                    for (int n = 0; n < 2; ++n) { const f32x4 o = r[m][bj][n] + acc[ai][bj][m][n];
                        u32x2 w; w.x = cvt_pk_bf16(o[0], o[1]); w.y = cvt_pk_bf16(o[2], o[3]); *(u32x2*)(XB + ro + bj * 128 + n * 16) = w;
                        ss += (o[0] * o[0] + o[1] * o[1]) + (o[2] * o[2] + o[3] * o[3]); }
                { const auto a = __builtin_amdgcn_permlane16_swap(__float_as_uint(ss), __float_as_uint(ss), false, false); ss = __uint_as_float(a[0]) + __uint_as_float(a[1]); }
                { const auto b = __builtin_amdgcn_permlane32_swap(__float_as_uint(ss), __float_as_uint(ss), false, false); ss = __uint_as_float(b[0]) + __uint_as_float(b[1]); }
                if (fq == 0) atomicAdd(SS + row, ss); } }
    }
};
struct EpiPQ {
    static constexpr bool PERM = true, AFTER_DRAIN = false;
    bf16* O; const float* SS;
    __device__ __forceinline__ void operator()(const f32x4 (&acc)[2][2][4][2], const pg8::Unit& u, int wr, int wc, int fr, int fq) const {
        const int row0 = u.pm * 256 + wr * 64 + fr, col0 = u.pn * 256 + wc * 32 + 8 * fq;
#pragma unroll
        for (int ai = 0; ai < 2; ++ai)
#pragma unroll
            for (int m = 0; m < 4; ++m) { const int row = row0 + ai * 128 + m * 16; const float rs = 1.0f / sqrtf(SS[row] * (1.f / 1024.f) + EPS); bf16* rowp = O + (size_t)row * 2048 + col0;
#pragma unroll
                for (int bj = 0; bj < 2; ++bj) *(u32x4*)(rowp + bj * 128) = pack8(acc[ai][bj][m][0] * rs, acc[ai][bj][m][1] * rs); }
    }
};

__device__ __forceinline__ void transpose_item(const float* W, int ldw, int src0, int ncols, bf16* WT, int dst0, LAS float* scr, int item, int lane, const float* kgain = nullptr) {
    const int nblk = (ncols + 31) >> 5, kb = item / nblk, nb = item - kb * nblk, k0 = 64 * kb, n0 = 32 * nb;
    const int nn = n0 + (lane & 31);
#pragma unroll 8
    for (int i = 0; i < 32; ++i) { const int kk = 2 * i + (lane >> 5); const float gk = kgain ? kgain[k0 + kk] : 1.0f; scr[kk * 33 + (lane & 31)] = (nn < ncols) ? W[(size_t)(k0 + kk) * ldw + src0 + nn] * gk : 0.f; }
    LDS_WAIT(); asm volatile("" ::: "memory");
    const int c = lane & 7;
#pragma unroll
    for (int j = 0; j < 4; ++j) { const int n = (lane >> 3) + 8 * j; const LAS float* s = scr + (8 * c) * 33 + n;
        u32x4 o; o.x = cvt_pk_bf16(s[0 * 33], s[1 * 33]); o.y = cvt_pk_bf16(s[2 * 33], s[3 * 33]); o.z = cvt_pk_bf16(s[4 * 33], s[5 * 33]); o.w = cvt_pk_bf16(s[6 * 33], s[7 * 33]);
        if (n0 + n < ncols) *(u32x4*)(WT + (size_t)(dst0 + n0 + n) * 1024 + k0 + 8 * c) = o; }
    LDS_WAIT(); asm volatile("" ::: "memory");
}
__device__ __forceinline__ int titems(int ncols) { return 16 * ((ncols + 31) >> 5); }
__device__ __forceinline__ void rms_row_to_bf16(const float* xrow, const float* g, bf16* orow, int lane) {
    const f32x4* xr = (const f32x4*)xrow + lane; const f32x4* gr = (const f32x4*)g + lane;
    f32x4 v[4]; float s = 0.f;
#pragma unroll
    for (int j = 0; j < 4; ++j) { v[j] = xr[64 * j]; s += (v[j].x * v[j].x + v[j].y * v[j].y) + (v[j].z * v[j].z + v[j].w * v[j].w); }
    const float rstd = 1.0f / sqrtf(wave_sum(s) * (1.f / 1024.f) + EPS);
    u32x2* o8 = (u32x2*)orow + lane;
#pragma unroll
    for (int j = 0; j < 4; ++j) { const f32x4 gg = gr[64 * j]; u32x2 o; o.x = cvt_pk_bf16(v[j].x * rstd * gg.x, v[j].y * rstd * gg.y); o.y = cvt_pk_bf16(v[j].z * rstd * gg.z, v[j].w * rstd * gg.w); o8[64 * j] = o; }
}
__device__ __forceinline__ void rms_rows4_to_bf16(const float* x0, size_t rstride, const float* g, bf16* o0, int lane) {
    f32x4 v[4][4];
#pragma unroll
    for (int i = 0; i < 4; ++i) { const f32x4* xr = (const f32x4*)(x0 + (size_t)i * rstride) + lane;
#pragma unroll
        for (int j = 0; j < 4; ++j) v[i][j] = xr[64 * j]; }
    const f32x4* gr = (const f32x4*)g + lane;
#pragma unroll
    for (int i = 0; i < 4; ++i) { float s = 0.f;
#pragma unroll
        for (int j = 0; j < 4; ++j) s += (v[i][j].x * v[i][j].x + v[i][j].y * v[i][j].y) + (v[i][j].z * v[i][j].z + v[i][j].w * v[i][j].w);
        const float rstd = 1.0f / sqrtf(wave_sum(s) * (1.f / 1024.f) + EPS);
        u32x2* o8 = (u32x2*)(o0 + (size_t)i * rstride) + lane;
#pragma unroll
        for (int j = 0; j < 4; ++j) { const f32x4 gg = gr[64 * j]; u32x2 o; o.x = cvt_pk_bf16(v[i][j].x * rstd * gg.x, v[i][j].y * rstd * gg.y); o.y = cvt_pk_bf16(v[i][j].z * rstd * gg.z, v[i][j].w * rstd * gg.w); o8[64 * j] = o; } }
}
__device__ __forceinline__ void rms_row_to_f32(const float* xrow, const float* g, float* orow, int lane) {
    const f32x4* xr = (const f32x4*)xrow + lane; const f32x4* gr = (const f32x4*)g + lane;
    f32x4 v[4]; float s = 0.f;
#pragma unroll
    for (int j = 0; j < 4; ++j) { v[j] = xr[64 * j]; s += (v[j].x * v[j].x + v[j].y * v[j].y) + (v[j].z * v[j].z + v[j].w * v[j].w); }
    const float rstd = 1.0f / sqrtf(wave_sum(s) * (1.f / 1024.f) + EPS);
    f32x4* o = (f32x4*)orow + lane;
#pragma unroll
    for (int j = 0; j < 4; ++j) { const f32x4 gg = gr[64 * j]; o[64 * j] = v[j] * rstd * gg; }
}
__device__ __forceinline__ void cvt_stream(const float* src, bf16* dst, size_t n, size_t gtid, size_t gthreads) {
    for (size_t i = gtid * 8; i < n; i += gthreads * 8) { const f32x4 a = *(const f32x4*)(src + i), b = *(const f32x4*)(src + i + 4); *(u32x4*)(dst + i) = pack8(a, b); }
}

__device__ __forceinline__ void memattn_unit(LAS unsigned char* lds, int unit, int layer, const bf16* KV, const bf16* QMEM, bf16* MIX, int tid, int wave, int lane) {
    const int b = unit >> 6, qb = (unit >> 2) & 15, hd = unit & 3;
    const bf16* kvb = KV + (size_t)(b * 256) * 1024 + layer * 512 + hd * 64;
    LAS unsigned char* Ks = lds; LAS unsigned char* Vt = lds + 36864;
    for (int idx = tid; idx < 2048; idx += NTHR) { const int key = idx >> 3, ch = idx & 7;
        const u32x4 kk = *(const u32x4*)(kvb + (size_t)key * 1024 + ch * 8);
        *(LAS u32x4*)(Ks + key * 144 + ch * 16) = kk;
        const u32x4 vv = *(const u32x4*)(kvb + 256 + (size_t)key * 1024 + ch * 8);
#pragma unroll
        for (int e = 0; e < 4; ++e) { const unsigned w = vv[e];
            *(LAS unsigned short*)(Vt + (ch * 8 + 2 * e) * 520 + key * 2) = (unsigned short)(w & 0xffffu);
            *(LAS unsigned short*)(Vt + (ch * 8 + 2 * e + 1) * 520 + key * 2) = (unsigned short)(w >> 16); } }
    __syncthreads();
    const int q = lane & 31, hh = lane >> 5;
    const size_t t = (size_t)b * SEQ + qb * 256 + wave * 32 + q;
    bf16x8 qf[4];
#pragma unroll
    for (int ks = 0; ks < 4; ++ks) qf[ks] = *(const bf16x8*)(QMEM + t * 256 + hd * 64 + ks * 16 + hh * 8);
    f32x16 s[8];
#pragma unroll
    for (int kt = 0; kt < 8; ++kt) {
#pragma unroll
        for (int r = 0; r < 16; ++r) s[kt][r] = 0.f;
#pragma unroll
        for (int ks = 0; ks < 4; ++ks) { const bf16x8 a = *(const LAS bf16x8*)(Ks + (kt * 32 + q) * 144 + (ks * 16 + hh * 8) * 2);
            s[kt] = __builtin_amdgcn_mfma_f32_32x32x16_bf16(a, qf[ks], s[kt], 0, 0, 0); } }
    float mx = -3.0e38f;
#pragma unroll
    for (int kt = 0; kt < 8; ++kt)
#pragma unroll
        for (int r = 0; r < 16; ++r) mx = fmaxf(mx, s[kt][r]);
    mx = fmaxf(mx, __shfl_xor(mx, 32));
    float l = 0.f;
#pragma unroll
    for (int kt = 0; kt < 8; ++kt)
#pragma unroll
        for (int r = 0; r < 16; ++r) { const float p = __expf((s[kt][r] - mx) * 0.125f); s[kt][r] = p; l += p; }
    l += __shfl_xor(l, 32);
    f32x16 o[2];
#pragma unroll
    for (int dt = 0; dt < 2; ++dt)
#pragma unroll
        for (int r = 0; r < 16; ++r) o[dt][r] = 0.f;
#pragma unroll
    for (int kt = 0; kt < 8; ++kt)
#pragma unroll
        for (int si = 0; si < 2; ++si) {
            union { bf16x8 v; unsigned u[4]; } pb;
#pragma unroll
            for (int e = 0; e < 4; ++e) pb.u[e] = cvt_pk_bf16(s[kt][8 * si + 2 * e], s[kt][8 * si + 2 * e + 1]);
#pragma unroll
            for (int dt = 0; dt < 2; ++dt) { const LAS unsigned char* vp = Vt + (dt * 32 + q) * 520 + (kt * 32 + 16 * si + 4 * hh) * 2;
                union { bf16x8 v; u32x2 h[2]; } va; va.h[0] = *(const LAS u32x2*)vp; va.h[1] = *(const LAS u32x2*)(vp + 16);
                o[dt] = __builtin_amdgcn_mfma_f32_32x32x16_bf16(va.v, pb.v, o[dt], 0, 0, 0); } }
    const float inv = 1.0f / l;
#pragma unroll
    for (int dt = 0; dt < 2; ++dt)
#pragma unroll
        for (int g = 0; g < 4; ++g) { u32x2 w; w.x = cvt_pk_bf16(o[dt][4 * g] * inv, o[dt][4 * g + 1] * inv); w.y = cvt_pk_bf16(o[dt][4 * g + 2] * inv, o[dt][4 * g + 3] * inv);
            *(u32x2*)(MIX + t * 1024 + 768 + hd * 64 + dt * 32 + 8 * g + 4 * hh) = w; }
    __syncthreads();
}

constexpr int SS_ACS = 0, SS_DTV = 6144, SS_WW = 12288, SS_XS = 18432;
constexpr int SS_BT = SS_XS + 6 * 64 * 272;
static_assert(SS_BT + 128 * 272 <= LDS_SCR_BYTES, "SSD LDS map");

__device__ __forceinline__ float softplus_f(float x) { return fmaxf(x, 0.f) + log1pf(__expf(-fabsf(x))); }
__device__ __forceinline__ float silu_f(float v) { return v / (1.0f + __expf(-v)); }

__device__ __forceinline__ void ssd_chunk_scalars(LAS unsigned char* lds, const float* DT, size_t t0, const float* dt_bias, const float* a_log, float* dec, int wave, int lane) {
    LAS float* ACS = (LAS float*)(lds + SS_ACS); LAS float* DTV = (LAS float*)(lds + SS_DTV); LAS float* WW = (LAS float*)(lds + SS_WW);
    for (int h = wave; h < 12; h += NWAVES) {
        const float bias = dt_bias[h], a = -__expf(a_log[h]);
        const float d0 = softplus_f(DT[(t0 + 2 * lane) * 16 + h] + bias), d1 = softplus_f(DT[(t0 + 2 * lane + 1) * 16 + h] + bias);
        const float da0 = d0 * a, da1 = d1 * a;
        float v = da0 + da1;
#pragma unroll
        for (int o = 1; o < 64; o <<= 1) { const float t = __shfl_up(v, o); if (lane >= o) v += t; }
        const float total = __shfl(v, 63);
        const float c1 = v, c0 = v - da1;
        ACS[h * 128 + 2 * lane] = c0; ACS[h * 128 + 2 * lane + 1] = c1;
        DTV[h * 128 + 2 * lane] = d0; DTV[h * 128 + 2 * lane + 1] = d1;
        WW[h * 128 + 2 * lane] = __expf(total - c0) * d0; WW[h * 128 + 2 * lane + 1] = __expf(total - c1) * d1;
        if (dec != nullptr && lane == 0) dec[h] = __expf(total);
    }
}

__device__ __forceinline__ void ssd_states_unit(LAS unsigned char* lds, int unit, const bf16* XBC, const float* DT, const float* conv_w, const float* conv_b,
                                                const float* dt_bias, const float* a_log, bf16* XC, bf16* STATES, float* DEC, int tid, int wave, int lane) {
    const int b = unit >> 5, c = unit & 31; const size_t t0 = (size_t)b * SEQ + c * 128;
    __syncthreads();
    ssd_chunk_scalars(lds, DT, t0, dt_bias, a_log, DEC + (size_t)unit * 12, wave, lane);
    __syncthreads();
    const LAS float* WW = (const LAS float*)(lds + SS_WW);
    const int q = lane & 31, hh = lane >> 5;
    for (int g = 0; g < 2; ++g) {
        for (int idx = tid; idx < 1280; idx += NTHR) {
            const int cg = idx % 80, tg = idx / 80;
            const int col = cg < 48 ? g * 384 + cg * 8 : (cg < 64 ? 768 + g * 128 + (cg - 48) * 8 : 1024 + g * 128 + (cg - 64) * 8);
            float w[4][8], bs[8];
#pragma unroll
            for (int j = 0; j < 4; ++j) { const f32x4 a = *(const f32x4*)(conv_w + j * 1280 + col), bb = *(const f32x4*)(conv_w + j * 1280 + col + 4);
                w[j][0] = a.x; w[j][1] = a.y; w[j][2] = a.z; w[j][3] = a.w; w[j][4] = bb.x; w[j][5] = bb.y; w[j][6] = bb.z; w[j][7] = bb.w; }
            { const f32x4 a = *(const f32x4*)(conv_b + col), bb = *(const f32x4*)(conv_b + col + 4); bs[0] = a.x; bs[1] = a.y; bs[2] = a.z; bs[3] = a.w; bs[4] = bb.x; bs[5] = bb.y; bs[6] = bb.z; bs[7] = bb.w; }
            u32x4 rows[11];
#pragma unroll
            for (int i = 0; i < 11; ++i) { const int lt = tg * 8 - 3 + i;
                rows[i] = (c * 128 + lt >= 0) ? *(const u32x4*)(XBC + (t0 + lt) * 1280 + col) : (u32x4){0u, 0u, 0u, 0u}; }
            float o[8][8];
#pragma unroll
            for (int tt = 0; tt < 8; ++tt)
#pragma unroll
                for (int e = 0; e < 8; ++e) { float acc = bs[e];
#pragma unroll
                    for (int j = 0; j < 4; ++j) { const unsigned wd = rows[tt + j][e >> 1]; const float xv = (e & 1) ? __uint_as_float(wd & 0xffff0000u) : __uint_as_float(wd << 16); acc += w[j][e] * xv; }
                    o[tt][e] = silu_f(acc); }
#pragma unroll
            for (int tt = 0; tt < 8; ++tt) { u32x4 pk; pk.x = pg8::cvt_pk_bf16(o[tt][0], o[tt][1]); pk.y = pg8::cvt_pk_bf16(o[tt][2], o[tt][3]); pk.z = pg8::cvt_pk_bf16(o[tt][4], o[tt][5]); pk.w = pg8::cvt_pk_bf16(o[tt][6], o[tt][7]);
                *(u32x4*)(XC + (t0 + tg * 8 + tt) * 1280 + col) = pk; }
            if (cg < 48) {
                const int hl = cg >> 3, h = g * 6 + hl;
                float ws8[8];
#pragma unroll
                for (int tt = 0; tt < 8; ++tt) ws8[tt] = WW[h * 128 + tg * 8 + tt];
#pragma unroll
                for (int e = 0; e < 8; ++e) { u32x4 pk; pk.x = pg8::cvt_pk_bf16(o[0][e] * ws8[0], o[1][e] * ws8[1]); pk.y = pg8::cvt_pk_bf16(o[2][e] * ws8[2], o[3][e] * ws8[3]);
                    pk.z = pg8::cvt_pk_bf16(o[4][e] * ws8[4], o[5][e] * ws8[5]); pk.w = pg8::cvt_pk_bf16(o[6][e] * ws8[6], o[7][e] * ws8[7]);
                    *(LAS u32x4*)(lds + SS_XS + (cg * 8 + e) * 272 + tg * 16) = pk; }
            } else if (cg < 64) {
#pragma unroll
                for (int e = 0; e < 8; ++e) { u32x4 pk; pk.x = pg8::cvt_pk_bf16(o[0][e], o[1][e]); pk.y = pg8::cvt_pk_bf16(o[2][e], o[3][e]); pk.z = pg8::cvt_pk_bf16(o[4][e], o[5][e]); pk.w = pg8::cvt_pk_bf16(o[6][e], o[7][e]);
                    *(LAS u32x4*)(lds + SS_BT + ((cg - 48) * 8 + e) * 272 + tg * 16) = pk; }
            }
        }
        __syncthreads();
        const int pt = wave >> 2, nt = wave & 3;
#pragma unroll 1
        for (int hl = 0; hl < 6; ++hl) {
            f32x16 acc;
#pragma unroll
            for (int r = 0; r < 16; ++r) acc[r] = 0.f;
#pragma unroll
            for (int ks = 0; ks < 8; ++ks) {
                const bf16x8 a = *(const LAS bf16x8*)(lds + SS_XS + (hl * 64 + pt * 32 + q) * 272 + (ks * 16 + hh * 8) * 2);
                const bf16x8 bb = *(const LAS bf16x8*)(lds + SS_BT + (nt * 32 + q) * 272 + (ks * 16 + hh * 8) * 2);
                acc = __builtin_amdgcn_mfma_f32_32x32x16_bf16(a, bb, acc, 0, 0, 0); }
            bf16* st = STATES + ((size_t)unit * 12 + g * 6 + hl) * 8192 + nt * 32 + q;
#pragma unroll
            for (int r = 0; r < 16; ++r) { const int p = pt * 32 + (r & 3) + 8 * (r >> 2) + 4 * hh; st[p * 128] = (bf16)(cvt_pk_bf16(acc[r], 0.f) & 0xffffu); }
        }
        __syncthreads();
    }
}

__device__ __forceinline__ void ssd_scan(bf16* STATES, const float* DEC, size_t gtid, size_t gthreads) {
    for (size_t i = gtid; i < (size_t)BATCH * 12 * 64 * 16; i += gthreads) {
        const int b = (int)(i / (12 * 64 * 16)); const int rem = (int)(i - (size_t)b * (12 * 64 * 16)); const int h = rem / 1024, pn = rem - h * 1024;
        float hs[8];
#pragma unroll
        for (int e = 0; e < 8; ++e) hs[e] = 0.f;
        bf16* base = STATES + ((size_t)b * 32 * 12 + h) * 8192 + (size_t)pn * 8;
#pragma unroll 4
        for (int c = 0; c < 32; ++c) {
            bf16* p = base + (size_t)c * 12 * 8192;
            const u32x4 sv = *(const u32x4*)p; const float dc = DEC[(b * 32 + c) * 12 + h];
            u32x4 ov; ov.x = cvt_pk_bf16(hs[0], hs[1]); ov.y = cvt_pk_bf16(hs[2], hs[3]); ov.z = cvt_pk_bf16(hs[4], hs[5]); ov.w = cvt_pk_bf16(hs[6], hs[7]);
            *(u32x4*)p = ov;
#pragma unroll
            for (int e = 0; e < 4; ++e) { hs[2 * e] = hs[2 * e] * dc + __uint_as_float(sv[e] << 16); hs[2 * e + 1] = hs[2 * e + 1] * dc + __uint_as_float(sv[e] & 0xffff0000u); }
        }
    }
}

__device__ __forceinline__ void ssd_out_unit(LAS unsigned char* lds, int unit, const bf16* XC, const float* DT, const bf16* Z, const bf16* HPREV, const float* dt_bias, const float* a_log,
                                             const float* d_skip, const float* out_norm, bf16* Y, bf16* MIX, int tid, int wave, int lane) {
    const int b = unit >> 5, c = unit & 31; const size_t t0 = (size_t)b * SEQ + c * 128;
    __syncthreads();
    ssd_chunk_scalars(lds, DT, t0, dt_bias, a_log, nullptr, wave, lane);
    const LAS float* ACS = (const LAS float*)(lds + SS_ACS); const LAS float* DTV = (const LAS float*)(lds + SS_DTV);
    const int q = lane & 31, hh = lane >> 5, lt = wave >> 1, pt = wave & 1;
    const bf16* hp = HPREV + (size_t)unit * 12 * 8192;
    unsigned dmask = 0u;
#pragma unroll
    for (int r = 0; r < 16; ++r) dmask |= (((r & 3) + 8 * (r >> 2) + 4 * hh) <= q) ? (1u << r) : 0u;
    for (int g = 0; g < 2; ++g) {
        __syncthreads();
        for (int idx = tid; idx < 768; idx += NTHR) { const int cg = idx % 48, tg = idx / 48;
            u32x4 rows[8];
#pragma unroll
            for (int i = 0; i < 8; ++i) rows[i] = *(const u32x4*)(XC + (t0 + tg * 8 + i) * 1280 + g * 384 + cg * 8);
#pragma unroll
            for (int e = 0; e < 8; ++e) { u32x4 pk;
#pragma unroll
                for (int k2 = 0; k2 < 4; ++k2) { const unsigned lo = rows[2 * k2][e >> 1], hi2 = rows[2 * k2 + 1][e >> 1];
                    pk[k2] = (e & 1) ? ((lo >> 16) | (hi2 & 0xffff0000u)) : ((lo & 0xffffu) | (hi2 << 16)); }
                *(LAS u32x4*)(lds + SS_XS + (cg * 8 + e) * 272 + tg * 16) = pk; } }
        bf16x8 cf[8];
#pragma unroll
        for (int ks = 0; ks < 8; ++ks) cf[ks] = *(const bf16x8*)(XC + (t0 + lt * 32 + q) * 1280 + 1024 + g * 128 + ks * 16 + hh * 8);
        f32x16 cb[4];
#pragma unroll
        for (int st = 0; st < 4; ++st) {
#pragma unroll
            for (int r = 0; r < 16; ++r) cb[st][r] = 0.f;
            if (st <= lt) {
#pragma unroll
                for (int ks = 0; ks < 8; ++ks) { const bf16x8 a = *(const bf16x8*)(XC + (t0 + st * 32 + q) * 1280 + 768 + g * 128 + ks * 16 + hh * 8);
                    cb[st] = __builtin_amdgcn_mfma_f32_32x32x16_bf16(a, cf[ks], cb[st], 0, 0, 0); } } }
        __syncthreads();
#pragma unroll 1
        for (int hl = 0; hl < 6; ++hl) {
            const int h = g * 6 + hl;
            f32x16 yd, yo;
#pragma unroll
            for (int r = 0; r < 16; ++r) { yd[r] = 0.f; yo[r] = 0.f; }
            const int l = lt * 32 + q; const float al = ACS[h * 128 + l];
#pragma unroll
            for (int st = 0; st < 4; ++st) {
                if (st <= lt) {
                    float mm[16];
#pragma unroll
                    for (int r = 0; r < 16; ++r) { const int s = st * 32 + (r & 3) + 8 * (r >> 2) + 4 * hh;
                        const float v = cb[st][r] * __expf(al - ACS[h * 128 + s]) * DTV[h * 128 + s]; mm[r] = (st < lt || ((dmask >> r) & 1u)) ? v : 0.f; }
#pragma unroll
                    for (int si = 0; si < 2; ++si) {
                        union { bf16x8 v; unsigned u[4]; } af;
#pragma unroll
                        for (int e = 0; e < 4; ++e) af.u[e] = cvt_pk_bf16(mm[8 * si + 2 * e], mm[8 * si + 2 * e + 1]);
                        const LAS unsigned char* xp = lds + SS_XS + (hl * 64 + pt * 32 + q) * 272 + (st * 32 + 16 * si + 4 * hh) * 2;
                        union { bf16x8 v; u32x2 hv[2]; } xb; xb.hv[0] = *(const LAS u32x2*)xp; xb.hv[1] = *(const LAS u32x2*)(xp + 16);
                        yd = __builtin_amdgcn_mfma_f32_32x32x16_bf16(af.v, xb.v, yd, 0, 0, 0); } } }
#pragma unroll
            for (int ks = 0; ks < 8; ++ks) { const bf16x8 hb = *(const bf16x8*)(hp + (size_t)h * 8192 + (pt * 32 + q) * 128 + ks * 16 + hh * 8);
                yo = __builtin_amdgcn_mfma_f32_32x32x16_bf16(cf[ks], hb, yo, 0, 0, 0); }
            const float dsk = d_skip[h];
#pragma unroll
            for (int qd = 0; qd < 4; ++qd) { const int l0 = lt * 32 + 8 * qd + 4 * hh;
                const u32x2 xv = *(const LAS u32x2*)(lds + SS_XS + (hl * 64 + pt * 32 + q) * 272 + l0 * 2);
#pragma unroll
                for (int e = 0; e < 4; ++e) { const int r = 4 * qd + e; const unsigned wd = xv[e >> 1]; const float xs = (e & 1) ? __uint_as_float(wd & 0xffff0000u) : __uint_as_float(wd << 16);
                    const float yv = yd[r] + __expf(ACS[h * 128 + l0 + e]) * yo[r] + xs * dsk;
                    Y[(t0 + l0 + e) * 768 + h * 64 + pt * 32 + q] = (bf16)(cvt_pk_bf16(yv, 0.f) & 0xffffu); } }
        }
    }
    VM_WAIT(); __syncthreads();
    __builtin_amdgcn_fence(__ATOMIC_ACQUIRE, "agent"); VM_WAIT();
    for (int t4 = wave * 16; t4 < wave * 16 + 16; t4 += 4) {
        u32x2 yv[4][3], zv[4][3];
#pragma unroll
        for (int k = 0; k < 4; ++k)
#pragma unroll
            for (int j = 0; j < 3; ++j) { const size_t t = t0 + t4 + k; yv[k][j] = *(const u32x2*)(Y + t * 768 + j * 256 + lane * 4); zv[k][j] = *(const u32x2*)(Z + t * 768 + j * 256 + lane * 4); }
#pragma unroll
        for (int k = 0; k < 4; ++k) { const size_t t = t0 + t4 + k;
            float v[12]; float ss = 0.f;
#pragma unroll
            for (int j = 0; j < 3; ++j)
#pragma unroll
                for (int e = 0; e < 4; ++e) { const unsigned yw = yv[k][j][e >> 1], zw = zv[k][j][e >> 1];
                    const float yy = (e & 1) ? __uint_as_float(yw & 0xffff0000u) : __uint_as_float(yw << 16), zz = (e & 1) ? __uint_as_float(zw & 0xffff0000u) : __uint_as_float(zw << 16);
                    const float x = yy * silu_f(zz); v[4 * j + e] = x; ss += x * x; }
            const float rstd = 1.0f / sqrtf(wave_sum(ss) * (1.f / 768.f) + EPS);
#pragma unroll
            for (int j = 0; j < 3; ++j) { const f32x4 gg = *(const f32x4*)(out_norm + j * 256 + lane * 4);
                u32x2 o; o.x = cvt_pk_bf16(v[4 * j] * rstd * gg.x, v[4 * j + 1] * rstd * gg.y); o.y = cvt_pk_bf16(v[4 * j + 2] * rstd * gg.z, v[4 * j + 3] * rstd * gg.w);
                *(u32x2*)(MIX + t * 1024 + j * 256 + lane * 4) = o; } } }
}

constexpr int DS_IKL = 145408;
constexpr int DS_SC = 0, DS_IMG = 0, DS_IMG_W = 32 * 528, DS_QL = 0, DS_SEL = 8 * DS_IMG_W, DS_RB = DS_SEL + 8192, DS_END = DS_RB + 2048;
static_assert(DS_SEL >= 8 * 4096 * 4 && DS_END <= DS_IKL && DS_IKL + 16384 <= LDS_SCR_BYTES, "DSA LDS map");
typedef short s16x4 __attribute__((ext_vector_type(4)));

__device__ __forceinline__ int t5_bucket(int n) {
    if (n < 16) return n;
    const float v = logf((float)n / 16.0f) / 2.0794415416798357f * 16.0f;
    const int l = 16 + (int)v; return l < 31 ? l : 31;
}
__device__ __forceinline__ unsigned sortable_u32(float f) { const unsigned b = __float_as_uint(f); return b ^ ((unsigned)((int)b >> 31) | 0x80000000u); }
__device__ __forceinline__ unsigned mbcnt64(unsigned long long m) { return __builtin_amdgcn_mbcnt_hi((unsigned)(m >> 32), __builtin_amdgcn_mbcnt_lo((unsigned)m, 0u)); }
__device__ __forceinline__ unsigned wave_sum_u32(unsigned x) {
    x += (unsigned)__builtin_amdgcn_update_dpp(0, (int)x, 0xB1, 0xf, 0xf, false);
    x += (unsigned)__builtin_amdgcn_update_dpp(0, (int)x, 0x4E, 0xf, 0xf, false);
    x += (unsigned)__builtin_amdgcn_update_dpp(0, (int)x, 0x141, 0xf, 0xf, false);
    x += (unsigned)__builtin_amdgcn_update_dpp(0, (int)x, 0x140, 0xf, 0xf, false);
    { const auto a = __builtin_amdgcn_permlane16_swap(x, x, false, false); x = a[0] + a[1]; }
    { const auto b = __builtin_amdgcn_permlane32_swap(x, x, false, false); x = b[0] + b[1]; }
    return x;
}
__device__ __forceinline__ float kg_max(float v) {
    { const auto a = __builtin_amdgcn_permlane16_swap(__float_as_uint(v), __float_as_uint(v), false, false); v = fmaxf(__uint_as_float(a[0]), __uint_as_float(a[1])); }
    { const auto b = __builtin_amdgcn_permlane32_swap(__float_as_uint(v), __float_as_uint(v), false, false); v = fmaxf(__uint_as_float(b[0]), __uint_as_float(b[1])); }
    return v;
}
#define CNT_GE(cnt, uu, cand) asm volatile("v_cmp_ge_u32 vcc, %1, %2\n\tv_addc_co_u32 %0, vcc, 0, %0, vcc" : "+v"(cnt) : "v"(uu), "v"(cand) : "vcc")
#define CNT_GT(cnt, uu, cand) asm volatile("v_cmp_gt_u32 vcc, %1, %2\n\tv_addc_co_u32 %0, vcc, 0, %0, vcc" : "+v"(cnt) : "v"(uu), "v"(cand) : "vcc")
__device__ __forceinline__ float wave_min_f32(float x) {
    x = fminf(x, __uint_as_float((unsigned)__builtin_amdgcn_update_dpp(0, (int)__float_as_uint(x), 0xB1, 0xf, 0xf, false)));
    x = fminf(x, __uint_as_float((unsigned)__builtin_amdgcn_update_dpp(0, (int)__float_as_uint(x), 0x4E, 0xf, 0xf, false)));
    x = fminf(x, __uint_as_float((unsigned)__builtin_amdgcn_update_dpp(0, (int)__float_as_uint(x), 0x141, 0xf, 0xf, false)));
    x = fminf(x, __uint_as_float((unsigned)__builtin_amdgcn_update_dpp(0, (int)__float_as_uint(x), 0x140, 0xf, 0xf, false)));
    { const auto a = __builtin_amdgcn_permlane16_swap(__float_as_uint(x), __float_as_uint(x), false, false); x = fminf(__uint_as_float(a[0]), __uint_as_float(a[1])); }
    { const auto b = __builtin_amdgcn_permlane32_swap(__float_as_uint(x), __float_as_uint(x), false, false); x = fminf(__uint_as_float(b[0]), __uint_as_float(b[1])); }
    return x;
}
__device__ __forceinline__ float wave_max_f32(float x) {
    x = fmaxf(x, __uint_as_float((unsigned)__builtin_amdgcn_update_dpp(0, (int)__float_as_uint(x), 0xB1, 0xf, 0xf, false)));
    x = fmaxf(x, __uint_as_float((unsigned)__builtin_amdgcn_update_dpp(0, (int)__float_as_uint(x), 0x4E, 0xf, 0xf, false)));
    x = fmaxf(x, __uint_as_float((unsigned)__builtin_amdgcn_update_dpp(0, (int)__float_as_uint(x), 0x141, 0xf, 0xf, false)));
    x = fmaxf(x, __uint_as_float((unsigned)__builtin_amdgcn_update_dpp(0, (int)__float_as_uint(x), 0x140, 0xf, 0xf, false)));
    { const auto a = __builtin_amdgcn_permlane16_swap(__float_as_uint(x), __float_as_uint(x), false, false); x = fmaxf(__uint_as_float(a[0]), __uint_as_float(a[1])); }
    { const auto b = __builtin_amdgcn_permlane32_swap(__float_as_uint(x), __float_as_uint(x), false, false); x = fmaxf(__uint_as_float(b[0]), __uint_as_float(b[1])); }
    return x;
}
__device__ __forceinline__ f32x4 mfma16(bf16x8 a, bf16x8 b, f32x4 c) { return __builtin_amdgcn_mfma_f32_16x16x32_bf16(a, b, c, 0, 0, 0); }

__device__ __forceinline__ void dsa_unit(LAS unsigned char* lds, int unit, bf16* QL, const bf16* CKV, const bf16* IQ, const bf16* IK, const float* IW, int tid, int wave, int lane_in) {
    const int lane = lane_in;
    const int b = unit & 7, qb = unit >> 3, t0 = qb * 8; const size_t tok0 = (size_t)b * SEQ + t0;
    LAS float* SC = (LAS float*)(lds + DS_SC); LAS unsigned* SEL = (LAS unsigned*)(lds + DS_SEL); const LAS float* RB = (const LAS float*)(lds + DS_RB);
    __syncthreads();
    for (int _ra = 0; _ra <= (DSA_PROBE & 1); ++_ra) {
        int lnA = lane; asm volatile("" : "+v"(lnA));
        int tid_a = tid; asm volatile("" : "+v"(tid_a));
        const int mt = wave & 1, q = lnA & 31, hh = lnA >> 5;
        const int qi = 4 * mt + 2 * ((q >> 2) & 1) + (q >> 4), hi = ((q >> 3) & 1) * 4 + (q & 3);
        bf16x8 af[4];
#pragma unroll
        for (int ks = 0; ks < 4; ++ks) af[ks] = *(const bf16x8*)(IQ + (tok0 + qi) * 512 + hi * 64 + ks * 16 + hh * 8);
        float wv[16];
        { const f32x4 a0 = *(const f32x4*)(IW + (tok0 + 4 * mt + 2 * hh) * 8), a1 = *(const f32x4*)(IW + (tok0 + 4 * mt + 2 * hh) * 8 + 4);
          const f32x4 b0 = *(const f32x4*)(IW + (tok0 + 4 * mt + 2 * hh + 1) * 8), b1 = *(const f32x4*)(IW + (tok0 + 4 * mt + 2 * hh + 1) * 8 + 4);
#pragma unroll
          for (int e = 0; e < 4; ++e) { wv[e] = a0[e]; wv[4 + e] = a1[e]; wv[8 + e] = b0[e]; wv[12 + e] = b1[e]; } }
        const int nkt = (t0 + 8 + 31) >> 5, ngr = (nkt + 3) >> 2;
        LAS unsigned char* IKL = lds + DS_IKL;
        const u32x4* ikg = (const u32x4*)(IK + (size_t)b * SEQ * 64) + tid_a;
        const int st0 = (tid_a >> 3) * 128 + (((tid_a & 7) ^ ((tid_a >> 3) & 7)) << 4), st1 = st0 + 64 * 128;
        const int jt = wave >> 1;
        const int rd0 = (jt * 32 + q) * 128; const int rx = (jt * 32 + q) & 7;
        u32x4 g0 = ikg[0], g1 = ikg[512];
#pragma unroll 1
        for (int g = 0; g < ngr; ++g) {
            __syncthreads();
            *(LAS u32x4*)(IKL + st0) = g0; *(LAS u32x4*)(IKL + st1) = g1;
            __syncthreads();
            if (g + 1 < ngr) { g0 = ikg[(size_t)(g + 1) * 1024]; g1 = ikg[(size_t)(g + 1) * 1024 + 512]; }
            const int kt = g * 4 + jt;
            if (kt < nkt) {
                f32x16 acc;
#pragma unroll
                for (int r = 0; r < 16; ++r) acc[r] = 0.f;
#pragma unroll
                for (int ks = 0; ks < 4; ++ks) { const bf16x8 bf = *(const LAS bf16x8*)(IKL + rd0 + (((2 * ks + hh) ^ rx) << 4)); acc = __builtin_amdgcn_mfma_f32_32x32x16_bf16(af[ks], bf, acc, 0, 0, 0); }
                float s0 = 0.f, s1 = 0.f;
#pragma unroll
                for (int r = 0; r < 8; ++r) { s0 += wv[r] * fmaxf(acc[r], 0.f); s1 += wv[8 + r] * fmaxf(acc[8 + r], 0.f); }
                const int key = kt * 32 + q;
                SC[(4 * mt + 2 * hh) * 4096 + key] = s0; SC[(4 * mt + 2 * hh + 1) * 4096 + key] = s1; }
        }
    }
    __syncthreads();
    int lnD = lane_in; asm volatile("" : "+v"(lnD));
    const int fr = lnD & 15, kg = lnD >> 4;
    bf16x8 ql[8];
#pragma unroll
    for (int ks = 0; ks < 8; ++ks) ql[ks] = (fr < 12) ? *(const bf16x8*)(QL + ((tok0 + wave) * 12 + fr) * 256 + ks * 32 + kg * 8) : (bf16x8){0, 0, 0, 0, 0, 0, 0, 0};
    const int t = t0 + wave, n = t + 1; const int nsel = n < 256 ? n : 256;
    for (int _rb = 0; _rb <= ((DSA_PROBE >> 1) & 1); ++_rb) {
        int lane = lane_in; asm volatile("" : "+v"(lane));
        LAS unsigned* selw = SEL + wave * 256;
        if (n <= 256) {
            for (int i = lane; i < n; i += 64) selw[i] = (unsigned)i | ((unsigned)t5_bucket(t - i) << 16);
        } else {
            const LAS float* sc = SC + wave * 4096;
            const int ni = (n + 63) >> 6;
            float f[64];
#pragma unroll
            for (int i = 0; i < 64; ++i) { const int s = 64 * i + lane; f[i] = (s < n) ? sc[s] + 0.f : -3.0e38f; }
            float lo, hi, T = 0.f; bool conv = false;
            { float m0 = -3.0e38f, m1 = -3.0e38f, m2 = -3.0e38f, m3 = -3.0e38f;
#pragma unroll
              for (int g4 = 0; g4 < 4; ++g4) if (ni > 16 * g4) {
#pragma unroll
                  for (int i = 16 * g4; i < 16 * g4 + 16; i += 4) { m0 = fmaxf(m0, f[i]); m1 = fmaxf(m1, f[i + 1]); m2 = fmaxf(m2, f[i + 2]); m3 = fmaxf(m3, f[i + 3]); } }
              lo = wave_min_f32(fminf(fminf(m0, m1), fminf(m2, m3))); hi = wave_max_f32(fmaxf(fmaxf(m0, m1), fmaxf(m2, m3))); }
#pragma unroll 1
            for (int it = 0; it < 26; ++it) {
                const float mid = 0.5f * lo + 0.5f * hi; unsigned cl = 0u;
#pragma unroll
                for (int g4 = 0; g4 < 4; ++g4) if (ni > 16 * g4) {
#pragma unroll
                    for (int i = 16 * g4; i < 16 * g4 + 16; ++i) asm volatile("v_cmp_ge_f32 vcc, %1, %2\n\tv_addc_co_u32 %0, vcc, 0, %0, vcc" : "+v"(cl) : "v"(f[i]), "v"(mid) : "vcc"); }
                asm volatile("s_nop 1" ::: "memory");
                const unsigned cnt = (unsigned)__builtin_amdgcn_readfirstlane((int)wave_sum_u32(cl));
                if (cnt == 256u) { T = mid; conv = true; break; }
                if (cnt > 256u) lo = mid; else hi = mid;
            }
            if (!conv) {
                unsigned Tu = 0u;
#pragma unroll 1
                for (int bit = 31; bit >= 0; --bit) {
                    const unsigned cand = Tu | (1u << bit); unsigned cl = 0u;
#pragma unroll
                    for (int g4 = 0; g4 < 4; ++g4) if (ni > 16 * g4) {
#pragma unroll
                        for (int i = 16 * g4; i < 16 * g4 + 16; ++i) { const unsigned uu = (f[i] == -3.0e38f) ? 0u : sortable_u32(f[i]); CNT_GE(cl, uu, cand); } }
                    asm volatile("s_nop 1" ::: "memory");
                    const unsigned cnt = (unsigned)__builtin_amdgcn_readfirstlane((int)wave_sum_u32(cl));
                    if (cnt >= 256u) Tu = cand;
                    if (cnt == 256u) break;
                }
                T = __uint_as_float((Tu & 0x80000000u) ? (Tu ^ 0x80000000u) : ~Tu);
            }
            unsigned G;
            { unsigned gl = 0u;
#pragma unroll
              for (int g4 = 0; g4 < 4; ++g4) if (ni > 16 * g4) {
#pragma unroll
                  for (int i = 16 * g4; i < 16 * g4 + 16; ++i) asm volatile("v_cmp_gt_f32 vcc, %1, %2\n\tv_addc_co_u32 %0, vcc, 0, %0, vcc" : "+v"(gl) : "v"(f[i]), "v"(T) : "vcc"); }
              asm volatile("s_nop 1" ::: "memory");
              G = (unsigned)__builtin_amdgcn_readfirstlane((int)wave_sum_u32(gl)); }
            const unsigned need_eq = 256u - G;
            unsigned pos = 0u, eq_used = 0u;
#pragma unroll
            for (int g4 = 0; g4 < 4; ++g4) if (ni > 16 * g4) {
#pragma unroll
                for (int i = 16 * g4; i < 16 * g4 + 16; ++i) {
                    const bool gt = f[i] > T, eq = f[i] == T;
                    const unsigned long long meq = __ballot(eq);
                    const bool sl = gt || (eq && (eq_used + mbcnt64(meq) < need_eq));
                    const unsigned long long msl = __ballot(sl);
                    if (sl) selw[pos + mbcnt64(msl)] = (unsigned)(64 * i + lane);
                    pos += (unsigned)__popcll(msl); eq_used += (unsigned)__popcll(meq); } }
#pragma unroll 1
            for (int i = lane; i < 256; i += 64) { const unsigned s = selw[i]; selw[i] = s | ((unsigned)t5_bucket(t - (int)s) << 16); }
        }
    }
    __syncthreads();
    f32x4 O[16];
#pragma unroll
    for (int ct = 0; ct < 16; ++ct) O[ct] = (f32x4){0.f, 0.f, 0.f, 0.f};
    float mrun = -3.0e38f, lrun = 0.f;
    for (int _rd = 0; _rd <= ((DSA_PROBE >> 3) & 1); ++_rd) {
        const unsigned rowmask = ((DSA_PROBE & 32) && _rd == 0) ? 0x7ffu : 0xffffu;
        if (_rd) { mrun = -3.0e38f; lrun = 0.f;
_Pragma("unroll") for (int ct = 0; ct < 16; ++ct) O[ct] = (f32x4){0.f, 0.f, 0.f, 0.f}; }
        const LAS unsigned* selw = SEL + wave * 256;
        LAS unsigned char* img = lds + DS_IMG + wave * DS_IMG_W;
        const int nsteps = (nsel + 31) >> 5;
        const int hh2 = lnD >> 5, c32 = lnD & 31; const bf16* ckr = CKV + (size_t)b * SEQ * 256 + c32 * 8;
        bf16x8 b0[8], b1[8], b2[8];
#pragma unroll
        for (int ks = 0; ks < 8; ++ks) { b0[ks] = (bf16x8){0, 0, 0, 0, 0, 0, 0, 0}; b1[ks] = b0[ks]; b2[ks] = b0[ks]; }
        const int ntiles = 2 * nsteps;
#define DSA_GATHER(X, tile) do { _Pragma("unroll") for (int j = 0; j < 8; ++j) { const int k_ = (tile) * 16 + 2 * j + hh2; const unsigned e_ = selw[k_ < nsel ? k_ : nsel - 1]; \
            if (!((DSA_PROBE & 128) && _rd == 0)) X[j] = *(const bf16x8*)(ckr + (size_t)(e_ & rowmask) * 256); } } while (0)
#define DSA_STEP(X0, X1, st) do { \
            f32x4 d0 = {0.f, 0.f, 0.f, 0.f}, d1 = {0.f, 0.f, 0.f, 0.f}; \
            _Pragma("unroll") for (int j = 0; j < 8; ++j) *(LAS bf16x8*)(img + (2 * j + hh2) * 528 + c32 * 16) = X0[j]; \
            if (2 * (st) + 3 < ntiles) DSA_GATHER(X0, 2 * (st) + 3);                \
            _Pragma("unroll") for (int j = 0; j < 8; ++j) *(LAS bf16x8*)(img + (16 + 2 * j + hh2) * 528 + c32 * 16) = X1[j]; \
            if (2 * (st) + 4 < ntiles) DSA_GATHER(X1, 2 * (st) + 4); \
            _Pragma("unroll") for (int k4 = 0; k4 < 8; k4 += 2) { bf16x8 fa[2], fb[2]; \
                _Pragma("unroll") for (int ks = 0; ks < 2; ++ks) { fa[ks] = *(const LAS bf16x8*)(img + fr * 528 + ((k4 + ks) * 32 + kg * 8) * 2); fb[ks] = *(const LAS bf16x8*)(img + (16 + fr) * 528 + ((k4 + ks) * 32 + kg * 8) * 2); } \
                _Pragma("unroll") for (int ks = 0; ks < 2; ++ks) { d0 = mfma16(fa[ks], ql[k4 + ks], d0); d1 = mfma16(fb[ks], ql[k4 + ks], d1); } } \
            const u32x4 s0 = *(const LAS u32x4*)(selw + (st) * 32 + kg * 4), s1 = *(const LAS u32x4*)(selw + (st) * 32 + 16 + kg * 4); \
            float lg[8]; float mloc = -3.0e38f; \
            _Pragma("unroll") for (int r = 0; r < 4; ++r) { \
                const float v0 = d0[r] + RB[((s0[r] >> 16) & 31u) * 16 + fr], v1 = d1[r] + RB[((s1[r] >> 16) & 31u) * 16 + fr]; \
                lg[r] = ((st) * 32 + kg * 4 + r < nsel) ? v0 : -3.0e38f; lg[4 + r] = ((st) * 32 + 16 + kg * 4 + r < nsel) ? v1 : -3.0e38f; \
                mloc = fmaxf(mloc, fmaxf(lg[r], lg[4 + r])); } \
            if (__any(mloc > mrun + 16.0f)) {                                       \
                mloc = kg_max(mloc); \
                const float mnew = fmaxf(mrun, mloc); \
                const float alpha = __expf(mrun - mnew); lrun *= alpha; \
                float ar[4]; \
                _Pragma("unroll") for (int r = 0; r < 4; ++r) ar[r] = __shfl(alpha, kg * 4 + r); \
                _Pragma("unroll") for (int ct = 0; ct < 16; ++ct) _Pragma("unroll") for (int r = 0; r < 4; ++r) O[ct][r] *= ar[r]; \
                mrun = mnew; } \
            float p[8]; \
            _Pragma("unroll") for (int r = 0; r < 8; ++r) { p[r] = (lg[r] > -1.0e38f) ? __expf(lg[r] - mrun) : 0.f; lrun += p[r]; } \
            union { bf16x8 v; unsigned w[4]; } pa; \
            pa.w[0] = cvt_pk_bf16(p[0], p[1]); pa.w[1] = cvt_pk_bf16(p[2], p[3]); pa.w[2] = cvt_pk_bf16(p[4], p[5]); pa.w[3] = cvt_pk_bf16(p[6], p[7]); \
            const LAS unsigned char* tb = img + (kg * 4 + (fr >> 2)) * 528 + (fr & 3) * 8; \
            if (!((DSA_PROBE & 64) && _rd == 0)) { \
            _Pragma("unroll") for (int c8 = 0; c8 < 16; c8 += 4) { \
                union { bf16x8 v; s16x4 h[2]; } bb[4]; \
                _Pragma("unroll") for (int cj = 0; cj < 4; ++cj) { bb[cj].h[0] = __builtin_amdgcn_ds_read_tr16_b64_v4i16((LAS s16x4*)(tb + (c8 + cj) * 32)); \
                    bb[cj].h[1] = __builtin_amdgcn_ds_read_tr16_b64_v4i16((LAS s16x4*)(tb + 16 * 528 + (c8 + cj) * 32)); } \
                _Pragma("unroll") for (int cj = 0; cj < 4; ++cj) O[c8 + cj] = mfma16(pa.v, bb[cj].v, O[c8 + cj]); } } } while (0)
        DSA_GATHER(b0, 0); DSA_GATHER(b1, 1); if (ntiles > 2) DSA_GATHER(b2, 2);
        for (int st = 0; st < nsteps; st += 3) {
            DSA_STEP(b0, b1, st);
            if (st + 1 < nsteps) DSA_STEP(b2, b0, st + 1);
            if (st + 2 < nsteps) DSA_STEP(b1, b2, st + 2);
        }
    }
#undef DSA_GATHER
#undef DSA_STEP
    lrun += __shfl_xor(lrun, 16); lrun += __shfl_xor(lrun, 32);
    const float inv = 1.0f / lrun;
    float ir[4];
#pragma unroll
    for (int r = 0; r < 4; ++r) ir[r] = __shfl(inv, kg * 4 + r);
    __syncthreads();
    if (kg < 3) {
#pragma unroll
        for (int ct = 0; ct < 16; ++ct)
#pragma unroll
            for (int r = 0; r < 4; ++r) *(LAS unsigned short*)(lds + DS_QL + ((wave * 12 + kg * 4 + r) * 256 + ct * 16 + fr) * 2) = (unsigned short)(cvt_pk_bf16(O[ct][r] * ir[r], 0.f) & 0xffffu);
    }
    __syncthreads();
    { const LAS u32x4* src = (const LAS u32x4*)(lds + DS_QL + wave * 12 * 256 * 2); u32x4* dst = (u32x4*)(QL + (tok0 + wave) * 12 * 256);
#pragma unroll
      for (int j = 0; j < 6; ++j) dst[j * 64 + lnD] = src[j * 64 + lnD]; }
}

__device__ __forceinline__ void qlat_phase(LAS unsigned char* lds, int u0, int ustep, int nunits, const bf16* Q, const bf16* UK, bf16* QL, int tid, int wave, int lane_in) {
    int lane = lane_in; asm volatile("" : "+v"(lane));
    const int q = lane & 31, hh = lane >> 5;
    u32x4 pre[2]; bf16x8 af[4];
#define QL_LOAD(unit) do { const int tb_ = (unit) / 12, h_ = (unit) - tb_ * 12; \
        _Pragma("unroll") for (int i = 0; i < 2; ++i) { const int idx = tid + i * NTHR, row = idx >> 3, ch = idx & 7; pre[i] = *(const u32x4*)(Q + ((size_t)tb_ * 128 + row) * 768 + h_ * 64 + ch * 8); } \
        _Pragma("unroll") for (int ks = 0; ks < 4; ++ks) af[ks] = *(const bf16x8*)(UK + ((size_t)h_ * 256 + wave * 32 + q) * 64 + ks * 16 + hh * 8); } while (0)
    if (u0 < nunits) QL_LOAD(u0);
    for (int unit = u0; unit < nunits; unit += ustep) {
        const int tb = unit / 12, h = unit - tb * 12; const size_t tok0 = (size_t)tb * 128;
        __syncthreads();
#pragma unroll
        for (int i = 0; i < 2; ++i) { const int idx = tid + i * NTHR, row = idx >> 3, ch = idx & 7; *(LAS u32x4*)(lds + row * 144 + ch * 16) = pre[i]; }
        bf16x8 afc[4];
#pragma unroll
        for (int ks = 0; ks < 4; ++ks) afc[ks] = af[ks];
        __syncthreads();
        if (unit + ustep < nunits) QL_LOAD(unit + ustep);
#pragma unroll
        for (int nt = 0; nt < 4; ++nt) {
            f32x16 acc;
#pragma unroll
            for (int r = 0; r < 16; ++r) acc[r] = 0.f;
#pragma unroll
            for (int ks = 0; ks < 4; ++ks) { const bf16x8 bq = *(const LAS bf16x8*)(lds + (nt * 32 + q) * 144 + (ks * 16 + hh * 8) * 2); acc = __builtin_amdgcn_mfma_f32_32x32x16_bf16(afc[ks], bq, acc, 0, 0, 0); }
#pragma unroll
            for (int g = 0; g < 4; ++g) { u32x2 w; w.x = cvt_pk_bf16(acc[4 * g] * 0.125f, acc[4 * g + 1] * 0.125f); w.y = cvt_pk_bf16(acc[4 * g + 2] * 0.125f, acc[4 * g + 3] * 0.125f);
                *(LAS u32x2*)(lds + 18432 + (nt * 32 + q) * 528 + (wave * 32 + 8 * g + 4 * hh) * 2) = w; }
        }
        __syncthreads();
        for (int idx = tid; idx < 4096; idx += NTHR) { const int row = idx >> 5, ch = idx & 31;
            *(u32x4*)(QL + ((tok0 + row) * 12 + h) * 256 + ch * 8) = *(const LAS u32x4*)(lds + 18432 + row * 528 + ch * 16); }
    }
#undef QL_LOAD
}
__device__ __forceinline__ void uv_phase(LAS unsigned char* lds, int u0, int ustep, int nunits, const bf16* QL, const bf16* UVT, bf16* MIX, int tid, int wave, int lane_in) {
    int lane = lane_in; asm volatile("" : "+v"(lane));
    const int q = lane & 31, hh = lane >> 5, mt = wave >> 1, nt = wave & 1;
    u32x4 pre[8];
#define UV_LOAD(unit) do { const int tb_ = (unit) / 12, h_ = (unit) - tb_ * 12; _Pragma("unroll") for (int i = 0; i < 8; ++i) { const int idx = tid + i * NTHR, row = idx >> 5, ch = idx & 31; \
        pre[i] = *(const u32x4*)(QL + (((size_t)tb_ * 128 + row) * 12 + h_) * 256 + ch * 8); } } while (0)
    if (u0 < nunits) UV_LOAD(u0);
    for (int unit = u0; unit < nunits; unit += ustep) {
        const int tb = unit / 12, h = unit - tb * 12; const size_t tok0 = (size_t)tb * 128;
        __syncthreads();
#pragma unroll
        for (int i = 0; i < 8; ++i) { const int idx = tid + i * NTHR, row = idx >> 5, ch = idx & 31; *(LAS u32x4*)(lds + row * 528 + ch * 16) = pre[i]; }
        const bf16* bp = UVT + ((size_t)h * 64 + nt * 32 + q) * 256 + hh * 8;
        bf16x8 bw[16];
#pragma unroll
        for (int ks = 0; ks < 16; ++ks) bw[ks] = *(const bf16x8*)(bp + ks * 16);
        __syncthreads();
        if (unit + ustep < nunits) UV_LOAD(unit + ustep);
        f32x16 acc;
#pragma unroll
        for (int r = 0; r < 16; ++r) acc[r] = 0.f;
#pragma unroll
        for (int ks = 0; ks < 16; ++ks) { const bf16x8 a = *(const LAS bf16x8*)(lds + (mt * 32 + q) * 528 + (ks * 16 + hh * 8) * 2); acc = __builtin_amdgcn_mfma_f32_32x32x16_bf16(a, bw[ks], acc, 0, 0, 0); }
#pragma unroll
        for (int r = 0; r < 16; ++r) *(LAS unsigned short*)(lds + 67584 + (mt * 32 + (r & 3) + 8 * (r >> 2) + 4 * hh) * 144 + (nt * 32 + q) * 2) = (unsigned short)(cvt_pk_bf16(acc[r], 0.f) & 0xffffu);
        __syncthreads();
        for (int idx = tid; idx < 1024; idx += NTHR) { const int row = idx >> 3, ch = idx & 7;
            *(u32x4*)(MIX + (tok0 + row) * 1024 + h * 64 + ch * 8) = *(const LAS u32x4*)(lds + 67584 + row * 144 + ch * 16); }
    }
#undef UV_LOAD
}

typedef __bf16 bf16v2_tt __attribute__((ext_vector_type(2)));
typedef float f32x2 __attribute__((ext_vector_type(2)));
__device__ __forceinline__ float dot2bf(unsigned a, unsigned b, float c) { return __builtin_amdgcn_fdot2_f32_bf16(__builtin_bit_cast(bf16v2_tt, a), __builtin_bit_cast(bf16v2_tt, b), c, false); }
__device__ __forceinline__ float unsortable_f32(unsigned u) { return __uint_as_float((u & 0x80000000u) ? (u ^ 0x80000000u) : ~u); }

constexpr int PA_SK = 0, PA_WB = 2 * 128 * 272, PA_WBYTES = 32 * 272;
static_assert(PA_WB + 8 * PA_WBYTES <= LDS_SCR_BYTES, "PEER-A LDS map");
__device__ __forceinline__ unsigned wave_max_u32(unsigned x) {
    { const unsigned t = (unsigned)__builtin_amdgcn_update_dpp(0, (int)x, 0xB1, 0xf, 0xf, false); x = t > x ? t : x; }
    { const unsigned t = (unsigned)__builtin_amdgcn_update_dpp(0, (int)x, 0x4E, 0xf, 0xf, false); x = t > x ? t : x; }
    { const unsigned t = (unsigned)__builtin_amdgcn_update_dpp(0, (int)x, 0x141, 0xf, 0xf, false); x = t > x ? t : x; }
    { const unsigned t = (unsigned)__builtin_amdgcn_update_dpp(0, (int)x, 0x140, 0xf, 0xf, false); x = t > x ? t : x; }
    { const auto a = __builtin_amdgcn_permlane16_swap(x, x, false, false); x = a[0] > a[1] ? a[0] : a[1]; }
    { const auto b = __builtin_amdgcn_permlane32_swap(x, x, false, false); x = b[0] > b[1] ? b[0] : b[1]; }
    return (unsigned)__builtin_amdgcn_readfirstlane((int)x);
}
__device__ __forceinline__ void peer_topk_load_sk(LAS unsigned char* lds, const bf16* SK, int tid) {
    __syncthreads();
    for (int idx = tid; idx < 4096; idx += NTHR) { const int row = idx >> 4, ch = idx & 15;
        *(LAS u32x4*)(lds + PA_SK + row * 272 + ch * 16) = *(const u32x4*)(SK + (size_t)row * 128 + ch * 8); }
    __syncthreads();
}
__device__ __forceinline__ void peer_topk_task(LAS unsigned char* lds, int task, const bf16* PQ, u32x2* TOPK, int wave, int lane_in) {
    int lane = lane_in; asm volatile("" : "+v"(lane));
    const int tg = task >> 4, sl = task & 15, half = sl & 1, q = lane & 31, hh = lane >> 5;
    LAS unsigned char* wb = lds + PA_WB + wave * PA_WBYTES;
#pragma unroll
    for (int j = 0; j < 8; ++j) { const int row = 4 * j + (lane >> 4), ch = lane & 15;
        *(LAS u32x4*)(wb + row * 272 + ch * 16) = *(const u32x4*)(PQ + ((size_t)tg * 32 + row) * 2048 + sl * 128 + ch * 8); }
    bf16x8 bq[8];
#pragma unroll
    for (int ks = 0; ks < 8; ++ks) bq[ks] = *(const LAS bf16x8*)(wb + q * 272 + (ks * 16 + hh * 8) * 2);
    float f[64];
    const LAS unsigned char* skp = lds + PA_SK + (half * 128 + q) * 272 + hh * 16;
#pragma unroll
    for (int kt = 0; kt < 4; ++kt) {
        f32x16 acc;
#pragma unroll
        for (int r = 0; r < 16; ++r) acc[r] = 0.f;
#pragma unroll
        for (int ks = 0; ks < 8; ++ks) { const bf16x8 a = *(const LAS bf16x8*)(skp + kt * 32 * 272 + ks * 32); acc = __builtin_amdgcn_mfma_f32_32x32x16_bf16(a, bq[ks], acc, 0, 0, 0); }
#pragma unroll
        for (int r = 0; r < 16; ++r) f[kt * 16 + r] = acc[r] + 0.f;
    }
    float lo, hi, T = 0.f;
    { float mn = 3.0e38f, mx = -3.0e38f;
#pragma unroll
      for (int g = 0; g < 8; ++g) { float m = f[8 * g];
#pragma unroll
          for (int i = 1; i < 8; ++i) m = fmaxf(m, f[8 * g + i]);
          mn = fminf(mn, m); mx = fmaxf(mx, m); }
      { const auto a2 = __builtin_amdgcn_permlane32_swap(__float_as_uint(mn), __float_as_uint(mn), false, false); mn = fminf(__uint_as_float(a2[0]), __uint_as_float(a2[1]));
        const auto b2 = __builtin_amdgcn_permlane32_swap(__float_as_uint(mx), __float_as_uint(mx), false, false); mx = fmaxf(__uint_as_float(b2[0]), __uint_as_float(b2[1])); }
      lo = mn; hi = mx; }
    bool done = false;
#pragma unroll 1
    for (int it = 0; it < 22; ++it) {
        const float mid = 0.5f * lo + 0.5f * hi; unsigned cnt = 0u;
#pragma unroll
        for (int i = 0; i < 64; ++i) asm volatile("v_cmp_ge_f32 vcc, %1, %2\n\tv_addc_co_u32 %0, vcc, 0, %0, vcc" : "+v"(cnt) : "v"(f[i]), "v"(mid) : "vcc");
        asm volatile("s_nop 1" ::: "memory");
        const auto sw = __builtin_amdgcn_permlane32_swap(cnt, cnt, false, false);
        const unsigned tot = sw[0] + sw[1];
        if (!done) { if (tot >= 16u) lo = mid; else hi = mid; if (tot == 16u) { T = mid; done = true; } }
        if (__all(done)) break;
    }
    if (!__all(done)) {
        unsigned Tu = 0u;
#pragma unroll 1
        for (int bit = 31; bit >= 0; --bit) {
            const unsigned cand = Tu | (1u << bit); unsigned cnt = 0u;
#pragma unroll
            for (int i = 0; i < 64; ++i) { const unsigned uu = sortable_u32(f[i]); CNT_GE(cnt, uu, cand); }
            asm volatile("s_nop 1" ::: "memory");
            const auto sw = __builtin_amdgcn_permlane32_swap(cnt, cnt, false, false);
            if (sw[0] + sw[1] >= 16u) Tu = cand;
        }
        if (!done) T = unsortable_f32(Tu);
    }
    unsigned gtc = 0u, eqc = 0u;
#pragma unroll
    for (int i = 0; i < 64; ++i) { asm volatile("v_cmp_gt_f32 vcc, %1, %2\n\tv_addc_co_u32 %0, vcc, 0, %0, vcc" : "+v"(gtc) : "v"(f[i]), "v"(T) : "vcc");
        asm volatile("v_cmp_eq_f32 vcc, %1, %2\n\tv_addc_co_u32 %0, vcc, 0, %0, vcc" : "+v"(eqc) : "v"(f[i]), "v"(T) : "vcc"); }
    asm volatile("s_nop 1" ::: "memory");
    unsigned pg, pe;
    { const auto a = __builtin_amdgcn_permlane32_swap(gtc, gtc, false, false); pg = a[0] + a[1] - gtc; const auto e = __builtin_amdgcn_permlane32_swap(eqc, eqc, false, false); pe = e[0] + e[1] - eqc; }
    const unsigned need_eq = 16u - (gtc + pg);
    const unsigned take0 = hh ? (pe < need_eq ? pe : need_eq) : (eqc < need_eq ? eqc : need_eq);
    const unsigned my_take = hh ? need_eq - take0 : take0;
    unsigned pos = hh ? (pg + take0) : 0u, eq_seen = 0u;
    LAS u32x2* stg = (LAS u32x2*)wb + q * 16;
#pragma unroll
    for (int i = 0; i < 64; ++i) {
        const bool eq = (f[i] == T); const bool sel = (f[i] > T) || (eq && eq_seen < my_take);
        if (sel) { u32x2 e; e.x = __float_as_uint(f[i]); e.y = (unsigned)((i >> 4) * 32 + (i & 3) + 8 * ((i >> 2) & 3) + 4 * hh); stg[pos] = e; pos += 1u; }
        eq_seen += eq ? 1u : 0u;
    }
#pragma unroll
    for (int j = 0; j < 4; ++j) { const int tk = 8 * j + (lane >> 3), ch = lane & 7;
        *(u32x4*)((unsigned char*)(TOPK + (((size_t)tg * 32 + tk) * 16 + sl) * 16) + ch * 16) = *(const LAS u32x4*)(wb + tk * 128 + ch * 16); }
}

template <bool LAST>
__device__ __forceinline__ void peer_tok(LAS unsigned char* lds_w, size_t tok, const u32x2* TOPK, const unsigned char* TABU, const unsigned char* TABV, const float* TSU, const float* TSV, bf16* HB, const float* SS, const float* gffn, float* xres, const float* gnext, int lane_in) {
    int lane = lane_in; asm volatile("" : "+v"(lane));
    LAS u32x2* EL = (LAS u32x2*)lds_w;
    LAS u32x4* EG = (LAS u32x4*)(lds_w + 1024);
    for (int _rp = 0; _rp <= (PEER_PROBE & 1); ++_rp)
#pragma unroll 1
    for (int head = 0; head < 8; ++head) {
        const u32x2* base = TOPK + (tok * 16 + head * 2) * 16;
        const u32x2 e0 = base[lane >> 2];
        const u32x4 e1a = *(const u32x4*)(base + 16 + 4 * (lane & 3)), e1b = *(const u32x4*)(base + 16 + 4 * (lane & 3) + 2);
        const float s0 = __uint_as_float(e0.x);
        float cs[4]; unsigned ck[4], u[4];
        cs[0] = s0 + __uint_as_float(e1a.x); ck[0] = e0.y * 128u + e1a.y; cs[1] = s0 + __uint_as_float(e1a.z); ck[1] = e0.y * 128u + e1a.w;
        cs[2] = s0 + __uint_as_float(e1b.x); ck[2] = e0.y * 128u + e1b.y; cs[3] = s0 + __uint_as_float(e1b.z); ck[3] = e0.y * 128u + e1b.w;
#pragma unroll
        for (int m = 0; m < 4; ++m) u[m] = sortable_u32(cs[m]);
        unsigned T = 0u;
#pragma unroll 1
        for (int bit = 31; bit >= 0; --bit) {
            const unsigned cand = T | (1u << bit); unsigned cnt = 0u;
#pragma unroll
            for (int m = 0; m < 4; ++m) cnt += (unsigned)__popcll(__ballot(u[m] >= cand));
            if (cnt >= 16u) T = cand;
            if (cnt == 16u) break;
        }
        unsigned G = 0u;
#pragma unroll
        for (int m = 0; m < 4; ++m) G += (unsigned)__popcll(__ballot(u[m] > T));
        const unsigned need_eq = 16u - G; unsigned pos = 0u, eq_used = 0u;
#pragma unroll
        for (int m = 0; m < 4; ++m) {
            const bool gt = u[m] > T, eq = u[m] == T;
            const unsigned long long meq = __ballot(eq);
            const bool sl = gt || (eq && (eq_used + mbcnt64(meq) < need_eq));
            const unsigned long long msl = __ballot(sl);
            if (sl) { u32x2 e; e.x = ck[m]; e.y = __float_as_uint(cs[m]); EL[head * 16 + pos + mbcnt64(msl)] = e; }
            pos += (unsigned)__popcll(msl); eq_used += (unsigned)__popcll(meq); }
    }
#pragma unroll
    for (int rep = 0; rep < 2; ++rep) { const int e = lane + 64 * rep; const u32x2 ent = EL[e]; const float sc = __uint_as_float(ent.y);
        const float su = TSU[ent.x], sv = TSV[ent.x];
        float mx = sc;
#pragma unroll
        for (int o = 1; o < 16; o <<= 1) mx = fmaxf(mx, __shfl_xor(mx, o));
        const float p = __expf(sc - mx); float sm = p;
#pragma unroll
        for (int o = 1; o < 16; o <<= 1) sm += __shfl_xor(sm, o);
        u32x4 w; w.x = ent.x; w.y = __float_as_uint(su); w.z = __float_as_uint(p / sm * sv); w.w = 0u; EG[e] = w; }
    int xq[4]; float sx;
    { const u32x4* hp = (const u32x4*)(HB + tok * 1024 + lane * 16); const u32x4 qa = hp[0], qb = hp[1]; float f[16]; float am = 0.f;
#pragma unroll
      for (int e = 0; e < 4; ++e) { f[2 * e] = __uint_as_float(qa[e] << 16); f[2 * e + 1] = __uint_as_float(qa[e] & 0xffff0000u); f[8 + 2 * e] = __uint_as_float(qb[e] << 16); f[8 + 2 * e + 1] = __uint_as_float(qb[e] & 0xffff0000u); }
      { const float rs_ = 1.0f / sqrtf(SS[tok] * (1.f / 1024.f) + EPS);
#pragma unroll
        for (int j = 0; j < 4; ++j) { const f32x4 gg = *(const f32x4*)(gffn + lane * 16 + 4 * j); f[4 * j] *= rs_ * gg[0]; f[4 * j + 1] *= rs_ * gg[1]; f[4 * j + 2] *= rs_ * gg[2]; f[4 * j + 3] *= rs_ * gg[3]; } }
#pragma unroll
      for (int c = 0; c < 16; ++c) am = fmaxf(am, fabsf(f[c]));
      am = wave_max(am); sx = am > 0.f ? am * (1.0f / 127.0f) : 1.0f; const float inv = 1.0f / sx;
#pragma unroll
      for (int e = 0; e < 4; ++e) { const int q0 = (int)rintf(f[4 * e] * inv), q1 = (int)rintf(f[4 * e + 1] * inv), q2 = (int)rintf(f[4 * e + 2] * inv), q3 = (int)rintf(f[4 * e + 3] * inv);
          xq[e] = (q0 & 0xff) | ((q1 & 0xff) << 8) | ((q2 & 0xff) << 16) | ((q3 & 0xff) << 24); } }
    f32x2 out2[8];
#pragma unroll
    for (int c = 0; c < 8; ++c) out2[c] = (f32x2){0.f, 0.f};
    const unsigned char* ubase = TABU + lane * 16; const unsigned char* vbase = TABV + lane * 16;
#define PT_LOAD(UB, VB, BT) do { _Pragma("unroll") for (int k = 0; k < 8; ++k) { const size_t ro = (size_t)EG[(BT) * 8 + k].x << 10; UB[k] = *(const u32x4*)(ubase + ro); VB[k] = *(const u32x4*)(vbase + ro); } } while (0)
#define PT_COMPUTE(UB, VB, BT) do { int di[8]; \
        _Pragma("unroll") for (int k = 0; k < 8; ++k) { int a0 = 0; \
            _Pragma("unroll") for (int e = 0; e < 4; ++e) a0 = __builtin_amdgcn_sdot4((int)UB[k][e], xq[e], a0, false); di[k] = a0; } \
        int r4[4], r2[2], v1; \
        { const bool h32 = (lane & 32) != 0; \
          _Pragma("unroll") for (int j = 0; j < 4; ++j) { const int send = h32 ? di[j] : di[j + 4], keep = h32 ? di[j + 4] : di[j]; r4[j] = keep + __shfl_xor(send, 32); } \
          const bool h16 = (lane & 16) != 0; \
          _Pragma("unroll") for (int j = 0; j < 2; ++j) { const int send = h16 ? r4[j] : r4[j + 2], keep = h16 ? r4[j + 2] : r4[j]; r2[j] = keep + __shfl_xor(send, 16); } \
          const bool h8 = (lane & 8) != 0; \
          { const int send = h8 ? r2[0] : r2[1], keep = h8 ? r2[1] : r2[0]; v1 = keep + __shfl_xor(send, 8); } \
          v1 += __shfl_xor(v1, 4); v1 += __shfl_xor(v1, 2); v1 += __shfl_xor(v1, 1); } \
        float act; { const u32x4 eg = EG[(BT) * 8 + (lane >> 3)]; const float v = (float)v1 * (__uint_as_float(eg.y) * sx); \
          const float t = __builtin_amdgcn_rcpf(fabsf(v) * 0.2316418882f + 1.0f); \
          float q = t * 0.5307027145f + (-0.7265760135f); q = q * t + 0.7107068705f; q = q * t + (-0.142248368f); q = q * t + 0.127414796f; q = q * t; \
          const float m = v * (q * __builtin_amdgcn_exp2f(v * v * (-0.72134752044f))); \
          act = (v < 0.f ? m : v - m) * __uint_as_float(eg.z); }                        \
        _Pragma("unroll") for (int k = 0; k < 8; ++k) { const float a = __uint_as_float(__builtin_amdgcn_readlane((int)__float_as_uint(act), 8 * k)); \
            _Pragma("unroll") for (int e = 0; e < 4; ++e) { out2[2 * e] += __builtin_amdgcn_cvt_pk_f32_fp8((int)VB[k][e], false) * a; out2[2 * e + 1] += __builtin_amdgcn_cvt_pk_f32_fp8((int)VB[k][e], true) * a; } } } while (0)
    {
        u32x4 ubA[8], vbA[8], ubB[8], vbB[8], ubC[8], vbC[8];
        PT_LOAD(ubA, vbA, 0); PT_LOAD(ubB, vbB, 1);
#pragma unroll 1
        for (int bt = 0; bt < 16; bt += 3) {
            { const int n2 = (bt + 2 < 16) ? bt + 2 : 15; PT_LOAD(ubC, vbC, n2); }
            PT_COMPUTE(ubA, vbA, bt);
            if (bt + 1 < 16) {
                { const int n3 = (bt + 3 < 16) ? bt + 3 : 15; PT_LOAD(ubA, vbA, n3); }
                PT_COMPUTE(ubB, vbB, bt + 1);
                { const int n4 = (bt + 4 < 16) ? bt + 4 : 15; PT_LOAD(ubB, vbB, n4); }
                PT_COMPUTE(ubC, vbC, bt + 2);
            }
        }
    }
#undef PT_LOAD
#undef PT_COMPUTE
    f32x4 xr[4]; float ss = 0.f;
    float* xq4 = xres + tok * 1024 + lane * 16;
#pragma unroll
    for (int j = 0; j < 4; ++j) { xr[j] = *(const f32x4*)(xq4 + 4 * j);
        xr[j][0] += out2[2 * j].x; xr[j][1] += out2[2 * j].y; xr[j][2] += out2[2 * j + 1].x; xr[j][3] += out2[2 * j + 1].y;
#pragma unroll
        for (int e = 0; e < 4; ++e) ss += xr[j][e] * xr[j][e]; }
    const float rstd = 1.0f / sqrtf(wave_sum(ss) * (1.f / 1024.f) + EPS);
    if (LAST) {
#pragma unroll
        for (int j = 0; j < 4; ++j) { const f32x4 gg = *(const f32x4*)(gnext + lane * 16 + 4 * j); *(f32x4*)(xq4 + 4 * j) = xr[j] * rstd * gg; }
    } else {
        u32x4 o0, o1;
#pragma unroll
        for (int j = 0; j < 4; ++j) { *(f32x4*)(xq4 + 4 * j) = xr[j]; const f32x4 gg = *(const f32x4*)(gnext + lane * 16 + 4 * j);
            const unsigned lo = cvt_pk_bf16(xr[j][0] * rstd * gg[0], xr[j][1] * rstd * gg[1]), hi = cvt_pk_bf16(xr[j][2] * rstd * gg[2], xr[j][3] * rstd * gg[3]);
            if (j < 2) { o0[2 * j] = lo; o0[2 * j + 1] = hi; } else { o1[2 * (j - 2)] = lo; o1[2 * (j - 2) + 1] = hi; } }
        u32x4* hq = (u32x4*)(HB + tok * 1024 + lane * 16); hq[0] = o0; hq[1] = o1;
    }
}

template <int R> __device__ __forceinline__ void rank_step(unsigned long long key, unsigned& rank) {
    const unsigned lo = (unsigned)__builtin_amdgcn_update_dpp(0, (int)(unsigned)key, 0x120 + R, 0xf, 0xf, false);
    const unsigned hi = (unsigned)__builtin_amdgcn_update_dpp(0, (int)(unsigned)(key >> 32), 0x120 + R, 0xf, 0xf, false);
    rank += ((((unsigned long long)hi << 32) | lo) > key) ? 1u : 0u;
    if constexpr (R < 15) rank_step<R + 1>(key, rank);
}
__device__ __forceinline__ void xcc_sync(unsigned* ctr, unsigned nloc, unsigned target);
constexpr int PW_SET = 6144, PW_HIST = 2 * PW_SET, PW_SL = PW_HIST + 1024, PW_ENTB = PW_SL + 512, PW_BYTES = PW_ENTB + 512;
template <bool LAST>
__device__ __forceinline__ void peer_wave(LAS unsigned char* lds_w, int m0, int mstep, int mcount, const u32x2* TOPK, const unsigned char* TABU, const unsigned char* TABV, const float* TSU, const float* TSV,
                                          bf16* HB, const float* SS, const float* gffn, float* xres, const float* gnext, int lane_in, unsigned* xctr, unsigned nloc, unsigned xbase) {
    int lane = lane_in; asm volatile("" : "+v"(lane));
    LAS unsigned* HIST = (LAS unsigned*)(lds_w + PW_HIST);
    LAS u32x2* SLs = (LAS u32x2*)(lds_w + PW_SL);
    int ri, rj;
    { const int L = lane;
      if (L < 16) { ri = 0; rj = L; } else if (L < 24) { ri = 1; rj = L - 16; } else if (L < 29) { ri = 2; rj = L - 24; } else if (L < 33) { ri = 3; rj = L - 29; }
      else if (L < 36) { ri = 4; rj = L - 33; } else if (L < 38) { ri = 5; rj = L - 36; } else if (L < 40) { ri = 6; rj = L - 38; } else if (L < 42) { ri = 7; rj = L - 40; }
      else if (L < 50) { ri = L - 34; rj = 0; } else { ri = 0; rj = 0; } }
#define PW_ENT(tokC, head) TOPK[((tokC + (lane >> 5)) * 16 + (head) * 2) * 16 + (lane & 31)]
#define PW_CAND(ent, head, ELc) do { \
        const unsigned long long key = ((unsigned long long)sortable_u32(__uint_as_float(ent.x)) << 32) | (unsigned)(15 - (lane & 15)); \
        unsigned rank = 0u; rank_step<1>(key, rank); \
        SLs[(lane >> 4) * 16 + rank] = ent; \
_Pragma("unroll 1") \
        for (int tk = 0; tk < 2; ++tk) { \
            const u32x2 ea = SLs[(tk * 2) * 16 + ri], eb = SLs[(tk * 2 + 1) * 16 + rj]; \
            const float cs = __uint_as_float(ea.x) + __uint_as_float(eb.x); const unsigned ck = ea.y * 128u + eb.y; \
            const bool vld = lane < 50; \
              \
            float lo = wave_min_f32(vld ? cs : 3.0e38f), hi = wave_max_f32(vld ? cs : -3.0e38f); bool sl = false; bool conv = false; \
            _Pragma("unroll 1") for (int it = 0; it < 24; ++it) { \
                const float mid = 0.5f * lo + 0.5f * hi; const bool ge = vld && (cs >= mid); const unsigned cnt = (unsigned)__popcll(__ballot(ge)); \
                if (cnt == 16u) { sl = ge; conv = true; break; } \
                if (cnt > 16u) lo = mid; else hi = mid; } \
            if (!conv) {                                                                \
                const unsigned u = vld ? sortable_u32(cs) : 0u; \
                unsigned T = 0u; \
                _Pragma("unroll 1") for (int bit = 31; bit >= 0; --bit) { \
                    const unsigned cand = T | (1u << bit); const unsigned cnt = (unsigned)__popcll(__ballot(u >= cand)); \
                    if (cnt >= 16u) T = cand; \
                    if (cnt == 16u) break; \
                } \
                const unsigned G = (unsigned)__popcll(__ballot(u > T)); const unsigned need_eq = 16u - G; \
                const bool gt = u > T, eq = u == T; \
                const unsigned long long meq = __ballot(eq); \
                sl = gt || (eq && (mbcnt64(meq) < need_eq)); } \
            const unsigned long long msl = __ballot(sl); \
            if (sl) { u32x2 e; e.x = ck; e.y = __float_as_uint(cs); ELc[(tk * 8 + head) * 16 + mbcnt64(msl)] = e; } \
        } \
        } while (0)
    if (m0 >= mcount) return;
    {
        LAS u32x2* ELc = (LAS u32x2*)lds_w; LAS u32x4* EGc = (LAS u32x4*)(lds_w + 2048); const size_t tokC = (size_t)m0 * 2;
        HIST[lane] = 0u; HIST[64 + lane] = 0u;
        for (int _rp = 0; _rp <= (PEER_PROBE & 1); ++_rp)
#pragma unroll 1
        for (int head = 0; head < 8; ++head) { const u32x2 ent = PW_ENT(tokC, head); PW_CAND(ent, head, ELc); }
    u32x4 ent4[4]; unsigned rk[4];
#pragma unroll
    for (int rep = 0; rep < 4; ++rep) { const int e = lane + 64 * rep; const u32x2 ent = ELc[e]; const float sc = __uint_as_float(ent.y);
        const float su = TSU[ent.x], sv = TSV[ent.x];
        float mx = sc;
#pragma unroll
        for (int o = 1; o < 16; o <<= 1) mx = fmaxf(mx, __shfl_xor(mx, o));
        const float p = __expf(sc - mx); float sm = p;
#pragma unroll
        for (int o = 1; o < 16; o <<= 1) sm += __shfl_xor(sm, o);
        ent4[rep].x = ent.x; ent4[rep].y = __float_as_uint(su); ent4[rep].z = __float_as_uint(p / sm * sv); ent4[rep].w = (unsigned)(rep >> 1);
        rk[rep] = atomicAdd((unsigned*)&HIST[(rep >> 1) * 64 + (ent.x >> 8)], 1u); }
    { const unsigned c0 = HIST[2 * lane], c1 = HIST[2 * lane + 1]; unsigned inc = c0 + c1;
_Pragma("unroll")
      for (int o = 1; o < 64; o <<= 1) { const unsigned t = (unsigned)__shfl_up((int)inc, o); if (lane >= o) inc += t; }
      HIST[128 + 2 * lane] = inc - c0 - c1; HIST[128 + 2 * lane + 1] = inc - c1; }
#pragma unroll
    for (int rep = 0; rep < 4; ++rep) EGc[HIST[128 + (rep >> 1) * 64 + (ent4[rep].x >> 8)] + rk[rep]] = ent4[rep];
    }
    int par = 0;
#pragma unroll 1
    for (int m = m0; m < mcount; m += mstep, par ^= 1) {
        const size_t tok0 = (size_t)m * 2; const bool has_next = (m + mstep) < mcount; const size_t tokC = (size_t)(m + mstep) * 2;
        if (PEER_WGSYNC == 1 || (PEER_WGSYNC >= 3 && PEER_WGSYNC < 6)) __syncthreads();
        if (PEER_WGSYNC == 2) xcc_sync(xctr, nloc, xbase + (unsigned)((m - m0) / mstep) + 1u);
        const unsigned xseq = (xbase + (unsigned)((m - m0) / mstep)) * (PEER_WGSYNC == 6 ? 4u : 8u);
        if (PEER_WGSYNC == 6 || PEER_WGSYNC == 7) xcc_sync(xctr, nloc, xseq + 1u);
        LAS u32x4* EGg = (LAS u32x4*)(lds_w + par * PW_SET + 2048);
        LAS u32x2* ELc = (LAS u32x2*)(lds_w + (par ^ 1) * PW_SET); LAS u32x4* EGc = (LAS u32x4*)(lds_w + (par ^ 1) * PW_SET + 2048);
        int x0q[4], x1q[4]; float sx0, sx1;
        {
    float gf[16];
#pragma unroll
    for (int j = 0; j < 4; ++j) { const f32x4 gg = *(const f32x4*)(gffn + lane * 16 + 4 * j); gf[4 * j] = gg[0]; gf[4 * j + 1] = gg[1]; gf[4 * j + 2] = gg[2]; gf[4 * j + 3] = gg[3]; }

#define PP_QUANT(xq, sx, tk) do { const u32x4* hp = (const u32x4*)(HB + (tok0 + (tk)) * 1024 + lane * 16); const u32x4 qa = hp[0], qb = hp[1]; float f[16]; float am = 0.f; \
        const float rs_ = 1.0f / sqrtf(SS[tok0 + (tk)] * (1.f / 1024.f) + EPS); \
        _Pragma("unroll") for (int e = 0; e < 4; ++e) { f[2 * e] = __uint_as_float(qa[e] << 16); f[2 * e + 1] = __uint_as_float(qa[e] & 0xffff0000u); f[8 + 2 * e] = __uint_as_float(qb[e] << 16); f[8 + 2 * e + 1] = __uint_as_float(qb[e] & 0xffff0000u); } \
        _Pragma("unroll") for (int c = 0; c < 16; ++c) f[c] *= rs_ * gf[c]; \
        _Pragma("unroll") for (int c = 0; c < 16; ++c) am = fmaxf(am, fabsf(f[c])); \
        am = wave_max(am); sx = am > 0.f ? am * (1.0f / 127.0f) : 1.0f; const float inv = 1.0f / sx; \
        _Pragma("unroll") for (int e = 0; e < 4; ++e) { const int q0 = (int)rintf(f[4 * e] * inv), q1 = (int)rintf(f[4 * e + 1] * inv), q2 = (int)rintf(f[4 * e + 2] * inv), q3 = (int)rintf(f[4 * e + 3] * inv); \
            xq[e] = (q0 & 0xff) | ((q1 & 0xff) << 8) | ((q2 & 0xff) << 16) | ((q3 & 0xff) << 24); } } while (0)
        PP_QUANT(x0q, sx0, 0); PP_QUANT(x1q, sx1, 1);
#undef PP_QUANT
        }
        f32x2 out0[8], out1[8];
#pragma unroll
        for (int c = 0; c < 8; ++c) { out0[c] = (f32x2){0.f, 0.f}; out1[c] = (f32x2){0.f, 0.f}; }
#define PP_LOAD(UB, VB, TK, J) do { const unsigned idv = EGg[(TK) * 128 + (J) * 8 + (lane & 7)].x & idmask; \
        _Pragma("unroll") for (int k = 0; k < 8; ++k) { const unsigned id = (unsigned)__builtin_amdgcn_readlane((int)idv, k); const unsigned char* rp = TABU + ((size_t)id << 11) + lane * 16; \
            UB[k] = *(const u32x4*)rp; VB[k] = *(const u32x4*)(rp + 1024); } } while (0)
#define PP_COMPUTE(UB, VB, TK, J, XQ, SX, OUT) do { int di[8]; \
        const u32x4 eg = EGg[(TK) * 128 + (J) * 8 + (lane >> 3)]; \
        _Pragma("unroll") for (int k = 0; k < 8; ++k) { int a0 = 0; \
            _Pragma("unroll") for (int e = 0; e < 4; ++e) a0 = __builtin_amdgcn_sdot4((int)UB[k][e], XQ[e], a0, false); \
            di[k] = a0; } \
        int r4[4], r2[2], v1; \
        _Pragma("unroll") for (int j = 0; j < 4; ++j) { const auto sw = __builtin_amdgcn_permlane32_swap((unsigned)di[j], (unsigned)di[j + 4], false, false); r4[j] = (int)(sw[0] + sw[1]); }     \
        _Pragma("unroll") for (int j = 0; j < 2; ++j) { const auto sw = __builtin_amdgcn_permlane16_swap((unsigned)r4[j], (unsigned)r4[j + 2], false, false); r2[j] = (int)(sw[0] + sw[1]); }     \
        { const bool h8 = (lane & 8) != 0; const int send = h8 ? r2[0] : r2[1], keep = h8 ? r2[1] : r2[0]; \
          v1 = keep + __builtin_amdgcn_update_dpp(0, send, 0x128, 0xf, 0xf, false);                                         \
          v1 += __builtin_amdgcn_update_dpp(0, v1, 0xB1, 0xf, 0xf, false); v1 += __builtin_amdgcn_update_dpp(0, v1, 0x4E, 0xf, 0xf, false); v1 += __builtin_amdgcn_update_dpp(0, v1, 0x141, 0xf, 0xf, false); }     \
        float act; { const float v = (float)v1 * __uint_as_float(eg.y) * SX; \
          const float t = __builtin_amdgcn_rcpf(fabsf(v) * 0.2316418882f + 1.0f); \
          float q = t * 0.5307027145f + (-0.7265760135f); q = q * t + 0.7107068705f; q = q * t + (-0.142248368f); q = q * t + 0.127414796f; q = q * t; \
          const float m = v * (q * __builtin_amdgcn_exp2f(v * v * (-0.72134752044f))); \
          act = (v < 0.f ? m : v - m) * __uint_as_float(eg.z) * amul; } \
        _Pragma("unroll") for (int k = 0; k < 8; ++k) { const float a = __uint_as_float(__builtin_amdgcn_readlane((int)__float_as_uint(act), 8 * k)); \
            _Pragma("unroll") for (int e = 0; e < 4; ++e) { OUT[2 * e] += __builtin_amdgcn_cvt_pk_f32_fp8((int)VB[k][e], false) * a; OUT[2 * e + 1] += __builtin_amdgcn_cvt_pk_f32_fp8((int)VB[k][e], true) * a; } } } while (0)
        for (int _rg = ((PEER_PROBE & 6) ? 0 : 1); _rg < 2; ++_rg) {
            const unsigned idmask = (_rg == 0 && (PEER_PROBE & 4)) ? 1023u : 0xffffffffu; const float amul = _rg ? 1.0f : 0.0f;
            u32x4 ubA[8], vbA[8], ubB[8], vbB[8];
#define PW_DMA(head) do { if (has_next && lane < 32) { const unsigned char* g_ = (const unsigned char*)(TOPK + ((tokC + (lane >> 4)) * 16 + (head) * 2) * 16) + (lane & 15) * 16; \
                __builtin_amdgcn_global_load_lds((const unsigned*)g_, (LAS unsigned*)(lds_w + PW_ENTB), 16, 0, 0); } } while (0)
            PW_DMA(0);
            PP_LOAD(ubA, vbA, 0, (par ? 15 : 0));
#pragma unroll 1
            for (int j = 0; j < 16; ++j) {
                if ((PEER_WGSYNC == 3 && (j & 3) == 0) || (PEER_WGSYNC == 4 && (j & 1) == 0) || PEER_WGSYNC == 5) __syncthreads();
                if (PEER_WGSYNC == 6) { if ((j & 3) == 0 && j) xcc_sync(xctr, nloc, xseq + 1u + (unsigned)(j >> 2)); else if ((j & 1) == 0) __syncthreads(); }
                if (PEER_WGSYNC == 7) { if ((j & 1) == 0 && j) xcc_sync(xctr, nloc, xseq + 1u + (unsigned)(j >> 1)); }
                const int jj = par ? 15 - j : j;
                PP_LOAD(ubB, vbB, 1, jj);
                PP_COMPUTE(ubA, vbA, 0, jj, x0q, sx0, out0);
                const int nj0 = (j + 1 < 16) ? j + 1 : 15; const int nj = par ? 15 - nj0 : nj0;
                if (has_next && (j & 1) == 0) { const int head = j >> 1; asm volatile("s_waitcnt vmcnt(16)" ::: "memory");
                    const u32x2 entN = ((const LAS u32x2*)(lds_w + PW_ENTB))[lane]; PW_CAND(entN, head, ELc); }
                if ((j & 1) == 1 && j < 15) PW_DMA((j + 1) >> 1);
                PP_LOAD(ubA, vbA, 0, nj);
                PP_COMPUTE(ubB, vbB, 1, jj, x1q, sx1, out1);
            }
        }
#undef PP_LOAD
#undef PP_COMPUTE
        if (has_next) {
            HIST[lane] = 0u; HIST[64 + lane] = 0u;
        u32x4 ent4[4]; unsigned rk[4];
#pragma unroll
        for (int rep = 0; rep < 4; ++rep) { const int e = lane + 64 * rep; const u32x2 ent = ELc[e]; const float sc = __uint_as_float(ent.y);
            const float su = TSU[ent.x], sv = TSV[ent.x];
            float mx = sc;
#pragma unroll
            for (int o = 1; o < 16; o <<= 1) mx = fmaxf(mx, __shfl_xor(mx, o));
            const float p = __expf(sc - mx); float sm = p;
#pragma unroll
            for (int o = 1; o < 16; o <<= 1) sm += __shfl_xor(sm, o);
            ent4[rep].x = ent.x; ent4[rep].y = __float_as_uint(su); ent4[rep].z = __float_as_uint(p / sm * sv); ent4[rep].w = (unsigned)(rep >> 1);
            rk[rep] = atomicAdd((unsigned*)&HIST[(rep >> 1) * 64 + (ent.x >> 8)], 1u); }
        { const unsigned c0 = HIST[2 * lane], c1 = HIST[2 * lane + 1]; unsigned inc = c0 + c1;
_Pragma("unroll")
      for (int o = 1; o < 64; o <<= 1) { const unsigned t = (unsigned)__shfl_up((int)inc, o); if (lane >= o) inc += t; }
      HIST[128 + 2 * lane] = inc - c0 - c1; HIST[128 + 2 * lane + 1] = inc - c1; }
#pragma unroll
        for (int rep = 0; rep < 4; ++rep) EGc[HIST[128 + (rep >> 1) * 64 + (ent4[rep].x >> 8)] + rk[rep]] = ent4[rep];
        }
#pragma unroll
        for (int tk = 0; tk < 2; ++tk) {
            float xr[16]; float ss = 0.f;
            { const u32x4* hp = (const u32x4*)(HB + (tok0 + tk) * 1024 + lane * 16); const u32x4 qa = hp[0], qb = hp[1];
#pragma unroll
              for (int e = 0; e < 4; ++e) { xr[2 * e] = __uint_as_float(qa[e] << 16); xr[2 * e + 1] = __uint_as_float(qa[e] & 0xffff0000u); xr[8 + 2 * e] = __uint_as_float(qb[e] << 16); xr[8 + 2 * e + 1] = __uint_as_float(qb[e] & 0xffff0000u); } }
#pragma unroll
            for (int c = 0; c < 16; ++c) { const f32x2 o2 = tk ? out1[c >> 1] : out0[c >> 1]; xr[c] += (c & 1) ? o2.y : o2.x; ss += xr[c] * xr[c]; }
            const float rstd = 1.0f / sqrtf(wave_sum(ss) * (1.f / 1024.f) + EPS);
            if (LAST) {
                float* xq = xres + (tok0 + tk) * 1024 + lane * 16;
#pragma unroll
                for (int j = 0; j < 4; ++j) { const f32x4 gg = *(const f32x4*)(gnext + lane * 16 + 4 * j); *(f32x4*)(xq + 4 * j) = (f32x4){xr[4 * j] * rstd * gg[0], xr[4 * j + 1] * rstd * gg[1], xr[4 * j + 2] * rstd * gg[2], xr[4 * j + 3] * rstd * gg[3]}; }
            } else {
                u32x4 o0, o1, r0, r1;
#pragma unroll
                for (int j = 0; j < 4; ++j) { const f32x4 gg = *(const f32x4*)(gnext + lane * 16 + 4 * j);
                    const unsigned lo = cvt_pk_bf16(xr[4 * j] * rstd * gg[0], xr[4 * j + 1] * rstd * gg[1]), hi = cvt_pk_bf16(xr[4 * j + 2] * rstd * gg[2], xr[4 * j + 3] * rstd * gg[3]);
                    const unsigned rl = cvt_pk_bf16(xr[4 * j], xr[4 * j + 1]), rh = cvt_pk_bf16(xr[4 * j + 2], xr[4 * j + 3]);
                    if (j < 2) { o0[2 * j] = lo; o0[2 * j + 1] = hi; r0[2 * j] = rl; r0[2 * j + 1] = rh; } else { o1[2 * (j - 2)] = lo; o1[2 * (j - 2) + 1] = hi; r1[2 * (j - 2)] = rl; r1[2 * (j - 2) + 1] = rh; } }
                u32x4* hq = (u32x4*)(HB + (tok0 + tk) * 1024 + lane * 16); hq[0] = o0; hq[1] = o1;
                u32x4* xq2 = (u32x4*)((bf16*)xres + (tok0 + tk) * 1024 + lane * 16); xq2[0] = r0; xq2[1] = r1;
            }
        }
    }
#undef PW_CAND
#undef PW_ENT
#undef PW_DMA
}

template <bool LAST>
__device__ __forceinline__ void peer_pair(LAS unsigned char* lds_w, size_t tok0, const u32x2* TOPK, const unsigned char* TABU, const unsigned char* TABV, const float* TSU, const float* TSV, bf16* HB, const float* SS, const float* gffn, float* xres, const float* gnext, int lane_in) {
    int lane = lane_in; asm volatile("" : "+v"(lane));
    LAS u32x2* EL = (LAS u32x2*)lds_w;
    LAS u32x4* EG = (LAS u32x4*)(lds_w + 2048);
    LAS unsigned* HIST = (LAS unsigned*)(lds_w + 2048 + 4096);
    if (lane < 32) HIST[lane] = 0u;
    int ri, rj;
    { const int L = lane;
      if (L < 16) { ri = 0; rj = L; } else if (L < 24) { ri = 1; rj = L - 16; } else if (L < 29) { ri = 2; rj = L - 24; } else if (L < 33) { ri = 3; rj = L - 29; }
      else if (L < 36) { ri = 4; rj = L - 33; } else if (L < 38) { ri = 5; rj = L - 36; } else if (L < 40) { ri = 6; rj = L - 38; } else if (L < 42) { ri = 7; rj = L - 40; }
      else if (L < 50) { ri = L - 34; rj = 0; } else { ri = 0; rj = 0; } }
    LAS u32x2* SLs = (LAS u32x2*)(lds_w + 6400);
    for (int _rp = 0; _rp <= (PEER_PROBE & 1); ++_rp)
#pragma unroll 1
    for (int head = 0; head < 8; ++head) {
        const u32x2 ent = TOPK[((tok0 + (lane >> 5)) * 16 + head * 2) * 16 + (lane & 31)];
        const unsigned long long key = ((unsigned long long)sortable_u32(__uint_as_float(ent.x)) << 32) | (unsigned)(15 - (lane & 15));
        unsigned rank = 0u; rank_step<1>(key, rank);
        SLs[(lane >> 4) * 16 + rank] = ent;
#pragma unroll 1
        for (int tk = 0; tk < 2; ++tk) {
            const u32x2 ea = SLs[(tk * 2) * 16 + ri], eb = SLs[(tk * 2 + 1) * 16 + rj];
            const float cs = __uint_as_float(ea.x) + __uint_as_float(eb.x); const unsigned ck = ea.y * 128u + eb.y;
            const unsigned u = (lane < 50) ? sortable_u32(cs) : 0u;
            unsigned T = 0u;
#pragma unroll 1
            for (int bit = 31; bit >= 0; --bit) {
                const unsigned cand = T | (1u << bit); const unsigned cnt = (unsigned)__popcll(__ballot(u >= cand));
                if (cnt >= 16u) T = cand;
                if (cnt == 16u) break;
            }
            const unsigned G = (unsigned)__popcll(__ballot(u > T)); const unsigned need_eq = 16u - G;
            const bool gt = u > T, eq = u == T;
            const unsigned long long meq = __ballot(eq);
            const bool sl = gt || (eq && (mbcnt64(meq) < need_eq));
            const unsigned long long msl = __ballot(sl);
            if (sl) { u32x2 e; e.x = ck; e.y = __float_as_uint(cs); EL[(tk * 8 + head) * 16 + mbcnt64(msl)] = e; }
        }
    }
    u32x4 ent4[4]; unsigned rk[4];
#pragma unroll
    for (int rep = 0; rep < 4; ++rep) { const int e = lane + 64 * rep; const u32x2 ent = EL[e]; const float sc = __uint_as_float(ent.y);
        const float su = TSU[ent.x], sv = TSV[ent.x];
        float mx = sc;
#pragma unroll
        for (int o = 1; o < 16; o <<= 1) mx = fmaxf(mx, __shfl_xor(mx, o));
        const float p = __expf(sc - mx); float sm = p;
#pragma unroll
        for (int o = 1; o < 16; o <<= 1) sm += __shfl_xor(sm, o);
        ent4[rep].x = ent.x; ent4[rep].y = __float_as_uint(su); ent4[rep].z = __float_as_uint(p / sm * sv); ent4[rep].w = (unsigned)(rep >> 1);
        rk[rep] = atomicAdd((unsigned*)&HIST[ent.x >> 9], 1u); }
    { unsigned c = (lane < 32) ? HIST[lane] : 0u, inc = c;
#pragma unroll
      for (int o = 1; o < 32; o <<= 1) { const unsigned t = (unsigned)__shfl_up((int)inc, o); if ((lane & 31) >= o) inc += t; }
      if (lane < 32) HIST[32 + lane] = inc - c; }
#pragma unroll
    for (int rep = 0; rep < 4; ++rep) EG[HIST[32 + (ent4[rep].x >> 9)] + rk[rep]] = ent4[rep];
    int x0q[4], x1q[4]; float sx0, sx1;
    float gf[16];
#pragma unroll
    for (int j = 0; j < 4; ++j) { const f32x4 gg = *(const f32x4*)(gffn + lane * 16 + 4 * j); gf[4 * j] = gg[0]; gf[4 * j + 1] = gg[1]; gf[4 * j + 2] = gg[2]; gf[4 * j + 3] = gg[3]; }
#define PP_QUANT(xq, sx, tk) do { const u32x4* hp = (const u32x4*)(HB + (tok0 + (tk)) * 1024 + lane * 16); const u32x4 qa = hp[0], qb = hp[1]; float f[16]; float am = 0.f; \
        const float rs_ = 1.0f / sqrtf(SS[tok0 + (tk)] * (1.f / 1024.f) + EPS); \
        _Pragma("unroll") for (int e = 0; e < 4; ++e) { f[2 * e] = __uint_as_float(qa[e] << 16); f[2 * e + 1] = __uint_as_float(qa[e] & 0xffff0000u); f[8 + 2 * e] = __uint_as_float(qb[e] << 16); f[8 + 2 * e + 1] = __uint_as_float(qb[e] & 0xffff0000u); } \
        _Pragma("unroll") for (int c = 0; c < 16; ++c) f[c] *= rs_ * gf[c]; \
        _Pragma("unroll") for (int c = 0; c < 16; ++c) am = fmaxf(am, fabsf(f[c])); \
        am = wave_max(am); sx = am > 0.f ? am * (1.0f / 127.0f) : 1.0f; const float inv = 1.0f / sx; \
        _Pragma("unroll") for (int e = 0; e < 4; ++e) { const int q0 = (int)rintf(f[4 * e] * inv), q1 = (int)rintf(f[4 * e + 1] * inv), q2 = (int)rintf(f[4 * e + 2] * inv), q3 = (int)rintf(f[4 * e + 3] * inv); \
            xq[e] = (q0 & 0xff) | ((q1 & 0xff) << 8) | ((q2 & 0xff) << 16) | ((q3 & 0xff) << 24); } } while (0)
    PP_QUANT(x0q, sx0, 0); PP_QUANT(x1q, sx1, 1);
#undef PP_QUANT
    f32x2 outp[16];
#pragma unroll
    for (int c = 0; c < 16; ++c) outp[c] = (f32x2){0.f, 0.f};
#define PP_LOAD(UB, VB, BT) do { _Pragma("unroll") for (int k = 0; k < 8; ++k) { const unsigned id = EG[(BT) * 8 + k].x; UB[k] = *(const u32x4*)(TABU + (size_t)id * 1024 + lane * 16); VB[k] = *(const u32x4*)(TABV + (size_t)id * 1024 + lane * 16); } } while (0)
#define PP_COMPUTE(UB, VB, BT) do { int di[8]; \
        _Pragma("unroll") for (int k = 0; k < 8; ++k) { int a0 = 0, a1 = 0; \
            _Pragma("unroll") for (int e = 0; e < 4; ++e) { a0 = __builtin_amdgcn_sdot4((int)UB[k][e], x0q[e], a0, false); a1 = __builtin_amdgcn_sdot4((int)UB[k][e], x1q[e], a1, false); } \
            const unsigned tkk = (unsigned)__builtin_amdgcn_readfirstlane((int)EG[(BT) * 8 + k].w); di[k] = tkk ? a1 : a0; } \
        int r4[4], r2[2], v1; \
        { const bool h32 = (lane & 32) != 0; \
          _Pragma("unroll") for (int j = 0; j < 4; ++j) { const int send = h32 ? di[j] : di[j + 4], keep = h32 ? di[j + 4] : di[j]; r4[j] = keep + __shfl_xor(send, 32); } \
          const bool h16 = (lane & 16) != 0; \
          _Pragma("unroll") for (int j = 0; j < 2; ++j) { const int send = h16 ? r4[j] : r4[j + 2], keep = h16 ? r4[j + 2] : r4[j]; r2[j] = keep + __shfl_xor(send, 16); } \
          const bool h8 = (lane & 8) != 0; \
          { const int send = h8 ? r2[0] : r2[1], keep = h8 ? r2[1] : r2[0]; v1 = keep + __shfl_xor(send, 8); } \
          v1 += __shfl_xor(v1, 4); v1 += __shfl_xor(v1, 2); v1 += __shfl_xor(v1, 1); } \
        float act; { const u32x4 eg = EG[(BT) * 8 + (lane >> 3)]; const float v = (float)v1 * __uint_as_float(eg.y) * (eg.w ? sx1 : sx0); \
          const float t = __builtin_amdgcn_rcpf(fabsf(v) * 0.2316418882f + 1.0f); \
          float q = t * 0.5307027145f + (-0.7265760135f); q = q * t + 0.7107068705f; q = q * t + (-0.142248368f); q = q * t + 0.127414796f; q = q * t; \
          const float m = v * (q * __builtin_amdgcn_exp2f(v * v * (-0.72134752044f))); \
          act = (v < 0.f ? m : v - m) * __uint_as_float(eg.z); }                        \
        _Pragma("unroll") for (int k = 0; k < 8; ++k) { const float a = __uint_as_float(__builtin_amdgcn_readlane((int)__float_as_uint(act), 8 * k)); \
            const unsigned tkk = (unsigned)__builtin_amdgcn_readfirstlane((int)EG[(BT) * 8 + k].w); \
            const f32x2 a2 = tkk ? (f32x2){0.f, a} : (f32x2){a, 0.f}; \
            _Pragma("unroll") for (int e = 0; e < 4; ++e) { const f32x2 lo = __builtin_amdgcn_cvt_pk_f32_fp8((int)VB[k][e], false), hi = __builtin_amdgcn_cvt_pk_f32_fp8((int)VB[k][e], true); \
                outp[4 * e] += a2 * lo.x; outp[4 * e + 1] += a2 * lo.y; outp[4 * e + 2] += a2 * hi.x; outp[4 * e + 3] += a2 * hi.y; } } } while (0)
    for (int _rg = ((PEER_PROBE & 6) ? 0 : 1); _rg < 2; ++_rg) {
        const bool noload = (PEER_PROBE & 4) && _rg == 0;
#pragma unroll
        for (int c = 0; c < 16; ++c) outp[c] = (f32x2){0.f, 0.f};
        u32x4 ubA[8], vbA[8], ubB[8], vbB[8];
#pragma unroll
        for (int k = 0; k < 8; ++k) { ubA[k] = (u32x4){0u, 0u, 0u, 0u}; vbA[k] = ubA[k]; ubB[k] = ubA[k]; vbB[k] = ubA[k]; }
        if (!noload) PP_LOAD(ubA, vbA, 0);
#pragma unroll 1
        for (int bt = 0; bt < 32; bt += 2) {
            if (!noload) PP_LOAD(ubB, vbB, bt + 1);
            PP_COMPUTE(ubA, vbA, bt);
            const int nb = (bt + 2 < 32) ? bt + 2 : 31;
            if (!noload) PP_LOAD(ubA, vbA, nb);
            PP_COMPUTE(ubB, vbB, bt + 1);
        }
    }
#undef PP_LOAD
#undef PP_COMPUTE
#pragma unroll
    for (int tk = 0; tk < 2; ++tk) {
        f32x4 xr[4]; float ss = 0.f;
        float* xq = xres + (tok0 + tk) * 1024 + lane * 16;
#pragma unroll
        for (int j = 0; j < 4; ++j) { xr[j] = *(const f32x4*)(xq + 4 * j);
#pragma unroll
            for (int e = 0; e < 4; ++e) { xr[j][e] += tk ? outp[4 * j + e].y : outp[4 * j + e].x; ss += xr[j][e] * xr[j][e]; } }
        const float rstd = 1.0f / sqrtf(wave_sum(ss) * (1.f / 1024.f) + EPS);
        if (LAST) {
#pragma unroll
            for (int j = 0; j < 4; ++j) { const f32x4 gg = *(const f32x4*)(gnext + lane * 16 + 4 * j); *(f32x4*)(xq + 4 * j) = xr[j] * rstd * gg; }
        } else {
            u32x4 o0, o1;
#pragma unroll
            for (int j = 0; j < 4; ++j) { *(f32x4*)(xq + 4 * j) = xr[j]; const f32x4 gg = *(const f32x4*)(gnext + lane * 16 + 4 * j);
                const unsigned lo = cvt_pk_bf16(xr[j][0] * rstd * gg[0], xr[j][1] * rstd * gg[1]), hi = cvt_pk_bf16(xr[j][2] * rstd * gg[2], xr[j][3] * rstd * gg[3]);
                if (j < 2) { o0[2 * j] = lo; o0[2 * j + 1] = hi; } else { o1[2 * (j - 2)] = lo; o1[2 * (j - 2) + 1] = hi; } }
            u32x4* hq = (u32x4*)(HB + (tok0 + tk) * 1024 + lane * 16); hq[0] = o0; hq[1] = o1;
        }
    }
}

__device__ __forceinline__ void pair_prepare(LAS unsigned char* lds_w, size_t tok0, const u32x2* TOPK, const float* TSU, const float* TSV, int lane_in) {
    int lane = lane_in; asm volatile("" : "+v"(lane));
    LAS u32x2* EL = (LAS u32x2*)lds_w;
    LAS u32x4* EG = (LAS u32x4*)(lds_w + 2048);
    LAS unsigned* HIST = (LAS unsigned*)(lds_w + 2048 + 4096);
    if (lane < 32) HIST[lane] = 0u;
    for (int _rp = 0; _rp <= (PEER_PROBE & 1); ++_rp)
#pragma unroll 1
    for (int th = 0; th < 16; ++th) { const int tk = th >> 3, head = th & 7;
        const u32x2* base = TOPK + ((tok0 + tk) * 16 + head * 2) * 16;
        const u32x2 e0 = base[lane >> 2];
        const u32x4 e1a = *(const u32x4*)(base + 16 + 4 * (lane & 3)), e1b = *(const u32x4*)(base + 16 + 4 * (lane & 3) + 2);
        const float s0 = __uint_as_float(e0.x);
        float cs[4]; unsigned ck[4], u[4];
        cs[0] = s0 + __uint_as_float(e1a.x); ck[0] = e0.y * 128u + e1a.y; cs[1] = s0 + __uint_as_float(e1a.z); ck[1] = e0.y * 128u + e1a.w;
        cs[2] = s0 + __uint_as_float(e1b.x); ck[2] = e0.y * 128u + e1b.y; cs[3] = s0 + __uint_as_float(e1b.z); ck[3] = e0.y * 128u + e1b.w;
#pragma unroll
        for (int m = 0; m < 4; ++m) u[m] = sortable_u32(cs[m]);
        unsigned T = 0u;
#pragma unroll 1
        for (int bit = 31; bit >= 0; --bit) {
            const unsigned cand = T | (1u << bit); unsigned cnt = 0u;
#pragma unroll
            for (int m = 0; m < 4; ++m) cnt += (unsigned)__popcll(__ballot(u[m] >= cand));
            if (cnt >= 16u) T = cand;
            if (cnt == 16u) break;
        }
        unsigned G = 0u;
#pragma unroll
        for (int m = 0; m < 4; ++m) G += (unsigned)__popcll(__ballot(u[m] > T));
        const unsigned need_eq = 16u - G; unsigned pos = 0u, eq_used = 0u;
#pragma unroll
        for (int m = 0; m < 4; ++m) {
            const bool gt = u[m] > T, eq = u[m] == T;
            const unsigned long long meq = __ballot(eq);
            const bool sl = gt || (eq && (eq_used + mbcnt64(meq) < need_eq));
            const unsigned long long msl = __ballot(sl);
            if (sl) { u32x2 e; e.x = ck[m]; e.y = __float_as_uint(cs[m]); EL[th * 16 + pos + mbcnt64(msl)] = e; }
            pos += (unsigned)__popcll(msl); eq_used += (unsigned)__popcll(meq); }
    }
    u32x4 ent4[4]; unsigned rk[4];
#pragma unroll
    for (int rep = 0; rep < 4; ++rep) { const int e = lane + 64 * rep; const u32x2 ent = EL[e]; const float sc = __uint_as_float(ent.y);
        const float su = TSU[ent.x], sv = TSV[ent.x];
        float mx = sc;
#pragma unroll
        for (int o = 1; o < 16; o <<= 1) mx = fmaxf(mx, __shfl_xor(mx, o));
        const float p = __expf(sc - mx); float sm = p;
#pragma unroll
        for (int o = 1; o < 16; o <<= 1) sm += __shfl_xor(sm, o);
        ent4[rep].x = ent.x; ent4[rep].y = __float_as_uint(su); ent4[rep].z = __float_as_uint(p / sm * sv); ent4[rep].w = (unsigned)(rep >> 1);
        rk[rep] = atomicAdd((unsigned*)&HIST[ent.x >> 9], 1u); }
    { unsigned c = (lane < 32) ? HIST[lane] : 0u, inc = c;
#pragma unroll
      for (int o = 1; o < 32; o <<= 1) { const unsigned t = (unsigned)__shfl_up((int)inc, o); if ((lane & 31) >= o) inc += t; }
      if (lane < 32) HIST[32 + lane] = inc - c; }
#pragma unroll
    for (int rep = 0; rep < 4; ++rep) EG[HIST[32 + (ent4[rep].x >> 9)] + rk[rep]] = ent4[rep];
}
__device__ __forceinline__ void pair_pass1(LAS unsigned char* lds_w, size_t tok0, const unsigned char* TABU, const bf16* HB, int lane_in) {
    int lane = lane_in; asm volatile("" : "+v"(lane));
    LAS u32x4* EG = (LAS u32x4*)(lds_w + 2048);
    f32x2 xp[16];
    { const u32x4* h0 = (const u32x4*)(HB + tok0 * 1024 + lane * 16); const u32x4* h1 = (const u32x4*)(HB + (tok0 + 1) * 1024 + lane * 16);
      const u32x4 a0 = h0[0], b0 = h0[1], a1 = h1[0], b1 = h1[1];
#pragma unroll
      for (int e = 0; e < 4; ++e) { xp[2 * e] = (f32x2){__uint_as_float(a0[e] << 16), __uint_as_float(a1[e] << 16)}; xp[2 * e + 1] = (f32x2){__uint_as_float(a0[e] & 0xffff0000u), __uint_as_float(a1[e] & 0xffff0000u)};
          xp[8 + 2 * e] = (f32x2){__uint_as_float(b0[e] << 16), __uint_as_float(b1[e] << 16)}; xp[8 + 2 * e + 1] = (f32x2){__uint_as_float(b0[e] & 0xffff0000u), __uint_as_float(b1[e] & 0xffff0000u)}; } }
    u32x4 ub[8];
#pragma unroll
    for (int k = 0; k < 8; ++k) ub[k] = *(const u32x4*)(TABU + (size_t)EG[k].x * 1024 + lane * 16);
#pragma unroll 1
    for (int bt = 0; bt < 32; ++bt) {
        u32x4 un[8];
        const int nb = (bt + 1 < 32) ? bt + 1 : bt;
#pragma unroll
        for (int k = 0; k < 8; ++k) un[k] = *(const u32x4*)(TABU + (size_t)EG[nb * 8 + k].x * 1024 + lane * 16);
        float d[8];
#pragma unroll
        for (int k = 0; k < 8; ++k) { f32x2 a = {0.f, 0.f};
#pragma unroll
            for (int e = 0; e < 4; ++e) { const f32x2 lo = __builtin_amdgcn_cvt_pk_f32_fp8((int)ub[k][e], false), hi = __builtin_amdgcn_cvt_pk_f32_fp8((int)ub[k][e], true);
                a += xp[4 * e] * lo.x; a += xp[4 * e + 1] * lo.y; a += xp[4 * e + 2] * hi.x; a += xp[4 * e + 3] * hi.y; }
            const unsigned tkk = (unsigned)__builtin_amdgcn_readfirstlane((int)EG[bt * 8 + k].w);
            d[k] = tkk ? a.y : a.x; }
        float r4[4], r2[2], v1;
        { const bool h32 = (lane & 32) != 0;
#pragma unroll
          for (int j = 0; j < 4; ++j) { const float send = h32 ? d[j] : d[j + 4], keep = h32 ? d[j + 4] : d[j]; r4[j] = keep + __shfl_xor(send, 32); }
          const bool h16 = (lane & 16) != 0;
#pragma unroll
          for (int j = 0; j < 2; ++j) { const float send = h16 ? r4[j] : r4[j + 2], keep = h16 ? r4[j + 2] : r4[j]; r2[j] = keep + __shfl_xor(send, 16); }
          const bool h8 = (lane & 8) != 0;
          { const float send = h8 ? r2[0] : r2[1], keep = h8 ? r2[1] : r2[0]; v1 = keep + __shfl_xor(send, 8); }
          v1 += __shfl_xor(v1, 4); v1 += __shfl_xor(v1, 2); v1 += __shfl_xor(v1, 1); }
        { const u32x4 eg = EG[bt * 8 + (lane >> 3)]; const float x = v1 * __uint_as_float(eg.y);
          const float act = 0.5f * x * (1.0f + erff(x * 0.70710678118654752f)) * __uint_as_float(eg.z);
          if ((lane & 7) == 0) *((LAS float*)&EG[bt * 8 + (lane >> 3)] + 1) = act; }
#pragma unroll
        for (int k = 0; k < 8; ++k) ub[k] = un[k];
    }
}
template <bool LAST>
__device__ __forceinline__ void pair_pass2(LAS unsigned char* lds_w, size_t tok0, const unsigned char* TABV, bf16* HB, float* xres, const float* gnext, int lane_in) {
    int lane = lane_in; asm volatile("" : "+v"(lane));
    LAS u32x4* EG = (LAS u32x4*)(lds_w + 2048);
    f32x2 outp[16];
#pragma unroll
    for (int c = 0; c < 16; ++c) outp[c] = (f32x2){0.f, 0.f};
    u32x4 vb[8];
#pragma unroll
    for (int k = 0; k < 8; ++k) vb[k] = *(const u32x4*)(TABV + (size_t)EG[k].x * 1024 + lane * 16);
#pragma unroll 1
    for (int bt = 0; bt < 32; ++bt) {
        u32x4 vn[8];
        const int nb = (bt + 1 < 32) ? bt + 1 : bt;
#pragma unroll
        for (int k = 0; k < 8; ++k) vn[k] = *(const u32x4*)(TABV + (size_t)EG[nb * 8 + k].x * 1024 + lane * 16);
#pragma unroll
        for (int k = 0; k < 8; ++k) { const u32x4 eg = EG[bt * 8 + k];
            const unsigned tkk = (unsigned)__builtin_amdgcn_readfirstlane((int)eg.w); const float a = __uint_as_float((unsigned)__builtin_amdgcn_readfirstlane((int)eg.y));
            const f32x2 a2 = tkk ? (f32x2){0.f, a} : (f32x2){a, 0.f};
#pragma unroll
            for (int e = 0; e < 4; ++e) { const f32x2 lo = __builtin_amdgcn_cvt_pk_f32_fp8((int)vb[k][e], false), hi = __builtin_amdgcn_cvt_pk_f32_fp8((int)vb[k][e], true);
                outp[4 * e] += a2 * lo.x; outp[4 * e + 1] += a2 * lo.y; outp[4 * e + 2] += a2 * hi.x; outp[4 * e + 3] += a2 * hi.y; } }
#pragma unroll
        for (int k = 0; k < 8; ++k) vb[k] = vn[k];
    }
#pragma unroll
    for (int tk = 0; tk < 2; ++tk) {
        f32x4 xr[4]; float ss = 0.f;
        float* xq = xres + (tok0 + tk) * 1024 + lane * 16;
#pragma unroll
        for (int j = 0; j < 4; ++j) { xr[j] = *(const f32x4*)(xq + 4 * j);
#pragma unroll
            for (int e = 0; e < 4; ++e) { xr[j][e] += tk ? outp[4 * j + e].y : outp[4 * j + e].x; ss += xr[j][e] * xr[j][e]; } }
        const float rstd = 1.0f / sqrtf(wave_sum(ss) * (1.f / 1024.f) + EPS);
        if (LAST) {
#pragma unroll
            for (int j = 0; j < 4; ++j) { const f32x4 gg = *(const f32x4*)(gnext + lane * 16 + 4 * j); *(f32x4*)(xq + 4 * j) = xr[j] * rstd * gg; }
        } else {
            u32x4 o0, o1;
#pragma unroll
            for (int j = 0; j < 4; ++j) { *(f32x4*)(xq + 4 * j) = xr[j]; const f32x4 gg = *(const f32x4*)(gnext + lane * 16 + 4 * j);
                const unsigned lo = cvt_pk_bf16(xr[j][0] * rstd * gg[0], xr[j][1] * rstd * gg[1]), hi = cvt_pk_bf16(xr[j][2] * rstd * gg[2], xr[j][3] * rstd * gg[3]);
                if (j < 2) { o0[2 * j] = lo; o0[2 * j + 1] = hi; } else { o1[2 * (j - 2)] = lo; o1[2 * (j - 2) + 1] = hi; } }
            u32x4* hq = (u32x4*)(HB + (tok0 + tk) * 1024 + lane * 16); hq[0] = o0; hq[1] = o1;
        }
    }
}

constexpr int PQ_EL = 0, PQ_EG = 4096, PQ_HIST = 12288, PQ_BYTES = 12800;
__device__ __forceinline__ void quad_prepare(LAS unsigned char* lds_w, size_t tok0, const u32x2* TOPK, const float* TSU, const float* TSV, int lane_in) {
    int lane = lane_in; asm volatile("" : "+v"(lane));
    LAS u32x2* EL = (LAS u32x2*)(lds_w + PQ_EL); LAS u32x4* EG = (LAS u32x4*)(lds_w + PQ_EG); LAS unsigned* HIST = (LAS unsigned*)(lds_w + PQ_HIST);
    if (lane < 32) HIST[lane] = 0u;
    for (int _rp = 0; _rp <= (PEER_PROBE & 1); ++_rp)
#pragma unroll 1
    for (int th = 0; th < 32; ++th) { const int tk = th >> 3, head = th & 7;
        const u32x2* base = TOPK + ((tok0 + tk) * 16 + head * 2) * 16;
        const u32x2 e0 = base[lane >> 2];
        const u32x4 e1a = *(const u32x4*)(base + 16 + 4 * (lane & 3)), e1b = *(const u32x4*)(base + 16 + 4 * (lane & 3) + 2);
        const float s0 = __uint_as_float(e0.x);
        float cs[4]; unsigned ck[4], u[4];
        cs[0] = s0 + __uint_as_float(e1a.x); ck[0] = e0.y * 128u + e1a.y; cs[1] = s0 + __uint_as_float(e1a.z); ck[1] = e0.y * 128u + e1a.w;
        cs[2] = s0 + __uint_as_float(e1b.x); ck[2] = e0.y * 128u + e1b.y; cs[3] = s0 + __uint_as_float(e1b.z); ck[3] = e0.y * 128u + e1b.w;
#pragma unroll
        for (int m = 0; m < 4; ++m) u[m] = sortable_u32(cs[m]);
        unsigned T = 0u;
#pragma unroll 1
        for (int bit = 31; bit >= 0; --bit) {
            const unsigned cand = T | (1u << bit); unsigned cnt = 0u;
#pragma unroll
            for (int m = 0; m < 4; ++m) cnt += (unsigned)__popcll(__ballot(u[m] >= cand));
            if (cnt >= 16u) T = cand;
            if (cnt == 16u) break;
        }
        unsigned G = 0u;
#pragma unroll
        for (int m = 0; m < 4; ++m) G += (unsigned)__popcll(__ballot(u[m] > T));
        const unsigned need_eq = 16u - G; unsigned pos = 0u, eq_used = 0u;
#pragma unroll
        for (int m = 0; m < 4; ++m) {
            const bool gt = u[m] > T, eq = u[m] == T;
            const unsigned long long meq = __ballot(eq);
            const bool sl = gt || (eq && (eq_used + mbcnt64(meq) < need_eq));
            const unsigned long long msl = __ballot(sl);
            if (sl) { u32x2 e; e.x = ck[m]; e.y = __float_as_uint(cs[m]); EL[th * 16 + pos + mbcnt64(msl)] = e; }
            pos += (unsigned)__popcll(msl); eq_used += (unsigned)__popcll(meq); }
    }
    u32x4 ent8[8]; unsigned rk[8];
#pragma unroll
    for (int rep = 0; rep < 8; ++rep) { const int e = lane + 64 * rep; const u32x2 ent = EL[e]; const float sc = __uint_as_float(ent.y);
        const float su = TSU[ent.x], sv = TSV[ent.x];
        float mx = sc;
#pragma unroll
        for (int o = 1; o < 16; o <<= 1) mx = fmaxf(mx, __shfl_xor(mx, o));
        const float p = __expf(sc - mx); float sm = p;
#pragma unroll
        for (int o = 1; o < 16; o <<= 1) sm += __shfl_xor(sm, o);
        ent8[rep].x = ent.x; ent8[rep].y = __float_as_uint(su); ent8[rep].z = __float_as_uint(p / sm * sv); ent8[rep].w = (unsigned)(rep >> 1);
        rk[rep] = atomicAdd((unsigned*)&HIST[ent.x >> 9], 1u); }
    { unsigned c = (lane < 32) ? HIST[lane] : 0u, inc = c;
#pragma unroll
      for (int o = 1; o < 32; o <<= 1) { const unsigned t = (unsigned)__shfl_up((int)inc, o); if ((lane & 31) >= o) inc += t; }
      if (lane < 32) HIST[32 + lane] = inc - c; }
#pragma unroll
    for (int rep = 0; rep < 8; ++rep) EG[HIST[32 + (ent8[rep].x >> 9)] + rk[rep]] = ent8[rep];
}
__device__ __forceinline__ void quad_pass1(LAS unsigned char* lds_w, size_t tok0, const unsigned char* TABU, const bf16* HB, int lane_in) {
    int lane = lane_in; asm volatile("" : "+v"(lane));
    LAS u32x4* EG = (LAS u32x4*)(lds_w + PQ_EG);
    float x0[16], x1[16], x2[16], x3[16];
#define PQ_LOADX(xx, tk) do { const u32x4* hp = (const u32x4*)(HB + (tok0 + (tk)) * 1024 + lane * 16); const u32x4 a = hp[0], b = hp[1]; \
        _Pragma("unroll") for (int e = 0; e < 4; ++e) { xx[2 * e] = __uint_as_float(a[e] << 16); xx[2 * e + 1] = __uint_as_float(a[e] & 0xffff0000u); xx[8 + 2 * e] = __uint_as_float(b[e] << 16); xx[8 + 2 * e + 1] = __uint_as_float(b[e] & 0xffff0000u); } } while (0)
    PQ_LOADX(x0, 0); PQ_LOADX(x1, 1); PQ_LOADX(x2, 2); PQ_LOADX(x3, 3);
#undef PQ_LOADX
    u32x4 ub[8];
#pragma unroll
    for (int k = 0; k < 8; ++k) ub[k] = *(const u32x4*)(TABU + (size_t)EG[k].x * 1024 + lane * 16);
#pragma unroll 1
    for (int bt = 0; bt < 64; ++bt) {
        u32x4 un[8];
        const int nb = (bt + 1 < 64) ? bt + 1 : bt;
#pragma unroll
        for (int k = 0; k < 8; ++k) un[k] = *(const u32x4*)(TABU + (size_t)EG[nb * 8 + k].x * 1024 + lane * 16);
        float d[8];
#pragma unroll
        for (int k = 0; k < 8; ++k) {
            float f[16];
#pragma unroll
            for (int e = 0; e < 4; ++e) { const f32x2 lo = __builtin_amdgcn_cvt_pk_f32_fp8((int)ub[k][e], false), hi = __builtin_amdgcn_cvt_pk_f32_fp8((int)ub[k][e], true); f[4 * e] = lo.x; f[4 * e + 1] = lo.y; f[4 * e + 2] = hi.x; f[4 * e + 3] = hi.y; }
            const unsigned tkk = (unsigned)__builtin_amdgcn_readfirstlane((int)EG[bt * 8 + k].w);
            float a = 0.f;
            if (tkk == 0u) {
#pragma unroll
                for (int c = 0; c < 16; ++c) a += f[c] * x0[c]; }
            else if (tkk == 1u) {
#pragma unroll
                for (int c = 0; c < 16; ++c) a += f[c] * x1[c]; }
            else if (tkk == 2u) {
#pragma unroll
                for (int c = 0; c < 16; ++c) a += f[c] * x2[c]; }
            else {
#pragma unroll
                for (int c = 0; c < 16; ++c) a += f[c] * x3[c]; }
            d[k] = a; }
        float r4[4], r2[2], v1;
        { const bool h32 = (lane & 32) != 0;
#pragma unroll
          for (int j = 0; j < 4; ++j) { const float send = h32 ? d[j] : d[j + 4], keep = h32 ? d[j + 4] : d[j]; r4[j] = keep + __shfl_xor(send, 32); }
          const bool h16 = (lane & 16) != 0;
#pragma unroll
          for (int j = 0; j < 2; ++j) { const float send = h16 ? r4[j] : r4[j + 2], keep = h16 ? r4[j + 2] : r4[j]; r2[j] = keep + __shfl_xor(send, 16); }
          const bool h8 = (lane & 8) != 0;
          { const float send = h8 ? r2[0] : r2[1], keep = h8 ? r2[1] : r2[0]; v1 = keep + __shfl_xor(send, 8); }
          v1 += __shfl_xor(v1, 4); v1 += __shfl_xor(v1, 2); v1 += __shfl_xor(v1, 1); }
        { const u32x4 eg = EG[bt * 8 + (lane >> 3)]; const float x = v1 * __uint_as_float(eg.y);
          const float act = 0.5f * x * (1.0f + erff(x * 0.70710678118654752f)) * __uint_as_float(eg.z);
          if ((lane & 7) == 0) *((LAS float*)&EG[bt * 8 + (lane >> 3)] + 1) = act; }
#pragma unroll
        for (int k = 0; k < 8; ++k) ub[k] = un[k];
    }
}
template <bool LAST>
__device__ __forceinline__ void quad_pass2(LAS unsigned char* lds_w, size_t tok0, const unsigned char* TABV, bf16* HB, float* xres, const float* gnext, int lane_in) {
    int lane = lane_in; asm volatile("" : "+v"(lane));
    LAS u32x4* EG = (LAS u32x4*)(lds_w + PQ_EG);
    float o0[16], o1[16], o2[16], o3[16];
#pragma unroll
    for (int c = 0; c < 16; ++c) { o0[c] = 0.f; o1[c] = 0.f; o2[c] = 0.f; o3[c] = 0.f; }
    u32x4 vb[8];
#pragma unroll
    for (int k = 0; k < 8; ++k) vb[k] = *(const u32x4*)(TABV + (size_t)EG[k].x * 1024 + lane * 16);
#pragma unroll 1
    for (int bt = 0; bt < 64; ++bt) {
        u32x4 vn[8];
        const int nb = (bt + 1 < 64) ? bt + 1 : bt;
#pragma unroll
        for (int k = 0; k < 8; ++k) vn[k] = *(const u32x4*)(TABV + (size_t)EG[nb * 8 + k].x * 1024 + lane * 16);
#pragma unroll
        for (int k = 0; k < 8; ++k) {
            float f[16];
#pragma unroll
            for (int e = 0; e < 4; ++e) { const f32x2 lo = __builtin_amdgcn_cvt_pk_f32_fp8((int)vb[k][e], false), hi = __builtin_amdgcn_cvt_pk_f32_fp8((int)vb[k][e], true); f[4 * e] = lo.x; f[4 * e + 1] = lo.y; f[4 * e + 2] = hi.x; f[4 * e + 3] = hi.y; }
            const u32x4 eg = EG[bt * 8 + k];
            const unsigned tkk = (unsigned)__builtin_amdgcn_readfirstlane((int)eg.w); const float a = __uint_as_float((unsigned)__builtin_amdgcn_readfirstlane((int)eg.y));
            if (tkk == 0u) {
#pragma unroll
                for (int c = 0; c < 16; ++c) o0[c] += a * f[c]; }
            else if (tkk == 1u) {
#pragma unroll
                for (int c = 0; c < 16; ++c) o1[c] += a * f[c]; }
            else if (tkk == 2u) {
#pragma unroll
                for (int c = 0; c < 16; ++c) o2[c] += a * f[c]; }
            else {
#pragma unroll
                for (int c = 0; c < 16; ++c) o3[c] += a * f[c]; } }
#pragma unroll
        for (int k = 0; k < 8; ++k) vb[k] = vn[k];
    }
#define PQ_FINAL(oo, tk) do { f32x4 xr[4]; float ss = 0.f; float* xq = xres + (tok0 + (tk)) * 1024 + lane * 16; \
        _Pragma("unroll") for (int j = 0; j < 4; ++j) { xr[j] = *(const f32x4*)(xq + 4 * j); _Pragma("unroll") for (int e = 0; e < 4; ++e) { xr[j][e] += oo[4 * j + e]; ss += xr[j][e] * xr[j][e]; } } \
        const float rstd = 1.0f / sqrtf(wave_sum(ss) * (1.f / 1024.f) + EPS); \
        if (LAST) { _Pragma("unroll") for (int j = 0; j < 4; ++j) { const f32x4 gg = *(const f32x4*)(gnext + lane * 16 + 4 * j); *(f32x4*)(xq + 4 * j) = xr[j] * rstd * gg; } } \
        else { u32x4 q0, q1; \
            _Pragma("unroll") for (int j = 0; j < 4; ++j) { *(f32x4*)(xq + 4 * j) = xr[j]; const f32x4 gg = *(const f32x4*)(gnext + lane * 16 + 4 * j); \
                const unsigned lo = cvt_pk_bf16(xr[j][0] * rstd * gg[0], xr[j][1] * rstd * gg[1]), hi = cvt_pk_bf16(xr[j][2] * rstd * gg[2], xr[j][3] * rstd * gg[3]); \
                if (j < 2) { q0[2 * j] = lo; q0[2 * j + 1] = hi; } else { q1[2 * (j - 2)] = lo; q1[2 * (j - 2) + 1] = hi; } } \
            u32x4* hq = (u32x4*)(HB + (tok0 + (tk)) * 1024 + lane * 16); hq[0] = q0; hq[1] = q1; } } while (0)
    PQ_FINAL(o0, 0); PQ_FINAL(o1, 1); PQ_FINAL(o2, 2); PQ_FINAL(o3, 3);
#undef PQ_FINAL
}
__device__ __forceinline__ void xcc_sync(unsigned* ctr, unsigned nloc, unsigned target) {
    __syncthreads();
    if (threadIdx.x == 0 && nloc > 0u) {
        __hip_atomic_fetch_add(ctr, 1u, __ATOMIC_RELAXED, __HIP_MEMORY_SCOPE_AGENT);
        unsigned sp = 0u;
        while (__hip_atomic_load(ctr, __ATOMIC_RELAXED, __HIP_MEMORY_SCOPE_AGENT) < nloc * target) { __builtin_amdgcn_s_sleep(1); if (++sp > (1u << 16)) break; }
    }
    __syncthreads();
}

__device__ __forceinline__ void row_to_fp8(const float* src, unsigned char* dst, float* scale, int lane) {
    const f32x4* sp = (const f32x4*)(src + lane * 16); f32x4 v[4]; float am = 0.f;
#pragma unroll
    for (int j = 0; j < 4; ++j) { v[j] = sp[j]; am = fmaxf(am, fmaxf(fmaxf(fabsf(v[j].x), fabsf(v[j].y)), fmaxf(fabsf(v[j].z), fabsf(v[j].w)))); }
    am = wave_max(am);
    const float sc = am > 0.f ? am * (1.0f / 448.0f) : 1.0f, inv = 1.0f / sc;
    u32x4 o;
#pragma unroll
    for (int j = 0; j < 4; ++j) { int w = 0; w = __builtin_amdgcn_cvt_pk_fp8_f32(v[j].x * inv, v[j].y * inv, w, false); w = __builtin_amdgcn_cvt_pk_fp8_f32(v[j].z * inv, v[j].w * inv, w, true); o[j] = (unsigned)w; }
    *(u32x4*)(dst + lane * 16) = o;
    if (lane == 0) *scale = sc;
}

__device__ __forceinline__ void row_to_int8(const float* src, unsigned char* dst, float* scale, int lane) {
    const f32x4* sp = (const f32x4*)(src + lane * 16); f32x4 v[4]; float am = 0.f;
#pragma unroll
    for (int j = 0; j < 4; ++j) { v[j] = sp[j]; am = fmaxf(am, fmaxf(fmaxf(fabsf(v[j].x), fabsf(v[j].y)), fmaxf(fabsf(v[j].z), fabsf(v[j].w)))); }
    am = wave_max(am);
    const float sc = am > 0.f ? am * (1.0f / 127.0f) : 1.0f, inv = 1.0f / sc;
    u32x4 o;
#pragma unroll
    for (int j = 0; j < 4; ++j) { const int q0 = (int)rintf(v[j].x * inv), q1 = (int)rintf(v[j].y * inv), q2 = (int)rintf(v[j].z * inv), q3 = (int)rintf(v[j].w * inv);
        o[j] = (unsigned)((q0 & 0xff) | ((q1 & 0xff) << 8) | ((q2 & 0xff) << 16) | ((q3 & 0xff) << 24)); }
    *(u32x4*)(dst + lane * 16) = o;
    if (lane == 0) *scale = sc;
}

template <bool FP8>
__device__ __forceinline__ void rows4_to_q8(const float* src, size_t rstride_f, unsigned char* dst, size_t rstride_b, float* scale, size_t sstride, int lane) {
    f32x4 v[4][4];
#pragma unroll
    for (int i = 0; i < 4; ++i) { const f32x4* sp = (const f32x4*)(src + (size_t)i * rstride_f + lane * 16);
#pragma unroll
        for (int j = 0; j < 4; ++j) v[i][j] = sp[j]; }
#pragma unroll
    for (int i = 0; i < 4; ++i) { float am = 0.f;
#pragma unroll
        for (int j = 0; j < 4; ++j) am = fmaxf(am, fmaxf(fmaxf(fabsf(v[i][j].x), fabsf(v[i][j].y)), fmaxf(fabsf(v[i][j].z), fabsf(v[i][j].w))));
        am = wave_max(am);
        const float sc = am > 0.f ? am * (FP8 ? (1.0f / 448.0f) : (1.0f / 127.0f)) : 1.0f, inv = 1.0f / sc;
        u32x4 o;
#pragma unroll
        for (int j = 0; j < 4; ++j) {
            if (FP8) { int w = 0; w = __builtin_amdgcn_cvt_pk_fp8_f32(v[i][j].x * inv, v[i][j].y * inv, w, false); w = __builtin_amdgcn_cvt_pk_fp8_f32(v[i][j].z * inv, v[i][j].w * inv, w, true); o[j] = (unsigned)w; }
            else { const int q0 = (int)rintf(v[i][j].x * inv), q1 = (int)rintf(v[i][j].y * inv), q2 = (int)rintf(v[i][j].z * inv), q3 = (int)rintf(v[i][j].w * inv);
                o[j] = (unsigned)((q0 & 0xff) | ((q1 & 0xff) << 8) | ((q2 & 0xff) << 16) | ((q3 & 0xff) << 24)); } }
        *(u32x4*)(dst + (size_t)i * rstride_b + lane * 16) = o;
        if (lane == 0) scale[(size_t)i * sstride] = sc; }
}

__global__ void __launch_bounds__(NTHR, 2) trunk_fwd(Args args) {
    extern __shared__ __attribute__((aligned(16))) unsigned char lds_raw[];
    LAS unsigned char* lds = (LAS unsigned char*)lds_raw;
    const int tid = threadIdx.x, lane = tid & 63, wave = __builtin_amdgcn_readfirstlane(tid >> 6);
    const int G = gridDim.x, bx = blockIdx.x;
    unsigned char* ws = args.ws;
    unsigned* ctl = (unsigned*)(ws + WS_CTL);
    volatile LAS unsigned* LCTL = (volatile LAS unsigned*)(lds + LDS_CTL);
    for (int u = tid; u < 512; u += NTHR) LCTL[u] = 0u;
    __syncthreads();
    XcdBarrier bar; bar.bar = ctl + CW_BAR; bar.x = 0; bar.st = nullptr;
    if (!MK_PER_PHASE) bar = xcd_barrier_post(ctl + CW_BAR, LCTL + 8);
    const int lo = args.ph_lo, hi = args.ph_hi;
#define IN(k) (lo <= (k) && (k) < hi)
#define SEAM(k) do { if (IN(k) && IN((k) + 1)) xcd_barrier(bar); } while (0)
#define SEAM2(k) do { if (IN(k) && IN((k) + 2)) xcd_barrier(bar); } while (0)
#define REP(k) for (int _r = 0; _r <= ((PROBE_MASK >> (k)) & 1); ++_r)
    const size_t gtid = (size_t)bx * NTHR + tid, gthreads = (size_t)G * NTHR;
    const int gw = bx * NWAVES + wave, NGW = G * NWAVES;

    const float* x_in = args.in[I_X];
    float* xres = args.out;
    bf16* WA = (bf16*)(ws + WS_WA); bf16* WB = (bf16*)(ws + WS_WB); bf16* WO = (bf16*)(ws + WS_WO); bf16* WKV = (bf16*)(ws + WS_WKV); bf16* WQ = (bf16*)(ws + WS_WQ);
    bf16* MEMN = (bf16*)(ws + WS_MEMN); bf16* KV = (bf16*)(ws + WS_KV); bf16* HB = (bf16*)(ws + WS_HB); bf16* MIX = (bf16*)(ws + WS_MIX);
    unsigned char* TAB8 = ws + WS_TAB;
    float* TSC = (float*)(ws + WS_TSC);
    unsigned char* AR = ws + WS_AR;
    bf16* QMEM = (bf16*)(AR + AR_QMEM);
    bf16* Qb = (bf16*)args.out; bf16* QMEM0 = (bf16*)args.out + (size_t)M * 768;
    bf16* QLb = (bf16*)(AR + AR_QL);
    bf16* Zb = (bf16*)(AR + AR_Z); bf16* XBC = (bf16*)(AR + AR_XBC); float* DTb = (float*)(AR + AR_DT); bf16* XC = (bf16*)(AR + AR_XC); bf16* STATES = (bf16*)(AR + AR_ST); bf16* Yb = (bf16*)(AR + AR_Y);
    float* DEC = (float*)(ws + WS_DEC); float* SSb = (float*)(ws + WS_SS);
    bf16* UKb = (bf16*)(ws + WS_UK); bf16* UVTb = (bf16*)(ws + WS_UVT); bf16* SUBKb = (bf16*)(ws + WS_SUBK);
    bf16* PQb = (bf16*)(AR + AR_PQ); u32x2* TOPK = (u32x2*)(AR + AR_TOPK);

    if (IN(0)) REP(0) {
        LAS float* scr = (LAS float*)(lds + LDS_SCR + wave * 8704);
        const float* awin = args.in[I_AWIN]; const float* bwin = args.in[I_BWIN];
        const int nA0 = titems(1536), nA1 = titems(256), nA2 = titems(64), nA3 = titems(8);
        const int nB0 = titems(2048), nB1 = titems(256), nB2 = titems(12);
        const int nO = titems(1024), nKV = titems(512), nQ = titems(2048);
        const int NIT = nA0 + nA1 + nA2 + nA3 + nB0 + nB1 + nB2 + 2 * nO + 2 * nKV + 2 * nQ;
        for (int it = gw; it < NIT; it += NGW) {
            int r = it;
            if (r < nA0) { transpose_item(awin, 1864, 0, 1536, WA, 0, scr, r, lane); continue; } r -= nA0;
            if (r < nA1) { transpose_item(awin, 1864, 1608, 256, WA, 1536, scr, r, lane); continue; } r -= nA1;
            if (r < nA2) { transpose_item(awin, 1864, 1536, 64, WA, 1792, scr, r, lane); continue; } r -= nA2;
            if (r < nA3) { transpose_item(awin, 1864, 1600, 8, WA, 1856, scr, r, lane); continue; } r -= nA3;
            if (r < nB0) { transpose_item(bwin, 2316, 0, 2048, WB, 0, scr, r, lane); continue; } r -= nB0;
            if (r < nB1) { transpose_item(bwin, 2316, 2060, 256, WB, 2048, scr, r, lane); continue; } r -= nB1;
            if (r < nB2) { transpose_item(bwin, 2316, 2048, 12, WB, 2304, scr, r, lane); continue; } r -= nB2;
            if (r < 2 * nO) { const int l = r / nO; transpose_item(args.in[I_WO] + (size_t)l * 1024 * 1024, 1024, 0, 1024, WO, l * 1024, scr, r - l * nO, lane); continue; } r -= 2 * nO;
            if (r < 2 * nKV) { const int l = r / nKV; transpose_item(args.in[I_WMEMKV] + (size_t)l * 1024 * 512, 512, 0, 512, WKV, l * 512, scr, r - l * nKV, lane); continue; } r -= 2 * nKV;
            { const int l = r / nQ; transpose_item(args.in[I_PWQ] + (size_t)l * 1024 * 2048, 2048, 0, 2048, WQ, l * 2048, scr, r - l * nQ, lane, args.in[I_FFNNORM] + l * D); }
        }
        for (size_t i = gtid; i < (size_t)(2048 - 1864) * 128; i += gthreads) *((u32x4*)(WA + (size_t)1864 * 1024) + i) = (u32x4){0u, 0u, 0u, 0u};
        for (size_t i = gtid; i < (size_t)(2560 - 2316) * 128; i += gthreads) *((u32x4*)(WB + (size_t)2316 * 1024) + i) = (u32x4){0u, 0u, 0u, 0u};
        for (size_t i = gtid; i < (size_t)2 * M; i += gthreads) SSb[i] = 0.f;
        for (int m = gw; m < BATCH * MEMLEN; m += NGW) rms_row_to_bf16(args.in[I_MEM] + (size_t)m * D, args.in[I_MEMNORM], MEMN + (size_t)m * D, lane);
        for (int m = gw; m < M; m += 4 * NGW) rms_rows4_to_bf16(x_in + (size_t)m * D, (size_t)NGW * D, args.in[I_MIXNORM], HB + (size_t)m * D, lane);
        cvt_stream(args.in[I_AWUK], UKb, (size_t)12 * 256 * 64, gtid, gthreads);
        for (size_t i = gtid; i < (size_t)12 * 64 * 256; i += gthreads) { const int h = (int)(i >> 14), d = (int)((i >> 8) & 63), c = (int)(i & 255);
            UVTb[i] = (bf16)(cvt_pk_bf16(args.in[I_AWUV][((size_t)h * 256 + c) * 64 + d], 0.f) & 0xffffu); }
        cvt_stream(args.in[I_PSUBK], SUBKb, (size_t)2 * 2 * 128 * 128, gtid, gthreads);
        for (int tbl = 0; tbl < 2; ++tbl) { const int l = tbl >> 1, tv = tbl & 1;
            const float* srcb = args.in[tv ? I_PV : I_PU] + (size_t)l * 16384 * 1024; unsigned char* dstb = TAB8 + (size_t)l * 32 * MiB + (size_t)tv * 1024; float* scb = TSC + (l * 2 + tv) * 16384;
            for (int e = gw; e < 16384; e += 4 * NGW) {
                if (tv) rows4_to_q8<true>(srcb + (size_t)e * 1024, (size_t)NGW * 1024, dstb + (size_t)e * 2048, (size_t)NGW * 2048, scb + e, NGW, lane);
                else rows4_to_q8<false>(srcb + (size_t)e * 1024, (size_t)NGW * 1024, dstb + (size_t)e * 2048, (size_t)NGW * 2048, scb + e, NGW, lane); } }
    }
    SEAM(0);
    if (IN(1)) REP(1) {
        { pg8::Gemm g{HB, WA, M, NA, D}; pg8::StaticOrder S; S.init(M, NA, G, bx);
          EpiInA E{Qb, (float*)(AR + AR_CKV32), (bf16*)(AR + AR_IQ), QMEM0, (bf16*)(AR + AR_IK), (float*)(AR + AR_IW)};
          pg8::gemm_phase<EpiInA, pg8::StaticOrder, true, true>(lds + LDS_SCR, g, S, E); }
        { pg8::Gemm g{MEMN, WKV, BATCH * MEMLEN, 1024, D}; pg8::StaticOrder S; S.init(BATCH * MEMLEN, 1024, G, bx);
          EpiPlain E{KV, 1024};
          pg8::gemm_phase<EpiPlain, pg8::StaticOrder, true, true>(lds + LDS_SCR, g, S, E); }
        if (bx >= 32) { const int gw2 = (bx - 32) * NWAVES + wave, NGW2 = (G - 32) * NWAVES;
            for (int tv = 0; tv < 2; ++tv) {
                const float* srcb = args.in[tv ? I_PV : I_PU] + (size_t)16384 * 1024; unsigned char* dstb = TAB8 + (size_t)32 * MiB + (size_t)tv * 1024; float* scb = TSC + (2 + tv) * 16384;
                for (int e = gw2; e < 4096; e += NGW2) {
                    if (tv) rows4_to_q8<true>(srcb + (size_t)e * 1024, (size_t)4096 * 1024, dstb + (size_t)e * 2048, (size_t)4096 * 2048, scb + e, 4096, lane);
                    else rows4_to_q8<false>(srcb + (size_t)e * 1024, (size_t)4096 * 1024, dstb + (size_t)e * 2048, (size_t)4096 * 2048, scb + e, 4096, lane); } } }
    }
    SEAM(1);
    if (IN(2)) REP(2) {
        { const float* src = (const float*)(AR + AR_CKV32); bf16* dst = (bf16*)(AR + AR_CKV); const f32x4 gg = *((const f32x4*)args.in[I_AKVNORM] + lane);
          for (int m = gw; m < M; m += 4 * NGW) {
              f32x4 v[4];
#pragma unroll
              for (int i = 0; i < 4; ++i) v[i] = *((const f32x4*)(src + (size_t)(m + i * NGW) * 256) + lane);
#pragma unroll
              for (int i = 0; i < 4; ++i) { const float ss = wave_sum((v[i].x * v[i].x + v[i].y * v[i].y) + (v[i].z * v[i].z + v[i].w * v[i].w)); const float rstd = 1.0f / sqrtf(ss * (1.f / 256.f) + EPS);
                  u32x2 o; o.x = cvt_pk_bf16(v[i].x * rstd * gg.x, v[i].y * rstd * gg.y); o.y = cvt_pk_bf16(v[i].z * rstd * gg.z, v[i].w * rstd * gg.w);
                  *((u32x2*)(dst + (size_t)(m + i * NGW) * 256) + lane) = o; } } }
        for (int u = bx; u < 512; u += G) memattn_unit(lds + LDS_SCR, u, 0, KV, QMEM0, MIX, tid, wave, lane);
        qlat_phase(lds + LDS_SCR, bx, G, 3072, Qb, UKb, QLb, tid, wave, lane);
    }
    SEAM(2);
    if (IN(3)) REP(3) {
        { LAS float* RB = (LAS float*)(lds + LDS_SCR + DS_RB); const float* rbias = args.in[I_RELBIAS];
          for (int i = tid; i < 512; i += NTHR) { const int bk = i >> 4, h = i & 15; RB[i] = h < 12 ? rbias[bk * 12 + h] : 0.f; } }
        for (int u = bx; u < 4096; u += G) dsa_unit(lds + LDS_SCR, u, QLb, (const bf16*)(AR + AR_CKV), (const bf16*)(AR + AR_IQ), (const bf16*)(AR + AR_IK), (const float*)(AR + AR_IW), tid, wave, lane);
    }
    SEAM(3);
    if (IN(4)) REP(4) { uv_phase(lds + LDS_SCR, bx, G, 3072, QLb, UVTb, MIX, tid, wave, lane); }
    SEAM(4);
    if (IN(5)) REP(5) {
        pg8::Gemm g{MIX, WO, M, D, D}; pg8::StaticOrder S; S.init(M, D, G, bx);
        EpiResid<false> E{x_in, HB, SSb};
        pg8::gemm_phase<EpiResid<false>, pg8::StaticOrder, true, true>(lds + LDS_SCR, g, S, E);
    }
    SEAM2(5);
    if (IN(7)) REP(7) {
        pg8::Gemm g{HB, WQ, M, 2048, D}; pg8::StaticOrder S; S.init(M, 2048, G, bx);
        EpiPQ E{PQb, SSb};
        pg8::gemm_phase<EpiPQ, pg8::StaticOrder, true, true>(lds + LDS_SCR, g, S, E);
    }
    SEAM(7);
    if (IN(8)) REP(8) { peer_topk_load_sk(lds + LDS_SCR, SUBKb, tid); for (int task = gw; task < 16384; task += NGW) peer_topk_task(lds + LDS_SCR, task, PQb, TOPK, wave, lane); }
    SEAM(8);
    if (IN(9)) { peer_wave<false>(lds + LDS_SCR + wave * PW_BYTES, gw, NGW, M / 2, TOPK, TAB8, TAB8 + 1024, TSC, TSC + 16384, HB, SSb, args.in[I_FFNNORM], xres, args.in[I_MIXNORM] + D, lane, ctl + CW_XS + 64 * xb_xcc_id(), MK_PER_PHASE ? 0u : LCTL[8], 0u); }
    SEAM(9);
    if (IN(10)) REP(10) {
        pg8::Gemm g{HB, WB, M, NB, D}; pg8::StaticOrder S; S.init(M, NB, G, bx);
        EpiInB E{(bf16*)(AR + AR_Z), (bf16*)(AR + AR_XBC), QMEM, (float*)(AR + AR_DT)};
        pg8::gemm_phase<EpiInB, pg8::StaticOrder, true, true>(lds + LDS_SCR, g, S, E);
    }
    SEAM(10);
    if (IN(11)) REP(11) {
        for (int u = bx; u < 512; u += G) memattn_unit(lds + LDS_SCR, u, 1, KV, QMEM, MIX, tid, wave, lane);
        for (int u = bx; u < 256; u += G) ssd_states_unit(lds + LDS_SCR, u, XBC, DTb, args.in[I_BCONVW], args.in[I_BCONVB], args.in[I_BDTBIAS], args.in[I_BALOG], XC, STATES, DEC, tid, wave, lane);
    }
    SEAM(11);
    if (IN(12)) { ssd_scan(STATES, DEC, gtid, gthreads); }
    SEAM(12);
    if (IN(13)) REP(13) { for (int u = bx; u < 256; u += G) ssd_out_unit(lds + LDS_SCR, u, XC, DTb, Zb, STATES, args.in[I_BDTBIAS], args.in[I_BALOG], args.in[I_BDSKIP], args.in[I_BOUTNORM], Yb, MIX, tid, wave, lane); }
    SEAM(13);
    if (IN(14)) {
        pg8::Gemm g{MIX, WO + (size_t)1024 * 1024, M, D, D}; pg8::StaticOrder S; S.init(M, D, G, bx);
        EpiResid<true> E{(const bf16*)xres, HB, SSb + M};
        pg8::gemm_phase<EpiResid<true>, pg8::StaticOrder, true, true>(lds + LDS_SCR, g, S, E);
    }
    SEAM2(14);
    if (IN(16)) REP(16) {
        pg8::Gemm g{HB, WQ + (size_t)2048 * 1024, M, 2048, D}; pg8::StaticOrder S; S.init(M, 2048, G, bx);
        EpiPQ E{PQb, SSb + M};
        pg8::gemm_phase<EpiPQ, pg8::StaticOrder, true, true>(lds + LDS_SCR, g, S, E);
    }
    SEAM(16);
    if (IN(17)) REP(17) { peer_topk_load_sk(lds + LDS_SCR, SUBKb + 32768, tid); for (int task = gw; task < 16384; task += NGW) peer_topk_task(lds + LDS_SCR, task, PQb, TOPK, wave, lane); }
    SEAM(17);
    if (IN(18)) { peer_wave<true>(lds + LDS_SCR + wave * PW_BYTES, gw, NGW, M / 2, TOPK, TAB8 + 32 * MiB, TAB8 + 32 * MiB + 1024, TSC + 32768, TSC + 49152, HB, SSb + M, args.in[I_FFNNORM] + D, xres, args.in[I_FINALNORM], lane, ctl + CW_XS + 64 * xb_xcc_id(), MK_PER_PHASE ? 0u : LCTL[8], 8u); }
#undef IN
#undef SEAM
#undef SEAM2
#undef REP
}

extern "C" void kernel_launch(void* const* d_in, const int* in_sizes, int n_in, void* d_out, int out_size, void* d_ws, size_t ws_size, hipStream_t stream) {
    static int grid = 0;
    if (grid == 0) {
        if (n_in != 24 || in_sizes[0] != M * D || out_size != M * D || ws_size < WS_END) { fprintf(stderr, "kernel_launch: unexpected shapes (n_in %d, ws %zu); nothing launched\n", n_in, ws_size); grid = -1; return; }
        int dev = 0, cus = 0, per_cu = 0;
        if (hipGetDevice(&dev) != hipSuccess || hipDeviceGetAttribute(&cus, hipDeviceAttributeMultiprocessorCount, dev) != hipSuccess) { grid = -1; return; }
        if (hipFuncSetAttribute((const void*)trunk_fwd, hipFuncAttributeMaxDynamicSharedMemorySize, LDS_BYTES) != hipSuccess) { fprintf(stderr, "kernel_launch: hipFuncSetAttribute failed\n"); grid = -1; return; }
        if (hipOccupancyMaxActiveBlocksPerMultiprocessor(&per_cu, (const void*)trunk_fwd, NTHR, LDS_BYTES) != hipSuccess || per_cu < 1) { fprintf(stderr, "kernel_launch: occupancy query says %d\n", per_cu); }
        (void)hipGetLastError();
        grid = cus;
    }
    if (grid < 0) return;
    if (hipMemsetAsync((char*)d_ws + WS_CTL, 0, CTL_ZERO_BYTES, stream) != hipSuccess) return;
    Args a{};
    for (int i = 0; i < 24; ++i) a.in[i] = (const float*)d_in[i];
    a.out = (float*)d_out; a.ws = (unsigned char*)d_ws;
#if MK_PER_PHASE
    for (int p = 0; p < NPHASE; ++p) { a.ph_lo = p; a.ph_hi = p + 1; hipLaunchKernelGGL(trunk_fwd, dim3(grid), dim3(NTHR), LDS_BYTES, stream, a); }
#else
    a.ph_lo = 0; a.ph_hi = NPHASE;
    hipLaunchKernelGGL(trunk_fwd, dim3(grid), dim3(NTHR), LDS_BYTES, stream, a);
#endif
}
```

```cpp
#include <hip/hip_runtime.h>
#include <cstdio>
#include <cstdint>
#ifndef PROBE_MASK
#define PROBE_MASK 0
#endif
#ifndef DSA_PROBE
#define DSA_PROBE 0
#endif
#ifndef PEER_PROBE
#define PEER_PROBE 0
#endif
#ifndef PEER_WGSYNC
#define PEER_WGSYNC 4
#endif
#ifndef MK_PER_PHASE
#define MK_PER_PHASE 0
#endif
namespace pg8 {
#define PG8_LAS __attribute__((address_space(3)))
typedef unsigned short bf16_t;
typedef short bf16x8 __attribute__((ext_vector_type(8)));
typedef float f32x4 __attribute__((ext_vector_type(4)));
typedef unsigned u32x4 __attribute__((ext_vector_type(4)));
constexpr int BM = 256, BK = 64, HALF = 128, HTB = HALF * BK * 2  , STAGE_BYTES = 8 * HTB, NXCD = 8, WGM = 8;

__host__ __device__ __forceinline__ int lds_byte(int r, int c) { const int st = (r >> 4) * 2 + (c >> 5), rr = r & 15, cc = c & 31, ob = rr * 64 + cc * 2; return st * 1024 + (ob ^ (((ob >> 9) & 1) << 5)); }
__host__ __device__ __forceinline__ void stage_rc(int b, int& R, int& C) { const int st = b / 1024, sb = b % 1024, swz = sb ^ (((sb >> 9) & 1) << 5); R = (st >> 1) * 16 + swz / 64; C = (st & 1) * 32 + (swz % 64) / 2; }
__host__ __device__ __forceinline__ int perm32(int rho) { const int n = rho >> 4, i = rho & 15; return 8 * (i >> 2) + 4 * n + (i & 3); }

struct Unit { int pm, pn; };
struct Gemm { const bf16_t* A; const bf16_t* Bt; int M, N, K; };

struct StaticOrder {
    int nM, nN, nwg, G, c;
    __host__ __device__ void init(int M, int N, int G_, int c_) { nM = M / BM; nN = N / BM; nwg = nM * nN; G = G_; c = c_; }
    __host__ __device__ bool next(int i, Unit& u) const {
        const long L = (long)i * G + c; if (L >= nwg) return false;
        int wgid = (int)L; { const int q = nwg / NXCD, r = nwg % NXCD, xcd = wgid % NXCD, off = wgid / NXCD; wgid = (xcd < r ? xcd * (q + 1) : r * (q + 1) + (xcd - r) * q) + off; }
        const int nig = WGM * nN, gid = wgid / nig, fm = gid * WGM, gsz = (nM - fm) < WGM ? (nM - fm) : WGM;
        u.pm = fm + ((wgid % nig) % gsz); u.pn = (wgid % nig) / gsz; return true;
    }
    __device__ __forceinline__ void a_ready(const Unit&) const {}
    __device__ __forceinline__ void done(const Unit&) const {}
};
__device__ __forceinline__ unsigned cvt_pk_bf16(float lo, float hi) { unsigned r; asm volatile("v_cvt_pk_bf16_f32 %0, %1, %2" : "=v"(r) : "v"(lo), "v"(hi)); return r; }
template <class Epi, class Sched, bool ALIGN_EPI = false, bool SP2 = false>
__device__ __forceinline__ void gemm_phase(PG8_LAS unsigned char* lds, const Gemm g, const Sched& S, const Epi& E) {
    const int tid = threadIdx.x, wid = __builtin_amdgcn_readfirstlane(tid >> 6), lane = tid & 63, wr = wid >> 2, wc = wid & 3, fr = lane & 15, fq = lane >> 4;
    const int K = g.K, nt = K / BK;
    unsigned voffA[2], voffB[2];
#pragma unroll
    for (int i = 0; i < 2; ++i) { int R, C; stage_rc(tid * 16 + i * 8192, R, C); const int Rb = Epi::PERM ? ((R & ~31) + perm32(R & 31)) : R;
        voffA[i] = (unsigned)(R * K + C) * 2u; voffB[i] = (unsigned)(Rb * K + C) * 2u; }
    const size_t kstep = (size_t)(BK * 2);
    const size_t hstep = (size_t)HALF * K * 2;
    const size_t tstep = 2 * hstep;
    const unsigned ldsw = (unsigned)wid * 1024u;
    const int aoff = lds_byte(wr * 64 + fr, fq * 8), boff = lds_byte(wc * 32 + fr, fq * 8);
#define PG8_SA(b, h) (((b) * 2 + (h)) * HTB)
#define PG8_SB(b, h) ((4 + (b) * 2 + (h)) * HTB)
#define PG8_STAGE(bufoff, gbase, voff) do { _Pragma("unroll") for (int _i = 0; _i < 2; ++_i) \
        __builtin_amdgcn_global_load_lds((const unsigned*)((const char*)(gbase) + (voff)[_i]), (PG8_LAS unsigned*)(lds + (bufoff) + ldsw + _i * 8192), 16, 0, 0); } while (0)
#define PG8_LDA(dst, b, h) do { _Pragma("unroll") for (int m = 0; m < 4; ++m) _Pragma("unroll") for (int k = 0; k < 2; ++k) dst[m][k] = *(const PG8_LAS bf16x8*)(lds + PG8_SA(b, h) + aoff + m * 2048 + k * 1024); } while (0)
#define PG8_LDB(dst, b, h) do { _Pragma("unroll") for (int n = 0; n < 2; ++n) _Pragma("unroll") for (int k = 0; k < 2; ++k) dst[n][k] = *(const PG8_LAS bf16x8*)(lds + PG8_SB(b, h) + boff + n * 2048 + k * 1024); } while (0)
#define PG8_MMA(ai, bj, At, Bt) do { __builtin_amdgcn_s_setprio(1); _Pragma("unroll") for (int m = 0; m < 4; ++m) _Pragma("unroll") for (int n = 0; n < 2; ++n) _Pragma("unroll") for (int k = 0; k < 2; ++k) \
        acc[ai][bj][m][n] = __builtin_amdgcn_mfma_f32_16x16x32_bf16(Bt[n][k], At[m][k], acc[ai][bj][m][n], 0, 0, 0); __builtin_amdgcn_s_setprio(0); } while (0)
#define PG8_WAIT_V(n) asm volatile("s_waitcnt vmcnt(" #n ")" ::: "memory")
#define PG8_WAIT_L(n) asm volatile("s_waitcnt lgkmcnt(" #n ")" ::: "memory")
#define PG8_BAR __builtin_amdgcn_s_barrier()
#define PG8_SCHED __builtin_amdgcn_sched_barrier(0)
    Unit cur, nxt; int ui = 0;
    if (!S.next(0, cur)) return;
    f32x4 acc[2][2][4][2];
#pragma unroll
    for (int a = 0; a < 2; ++a)
#pragma unroll
        for (int b = 0; b < 2; ++b)
#pragma unroll
            for (int m = 0; m < 4; ++m)
#pragma unroll
                for (int n = 0; n < 2; ++n) acc[a][b][m][n] = (f32x4){0.f, 0.f, 0.f, 0.f};
    bf16x8 At[4][2], B0[2][2], B1[2][2];
    const char* cA = (const char*)g.A + (size_t)cur.pm * tstep; const char* cB = (const char*)g.Bt + (size_t)cur.pn * tstep;
    S.a_ready(cur);
    if constexpr (SP2) {
        PG8_STAGE(PG8_SB(0, 0), cB, voffB); PG8_STAGE(PG8_SB(0, 1), cB + hstep, voffB); PG8_STAGE(PG8_SA(0, 0), cA, voffA); PG8_STAGE(PG8_SA(0, 1), cA + hstep, voffA);
        if (wr == 1) PG8_BAR;
        PG8_WAIT_V(2); PG8_BAR;
        PG8_STAGE(PG8_SB(1, 0), cB + kstep, voffB); PG8_STAGE(PG8_SA(1, 0), cA + kstep, voffA); PG8_STAGE(PG8_SB(1, 1), cB + hstep + kstep, voffB);
        PG8_WAIT_V(6); PG8_BAR;
    } else {
        PG8_STAGE(PG8_SB(0, 0), cB, voffB); PG8_STAGE(PG8_SA(0, 0), cA, voffA); PG8_STAGE(PG8_SB(0, 1), cB + hstep, voffB); PG8_STAGE(PG8_SA(0, 1), cA + hstep, voffA);
        if (wr == 1) PG8_BAR;
        PG8_WAIT_V(4); PG8_BAR;
        PG8_STAGE(PG8_SB(1, 0), cB + kstep, voffB); PG8_STAGE(PG8_SA(1, 0), cA + kstep, voffA); PG8_STAGE(PG8_SB(1, 1), cB + hstep + kstep, voffB);
        PG8_WAIT_V(6); PG8_BAR;
    }
    for (;;) {
        const bool has_next = S.next(ui + 1, nxt);
        const char* nA = has_next ? (const char*)g.A + (size_t)nxt.pm * tstep : cA; const char* nB = has_next ? (const char*)g.Bt + (size_t)nxt.pn * tstep : cB;
        for (int t = 0; t < nt; t += 2) {
            const bool last = (t == nt - 2);
            const char* a1 = cA + (size_t)(t + 1) * kstep;
            const char* a2 = last ? nA : cA + (size_t)(t + 2) * kstep; const char* b2 = last ? nB : cB + (size_t)(t + 2) * kstep;
            const char* a3 = a2 + kstep; const char* b3 = b2 + kstep;
            if (last && has_next) S.a_ready(nxt);
            if constexpr (SP2) {
            PG8_LDB(B0, 0, 0); PG8_LDB(B1, 0, 1); PG8_SCHED; PG8_LDA(At, 0, 0); PG8_STAGE(PG8_SA(1, 1), a1 + hstep, voffA);
            PG8_WAIT_V(8); PG8_WAIT_L(0); PG8_BAR; PG8_MMA(0, 0, At, B0); PG8_MMA(0, 1, At, B1); PG8_BAR; PG8_SCHED;
            PG8_LDA(At, 0, 1); PG8_STAGE(PG8_SB(0, 0), b2, voffB); PG8_STAGE(PG8_SB(0, 1), b2 + hstep, voffB); PG8_STAGE(PG8_SA(0, 0), a2, voffA);
            PG8_WAIT_V(8); PG8_WAIT_L(0); PG8_BAR; PG8_MMA(1, 0, At, B0); PG8_MMA(1, 1, At, B1); PG8_BAR; PG8_SCHED;
            PG8_LDB(B0, 1, 0); PG8_LDB(B1, 1, 1); PG8_SCHED; PG8_LDA(At, 1, 0); PG8_STAGE(PG8_SA(0, 1), a2 + hstep, voffA);
            PG8_WAIT_V(8); PG8_WAIT_L(0); PG8_BAR; PG8_MMA(0, 0, At, B0); PG8_MMA(0, 1, At, B1); PG8_BAR; PG8_SCHED;
            PG8_LDA(At, 1, 1); PG8_STAGE(PG8_SB(1, 0), b3, voffB); PG8_STAGE(PG8_SB(1, 1), b3 + hstep, voffB); PG8_STAGE(PG8_SA(1, 0), a3, voffA);
            PG8_WAIT_V(8); PG8_WAIT_L(0); PG8_BAR; PG8_MMA(1, 0, At, B0); PG8_MMA(1, 1, At, B1); PG8_BAR; PG8_SCHED;
            } else {
            PG8_LDB(B0, 0, 0); PG8_SCHED; PG8_LDA(At, 0, 0); PG8_STAGE(PG8_SA(1, 1), a1 + hstep, voffA);
            PG8_WAIT_L(8); PG8_BAR; PG8_WAIT_L(0); PG8_MMA(0, 0, At, B0); PG8_BAR; PG8_SCHED;
            PG8_LDB(B1, 0, 1); PG8_STAGE(PG8_SB(0, 0), b2, voffB);
            PG8_BAR; PG8_WAIT_L(0); PG8_MMA(0, 1, At, B1); PG8_BAR;
            PG8_LDA(At, 0, 1); PG8_STAGE(PG8_SA(0, 0), a2, voffA);
            PG8_BAR; PG8_WAIT_L(0); PG8_MMA(1, 0, At, B0); PG8_BAR; PG8_SCHED;
            PG8_STAGE(PG8_SB(0, 1), b2 + hstep, voffB);
            PG8_WAIT_V(6); PG8_BAR; PG8_MMA(1, 1, At, B1); PG8_BAR;
            PG8_LDB(B0, 1, 0); PG8_SCHED; PG8_LDA(At, 1, 0); PG8_STAGE(PG8_SA(0, 1), a2 + hstep, voffA);
            PG8_WAIT_L(8); PG8_BAR; PG8_WAIT_L(0); PG8_MMA(0, 0, At, B0); PG8_BAR; PG8_SCHED;
            PG8_LDB(B1, 1, 1); PG8_STAGE(PG8_SB(1, 0), b3, voffB);
            PG8_BAR; PG8_WAIT_L(0); PG8_MMA(0, 1, At, B1); PG8_BAR;
            PG8_LDA(At, 1, 1); PG8_STAGE(PG8_SA(1, 0), a3, voffA);
            PG8_BAR; PG8_WAIT_L(0); PG8_MMA(1, 0, At, B0); PG8_BAR; PG8_SCHED;
            PG8_STAGE(PG8_SB(1, 1), b3 + hstep, voffB);
            PG8_WAIT_V(6); PG8_BAR; PG8_MMA(1, 1, At, B1); PG8_BAR;
            }
        }
        if constexpr (ALIGN_EPI) { if (wr == 0) PG8_BAR; }
        if constexpr (!Epi::AFTER_DRAIN) { E(acc, cur, wr, wc, fr, fq); S.done(cur); }
        if (!has_next) break;
#pragma unroll
        for (int a = 0; a < 2; ++a)
#pragma unroll
            for (int b = 0; b < 2; ++b)
#pragma unroll
                for (int m = 0; m < 4; ++m)
#pragma unroll
                    for (int n = 0; n < 2; ++n) acc[a][b][m][n] = (f32x4){0.f, 0.f, 0.f, 0.f};
        cur = nxt; cA = nA; cB = nB; ++ui;
        if constexpr (ALIGN_EPI) { if (wr == 1) PG8_BAR; }
    }
    PG8_WAIT_V(0);
    if constexpr (!ALIGN_EPI) { if (wr == 0) PG8_BAR; }
    PG8_BAR;
    if constexpr (Epi::AFTER_DRAIN) { E.fused(acc, cur, wr, wc, fr, fq, lds, wid, lane); S.done(cur); }
#undef PG8_SA
#undef PG8_SB
#undef PG8_STAGE
#undef PG8_LDA
#undef PG8_LDB
#undef PG8_MMA
#undef PG8_WAIT_V
#undef PG8_WAIT_L
#undef PG8_BAR
#undef PG8_SCHED
}
}

#define LAS __attribute__((address_space(3)))
typedef unsigned short bf16;
typedef short bf16x8 __attribute__((ext_vector_type(8)));
typedef short bf16x4 __attribute__((ext_vector_type(4)));
typedef float f32x4 __attribute__((ext_vector_type(4)));
typedef float f32x16 __attribute__((ext_vector_type(16)));
typedef unsigned u32x4 __attribute__((ext_vector_type(4)));
typedef unsigned u32x2 __attribute__((ext_vector_type(2)));
typedef __bf16 bf16v2_t __attribute__((ext_vector_type(2)));
__device__ __forceinline__ unsigned cvt_pk_bf16(float lo, float hi) { bf16v2_t v; v.x = (__bf16)lo; v.y = (__bf16)hi; return __builtin_bit_cast(unsigned, v); }

constexpr int NWAVES = 8, NTHR = 512;
constexpr int D = 1024, BATCH = 8, SEQ = 4096, M = BATCH * SEQ, MEMLEN = 256;
constexpr int NA = 2048, NB = 2560;
constexpr float EPS = 1e-6f;
constexpr int NPHASE = 19;

constexpr size_t MiB = 1u << 20;
constexpr size_t WS_CTL = 0, CTL_ZERO_BYTES = 1 * MiB;
constexpr size_t WS_WA = 1 * MiB, WS_WB = 5 * MiB, WS_WO = 10 * MiB, WS_WKV = 14 * MiB, WS_WQ = 16 * MiB;
constexpr size_t WS_DEC = 25 * MiB + 512 * 1024, WS_TSC = 26 * MiB, WS_SS = 27 * MiB;
constexpr size_t WS_UK = 24 * MiB, WS_UVT = 24 * MiB + 512 * 1024, WS_SUBK = 25 * MiB;
constexpr size_t WS_MEMN = 32 * MiB, WS_KV = 36 * MiB, WS_HB = 40 * MiB, WS_MIX = 104 * MiB, WS_TAB = 168 * MiB, WS_AR = 232 * MiB, WS_END = 512 * MiB;
constexpr size_t AR_CKV32 = 0, AR_CKV = 32 * MiB, AR_IQ = 48 * MiB, AR_IK = 80 * MiB, AR_IW = 84 * MiB, AR_QL = 88 * MiB, AR_QMEM = 136 * MiB;
constexpr size_t AR_Z = 0, AR_XBC = 48 * MiB, AR_DT = 128 * MiB, AR_XC = 152 * MiB, AR_ST = 232 * MiB, AR_Y = 48 * MiB;
constexpr size_t AR_PQ = 152 * MiB, AR_TOPK = 0;
constexpr int CW_XS = 8192;
constexpr int CW_BAR = 4096;

constexpr int LDS_BYTES = 163840;
constexpr int LDS_SCR = 0, LDS_SCR_BYTES = 161792;
constexpr int LDS_CTL = 161792;

__device__ __forceinline__ float bf2f(unsigned short b) { return __uint_as_float(((unsigned)b) << 16); }
__device__ __forceinline__ float wave_sum(float v) {
#pragma unroll
    for (int o = 1; o < 64; o <<= 1) v += __shfl_xor(v, o);
    return v;
}
__device__ __forceinline__ float wave_max(float v) {
#pragma unroll
    for (int o = 1; o < 64; o <<= 1) v = fmaxf(v, __shfl_xor(v, o));
    return v;
}
#define LDS_WAIT() asm volatile("s_waitcnt lgkmcnt(0)" ::: "memory")
#define VM_WAIT() asm volatile("s_waitcnt vmcnt(0)" ::: "memory")

#define XB_TMO      128
#define XB_XCNT(j)  (256  + 64 * (j))
#define XB_XSUB(j)  (1280 + 64 * (j))
#define XB_XGEN(j)  (2304 + 64 * (j))
#define XB_TOP      3328
#define XB_TOPGEN   3392
#define XCD_BAR_WORDS 3456
#define XB_SPIN_CAP (1u << 22)

__device__ __forceinline__ unsigned xb_ld(unsigned* p)              { return __hip_atomic_load(p, __ATOMIC_RELAXED, __HIP_MEMORY_SCOPE_AGENT); }
__device__ __forceinline__ unsigned xb_add(unsigned* p, unsigned v) { return __hip_atomic_fetch_add(p, v, __ATOMIC_RELAXED, __HIP_MEMORY_SCOPE_AGENT); }
__device__ __forceinline__ unsigned xb_xcc_id() { return (unsigned)__builtin_amdgcn_s_getreg((3 << 11) | 20) & 0xFu; }
#define XB_SPIN(cond, bar) do { unsigned _sp = 0; while (cond) { __builtin_amdgcn_s_sleep(1); \
    if ((++_sp & 255u) == 0u) { if (xb_ld(&(bar)[XB_TMO])) break; if (_sp > XB_SPIN_CAP) { atomicAdd(&(bar)[XB_TMO], 1u); break; } } } } while (0)

struct XcdBarrier {
    unsigned* bar; unsigned x;
    volatile LAS unsigned* st;
};

__device__ __forceinline__ XcdBarrier xcd_barrier_post(unsigned* bar, volatile LAS unsigned* st) {
    XcdBarrier b; b.bar = bar; b.x = xb_xcc_id(); b.st = st;
    if (threadIdx.x == 0) (void)xb_add(&bar[XB_XCNT(b.x)], 1u);
    return b;
}
__device__ __forceinline__ void xcd_barrier_complete(unsigned* bar, unsigned x, unsigned& nloc, unsigned& nx) {
    const unsigned G = gridDim.x * gridDim.y * gridDim.z;
    unsigned sum, cnt, mine, sp = 0u;
    for (;;) {
        sum = 0u; cnt = 0u; mine = 0u;
#pragma unroll
        for (unsigned j = 0; j < 16; ++j) { const unsigned c = xb_ld(&bar[XB_XCNT(j)]); sum += c; cnt += (c > 0u) ? 1u : 0u; mine = (j == x) ? c : mine; }
        if (sum == G) break;
        __builtin_amdgcn_s_sleep(1);
        if ((++sp & 255u) == 0u) { if (xb_ld(&bar[XB_TMO])) break; if (sp > XB_SPIN_CAP) { atomicAdd(&bar[XB_TMO], 1u); break; } }
    }
    nloc = mine > 0u ? mine : 1u; nx = cnt > 0u ? cnt : 1u;
}

__device__ __forceinline__ void xcd_barrier(const XcdBarrier& b) {
    asm volatile("s_waitcnt vmcnt(0)" ::: "memory");
    __syncthreads();
    if (threadIdx.x == 0) {
        unsigned* bar = b.bar;
        __builtin_amdgcn_s_waitcnt(0);
        unsigned nloc = b.st[0], nx = b.st[1];
        if (nloc == 0u) { xcd_barrier_complete(bar, b.x, nloc, nx); b.st[0] = nloc; b.st[1] = nx; }
        const unsigned old = xb_add(&bar[XB_XSUB(b.x)], 1u);
        const unsigned gen = old / nloc;
        if (old + 1u == (gen + 1u) * nloc) {
            __builtin_amdgcn_fence(__ATOMIC_RELEASE, "agent");
            asm volatile("s_waitcnt vmcnt(0)" ::: "memory");
            const unsigned og = xb_add(&bar[XB_TOP], 1u);
            const unsigned tg = og / nx;
            if (og + 1u == (tg + 1u) * nx) xb_add(&bar[XB_TOPGEN], 1u);
            else XB_SPIN(xb_ld(&bar[XB_TOPGEN]) == tg, bar);
            __builtin_amdgcn_fence(__ATOMIC_ACQUIRE, "agent");
            xb_add(&bar[XB_XGEN(b.x)], 1u);
            asm volatile("s_waitcnt vmcnt(0)" ::: "memory");
        } else {
            XB_SPIN(xb_ld(&bar[XB_XGEN(b.x)]) == gen, bar);
            __builtin_amdgcn_fence(__ATOMIC_ACQUIRE, "agent");
            asm volatile("s_waitcnt vmcnt(0)" ::: "memory");
        }
    }
    __syncthreads();
}

struct Args { const float* in[24]; float* out; unsigned char* ws; int ph_lo, ph_hi; };
enum { I_X = 0, I_MEM, I_MEMNORM, I_RELBIAS, I_MIXNORM, I_FFNNORM, I_FINALNORM, I_WO, I_WMEMKV, I_AWIN, I_AKVNORM, I_AWUK, I_AWUV,
       I_BWIN, I_BCONVW, I_BCONVB, I_BDTBIAS, I_BALOG, I_BDSKIP, I_BOUTNORM, I_PWQ, I_PSUBK, I_PU, I_PV };

__device__ __forceinline__ u32x4 pack8(const f32x4 v0, const f32x4 v1) {
    u32x4 w; w.x = pg8::cvt_pk_bf16(v0[0], v0[1]); w.y = pg8::cvt_pk_bf16(v0[2], v0[3]); w.z = pg8::cvt_pk_bf16(v1[0], v1[1]); w.w = pg8::cvt_pk_bf16(v1[2], v1[3]); return w;
}
struct EpiPlain {
    static constexpr bool PERM = true, AFTER_DRAIN = false;
    bf16* O; int ld;
    __device__ __forceinline__ void operator()(const f32x4 (&acc)[2][2][4][2], const pg8::Unit& u, int wr, int wc, int fr, int fq) const {
        const int row0 = u.pm * 256 + wr * 64 + fr, col0 = u.pn * 256 + wc * 32 + 8 * fq;
#pragma unroll
        for (int ai = 0; ai < 2; ++ai)
#pragma unroll
            for (int m = 0; m < 4; ++m) { bf16* rowp = O + (size_t)(row0 + ai * 128 + m * 16) * ld + col0;
#pragma unroll
                for (int bj = 0; bj < 2; ++bj) *(u32x4*)(rowp + bj * 128) = pack8(acc[ai][bj][m][0], acc[ai][bj][m][1]); }
    }
};
struct EpiInA {
    static constexpr bool PERM = true, AFTER_DRAIN = false;
    bf16* Q; float* CKV32; bf16* IQ; bf16* QMEM; bf16* IK; float* IW;
    __device__ __forceinline__ void operator()(const f32x4 (&acc)[2][2][4][2], const pg8::Unit& u, int wr, int wc, int fr, int fq) const {
        const int row0 = u.pm * 256 + wr * 64 + fr, cb0 = wc * 32 + 8 * fq, pn = u.pn;
#pragma unroll
        for (int ai = 0; ai < 2; ++ai)
#pragma unroll
            for (int m = 0; m < 4; ++m) { const size_t row = (size_t)(row0 + ai * 128 + m * 16);
#pragma unroll
                for (int bj = 0; bj < 2; ++bj) { const int cb = cb0 + bj * 128; const f32x4 v0 = acc[ai][bj][m][0], v1 = acc[ai][bj][m][1];
                    if (pn < 3) *(u32x4*)(Q + row * 768 + pn * 256 + cb) = pack8(v0, v1);
                    else if (pn == 3) { *(f32x4*)(CKV32 + row * 256 + cb) = v0; *(f32x4*)(CKV32 + row * 256 + cb + 4) = v1; }
                    else if (pn < 6) *(u32x4*)(IQ + row * 512 + (pn - 4) * 256 + cb) = pack8(v0, v1);
                    else if (pn == 6) *(u32x4*)(QMEM + row * 256 + cb) = pack8(v0, v1);
                    else { if (cb < 64) *(u32x4*)(IK + row * 64 + cb) = pack8(v0, v1);
                           else if (cb == 64) { *(f32x4*)(IW + row * 8) = v0; *(f32x4*)(IW + row * 8 + 4) = v1; } } } }
    }
};
struct EpiInB {
    static constexpr bool PERM = true, AFTER_DRAIN = false;
    bf16* Z; bf16* XBC; bf16* QMEM; float* DT;
    __device__ __forceinline__ void operator()(const f32x4 (&acc)[2][2][4][2], const pg8::Unit& u, int wr, int wc, int fr, int fq) const {
        const int row0 = u.pm * 256 + wr * 64 + fr, cb0 = wc * 32 + 8 * fq, pn = u.pn;
#pragma unroll
        for (int ai = 0; ai < 2; ++ai)
#pragma unroll
            for (int m = 0; m < 4; ++m) { const size_t row = (size_t)(row0 + ai * 128 + m * 16);
#pragma unroll
                for (int bj = 0; bj < 2; ++bj) { const int cb = cb0 + bj * 128; const f32x4 v0 = acc[ai][bj][m][0], v1 = acc[ai][bj][m][1];
                    if (pn < 3) *(u32x4*)(Z + row * 768 + pn * 256 + cb) = pack8(v0, v1);
                    else if (pn < 8) *(u32x4*)(XBC + row * 1280 + (pn - 3) * 256 + cb) = pack8(v0, v1);
                    else if (pn == 8) *(u32x4*)(QMEM + row * 256 + cb) = pack8(v0, v1);
                    else if (cb < 16) { *(f32x4*)(DT + row * 16 + cb) = v0; *(f32x4*)(DT + row * 16 + cb + 4) = v1; } } }
    }
};
template <bool RES_BF16> struct EpiResid {
    static constexpr bool PERM = false, AFTER_DRAIN = false;
    const void* RES; bf16* XB; float* SS;
    __device__ __forceinline__ void operator()(const f32x4 (&acc)[2][2][4][2], const pg8::Unit& u, int wr, int wc, int fr, int fq) const {
        const int row0 = u.pm * 256 + wr * 64 + fr, col0 = u.pn * 256 + wc * 32 + 4 * fq;
#pragma unroll
        for (int ai = 0; ai < 2; ++ai) {
            f32x4 r[4][2][2];
#pragma unroll
            for (int m = 0; m < 4; ++m) { const size_t ro = (size_t)(row0 + ai * 128 + m * 16) * 1024 + col0;
#pragma unroll
                for (int bj = 0; bj < 2; ++bj)
#pragma unroll
                    for (int n = 0; n < 2; ++n) {
                        if (RES_BF16) { const u32x2 t = *(const u32x2*)((const bf16*)RES + ro + bj * 128 + n * 16);
                            r[m][bj][n] = (f32x4){__uint_as_float(t.x << 16), __uint_as_float(t.x & 0xffff0000u), __uint_as_float(t.y << 16), __uint_as_float(t.y & 0xffff0000u)}; }
                        else r[m][bj][n] = *(const f32x4*)((const float*)RES + ro + bj * 128 + n * 16); } }
#pragma unroll
            for (int m = 0; m < 4; ++m) { const int row = row0 + ai * 128 + m * 16; const size_t ro = (size_t)row * 1024 + col0; float ss = 0.f;
#pragma unroll
                for (int bj = 0; bj < 2; ++bj)
#pragma unroll
                    for (int n = 0; n < 2; ++n) { const f32x4 o = r[m][bj][n] + acc[ai][bj][m][n];
                        u32x2 w; w.x = cvt_pk_bf16(o[0], o[1]); w.y = cvt_pk_bf16(o[2], o[3]); *(u32x2*)(XB + ro + bj * 128 + n * 16) = w;
                        ss += (o[0] * o[0] + o[1] * o[1]) + (o[2] * o[2] + o[3] * o[3]); }
                { const auto a = __builtin_amdgcn_permlane16_swap(__float_as_uint(ss), __float_as_uint(ss), false, false); ss = __uint_as_float(a[0]) + __uint_as_float(a[1]); }
                { const auto b = __builtin_amdgcn_permlane32_swap(__float_as_uint(ss), __float_as_uint(ss), false, false); ss = __uint_as_float(b[0]) + __uint_as_float(b[1]); }
                if (fq == 0) atomicAdd(SS + row, ss); } }
    }
};
struct EpiPQ {
    static constexpr bool PERM = true, AFTER_DRAIN = false;
    bf16* O; const float* SS;
    __device__ __forceinline__ void operator()(const f32x4 (&acc)[2][2][4][2], const pg8::Unit& u, int wr, int wc, int fr, int fq) const {
        const int row0 = u.pm * 256 + wr * 64 + fr, col0 = u.pn * 256 + wc * 32 + 8 * fq;
#pragma unroll
        for (int ai = 0; ai < 2; ++ai)
#pragma unroll
            for (int m = 0; m < 4; ++m) { const int row = row0 + ai * 128 + m * 16; const float rs = 1.0f / sqrtf(SS[row] * (1.f / 1024.f) + EPS); bf16* rowp = O + (size_t)row * 2048 + col0;
#pragma unroll
                for (int bj = 0; bj < 2; ++bj) *(u32x4*)(rowp + bj * 128) = pack8(acc[ai][bj][m][0] * rs, acc[ai][bj][m][1] * rs); }
    }
};

__device__ __forceinline__ void transpose_item(const float* W, int ldw, int src0, int ncols, bf16* WT, int dst0, LAS float* scr, int item, int lane, const float* kgain = nullptr) {
    const int nblk = (ncols + 31) >> 5, kb = item / nblk, nb = item - kb * nblk, k0 = 64 * kb, n0 = 32 * nb;
    const int nn = n0 + (lane & 31);
#pragma unroll 8
    for (int i = 0; i < 32; ++i) { const int kk = 2 * i + (lane >> 5); const float gk = kgain ? kgain[k0 + kk] : 1.0f; scr[kk * 33 + (lane & 31)] = (nn < ncols) ? W[(size_t)(k0 + kk) * ldw + src0 + nn] * gk : 0.f; }
    LDS_WAIT(); asm volatile("" ::: "memory");
    const int c = lane & 7;
#pragma unroll
    for (int j = 0; j < 4; ++j) { const int n = (lane >> 3) + 8 * j; const LAS float* s = scr + (8 * c) * 33 + n;
        u32x4 o; o.x = cvt_pk_bf16(s[0 * 33], s[1 * 33]); o.y = cvt_pk_bf16(s[2 * 33], s[3 * 33]); o.z = cvt_pk_bf16(s[4 * 33], s[5 * 33]); o.w = cvt_pk_bf16(s[6 * 33], s[7 * 33]);
        if (n0 + n < ncols) *(u32x4*)(WT + (size_t)(dst0 + n0 + n) * 1024 + k0 + 8 * c) = o; }
    LDS_WAIT(); asm volatile("" ::: "memory");
}
__device__ __forceinline__ int titems(int ncols) { return 16 * ((ncols + 31) >> 5); }
__device__ __forceinline__ void rms_row_to_bf16(const float* xrow, const float* g, bf16* orow, int lane) {
    const f32x4* xr = (const f32x4*)xrow + lane; const f32x4* gr = (const f32x4*)g + lane;
    f32x4 v[4]; float s = 0.f;
#pragma unroll
    for (int j = 0; j < 4; ++j) { v[j] = xr[64 * j]; s += (v[j].x * v[j].x + v[j].y * v[j].y) + (v[j].z * v[j].z + v[j].w * v[j].w); }
    const float rstd = 1.0f / sqrtf(wave_sum(s) * (1.f / 1024.f) + EPS);
    u32x2* o8 = (u32x2*)orow + lane;
#pragma unroll
    for (int j = 0; j < 4; ++j) { const f32x4 gg = gr[64 * j]; u32x2 o; o.x = cvt_pk_bf16(v[j].x * rstd * gg.x, v[j].y * rstd * gg.y); o.y = cvt_pk_bf16(v[j].z * rstd * gg.z, v[j].w * rstd * gg.w); o8[64 * j] = o; }
}
__device__ __forceinline__ void rms_rows4_to_bf16(const float* x0, size_t rstride, const float* g, bf16* o0, int lane) {
    f32x4 v[4][4];
#pragma unroll
    for (int i = 0; i < 4; ++i) { const f32x4* xr = (const f32x4*)(x0 + (size_t)i * rstride) + lane;
#pragma unroll
        for (int j = 0; j < 4; ++j) v[i][j] = xr[64 * j]; }
    const f32x4* gr = (const f32x4*)g + lane;
#pragma unroll
    for (int i = 0; i < 4; ++i) { float s = 0.f;
#pragma unroll
        for (int j = 0; j < 4; ++j) s += (v[i][j].x * v[i][j].x + v[i][j].y * v[i][j].y) + (v[i][j].z * v[i][j].z + v[i][j].w * v[i][j].w);
        const float rstd = 1.0f / sqrtf(wave_sum(s) * (1.f / 1024.f) + EPS);
        u32x2* o8 = (u32x2*)(o0 + (size_t)i * rstride) + lane;
#pragma unroll
        for (int j = 0; j < 4; ++j) { const f32x4 gg = gr[64 * j]; u32x2 o; o.x = cvt_pk_bf16(v[i][j].x * rstd * gg.x, v[i][j].y * rstd * gg.y); o.y = cvt_pk_bf16(v[i][j].z * rstd * gg.z, v[i][j].w * rstd * gg.w); o8[64 * j] = o; } }
}
__device__ __forceinline__ void rms_row_to_f32(const float* xrow, const float* g, float* orow, int lane) {
    const f32x4* xr = (const f32x4*)xrow + lane; const f32x4* gr = (const f32x4*)g + lane;
    f32x4 v[4]; float s = 0.f;
#pragma unroll
    for (int j = 0; j < 4; ++j) { v[j] = xr[64 * j]; s += (v[j].x * v[j].x + v[j].y * v[j].y) + (v[j].z * v[j].z + v[j].w * v[j].w); }
    const float rstd = 1.0f / sqrtf(wave_sum(s) * (1.f / 1024.f) + EPS);
    f32x4* o = (f32x4*)orow + lane;
#pragma unroll
    for (int j = 0; j < 4; ++j) { const f32x4 gg = gr[64 * j]; o[64 * j] = v[j] * rstd * gg; }
}
__device__ __forceinline__ void cvt_stream(const float* src, bf16* dst, size_t n, size_t gtid, size_t gthreads) {
    for (size_t i = gtid * 8; i < n; i += gthreads * 8) { const f32x4 a = *(const f32x4*)(src + i), b = *(const f32x4*)(src + i + 4); *(u32x4*)(dst + i) = pack8(a, b); }
}

__device__ __forceinline__ void memattn_unit(LAS unsigned char* lds, int unit, int layer, const bf16* KV, const bf16* QMEM, bf16* MIX, int tid, int wave, int lane) {
    const int b = unit >> 6, qb = (unit >> 2) & 15, hd = unit & 3;
    const bf16* kvb = KV + (size_t)(b * 256) * 1024 + layer * 512 + hd * 64;
    LAS unsigned char* Ks = lds; LAS unsigned char* Vt = lds + 36864;
    for (int idx = tid; idx < 2048; idx += NTHR) { const int key = idx >> 3, ch = idx & 7;
        const u32x4 kk = *(const u32x4*)(kvb + (size_t)key * 1024 + ch * 8);
        *(LAS u32x4*)(Ks + key * 144 + ch * 16) = kk;
        const u32x4 vv = *(const u32x4*)(kvb + 256 + (size_t)key * 1024 + ch * 8);
#pragma unroll
        for (int e = 0; e < 4; ++e) { const unsigned w = vv[e];
            *(LAS unsigned short*)(Vt + (ch * 8 + 2 * e) * 520 + key * 2) = (unsigned short)(w & 0xffffu);
            *(LAS unsigned short*)(Vt + (ch * 8 + 2 * e + 1) * 520 + key * 2) = (unsigned short)(w >> 16); } }
    __syncthreads();
    const int q = lane & 31, hh = lane >> 5;
    const size_t t = (size_t)b * SEQ + qb * 256 + wave * 32 + q;
    bf16x8 qf[4];
#pragma unroll
    for (int ks = 0; ks < 4; ++ks) qf[ks] = *(const bf16x8*)(QMEM + t * 256 + hd * 64 + ks * 16 + hh * 8);
    f32x16 s[8];
#pragma unroll
    for (int kt = 0; kt < 8; ++kt) {
#pragma unroll
        for (int r = 0; r < 16; ++r) s[kt][r] = 0.f;
#pragma unroll
        for (int ks = 0; ks < 4; ++ks) { const bf16x8 a = *(const LAS bf16x8*)(Ks + (kt * 32 + q) * 144 + (ks * 16 + hh * 8) * 2);
            s[kt] = __builtin_amdgcn_mfma_f32_32x32x16_bf16(a, qf[ks], s[kt], 0, 0, 0); } }
    float mx = -3.0e38f;
#pragma unroll
    for (int kt = 0; kt < 8; ++kt)
#pragma unroll
        for (int r = 0; r < 16; ++r) mx = fmaxf(mx, s[kt][r]);
    mx = fmaxf(mx, __shfl_xor(mx, 32));
    float l = 0.f;
#pragma unroll
    for (int kt = 0; kt < 8; ++kt)
#pragma unroll
        for (int r = 0; r < 16; ++r) { const float p = __expf((s[kt][r] - mx) * 0.125f); s[kt][r] = p; l += p; }
    l += __shfl_xor(l, 32);
    f32x16 o[2];
#pragma unroll
    for (int dt = 0; dt < 2; ++dt)
#pragma unroll
        for (int r = 0; r < 16; ++r) o[dt][r] = 0.f;
#pragma unroll
    for (int kt = 0; kt < 8; ++kt)
#pragma unroll
        for (int si = 0; si < 2; ++si) {
            union { bf16x8 v; unsigned u[4]; } pb;
#pragma unroll
            for (int e = 0; e < 4; ++e) pb.u[e] = cvt_pk_bf16(s[kt][8 * si + 2 * e], s[kt][8 * si + 2 * e + 1]);
#pragma unroll
            for (int dt = 0; dt < 2; ++dt) { const LAS unsigned char* vp = Vt + (dt * 32 + q) * 520 + (kt * 32 + 16 * si + 4 * hh) * 2;
                union { bf16x8 v; u32x2 h[2]; } va; va.h[0] = *(const LAS u32x2*)vp; va.h[1] = *(const LAS u32x2*)(vp + 16);
                o[dt] = __builtin_amdgcn_mfma_f32_32x32x16_bf16(va.v, pb.v, o[dt], 0, 0, 0); } }
    const float inv = 1.0f / l;
#pragma unroll
    for (int dt = 0; dt < 2; ++dt)
#pragma unroll
        for (int g = 0; g < 4; ++g) { u32x2 w; w.x = cvt_pk_bf16(o[dt][4 * g] * inv, o[dt][4 * g + 1] * inv); w.y = cvt_pk_bf16(o[dt][4 * g + 2] * inv, o[dt][4 * g + 3] * inv);
            *(u32x2*)(MIX + t * 1024 + 768 + hd * 64 + dt * 32 + 8 * g + 4 * hh) = w; }
    __syncthreads();
}

constexpr int SS_ACS = 0, SS_DTV = 6144, SS_WW = 12288, SS_XS = 18432;
constexpr int SS_BT = SS_XS + 6 * 64 * 272;
static_assert(SS_BT + 128 * 272 <= LDS_SCR_BYTES, "SSD LDS map");

__device__ __forceinline__ float softplus_f(float x) { return fmaxf(x, 0.f) + log1pf(__expf(-fabsf(x))); }
__device__ __forceinline__ float silu_f(float v) { return v / (1.0f + __expf(-v)); }

__device__ __forceinline__ void ssd_chunk_scalars(LAS unsigned char* lds, const float* DT, size_t t0, const float* dt_bias, const float* a_log, float* dec, int wave, int lane) {
    LAS float* ACS = (LAS float*)(lds + SS_ACS); LAS float* DTV = (LAS float*)(lds + SS_DTV); LAS float* WW = (LAS float*)(lds + SS_WW);
    for (int h = wave; h < 12; h += NWAVES) {
        const float bias = dt_bias[h], a = -__expf(a_log[h]);
        const float d0 = softplus_f(DT[(t0 + 2 * lane) * 16 + h] + bias), d1 = softplus_f(DT[(t0 + 2 * lane + 1) * 16 + h] + bias);
        const float da0 = d0 * a, da1 = d1 * a;
        float v = da0 + da1;
#pragma unroll
        for (int o = 1; o < 64; o <<= 1) { const float t = __shfl_up(v, o); if (lane >= o) v += t; }
        const float total = __shfl(v, 63);
        const float c1 = v, c0 = v - da1;
        ACS[h * 128 + 2 * lane] = c0; ACS[h * 128 + 2 * lane + 1] = c1;
        DTV[h * 128 + 2 * lane] = d0; DTV[h * 128 + 2 * lane + 1] = d1;
        WW[h * 128 + 2 * lane] = __expf(total - c0) * d0; WW[h * 128 + 2 * lane + 1] = __expf(total - c1) * d1;
        if (dec != nullptr && lane == 0) dec[h] = __expf(total);
    }
}

__device__ __forceinline__ void ssd_states_unit(LAS unsigned char* lds, int unit, const bf16* XBC, const float* DT, const float* conv_w, const float* conv_b,
                                                const float* dt_bias, const float* a_log, bf16* XC, bf16* STATES, float* DEC, int tid, int wave, int lane) {
    const int b = unit >> 5, c = unit & 31; const size_t t0 = (size_t)b * SEQ + c * 128;
    __syncthreads();
    ssd_chunk_scalars(lds, DT, t0, dt_bias, a_log, DEC + (size_t)unit * 12, wave, lane);
    __syncthreads();
    const LAS float* WW = (const LAS float*)(lds + SS_WW);
    const int q = lane & 31, hh = lane >> 5;
    for (int g = 0; g < 2; ++g) {
        for (int idx = tid; idx < 1280; idx += NTHR) {
            const int cg = idx % 80, tg = idx / 80;
            const int col = cg < 48 ? g * 384 + cg * 8 : (cg < 64 ? 768 + g * 128 + (cg - 48) * 8 : 1024 + g * 128 + (cg - 64) * 8);
            float w[4][8], bs[8];
#pragma unroll
            for (int j = 0; j < 4; ++j) { const f32x4 a = *(const f32x4*)(conv_w + j * 1280 + col), bb = *(const f32x4*)(conv_w + j * 1280 + col + 4);
                w[j][0] = a.x; w[j][1] = a.y; w[j][2] = a.z; w[j][3] = a.w; w[j][4] = bb.x; w[j][5] = bb.y; w[j][6] = bb.z; w[j][7] = bb.w; }
            { const f32x4 a = *(const f32x4*)(conv_b + col), bb = *(const f32x4*)(conv_b + col + 4); bs[0] = a.x; bs[1] = a.y; bs[2] = a.z; bs[3] = a.w; bs[4] = bb.x; bs[5] = bb.y; bs[6] = bb.z; bs[7] = bb.w; }
            u32x4 rows[11];
#pragma unroll
            for (int i = 0; i < 11; ++i) { const int lt = tg * 8 - 3 + i;
                rows[i] = (c * 128 + lt >= 0) ? *(const u32x4*)(XBC + (t0 + lt) * 1280 + col) : (u32x4){0u, 0u, 0u, 0u}; }
            float o[8][8];
#pragma unroll
            for (int tt = 0; tt < 8; ++tt)
#pragma unroll
                for (int e = 0; e < 8; ++e) { float acc = bs[e];
#pragma unroll
                    for (int j = 0; j < 4; ++j) { const unsigned wd = rows[tt + j][e >> 1]; const float xv = (e & 1) ? __uint_as_float(wd & 0xffff0000u) : __uint_as_float(wd << 16); acc += w[j][e] * xv; }
                    o[tt][e] = silu_f(acc); }
#pragma unroll
            for (int tt = 0; tt < 8; ++tt) { u32x4 pk; pk.x = pg8::cvt_pk_bf16(o[tt][0], o[tt][1]); pk.y = pg8::cvt_pk_bf16(o[tt][2], o[tt][3]); pk.z = pg8::cvt_pk_bf16(o[tt][4], o[tt][5]); pk.w = pg8::cvt_pk_bf16(o[tt][6], o[tt][7]);
                *(u32x4*)(XC + (t0 + tg * 8 + tt) * 1280 + col) = pk; }
            if (cg < 48) {
                const int hl = cg >> 3, h = g * 6 + hl;
                float ws8[8];
#pragma unroll
                for (int tt = 0; tt < 8; ++tt) ws8[tt] = WW[h * 128 + tg * 8 + tt];
#pragma unroll
                for (int e = 0; e < 8; ++e) { u32x4 pk; pk.x = pg8::cvt_pk_bf16(o[0][e] * ws8[0], o[1][e] * ws8[1]); pk.y = pg8::cvt_pk_bf16(o[2][e] * ws8[2], o[3][e] * ws8[3]);
                    pk.z = pg8::cvt_pk_bf16(o[4][e] * ws8[4], o[5][e] * ws8[5]); pk.w = pg8::cvt_pk_bf16(o[6][e] * ws8[6], o[7][e] * ws8[7]);
                    *(LAS u32x4*)(lds + SS_XS + (cg * 8 + e) * 272 + tg * 16) = pk; }
            } else if (cg < 64) {
#pragma unroll
                for (int e = 0; e < 8; ++e) { u32x4 pk; pk.x = pg8::cvt_pk_bf16(o[0][e], o[1][e]); pk.y = pg8::cvt_pk_bf16(o[2][e], o[3][e]); pk.z = pg8::cvt_pk_bf16(o[4][e], o[5][e]); pk.w = pg8::cvt_pk_bf16(o[6][e], o[7][e]);
                    *(LAS u32x4*)(lds + SS_BT + ((cg - 48) * 8 + e) * 272 + tg * 16) = pk; }
            }
        }
        __syncthreads();
        const int pt = wave >> 2, nt = wave & 3;
#pragma unroll 1
        for (int hl = 0; hl < 6; ++hl) {
            f32x16 acc;
#pragma unroll
            for (int r = 0; r < 16; ++r) acc[r] = 0.f;
#pragma unroll
            for (int ks = 0; ks < 8; ++ks) {
                const bf16x8 a = *(const LAS bf16x8*)(lds + SS_XS + (hl * 64 + pt * 32 + q) * 272 + (ks * 16 + hh * 8) * 2);
                const bf16x8 bb = *(const LAS bf16x8*)(lds + SS_BT + (nt * 32 + q) * 272 + (ks * 16 + hh * 8) * 2);
                acc = __builtin_amdgcn_mfma_f32_32x32x16_bf16(a, bb, acc, 0, 0, 0); }
            bf16* st = STATES + ((size_t)unit * 12 + g * 6 + hl) * 8192 + nt * 32 + q;
#pragma unroll
            for (int r = 0; r < 16; ++r) { const int p = pt * 32 + (r & 3) + 8 * (r >> 2) + 4 * hh; st[p * 128] = (bf16)(cvt_pk_bf16(acc[r], 0.f) & 0xffffu); }
        }
        __syncthreads();
    }
}

__device__ __forceinline__ void ssd_scan(bf16* STATES, const float* DEC, size_t gtid, size_t gthreads) {
    for (size_t i = gtid; i < (size_t)BATCH * 12 * 64 * 16; i += gthreads) {
        const int b = (int)(i / (12 * 64 * 16)); const int rem = (int)(i - (size_t)b * (12 * 64 * 16)); const int h = rem / 1024, pn = rem - h * 1024;
        float hs[8];
#pragma unroll
        for (int e = 0; e < 8; ++e) hs[e] = 0.f;
        bf16* base = STATES + ((size_t)b * 32 * 12 + h) * 8192 + (size_t)pn * 8;
#pragma unroll 4
        for (int c = 0; c < 32; ++c) {
            bf16* p = base + (size_t)c * 12 * 8192;
            const u32x4 sv = *(const u32x4*)p; const float dc = DEC[(b * 32 + c) * 12 + h];
            u32x4 ov; ov.x = cvt_pk_bf16(hs[0], hs[1]); ov.y = cvt_pk_bf16(hs[2], hs[3]); ov.z = cvt_pk_bf16(hs[4], hs[5]); ov.w = cvt_pk_bf16(hs[6], hs[7]);
            *(u32x4*)p = ov;
#pragma unroll
            for (int e = 0; e < 4; ++e) { hs[2 * e] = hs[2 * e] * dc + __uint_as_float(sv[e] << 16); hs[2 * e + 1] = hs[2 * e + 1] * dc + __uint_as_float(sv[e] & 0xffff0000u); }
        }
    }
}

__device__ __forceinline__ void ssd_out_unit(LAS unsigned char* lds, int unit, const bf16* XC, const float* DT, const bf16* Z, const bf16* HPREV, const float* dt_bias, const float* a_log,
                                             const float* d_skip, const float* out_norm, bf16* Y, bf16* MIX, int tid, int wave, int lane) {
    const int b = unit >> 5, c = unit & 31; const size_t t0 = (size_t)b * SEQ + c * 128;
    __syncthreads();
    ssd_chunk_scalars(lds, DT, t0, dt_bias, a_log, nullptr, wave, lane);
    const LAS float* ACS = (const LAS float*)(lds + SS_ACS); const LAS float* DTV = (const LAS float*)(lds + SS_DTV);
    const int q = lane & 31, hh = lane >> 5, lt = wave >> 1, pt = wave & 1;
    const bf16* hp = HPREV + (size_t)unit * 12 * 8192;
    unsigned dmask = 0u;
#pragma unroll
    for (int r = 0; r < 16; ++r) dmask |= (((r & 3) + 8 * (r >> 2) + 4 * hh) <= q) ? (1u << r) : 0u;
    for (int g = 0; g < 2; ++g) {
        __syncthreads();
        for (int idx = tid; idx < 768; idx += NTHR) { const int cg = idx % 48, tg = idx / 48;
            u32x4 rows[8];
#pragma unroll
            for (int i = 0; i < 8; ++i) rows[i] = *(const u32x4*)(XC + (t0 + tg * 8 + i) * 1280 + g * 384 + cg * 8);
#pragma unroll
            for (int e = 0; e < 8; ++e) { u32x4 pk;
#pragma unroll
                for (int k2 = 0; k2 < 4; ++k2) { const unsigned lo = rows[2 * k2][e >> 1], hi2 = rows[2 * k2 + 1][e >> 1];
                    pk[k2] = (e & 1) ? ((lo >> 16) | (hi2 & 0xffff0000u)) : ((lo & 0xffffu) | (hi2 << 16)); }
                *(LAS u32x4*)(lds + SS_XS + (cg * 8 + e) * 272 + tg * 16) = pk; } }
        bf16x8 cf[8];
#pragma unroll
        for (int ks = 0; ks < 8; ++ks) cf[ks] = *(const bf16x8*)(XC + (t0 + lt * 32 + q) * 1280 + 1024 + g * 128 + ks * 16 + hh * 8);
        f32x16 cb[4];
#pragma unroll
        for (int st = 0; st < 4; ++st) {
#pragma unroll
            for (int r = 0; r < 16; ++r) cb[st][r] = 0.f;
            if (st <= lt) {
#pragma unroll
                for (int ks = 0; ks < 8; ++ks) { const bf16x8 a = *(const bf16x8*)(XC + (t0 + st * 32 + q) * 1280 + 768 + g * 128 + ks * 16 + hh * 8);
                    cb[st] = __builtin_amdgcn_mfma_f32_32x32x16_bf16(a, cf[ks], cb[st], 0, 0, 0); } } }
        __syncthreads();
#pragma unroll 1
        for (int hl = 0; hl < 6; ++hl) {
            const int h = g * 6 + hl;
            f32x16 yd, yo;
#pragma unroll
            for (int r = 0; r < 16; ++r) { yd[r] = 0.f; yo[r] = 0.f; }
            const int l = lt * 32 + q; const float al = ACS[h * 128 + l];
#pragma unroll
            for (int st = 0; st < 4; ++st) {
                if (st <= lt) {
                    float mm[16];
#pragma unroll
                    for (int r = 0; r < 16; ++r) { const int s = st * 32 + (r & 3) + 8 * (r >> 2) + 4 * hh;
                        const float v = cb[st][r] * __expf(al - ACS[h * 128 + s]) * DTV[h * 128 + s]; mm[r] = (st < lt || ((dmask >> r) & 1u)) ? v : 0.f; }
#pragma unroll
                    for (int si = 0; si < 2; ++si) {
                        union { bf16x8 v; unsigned u[4]; } af;
#pragma unroll
                        for (int e = 0; e < 4; ++e) af.u[e] = cvt_pk_bf16(mm[8 * si + 2 * e], mm[8 * si + 2 * e + 1]);
                        const LAS unsigned char* xp = lds + SS_XS + (hl * 64 + pt * 32 + q) * 272 + (st * 32 + 16 * si + 4 * hh) * 2;
                        union { bf16x8 v; u32x2 hv[2]; } xb; xb.hv[0] = *(const LAS u32x2*)xp; xb.hv[1] = *(const LAS u32x2*)(xp + 16);
                        yd = __builtin_amdgcn_mfma_f32_32x32x16_bf16(af.v, xb.v, yd, 0, 0, 0); } } }
#pragma unroll
            for (int ks = 0; ks < 8; ++ks) { const bf16x8 hb = *(const bf16x8*)(hp + (size_t)h * 8192 + (pt * 32 + q) * 128 + ks * 16 + hh * 8);
                yo = __builtin_amdgcn_mfma_f32_32x32x16_bf16(cf[ks], hb, yo, 0, 0, 0); }
            const float dsk = d_skip[h];
#pragma unroll
            for (int qd = 0; qd < 4; ++qd) { const int l0 = lt * 32 + 8 * qd + 4 * hh;
                const u32x2 xv = *(const LAS u32x2*)(lds + SS_XS + (hl * 64 + pt * 32 + q) * 272 + l0 * 2);
#pragma unroll
                for (int e = 0; e < 4; ++e) { const int r = 4 * qd + e; const unsigned wd = xv[e >> 1]; const float xs = (e & 1) ? __uint_as_float(wd & 0xffff0000u) : __uint_as_float(wd << 16);
                    const float yv = yd[r] + __expf(ACS[h * 128 + l0 + e]) * yo[r] + xs * dsk;
                    Y[(t0 + l0 + e) * 768 + h * 64 + pt * 32 + q] = (bf16)(cvt_pk_bf16(yv, 0.f) & 0xffffu); } }
        }
    }
    VM_WAIT(); __syncthreads();
    __builtin_amdgcn_fence(__ATOMIC_ACQUIRE, "agent"); VM_WAIT();
    for (int t4 = wave * 16; t4 < wave * 16 + 16; t4 += 4) {
        u32x2 yv[4][3], zv[4][3];
#pragma unroll
        for (int k = 0; k < 4; ++k)
#pragma unroll
            for (int j = 0; j < 3; ++j) { const size_t t = t0 + t4 + k; yv[k][j] = *(const u32x2*)(Y + t * 768 + j * 256 + lane * 4); zv[k][j] = *(const u32x2*)(Z + t * 768 + j * 256 + lane * 4); }
#pragma unroll
        for (int k = 0; k < 4; ++k) { const size_t t = t0 + t4 + k;
            float v[12]; float ss = 0.f;
#pragma unroll
            for (int j = 0; j < 3; ++j)
#pragma unroll
                for (int e = 0; e < 4; ++e) { const unsigned yw = yv[k][j][e >> 1], zw = zv[k][j][e >> 1];
                    const float yy = (e & 1) ? __uint_as_float(yw & 0xffff0000u) : __uint_as_float(yw << 16), zz = (e & 1) ? __uint_as_float(zw & 0xffff0000u) : __uint_as_float(zw << 16);
                    const float x = yy * silu_f(zz); v[4 * j + e] = x; ss += x * x; }
            const float rstd = 1.0f / sqrtf(wave_sum(ss) * (1.f / 768.f) + EPS);
#pragma unroll
            for (int j = 0; j < 3; ++j) { const f32x4 gg = *(const f32x4*)(out_norm + j * 256 + lane * 4);
                u32x2 o; o.x = cvt_pk_bf16(v[4 * j] * rstd * gg.x, v[4 * j + 1] * rstd * gg.y); o.y = cvt_pk_bf16(v[4 * j + 2] * rstd * gg.z, v[4 * j + 3] * rstd * gg.w);
                *(u32x2*)(MIX + t * 1024 + j * 256 + lane * 4) = o; } } }
}

constexpr int DS_IKL = 145408;
constexpr int DS_SC = 0, DS_IMG = 0, DS_IMG_W = 32 * 528, DS_QL = 0, DS_SEL = 8 * DS_IMG_W, DS_RB = DS_SEL + 8192, DS_END = DS_RB + 2048;
static_assert(DS_SEL >= 8 * 4096 * 4 && DS_END <= DS_IKL && DS_IKL + 16384 <= LDS_SCR_BYTES, "DSA LDS map");
typedef short s16x4 __attribute__((ext_vector_type(4)));

__device__ __forceinline__ int t5_bucket(int n) {
    if (n < 16) return n;
    const float v = logf((float)n / 16.0f) / 2.0794415416798357f * 16.0f;
    const int l = 16 + (int)v; return l < 31 ? l : 31;
}
__device__ __forceinline__ unsigned sortable_u32(float f) { const unsigned b = __float_as_uint(f); return b ^ ((unsigned)((int)b >> 31) | 0x80000000u); }
__device__ __forceinline__ unsigned mbcnt64(unsigned long long m) { return __builtin_amdgcn_mbcnt_hi((unsigned)(m >> 32), __builtin_amdgcn_mbcnt_lo((unsigned)m, 0u)); }
__device__ __forceinline__ unsigned wave_sum_u32(unsigned x) {
    x += (unsigned)__builtin_amdgcn_update_dpp(0, (int)x, 0xB1, 0xf, 0xf, false);
    x += (unsigned)__builtin_amdgcn_update_dpp(0, (int)x, 0x4E, 0xf, 0xf, false);
    x += (unsigned)__builtin_amdgcn_update_dpp(0, (int)x, 0x141, 0xf, 0xf, false);
    x += (unsigned)__builtin_amdgcn_update_dpp(0, (int)x, 0x140, 0xf, 0xf, false);
    { const auto a = __builtin_amdgcn_permlane16_swap(x, x, false, false); x = a[0] + a[1]; }
    { const auto b = __builtin_amdgcn_permlane32_swap(x, x, false, false); x = b[0] + b[1]; }
    return x;
}
__device__ __forceinline__ float kg_max(float v) {
    { const auto a = __builtin_amdgcn_permlane16_swap(__float_as_uint(v), __float_as_uint(v), false, false); v = fmaxf(__uint_as_float(a[0]), __uint_as_float(a[1])); }
    { const auto b = __builtin_amdgcn_permlane32_swap(__float_as_uint(v), __float_as_uint(v), false, false); v = fmaxf(__uint_as_float(b[0]), __uint_as_float(b[1])); }
    return v;
}
#define CNT_GE(cnt, uu, cand) asm volatile("v_cmp_ge_u32 vcc, %1, %2\n\tv_addc_co_u32 %0, vcc, 0, %0, vcc" : "+v"(cnt) : "v"(uu), "v"(cand) : "vcc")
#define CNT_GT(cnt, uu, cand) asm volatile("v_cmp_gt_u32 vcc, %1, %2\n\tv_addc_co_u32 %0, vcc, 0, %0, vcc" : "+v"(cnt) : "v"(uu), "v"(cand) : "vcc")
__device__ __forceinline__ float wave_min_f32(float x) {
    x = fminf(x, __uint_as_float((unsigned)__builtin_amdgcn_update_dpp(0, (int)__float_as_uint(x), 0xB1, 0xf, 0xf, false)));
    x = fminf(x, __uint_as_float((unsigned)__builtin_amdgcn_update_dpp(0, (int)__float_as_uint(x), 0x4E, 0xf, 0xf, false)));
    x = fminf(x, __uint_as_float((unsigned)__builtin_amdgcn_update_dpp(0, (int)__float_as_uint(x), 0x141, 0xf, 0xf, false)));
    x = fminf(x, __uint_as_float((unsigned)__builtin_amdgcn_update_dpp(0, (int)__float_as_uint(x), 0x140, 0xf, 0xf, false)));
    { const auto a = __builtin_amdgcn_permlane16_swap(__float_as_uint(x), __float_as_uint(x), false, false); x = fminf(__uint_as_float(a[0]), __uint_as_float(a[1])); }
    { const auto b = __builtin_amdgcn_permlane32_swap(__float_as_uint(x), __float_as_uint(x), false, false); x = fminf(__uint_as_float(b[0]), __uint_as_float(b[1])); }
    return x;
}
__device__ __forceinline__ float wave_max_f32(float x) {
    x = fmaxf(x, __uint_as_float((unsigned)__builtin_amdgcn_update_dpp(0, (int)__float_as_uint(x), 0xB1, 0xf, 0xf, false)));
    x = fmaxf(x, __uint_as_float((unsigned)__builtin_amdgcn_update_dpp(0, (int)__float_as_uint(x), 0x4E, 0xf, 0xf, false)));
    x = fmaxf(x, __uint_as_float((unsigned)__builtin_amdgcn_update_dpp(0, (int)__float_as_uint(x), 0x141, 0xf, 0xf, false)));
    x = fmaxf(x, __uint_as_float((unsigned)__builtin_amdgcn_update_dpp(0, (int)__float_as_uint(x), 0x140, 0xf, 0xf, false)));
    { const auto a = __builtin_amdgcn_permlane16_swap(__float_as_uint(x), __float_as_uint(x), false, false); x = fmaxf(__uint_as_float(a[0]), __uint_as_float(a[1])); }
    { const auto b = __builtin_amdgcn_permlane32_swap(__float_as_uint(x), __float_as_uint(x), false, false); x = fmaxf(__uint_as_float(b[0]), __uint_as_float(b[1])); }
    return x;
}
__device__ __forceinline__ f32x4 mfma16(bf16x8 a, bf16x8 b, f32x4 c) { return __builtin_amdgcn_mfma_f32_16x16x32_bf16(a, b, c, 0, 0, 0); }

__device__ __forceinline__ void dsa_unit(LAS unsigned char* lds, int unit, bf16* QL, const bf16* CKV, const bf16* IQ, const bf16* IK, const float* IW, int tid, int wave, int lane_in) {
    const int lane = lane_in;
    const int b = unit & 7, qb = unit >> 3, t0 = qb * 8; const size_t tok0 = (size_t)b * SEQ + t0;
    LAS float* SC = (LAS float*)(lds + DS_SC); LAS unsigned* SEL = (LAS unsigned*)(lds + DS_SEL); const LAS float* RB = (const LAS float*)(lds + DS_RB);
    __syncthreads();
    for (int _ra = 0; _ra <= (DSA_PROBE & 1); ++_ra) {
        int lnA = lane; asm volatile("" : "+v"(lnA));
        int tid_a = tid; asm volatile("" : "+v"(tid_a));
        const int mt = wave & 1, q = lnA & 31, hh = lnA >> 5;
        const int qi = 4 * mt + 2 * ((q >> 2) & 1) + (q >> 4), hi = ((q >> 3) & 1) * 4 + (q & 3);
        bf16x8 af[4];
#pragma unroll
        for (int ks = 0; ks < 4; ++ks) af[ks] = *(const bf16x8*)(IQ + (tok0 + qi) * 512 + hi * 64 + ks * 16 + hh * 8);
        float wv[16];
        { const f32x4 a0 = *(const f32x4*)(IW + (tok0 + 4 * mt + 2 * hh) * 8), a1 = *(const f32x4*)(IW + (tok0 + 4 * mt + 2 * hh) * 8 + 4);
          const f32x4 b0 = *(const f32x4*)(IW + (tok0 + 4 * mt + 2 * hh + 1) * 8), b1 = *(const f32x4*)(IW + (tok0 + 4 * mt + 2 * hh + 1) * 8 + 4);
#pragma unroll
          for (int e = 0; e < 4; ++e) { wv[e] = a0[e]; wv[4 + e] = a1[e]; wv[8 + e] = b0[e]; wv[12 + e] = b1[e]; } }
        const int nkt = (t0 + 8 + 31) >> 5, ngr = (nkt + 3) >> 2;
        LAS unsigned char* IKL = lds + DS_IKL;
        const u32x4* ikg = (const u32x4*)(IK + (size_t)b * SEQ * 64) + tid_a;
        const int st0 = (tid_a >> 3) * 128 + (((tid_a & 7) ^ ((tid_a >> 3) & 7)) << 4), st1 = st0 + 64 * 128;
        const int jt = wave >> 1;
        const int rd0 = (jt * 32 + q) * 128; const int rx = (jt * 32 + q) & 7;
        u32x4 g0 = ikg[0], g1 = ikg[512];
#pragma unroll 1
        for (int g = 0; g < ngr; ++g) {
            __syncthreads();
            *(LAS u32x4*)(IKL + st0) = g0; *(LAS u32x4*)(IKL + st1) = g1;
            __syncthreads();
            if (g + 1 < ngr) { g0 = ikg[(size_t)(g + 1) * 1024]; g1 = ikg[(size_t)(g + 1) * 1024 + 512]; }
            const int kt = g * 4 + jt;
            if (kt < nkt) {
                f32x16 acc;
#pragma unroll
                for (int r = 0; r < 16; ++r) acc[r] = 0.f;
#pragma unroll
                for (int ks = 0; ks < 4; ++ks) { const bf16x8 bf = *(const LAS bf16x8*)(IKL + rd0 + (((2 * ks + hh) ^ rx) << 4)); acc = __builtin_amdgcn_mfma_f32_32x32x16_bf16(af[ks], bf, acc, 0, 0, 0); }
                float s0 = 0.f, s1 = 0.f;
#pragma unroll
                for (int r = 0; r < 8; ++r) { s0 += wv[r] * fmaxf(acc[r], 0.f); s1 += wv[8 + r] * fmaxf(acc[8 + r], 0.f); }
                const int key = kt * 32 + q;
                SC[(4 * mt + 2 * hh) * 4096 + key] = s0; SC[(4 * mt + 2 * hh + 1) * 4096 + key] = s1; }
        }
    }
    __syncthreads();
    int lnD = lane_in; asm volatile("" : "+v"(lnD));
    const int fr = lnD & 15, kg = lnD >> 4;
    bf16x8 ql[8];
#pragma unroll
    for (int ks = 0; ks < 8; ++ks) ql[ks] = (fr < 12) ? *(const bf16x8*)(QL + ((tok0 + wave) * 12 + fr) * 256 + ks * 32 + kg * 8) : (bf16x8){0, 0, 0, 0, 0, 0, 0, 0};
    const int t = t0 + wave, n = t + 1; const int nsel = n < 256 ? n : 256;
    for (int _rb = 0; _rb <= ((DSA_PROBE >> 1) & 1); ++_rb) {
        int lane = lane_in; asm volatile("" : "+v"(lane));
        LAS unsigned* selw = SEL + wave * 256;
        if (n <= 256) {
            for (int i = lane; i < n; i += 64) selw[i] = (unsigned)i | ((unsigned)t5_bucket(t - i) << 16);
        } else {
            const LAS float* sc = SC + wave * 4096;
            const int ni = (n + 63) >> 6;
            float f[64];
#pragma unroll
            for (int i = 0; i < 64; ++i) f[i] = sc[64 * i + lane];
#pragma unroll
            for (int i = 0; i < 64; ++i) { const int s = 64 * i + lane; f[i] = (s < n) ? f[i] + 0.f : -3.0e38f; }
            float lo, hi, T = 0.f; bool conv = false; unsigned clast = 0u;
            { float m0 = -3.0e38f, m1 = -3.0e38f, m2 = -3.0e38f, m3 = -3.0e38f;
#pragma unroll
              for (int g4 = 0; g4 < 4; ++g4) if (ni > 16 * g4) {
#pragma unroll
                  for (int i = 16 * g4; i < 16 * g4 + 16; i += 4) { m0 = fmaxf(m0, f[i]); m1 = fmaxf(m1, f[i + 1]); m2 = fmaxf(m2, f[i + 2]); m3 = fmaxf(m3, f[i + 3]); } }
              lo = wave_min_f32(fminf(fminf(m0, m1), fminf(m2, m3))); hi = wave_max_f32(fmaxf(fmaxf(m0, m1), fmaxf(m2, m3))); }
#pragma unroll 1
            for (int it = 0; it < 26; ++it) {
                const float mid = 0.5f * lo + 0.5f * hi; unsigned cl = 0u;
#pragma unroll
                for (int g4 = 0; g4 < 4; ++g4) if (ni > 16 * g4) {
#pragma unroll
                    for (int i = 16 * g4; i < 16 * g4 + 16; ++i) asm volatile("v_cmp_ge_f32 vcc, %1, %2\n\tv_addc_co_u32 %0, vcc, 0, %0, vcc" : "+v"(cl) : "v"(f[i]), "v"(mid) : "vcc"); }
                asm volatile("s_nop 1" ::: "memory");
                const unsigned cnt = (unsigned)__builtin_amdgcn_readfirstlane((int)wave_sum_u32(cl));
                if (cnt == 256u) { T = mid; conv = true; clast = cl; break; }
                if (cnt > 256u) lo = mid; else hi = mid;
            }
            if (!conv) {
                unsigned Tu = 0u;
#pragma unroll 1
                for (int bit = 31; bit >= 0; --bit) {
                    const unsigned cand = Tu | (1u << bit); unsigned cl = 0u;
#pragma unroll
                    for (int g4 = 0; g4 < 4; ++g4) if (ni > 16 * g4) {
#pragma unroll
                        for (int i = 16 * g4; i < 16 * g4 + 16; ++i) { const unsigned uu = (f[i] == -3.0e38f) ? 0u : sortable_u32(f[i]); CNT_GE(cl, uu, cand); } }
                    asm volatile("s_nop 1" ::: "memory");
                    const unsigned cnt = (unsigned)__builtin_amdgcn_readfirstlane((int)wave_sum_u32(cl));
                    if (cnt >= 256u) Tu = cand;
                    if (cnt == 256u) break;
                }
                T = __uint_as_float((Tu & 0x80000000u) ? (Tu ^ 0x80000000u) : ~Tu);
            }
            if (conv) {
                unsigned inc = clast;
#pragma unroll
                for (int o = 1; o < 64; o <<= 1) { const unsigned t_ = (unsigned)__shfl_up((int)inc, o); if (lane >= o) inc += t_; }
                unsigned p = inc - clast;
#pragma unroll
                for (int g4 = 0; g4 < 4; ++g4) if (ni > 16 * g4) {
#pragma unroll
                    for (int i = 16 * g4; i < 16 * g4 + 16; ++i) { if (f[i] >= T) { selw[p] = (unsigned)(64 * i + lane); p += 1u; } } }
            } else {
            unsigned G;
            { unsigned gl = 0u;
#pragma unroll
              for (int g4 = 0; g4 < 4; ++g4) if (ni > 16 * g4) {
#pragma unroll
                  for (int i = 16 * g4; i < 16 * g4 + 16; ++i) asm volatile("v_cmp_gt_f32 vcc, %1, %2\n\tv_addc_co_u32 %0, vcc, 0, %0, vcc" : "+v"(gl) : "v"(f[i]), "v"(T) : "vcc"); }
              asm volatile("s_nop 1" ::: "memory");
              G = (unsigned)__builtin_amdgcn_readfirstlane((int)wave_sum_u32(gl)); }
            const unsigned need_eq = 256u - G;
            unsigned pos = 0u, eq_used = 0u;
#pragma unroll
            for (int g4 = 0; g4 < 4; ++g4) if (ni > 16 * g4) {
#pragma unroll
                for (int i = 16 * g4; i < 16 * g4 + 16; ++i) {
                    const bool gt = f[i] > T, eq = f[i] == T;
                    const unsigned long long meq = __ballot(eq);
                    const bool sl = gt || (eq && (eq_used + mbcnt64(meq) < need_eq));
                    const unsigned long long msl = __ballot(sl);
                    if (sl) selw[pos + mbcnt64(msl)] = (unsigned)(64 * i + lane);
                    pos += (unsigned)__popcll(msl); eq_used += (unsigned)__popcll(meq); } }
            }
#pragma unroll 1
            for (int i = lane; i < 256; i += 64) { const unsigned s = selw[i]; selw[i] = s | ((unsigned)t5_bucket(t - (int)s) << 16); }
        }
    }
    __syncthreads();
    f32x4 O[16];
#pragma unroll
    for (int ct = 0; ct < 16; ++ct) O[ct] = (f32x4){0.f, 0.f, 0.f, 0.f};
    float mrun = -3.0e38f, lrun = 0.f;
    for (int _rd = 0; _rd <= ((DSA_PROBE >> 3) & 1); ++_rd) {
        const unsigned rowmask = ((DSA_PROBE & 32) && _rd == 0) ? 0x7ffu : 0xffffu;
        if (_rd) { mrun = -3.0e38f; lrun = 0.f;
_Pragma("unroll") for (int ct = 0; ct < 16; ++ct) O[ct] = (f32x4){0.f, 0.f, 0.f, 0.f}; }
        const LAS unsigned* selw = SEL + wave * 256;
        LAS unsigned char* img = lds + DS_IMG + wave * DS_IMG_W;
        const int nsteps = (nsel + 31) >> 5;
        const int hh2 = lnD >> 5, c32 = lnD & 31; const bf16* ckr = CKV + (size_t)b * SEQ * 256 + c32 * 8;
        bf16x8 b0[8], b1[8], b2[8];
#pragma unroll
        for (int ks = 0; ks < 8; ++ks) { b0[ks] = (bf16x8){0, 0, 0, 0, 0, 0, 0, 0}; b1[ks] = b0[ks]; b2[ks] = b0[ks]; }
        const int ntiles = 2 * nsteps;
#define DSA_GATHER(X, tile) do { _Pragma("unroll") for (int j = 0; j < 8; ++j) { const int k_ = (tile) * 16 + 2 * j + hh2; const unsigned e_ = selw[k_ < nsel ? k_ : nsel - 1]; \
            if (!((DSA_PROBE & 128) && _rd == 0)) X[j] = *(const bf16x8*)(ckr + (size_t)(e_ & rowmask) * 256); } } while (0)
#define DSA_STEP(X0, X1, st) do { \
            f32x4 d0 = {0.f, 0.f, 0.f, 0.f}, d1 = {0.f, 0.f, 0.f, 0.f}; \
            _Pragma("unroll") for (int j = 0; j < 8; ++j) *(LAS bf16x8*)(img + (2 * j + hh2) * 528 + c32 * 16) = X0[j]; \
            if (2 * (st) + 3 < ntiles) DSA_GATHER(X0, 2 * (st) + 3);                \
            _Pragma("unroll") for (int j = 0; j < 8; ++j) *(LAS bf16x8*)(img + (16 + 2 * j + hh2) * 528 + c32 * 16) = X1[j]; \
            if (2 * (st) + 4 < ntiles) DSA_GATHER(X1, 2 * (st) + 4); \
            _Pragma("unroll") for (int k4 = 0; k4 < 8; k4 += 2) { bf16x8 fa[2], fb[2]; \
                _Pragma("unroll") for (int ks = 0; ks < 2; ++ks) { fa[ks] = *(const LAS bf16x8*)(img + fr * 528 + ((k4 + ks) * 32 + kg * 8) * 2); fb[ks] = *(const LAS bf16x8*)(img + (16 + fr) * 528 + ((k4 + ks) * 32 + kg * 8) * 2); } \
                _Pragma("unroll") for (int ks = 0; ks < 2; ++ks) { d0 = mfma16(fa[ks], ql[k4 + ks], d0); d1 = mfma16(fb[ks], ql[k4 + ks], d1); } } \
            const u32x4 s0 = *(const LAS u32x4*)(selw + (st) * 32 + kg * 4), s1 = *(const LAS u32x4*)(selw + (st) * 32 + 16 + kg * 4); \
            float lg[8]; float mloc = -3.0e38f; \
            _Pragma("unroll") for (int r = 0; r < 4; ++r) { \
                const float v0 = d0[r] + RB[((s0[r] >> 16) & 31u) * 16 + fr], v1 = d1[r] + RB[((s1[r] >> 16) & 31u) * 16 + fr]; \
                lg[r] = ((st) * 32 + kg * 4 + r < nsel) ? v0 : -3.0e38f; lg[4 + r] = ((st) * 32 + 16 + kg * 4 + r < nsel) ? v1 : -3.0e38f; \
                mloc = fmaxf(mloc, fmaxf(lg[r], lg[4 + r])); } \
            if (__any(mloc > mrun + 16.0f)) {                                       \
                mloc = kg_max(mloc); \
                const float mnew = fmaxf(mrun, mloc); \
                const float alpha = __expf(mrun - mnew); lrun *= alpha; \
                float ar[4]; \
                _Pragma("unroll") for (int r = 0; r < 4; ++r) ar[r] = __shfl(alpha, kg * 4 + r); \
                _Pragma("unroll") for (int ct = 0; ct < 16; ++ct) _Pragma("unroll") for (int r = 0; r < 4; ++r) O[ct][r] *= ar[r]; \
                mrun = mnew; } \
            float p[8]; \
            _Pragma("unroll") for (int r = 0; r < 8; ++r) { p[r] = (lg[r] > -1.0e38f) ? __expf(lg[r] - mrun) : 0.f; lrun += p[r]; } \
            union { bf16x8 v; unsigned w[4]; } pa; \
            pa.w[0] = cvt_pk_bf16(p[0], p[1]); pa.w[1] = cvt_pk_bf16(p[2], p[3]); pa.w[2] = cvt_pk_bf16(p[4], p[5]); pa.w[3] = cvt_pk_bf16(p[6], p[7]); \
            const LAS unsigned char* tb = img + (kg * 4 + (fr >> 2)) * 528 + (fr & 3) * 8; \
            if (!((DSA_PROBE & 64) && _rd == 0)) { \
            _Pragma("unroll") for (int c8 = 0; c8 < 16; c8 += 4) { \
                union { bf16x8 v; s16x4 h[2]; } bb[4]; \
                _Pragma("unroll") for (int cj = 0; cj < 4; ++cj) { bb[cj].h[0] = __builtin_amdgcn_ds_read_tr16_b64_v4i16((LAS s16x4*)(tb + (c8 + cj) * 32)); \
                    bb[cj].h[1] = __builtin_amdgcn_ds_read_tr16_b64_v4i16((LAS s16x4*)(tb + 16 * 528 + (c8 + cj) * 32)); } \
                _Pragma("unroll") for (int cj = 0; cj < 4; ++cj) O[c8 + cj] = mfma16(pa.v, bb[cj].v, O[c8 + cj]); } } } while (0)
        DSA_GATHER(b0, 0); DSA_GATHER(b1, 1); if (ntiles > 2) DSA_GATHER(b2, 2);
        for (int st = 0; st < nsteps; st += 3) {
            DSA_STEP(b0, b1, st);
            if (st + 1 < nsteps) DSA_STEP(b2, b0, st + 1);
            if (st + 2 < nsteps) DSA_STEP(b1, b2, st + 2);
        }
    }
#undef DSA_GATHER
#undef DSA_STEP
    lrun += __shfl_xor(lrun, 16); lrun += __shfl_xor(lrun, 32);
    const float inv = 1.0f / lrun;
    float ir[4];
#pragma unroll
    for (int r = 0; r < 4; ++r) ir[r] = __shfl(inv, kg * 4 + r);
    __syncthreads();
    if (kg < 3) {
#pragma unroll
        for (int ct = 0; ct < 16; ++ct)
#pragma unroll
            for (int r = 0; r < 4; ++r) *(LAS unsigned short*)(lds + DS_QL + ((wave * 12 + kg * 4 + r) * 256 + ct * 16 + fr) * 2) = (unsigned short)(cvt_pk_bf16(O[ct][r] * ir[r], 0.f) & 0xffffu);
    }
    __syncthreads();
    { const LAS u32x4* src = (const LAS u32x4*)(lds + DS_QL + wave * 12 * 256 * 2); u32x4* dst = (u32x4*)(QL + (tok0 + wave) * 12 * 256);
#pragma unroll
      for (int j = 0; j < 6; ++j) dst[j * 64 + lnD] = src[j * 64 + lnD]; }
}

__device__ __forceinline__ void qlat_phase(LAS unsigned char* lds, int u0, int ustep, int nunits, const bf16* Q, const bf16* UK, bf16* QL, int tid, int wave, int lane_in) {
    int lane = lane_in; asm volatile("" : "+v"(lane));
    const int q = lane & 31, hh = lane >> 5;
    u32x4 pre[2]; bf16x8 af[4];
#define QL_LOAD(unit) do { const int tb_ = (unit) / 12, h_ = (unit) - tb_ * 12; \
        _Pragma("unroll") for (int i = 0; i < 2; ++i) { const int idx = tid + i * NTHR, row = idx >> 3, ch = idx & 7; pre[i] = *(const u32x4*)(Q + ((size_t)tb_ * 128 + row) * 768 + h_ * 64 + ch * 8); } \
        _Pragma("unroll") for (int ks = 0; ks < 4; ++ks) af[ks] = *(const bf16x8*)(UK + ((size_t)h_ * 256 + wave * 32 + q) * 64 + ks * 16 + hh * 8); } while (0)
    if (u0 < nunits) QL_LOAD(u0);
    for (int unit = u0; unit < nunits; unit += ustep) {
        const int tb = unit / 12, h = unit - tb * 12; const size_t tok0 = (size_t)tb * 128;
        __syncthreads();
#pragma unroll
        for (int i = 0; i < 2; ++i) { const int idx = tid + i * NTHR, row = idx >> 3, ch = idx & 7; *(LAS u32x4*)(lds + row * 144 + ch * 16) = pre[i]; }
        bf16x8 afc[4];
#pragma unroll
        for (int ks = 0; ks < 4; ++ks) afc[ks] = af[ks];
        __syncthreads();
        if (unit + ustep < nunits) QL_LOAD(unit + ustep);
#pragma unroll
        for (int nt = 0; nt < 4; ++nt) {
            f32x16 acc;
#pragma unroll
            for (int r = 0; r < 16; ++r) acc[r] = 0.f;
#pragma unroll
            for (int ks = 0; ks < 4; ++ks) { const bf16x8 bq = *(const LAS bf16x8*)(lds + (nt * 32 + q) * 144 + (ks * 16 + hh * 8) * 2); acc = __builtin_amdgcn_mfma_f32_32x32x16_bf16(afc[ks], bq, acc, 0, 0, 0); }
#pragma unroll
            for (int g = 0; g < 4; ++g) { u32x2 w; w.x = cvt_pk_bf16(acc[4 * g] * 0.125f, acc[4 * g + 1] * 0.125f); w.y = cvt_pk_bf16(acc[4 * g + 2] * 0.125f, acc[4 * g + 3] * 0.125f);
                *(LAS u32x2*)(lds + 18432 + (nt * 32 + q) * 528 + (wave * 32 + 8 * g + 4 * hh) * 2) = w; }
        }
        __syncthreads();
        for (int idx = tid; idx < 4096; idx += NTHR) { const int row = idx >> 5, ch = idx & 31;
            *(u32x4*)(QL + ((tok0 + row) * 12 + h) * 256 + ch * 8) = *(const LAS u32x4*)(lds + 18432 + row * 528 + ch * 16); }
    }
#undef QL_LOAD
}
__device__ __forceinline__ void uv_phase(LAS unsigned char* lds, int u0, int ustep, int nunits, const bf16* QL, const bf16* UVT, bf16* MIX, int tid, int wave, int lane_in) {
    int lane = lane_in; asm volatile("" : "+v"(lane));
    const int q = lane & 31, hh = lane >> 5, mt = wave >> 1, nt = wave & 1;
    u32x4 pre[8];
#define UV_LOAD(unit) do { const int tb_ = (unit) / 12, h_ = (unit) - tb_ * 12; _Pragma("unroll") for (int i = 0; i < 8; ++i) { const int idx = tid + i * NTHR, row = idx >> 5, ch = idx & 31; \
        pre[i] = *(const u32x4*)(QL + (((size_t)tb_ * 128 + row) * 12 + h_) * 256 + ch * 8); } } while (0)
    if (u0 < nunits) UV_LOAD(u0);
    for (int unit = u0; unit < nunits; unit += ustep) {
        const int tb = unit / 12, h = unit - tb * 12; const size_t tok0 = (size_t)tb * 128;
        __syncthreads();
#pragma unroll
        for (int i = 0; i < 8; ++i) { const int idx = tid + i * NTHR, row = idx >> 5, ch = idx & 31; *(LAS u32x4*)(lds + row * 528 + ch * 16) = pre[i]; }
        const bf16* bp = UVT + ((size_t)h * 64 + nt * 32 + q) * 256 + hh * 8;
        bf16x8 bw[16];
#pragma unroll
        for (int ks = 0; ks < 16; ++ks) bw[ks] = *(const bf16x8*)(bp + ks * 16);
        __syncthreads();
        if (unit + ustep < nunits) UV_LOAD(unit + ustep);
        f32x16 acc;
#pragma unroll
        for (int r = 0; r < 16; ++r) acc[r] = 0.f;
#pragma unroll
        for (int ks = 0; ks < 16; ++ks) { const bf16x8 a = *(const LAS bf16x8*)(lds + (mt * 32 + q) * 528 + (ks * 16 + hh * 8) * 2); acc = __builtin_amdgcn_mfma_f32_32x32x16_bf16(a, bw[ks], acc, 0, 0, 0); }
#pragma unroll
        for (int r = 0; r < 16; ++r) *(LAS unsigned short*)(lds + 67584 + (mt * 32 + (r & 3) + 8 * (r >> 2) + 4 * hh) * 144 + (nt * 32 + q) * 2) = (unsigned short)(cvt_pk_bf16(acc[r], 0.f) & 0xffffu);
        __syncthreads();
        for (int idx = tid; idx < 1024; idx += NTHR) { const int row = idx >> 3, ch = idx & 7;
            *(u32x4*)(MIX + (tok0 + row) * 1024 + h * 64 + ch * 8) = *(const LAS u32x4*)(lds + 67584 + row * 144 + ch * 16); }
    }
#undef UV_LOAD
}

typedef __bf16 bf16v2_tt __attribute__((ext_vector_type(2)));
typedef float f32x2 __attribute__((ext_vector_type(2)));
__device__ __forceinline__ float dot2bf(unsigned a, unsigned b, float c) { return __builtin_amdgcn_fdot2_f32_bf16(__builtin_bit_cast(bf16v2_tt, a), __builtin_bit_cast(bf16v2_tt, b), c, false); }
__device__ __forceinline__ float unsortable_f32(unsigned u) { return __uint_as_float((u & 0x80000000u) ? (u ^ 0x80000000u) : ~u); }

constexpr int PA_SK = 0, PA_WB = 2 * 128 * 272, PA_WBYTES = 32 * 272;
static_assert(PA_WB + 8 * PA_WBYTES <= LDS_SCR_BYTES, "PEER-A LDS map");
__device__ __forceinline__ unsigned wave_max_u32(unsigned x) {
    { const unsigned t = (unsigned)__builtin_amdgcn_update_dpp(0, (int)x, 0xB1, 0xf, 0xf, false); x = t > x ? t : x; }
    { const unsigned t = (unsigned)__builtin_amdgcn_update_dpp(0, (int)x, 0x4E, 0xf, 0xf, false); x = t > x ? t : x; }
    { const unsigned t = (unsigned)__builtin_amdgcn_update_dpp(0, (int)x, 0x141, 0xf, 0xf, false); x = t > x ? t : x; }
    { const unsigned t = (unsigned)__builtin_amdgcn_update_dpp(0, (int)x, 0x140, 0xf, 0xf, false); x = t > x ? t : x; }
    { const auto a = __builtin_amdgcn_permlane16_swap(x, x, false, false); x = a[0] > a[1] ? a[0] : a[1]; }
    { const auto b = __builtin_amdgcn_permlane32_swap(x, x, false, false); x = b[0] > b[1] ? b[0] : b[1]; }
    return (unsigned)__builtin_amdgcn_readfirstlane((int)x);
}
__device__ __forceinline__ void peer_topk_load_sk(LAS unsigned char* lds, const bf16* SK, int tid) {
    __syncthreads();
    for (int idx = tid; idx < 4096; idx += NTHR) { const int row = idx >> 4, ch = idx & 15;
        *(LAS u32x4*)(lds + PA_SK + row * 272 + ch * 16) = *(const u32x4*)(SK + (size_t)row * 128 + ch * 8); }
    __syncthreads();
}
__device__ __forceinline__ void peer_topk_task(LAS unsigned char* lds, int task, const bf16* PQ, u32x2* TOPK, int wave, int lane_in) {
    int lane = lane_in; asm volatile("" : "+v"(lane));
    const int tg = task >> 4, sl = task & 15, half = sl & 1, q = lane & 31, hh = lane >> 5;
    LAS unsigned char* wb = lds + PA_WB + wave * PA_WBYTES;
#pragma unroll
    for (int j = 0; j < 8; ++j) { const int row = 4 * j + (lane >> 4), ch = lane & 15;
        *(LAS u32x4*)(wb + row * 272 + ch * 16) = *(const u32x4*)(PQ + ((size_t)tg * 32 + row) * 2048 + sl * 128 + ch * 8); }
    bf16x8 bq[8];
#pragma unroll
    for (int ks = 0; ks < 8; ++ks) bq[ks] = *(const LAS bf16x8*)(wb + q * 272 + (ks * 16 + hh * 8) * 2);
    float f[64];
    const LAS unsigned char* skp = lds + PA_SK + (half * 128 + q) * 272 + hh * 16;
#pragma unroll
    for (int kt = 0; kt < 4; ++kt) {
        f32x16 acc;
#pragma unroll
        for (int r = 0; r < 16; ++r) acc[r] = 0.f;
#pragma unroll
        for (int ks = 0; ks < 8; ++ks) { const bf16x8 a = *(const LAS bf16x8*)(skp + kt * 32 * 272 + ks * 32); acc = __builtin_amdgcn_mfma_f32_32x32x16_bf16(a, bq[ks], acc, 0, 0, 0); }
#pragma unroll
        for (int r = 0; r < 16; ++r) f[kt * 16 + r] = acc[r] + 0.f;
    }
    float lo, hi, T = 0.f;
    { float mn = 3.0e38f, mx = -3.0e38f;
#pragma unroll
      for (int g = 0; g < 8; ++g) { float m = f[8 * g];
#pragma unroll
          for (int i = 1; i < 8; ++i) m = fmaxf(m, f[8 * g + i]);
          mn = fminf(mn, m); mx = fmaxf(mx, m); }
      { const auto a2 = __builtin_amdgcn_permlane32_swap(__float_as_uint(mn), __float_as_uint(mn), false, false); mn = fminf(__uint_as_float(a2[0]), __uint_as_float(a2[1]));
        const auto b2 = __builtin_amdgcn_permlane32_swap(__float_as_uint(mx), __float_as_uint(mx), false, false); mx = fmaxf(__uint_as_float(b2[0]), __uint_as_float(b2[1])); }
      lo = mn; hi = mx; }
    bool done = false;
#pragma unroll 1
    for (int it = 0; it < 22; ++it) {
        const float mid = 0.5f * lo + 0.5f * hi; unsigned cnt = 0u;
#pragma unroll
        for (int i = 0; i < 64; ++i) asm volatile("v_cmp_ge_f32 vcc, %1, %2\n\tv_addc_co_u32 %0, vcc, 0, %0, vcc" : "+v"(cnt) : "v"(f[i]), "v"(mid) : "vcc");
        asm volatile("s_nop 1" ::: "memory");
        const auto sw = __builtin_amdgcn_permlane32_swap(cnt, cnt, false, false);
        const unsigned tot = sw[0] + sw[1];
        if (!done) { if (tot >= 16u) lo = mid; else hi = mid; if (tot == 16u) { T = mid; done = true; } }
        if (__all(done)) break;
    }
    if (!__all(done)) {
        unsigned Tu = 0u;
#pragma unroll 1
        for (int bit = 31; bit >= 0; --bit) {
            const unsigned cand = Tu | (1u << bit); unsigned cnt = 0u;
#pragma unroll
            for (int i = 0; i < 64; ++i) { const unsigned uu = sortable_u32(f[i]); CNT_GE(cnt, uu, cand); }
            asm volatile("s_nop 1" ::: "memory");
            const auto sw = __builtin_amdgcn_permlane32_swap(cnt, cnt, false, false);
            if (sw[0] + sw[1] >= 16u) Tu = cand;
        }
        if (!done) T = unsortable_f32(Tu);
    }
    unsigned gtc = 0u, eqc = 0u;
#pragma unroll
    for (int i = 0; i < 64; ++i) { asm volatile("v_cmp_gt_f32 vcc, %1, %2\n\tv_addc_co_u32 %0, vcc, 0, %0, vcc" : "+v"(gtc) : "v"(f[i]), "v"(T) : "vcc");
        asm volatile("v_cmp_eq_f32 vcc, %1, %2\n\tv_addc_co_u32 %0, vcc, 0, %0, vcc" : "+v"(eqc) : "v"(f[i]), "v"(T) : "vcc"); }
    asm volatile("s_nop 1" ::: "memory");
    unsigned pg, pe;
    { const auto a = __builtin_amdgcn_permlane32_swap(gtc, gtc, false, false); pg = a[0] + a[1] - gtc; const auto e = __builtin_amdgcn_permlane32_swap(eqc, eqc, false, false); pe = e[0] + e[1] - eqc; }
    const unsigned need_eq = 16u - (gtc + pg);
    const unsigned take0 = hh ? (pe < need_eq ? pe : need_eq) : (eqc < need_eq ? eqc : need_eq);
    const unsigned my_take = hh ? need_eq - take0 : take0;
    unsigned pos = hh ? (pg + take0) : 0u, eq_seen = 0u;
    LAS u32x2* stg = (LAS u32x2*)wb + q * 16;
#pragma unroll
    for (int i = 0; i < 64; ++i) {
        const bool eq = (f[i] == T); const bool sel = (f[i] > T) || (eq && eq_seen < my_take);
        if (sel) { u32x2 e; e.x = __float_as_uint(f[i]); e.y = (unsigned)((i >> 4) * 32 + (i & 3) + 8 * ((i >> 2) & 3) + 4 * hh); stg[pos] = e; pos += 1u; }
        eq_seen += eq ? 1u : 0u;
    }
#pragma unroll
    for (int j = 0; j < 4; ++j) { const int tk = 8 * j + (lane >> 3), ch = lane & 7;
        *(u32x4*)((unsigned char*)(TOPK + (((size_t)tg * 32 + tk) * 16 + sl) * 16) + ch * 16) = *(const LAS u32x4*)(wb + tk * 128 + ch * 16); }
}

template <bool LAST>
__device__ __forceinline__ void peer_tok(LAS unsigned char* lds_w, size_t tok, const u32x2* TOPK, const unsigned char* TABU, const unsigned char* TABV, const float* TSU, const float* TSV, bf16* HB, const float* SS, const float* gffn, float* xres, const float* gnext, int lane_in) {
    int lane = lane_in; asm volatile("" : "+v"(lane));
    LAS u32x2* EL = (LAS u32x2*)lds_w;
    LAS u32x4* EG = (LAS u32x4*)(lds_w + 1024);
    for (int _rp = 0; _rp <= (PEER_PROBE & 1); ++_rp)
#pragma unroll 1
    for (int head = 0; head < 8; ++head) {
        const u32x2* base = TOPK + (tok * 16 + head * 2) * 16;
        const u32x2 e0 = base[lane >> 2];
        const u32x4 e1a = *(const u32x4*)(base + 16 + 4 * (lane & 3)), e1b = *(const u32x4*)(base + 16 + 4 * (lane & 3) + 2);
        const float s0 = __uint_as_float(e0.x);
        float cs[4]; unsigned ck[4], u[4];
        cs[0] = s0 + __uint_as_float(e1a.x); ck[0] = e0.y * 128u + e1a.y; cs[1] = s0 + __uint_as_float(e1a.z); ck[1] = e0.y * 128u + e1a.w;
        cs[2] = s0 + __uint_as_float(e1b.x); ck[2] = e0.y * 128u + e1b.y; cs[3] = s0 + __uint_as_float(e1b.z); ck[3] = e0.y * 128u + e1b.w;
#pragma unroll
        for (int m = 0; m < 4; ++m) u[m] = sortable_u32(cs[m]);
        unsigned T = 0u;
#pragma unroll 1
        for (int bit = 31; bit >= 0; --bit) {
            const unsigned cand = T | (1u << bit); unsigned cnt = 0u;
#pragma unroll
            for (int m = 0; m < 4; ++m) cnt += (unsigned)__popcll(__ballot(u[m] >= cand));
            if (cnt >= 16u) T = cand;
            if (cnt == 16u) break;
        }
        unsigned G = 0u;
#pragma unroll
        for (int m = 0; m < 4; ++m) G += (unsigned)__popcll(__ballot(u[m] > T));
        const unsigned need_eq = 16u - G; unsigned pos = 0u, eq_used = 0u;
#pragma unroll
        for (int m = 0; m < 4; ++m) {
            const bool gt = u[m] > T, eq = u[m] == T;
            const unsigned long long meq = __ballot(eq);
            const bool sl = gt || (eq && (eq_used + mbcnt64(meq) < need_eq));
            const unsigned long long msl = __ballot(sl);
            if (sl) { u32x2 e; e.x = ck[m]; e.y = __float_as_uint(cs[m]); EL[head * 16 + pos + mbcnt64(msl)] = e; }
            pos += (unsigned)__popcll(msl); eq_used += (unsigned)__popcll(meq); }
    }
#pragma unroll
    for (int rep = 0; rep < 2; ++rep) { const int e = lane + 64 * rep; const u32x2 ent = EL[e]; const float sc = __uint_as_float(ent.y);
        const float su = TSU[ent.x], sv = TSV[ent.x];
        float mx = sc;
#pragma unroll
        for (int o = 1; o < 16; o <<= 1) mx = fmaxf(mx, __shfl_xor(mx, o));
        const float p = __expf(sc - mx); float sm = p;
#pragma unroll
        for (int o = 1; o < 16; o <<= 1) sm += __shfl_xor(sm, o);
        u32x4 w; w.x = ent.x; w.y = __float_as_uint(su); w.z = __float_as_uint(p / sm * sv); w.w = 0u; EG[e] = w; }
    int xq[4]; float sx;
    { const u32x4* hp = (const u32x4*)(HB + tok * 1024 + lane * 16); const u32x4 qa = hp[0], qb = hp[1]; float f[16]; float am = 0.f;
#pragma unroll
      for (int e = 0; e < 4; ++e) { f[2 * e] = __uint_as_float(qa[e] << 16); f[2 * e + 1] = __uint_as_float(qa[e] & 0xffff0000u); f[8 + 2 * e] = __uint_as_float(qb[e] << 16); f[8 + 2 * e + 1] = __uint_as_float(qb[e] & 0xffff0000u); }
      { const float rs_ = 1.0f / sqrtf(SS[tok] * (1.f / 1024.f) + EPS);
#pragma unroll
        for (int j = 0; j < 4; ++j) { const f32x4 gg = *(const f32x4*)(gffn + lane * 16 + 4 * j); f[4 * j] *= rs_ * gg[0]; f[4 * j + 1] *= rs_ * gg[1]; f[4 * j + 2] *= rs_ * gg[2]; f[4 * j + 3] *= rs_ * gg[3]; } }
#pragma unroll
      for (int c = 0; c < 16; ++c) am = fmaxf(am, fabsf(f[c]));
      am = wave_max(am); sx = am > 0.f ? am * (1.0f / 127.0f) : 1.0f; const float inv = 1.0f / sx;
#pragma unroll
      for (int e = 0; e < 4; ++e) { const int q0 = (int)rintf(f[4 * e] * inv), q1 = (int)rintf(f[4 * e + 1] * inv), q2 = (int)rintf(f[4 * e + 2] * inv), q3 = (int)rintf(f[4 * e + 3] * inv);
          xq[e] = (q0 & 0xff) | ((q1 & 0xff) << 8) | ((q2 & 0xff) << 16) | ((q3 & 0xff) << 24); } }
    f32x2 out2[8];
#pragma unroll
    for (int c = 0; c < 8; ++c) out2[c] = (f32x2){0.f, 0.f};
    const unsigned char* ubase = TABU + lane * 16; const unsigned char* vbase = TABV + lane * 16;
#define PT_LOAD(UB, VB, BT) do { _Pragma("unroll") for (int k = 0; k < 8; ++k) { const size_t ro = (size_t)EG[(BT) * 8 + k].x << 10; UB[k] = *(const u32x4*)(ubase + ro); VB[k] = *(const u32x4*)(vbase + ro); } } while (0)
#define PT_COMPUTE(UB, VB, BT) do { int di[8]; \
        _Pragma("unroll") for (int k = 0; k < 8; ++k) { int a0 = 0; \
            _Pragma("unroll") for (int e = 0; e < 4; ++e) a0 = __builtin_amdgcn_sdot4((int)UB[k][e], xq[e], a0, false); di[k] = a0; } \
        int r4[4], r2[2], v1; \
        { const bool h32 = (lane & 32) != 0; \
          _Pragma("unroll") for (int j = 0; j < 4; ++j) { const int send = h32 ? di[j] : di[j + 4], keep = h32 ? di[j + 4] : di[j]; r4[j] = keep + __shfl_xor(send, 32); } \
          const bool h16 = (lane & 16) != 0; \
          _Pragma("unroll") for (int j = 0; j < 2; ++j) { const int send = h16 ? r4[j] : r4[j + 2], keep = h16 ? r4[j + 2] : r4[j]; r2[j] = keep + __shfl_xor(send, 16); } \
          const bool h8 = (lane & 8) != 0; \
          { const int send = h8 ? r2[0] : r2[1], keep = h8 ? r2[1] : r2[0]; v1 = keep + __shfl_xor(send, 8); } \
          v1 += __shfl_xor(v1, 4); v1 += __shfl_xor(v1, 2); v1 += __shfl_xor(v1, 1); } \
        float act; { const u32x4 eg = EG[(BT) * 8 + (lane >> 3)]; const float v = (float)v1 * (__uint_as_float(eg.y) * sx); \
          const float t = __builtin_amdgcn_rcpf(fabsf(v) * 0.2316418882f + 1.0f); \
          float q = t * 0.5307027145f + (-0.7265760135f); q = q * t + 0.7107068705f; q = q * t + (-0.142248368f); q = q * t + 0.127414796f; q = q * t; \
          const float m = v * (q * __builtin_amdgcn_exp2f(v * v * (-0.72134752044f))); \
          act = (v < 0.f ? m : v - m) * __uint_as_float(eg.z); }                        \
        _Pragma("unroll") for (int k = 0; k < 8; ++k) { const float a = __uint_as_float(__builtin_amdgcn_readlane((int)__float_as_uint(act), 8 * k)); \
            _Pragma("unroll") for (int e = 0; e < 4; ++e) { out2[2 * e] += __builtin_amdgcn_cvt_pk_f32_fp8((int)VB[k][e], false) * a; out2[2 * e + 1] += __builtin_amdgcn_cvt_pk_f32_fp8((int)VB[k][e], true) * a; } } } while (0)
    {
        u32x4 ubA[8], vbA[8], ubB[8], vbB[8], ubC[8], vbC[8];
        PT_LOAD(ubA, vbA, 0); PT_LOAD(ubB, vbB, 1);
#pragma unroll 1
        for (int bt = 0; bt < 16; bt += 3) {
            { const int n2 = (bt + 2 < 16) ? bt + 2 : 15; PT_LOAD(ubC, vbC, n2); }
            PT_COMPUTE(ubA, vbA, bt);
            if (bt + 1 < 16) {
                { const int n3 = (bt + 3 < 16) ? bt + 3 : 15; PT_LOAD(ubA, vbA, n3); }
                PT_COMPUTE(ubB, vbB, bt + 1);
                { const int n4 = (bt + 4 < 16) ? bt + 4 : 15; PT_LOAD(ubB, vbB, n4); }
                PT_COMPUTE(ubC, vbC, bt + 2);
            }
        }
    }
#undef PT_LOAD
#undef PT_COMPUTE
    f32x4 xr[4]; float ss = 0.f;
    float* xq4 = xres + tok * 1024 + lane * 16;
#pragma unroll
    for (int j = 0; j < 4; ++j) { xr[j] = *(const f32x4*)(xq4 + 4 * j);
        xr[j][0] += out2[2 * j].x; xr[j][1] += out2[2 * j].y; xr[j][2] += out2[2 * j + 1].x; xr[j][3] += out2[2 * j + 1].y;
#pragma unroll
        for (int e = 0; e < 4; ++e) ss += xr[j][e] * xr[j][e]; }
    const float rstd = 1.0f / sqrtf(wave_sum(ss) * (1.f / 1024.f) + EPS);
    if (LAST) {
#pragma unroll
        for (int j = 0; j < 4; ++j) { const f32x4 gg = *(const f32x4*)(gnext + lane * 16 + 4 * j); *(f32x4*)(xq4 + 4 * j) = xr[j] * rstd * gg; }
    } else {
        u32x4 o0, o1;
#pragma unroll
        for (int j = 0; j < 4; ++j) { *(f32x4*)(xq4 + 4 * j) = xr[j]; const f32x4 gg = *(const f32x4*)(gnext + lane * 16 + 4 * j);
            const unsigned lo = cvt_pk_bf16(xr[j][0] * rstd * gg[0], xr[j][1] * rstd * gg[1]), hi = cvt_pk_bf16(xr[j][2] * rstd * gg[2], xr[j][3] * rstd * gg[3]);
            if (j < 2) { o0[2 * j] = lo; o0[2 * j + 1] = hi; } else { o1[2 * (j - 2)] = lo; o1[2 * (j - 2) + 1] = hi; } }
        u32x4* hq = (u32x4*)(HB + tok * 1024 + lane * 16); hq[0] = o0; hq[1] = o1;
    }
}

__device__ __forceinline__ float row16_max(float x) {
    x = fmaxf(x, __uint_as_float((unsigned)__builtin_amdgcn_update_dpp(0, (int)__float_as_uint(x), 0xB1, 0xf, 0xf, false)));
    x = fmaxf(x, __uint_as_float((unsigned)__builtin_amdgcn_update_dpp(0, (int)__float_as_uint(x), 0x4E, 0xf, 0xf, false)));
    x = fmaxf(x, __uint_as_float((unsigned)__builtin_amdgcn_update_dpp(0, (int)__float_as_uint(x), 0x141, 0xf, 0xf, false)));
    x = fmaxf(x, __uint_as_float((unsigned)__builtin_amdgcn_update_dpp(0, (int)__float_as_uint(x), 0x140, 0xf, 0xf, false)));
    return x;
}
__device__ __forceinline__ float row16_sum(float x) {
    x += __uint_as_float((unsigned)__builtin_amdgcn_update_dpp(0, (int)__float_as_uint(x), 0xB1, 0xf, 0xf, false));
    x += __uint_as_float((unsigned)__builtin_amdgcn_update_dpp(0, (int)__float_as_uint(x), 0x4E, 0xf, 0xf, false));
    x += __uint_as_float((unsigned)__builtin_amdgcn_update_dpp(0, (int)__float_as_uint(x), 0x141, 0xf, 0xf, false));
    x += __uint_as_float((unsigned)__builtin_amdgcn_update_dpp(0, (int)__float_as_uint(x), 0x140, 0xf, 0xf, false));
    return x;
}
__device__ __forceinline__ float wave_sum_f32(float x) {
    x = row16_sum(x);
    { const auto a = __builtin_amdgcn_permlane16_swap(__float_as_uint(x), __float_as_uint(x), false, false); x = __uint_as_float(a[0]) + __uint_as_float(a[1]); }
    { const auto b = __builtin_amdgcn_permlane32_swap(__float_as_uint(x), __float_as_uint(x), false, false); x = __uint_as_float(b[0]) + __uint_as_float(b[1]); }
    return x;
}
__device__ __forceinline__ unsigned wave_incl_scan_u32(unsigned v) {
    v += (unsigned)__builtin_amdgcn_update_dpp(0, (int)v, 0x111, 0xf, 0xf, true);
    v += (unsigned)__builtin_amdgcn_update_dpp(0, (int)v, 0x112, 0xf, 0xf, true);
    v += (unsigned)__builtin_amdgcn_update_dpp(0, (int)v, 0x114, 0xf, 0xf, true);
    v += (unsigned)__builtin_amdgcn_update_dpp(0, (int)v, 0x118, 0xf, 0xf, true);
    v += (unsigned)__builtin_amdgcn_update_dpp(0, (int)v, 0x142, 0xa, 0xf, false);
    v += (unsigned)__builtin_amdgcn_update_dpp(0, (int)v, 0x143, 0xc, 0xf, false);
    return v;
}
template <int R> __device__ __forceinline__ void rank_step(unsigned long long key, unsigned& rank) {
    const unsigned lo = (unsigned)__builtin_amdgcn_update_dpp(0, (int)(unsigned)key, 0x120 + R, 0xf, 0xf, false);
    const unsigned hi = (unsigned)__builtin_amdgcn_update_dpp(0, (int)(unsigned)(key >> 32), 0x120 + R, 0xf, 0xf, false);
    rank += ((((unsigned long long)hi << 32) | lo) > key) ? 1u : 0u;
    if constexpr (R < 15) rank_step<R + 1>(key, rank);
}
__device__ __forceinline__ void xcc_sync(unsigned* ctr, unsigned nloc, unsigned target);
constexpr int PW_SET = 6144, PW_HIST = 2 * PW_SET, PW_SL = PW_HIST + 1024, PW_ENTB = PW_SL + 512, PW_BYTES = PW_ENTB + 512;
template <bool LAST>
__device__ __forceinline__ void peer_wave(LAS unsigned char* lds_w, int m0, int mstep, int mcount, const u32x2* TOPK, const unsigned char* TABU, const unsigned char* TABV, const float* TSU, const float* TSV,
                                          bf16* HB, const float* SS, const float* gffn, float* xres, const float* gnext, int lane_in, unsigned* xctr, unsigned nloc, unsigned xbase) {
    int lane = lane_in; asm volatile("" : "+v"(lane));
    LAS unsigned* HIST = (LAS unsigned*)(lds_w + PW_HIST);
    LAS u32x2* SLs = (LAS u32x2*)(lds_w + PW_SL);
    int ri, rj;
    { const int L = lane;
      if (L < 16) { ri = 0; rj = L; } else if (L < 24) { ri = 1; rj = L - 16; } else if (L < 29) { ri = 2; rj = L - 24; } else if (L < 33) { ri = 3; rj = L - 29; }
      else if (L < 36) { ri = 4; rj = L - 33; } else if (L < 38) { ri = 5; rj = L - 36; } else if (L < 40) { ri = 6; rj = L - 38; } else if (L < 42) { ri = 7; rj = L - 40; }
      else if (L < 50) { ri = L - 34; rj = 0; } else { ri = 0; rj = 0; } }
#define PW_ENT(tokC, head) TOPK[((tokC + (lane >> 5)) * 16 + (head) * 2) * 16 + (lane & 31)]
#define PW_CAND(ent, head, ELc) do { \
        const unsigned long long key = ((unsigned long long)sortable_u32(__uint_as_float(ent.x)) << 32) | (unsigned)(15 - (lane & 15)); \
        unsigned rank = 0u; rank_step<1>(key, rank); \
        SLs[(lane >> 4) * 16 + rank] = ent; \
        { const u32x2 ea0 = SLs[ri], eb0 = SLs[16 + rj], ea1 = SLs[32 + ri], eb1 = SLs[48 + rj]; \
          const float cs0 = __uint_as_float(ea0.x) + __uint_as_float(eb0.x), cs1 = __uint_as_float(ea1.x) + __uint_as_float(eb1.x); \
          const unsigned ck0 = ea0.y * 128u + eb0.y, ck1 = ea1.y * 128u + eb1.y; \
          const bool vld = lane < 50; \
            \
            \
          float lo0 = __uint_as_float((unsigned)__builtin_amdgcn_readlane((int)__float_as_uint(cs0), 32)), hi0 = __uint_as_float((unsigned)__builtin_amdgcn_readlane((int)__float_as_uint(cs0), 0)); \
          float lo1 = __uint_as_float((unsigned)__builtin_amdgcn_readlane((int)__float_as_uint(cs1), 32)), hi1 = __uint_as_float((unsigned)__builtin_amdgcn_readlane((int)__float_as_uint(cs1), 0)); \
          bool sl0 = false, sl1 = false, cv0 = false, cv1 = false; float mid0 = lo0, mid1 = lo1; \
          _Pragma("unroll 1") for (int it = 0; it < 24; ++it) { \
              const bool ge0 = vld && (cs0 >= mid0), ge1 = vld && (cs1 >= mid1); \
              const unsigned n0 = (unsigned)__popcll(__ballot(ge0)), n1 = (unsigned)__popcll(__ballot(ge1)); \
              if (!cv0) { if (n0 == 16u) { sl0 = ge0; cv0 = true; } else if (n0 > 16u) lo0 = mid0; else hi0 = mid0; } \
              if (!cv1) { if (n1 == 16u) { sl1 = ge1; cv1 = true; } else if (n1 > 16u) lo1 = mid1; else hi1 = mid1; } \
              if (cv0 && cv1) break; \
              mid0 = 0.5f * lo0 + 0.5f * hi0; mid1 = 0.5f * lo1 + 0.5f * hi1; } \
          _Pragma("unroll 1") for (int tk = 0; tk < 2; ++tk) { if (tk ? cv1 : cv0) continue;                \
              const unsigned u = vld ? sortable_u32(tk ? cs1 : cs0) : 0u; \
              unsigned T = 0u; \
              _Pragma("unroll 1") for (int bit = 31; bit >= 0; --bit) { \
                  const unsigned cand = T | (1u << bit); const unsigned cnt = (unsigned)__popcll(__ballot(u >= cand)); \
                  if (cnt >= 16u) T = cand; \
                  if (cnt == 16u) break; \
              } \
              const unsigned G = (unsigned)__popcll(__ballot(u > T)); const unsigned need_eq = 16u - G; \
              const bool gt = u > T, eq = u == T; \
              const unsigned long long meq = __ballot(eq); \
              const bool slx = gt || (eq && (mbcnt64(meq) < need_eq)); if (tk) sl1 = slx; else sl0 = slx; } \
          { const unsigned long long msl = __ballot(sl0); if (sl0) { u32x2 e; e.x = ck0; e.y = __float_as_uint(cs0); ELc[(head) * 16 + mbcnt64(msl)] = e; } } \
          { const unsigned long long msl = __ballot(sl1); if (sl1) { u32x2 e; e.x = ck1; e.y = __float_as_uint(cs1); ELc[(8 + head) * 16 + mbcnt64(msl)] = e; } } \
        } \
        } while (0)
    if (m0 >= mcount) return;
    {
        LAS u32x2* ELc = (LAS u32x2*)lds_w; LAS u32x4* EGc = (LAS u32x4*)(lds_w + 2048); const size_t tokC = (size_t)m0 * 2;
        HIST[lane] = 0u; HIST[64 + lane] = 0u;
        for (int _rp = 0; _rp <= (PEER_PROBE & 1); ++_rp)
#pragma unroll 1
        for (int head = 0; head < 8; ++head) { const u32x2 ent = PW_ENT(tokC, head); PW_CAND(ent, head, ELc); }
    u32x4 ent4[4]; unsigned rk[4];
#pragma unroll
    for (int rep = 0; rep < 4; ++rep) { const int e = lane + 64 * rep; const u32x2 ent = ELc[e]; const float sc = __uint_as_float(ent.y);
        const float su = TSU[ent.x], sv = TSV[ent.x];
        const float mx = row16_max(sc);
        const float p = __expf(sc - mx); const float sm = row16_sum(p);
        ent4[rep].x = ent.x; ent4[rep].y = __float_as_uint(su); ent4[rep].z = __float_as_uint(p / sm * sv); ent4[rep].w = (unsigned)(rep >> 1);
        rk[rep] = atomicAdd((unsigned*)&HIST[(rep >> 1) * 64 + (ent.x >> 8)], 1u); }
    { const unsigned c0 = HIST[2 * lane], c1 = HIST[2 * lane + 1]; const unsigned inc = wave_incl_scan_u32(c0 + c1);
      HIST[128 + 2 * lane] = inc - c0 - c1; HIST[128 + 2 * lane + 1] = inc - c1; }
#pragma unroll
    for (int rep = 0; rep < 4; ++rep) EGc[HIST[128 + (rep >> 1) * 64 + (ent4[rep].x >> 8)] + rk[rep]] = ent4[rep];
    }
    int par = 0;
#pragma unroll 1
    for (int m = m0; m < mcount; m += mstep, par ^= 1) {
        const size_t tok0 = (size_t)m * 2; const bool has_next = (m + mstep) < mcount; const size_t tokC = (size_t)(m + mstep) * 2;
        if (PEER_WGSYNC == 1 || (PEER_WGSYNC >= 3 && PEER_WGSYNC < 6)) __syncthreads();
        if (PEER_WGSYNC == 2) xcc_sync(xctr, nloc, xbase + (unsigned)((m - m0) / mstep) + 1u);
        const unsigned xseq = (xbase + (unsigned)((m - m0) / mstep)) * (PEER_WGSYNC == 6 ? 4u : 8u);
        if (PEER_WGSYNC == 6 || PEER_WGSYNC == 7) xcc_sync(xctr, nloc, xseq + 1u);
        LAS u32x4* EGg = (LAS u32x4*)(lds_w + par * PW_SET + 2048);
        LAS u32x2* ELc = (LAS u32x2*)(lds_w + (par ^ 1) * PW_SET); LAS u32x4* EGc = (LAS u32x4*)(lds_w + (par ^ 1) * PW_SET + 2048);
        int x0q[4], x1q[4]; float sx0, sx1;
        {
    int lq = lane_in; asm volatile("" : "+v"(lq));
    float gf[16];
#pragma unroll
    for (int j = 0; j < 4; ++j) { const f32x4 gg = *(const f32x4*)(gffn + lq * 16 + 4 * j); gf[4 * j] = gg[0]; gf[4 * j + 1] = gg[1]; gf[4 * j + 2] = gg[2]; gf[4 * j + 3] = gg[3]; }

#define PP_QUANT(xq, sx, tk) do { const u32x4* hp = (const u32x4*)(HB + (tok0 + (tk)) * 1024 + lq * 16); const u32x4 qa = hp[0], qb = hp[1]; float f[16]; float am = 0.f; \
        const float rs_ = 1.0f / sqrtf(SS[tok0 + (tk)] * (1.f / 1024.f) + EPS); \
        _Pragma("unroll") for (int e = 0; e < 4; ++e) { f[2 * e] = __uint_as_float(qa[e] << 16); f[2 * e + 1] = __uint_as_float(qa[e] & 0xffff0000u); f[8 + 2 * e] = __uint_as_float(qb[e] << 16); f[8 + 2 * e + 1] = __uint_as_float(qb[e] & 0xffff0000u); } \
        _Pragma("unroll") for (int c = 0; c < 16; ++c) f[c] *= rs_ * gf[c]; \
        _Pragma("unroll") for (int c = 0; c < 16; ++c) am = fmaxf(am, fabsf(f[c])); \
        am = wave_max_f32(am); sx = am > 0.f ? am * (1.0f / 127.0f) : 1.0f; const float inv = 1.0f / sx; \
        _Pragma("unroll") for (int e = 0; e < 4; ++e) { const int q0 = (int)rintf(f[4 * e] * inv), q1 = (int)rintf(f[4 * e + 1] * inv), q2 = (int)rintf(f[4 * e + 2] * inv), q3 = (int)rintf(f[4 * e + 3] * inv); \
            xq[e] = (q0 & 0xff) | ((q1 & 0xff) << 8) | ((q2 & 0xff) << 16) | ((q3 & 0xff) << 24); } } while (0)
        PP_QUANT(x0q, sx0, 0); PP_QUANT(x1q, sx1, 1);
#undef PP_QUANT
        }
        f32x2 out0[8], out1[8];
#pragma unroll
        for (int c = 0; c < 8; ++c) { out0[c] = (f32x2){0.f, 0.f}; out1[c] = (f32x2){0.f, 0.f}; }
#define PP_IDS(TK, J) (EGg[(TK) * 128 + (J) * 8 + (lane & 7)].x & idmask)
#define PP_LOAD_U(UB, IDV) do { unsigned lo_ = (unsigned)lane * 16u; asm volatile("" : "+v"(lo_)); _Pragma("unroll") for (int k = 0; k < 8; ++k) { const unsigned id = (unsigned)__builtin_amdgcn_readlane((int)(IDV), k); const unsigned char* rp_ = TABU + ((size_t)id << 11); UB[k] = *(const u32x4*)(rp_ + lo_); } } while (0)
#define PP_LOAD_V(VB, IDV) do { unsigned lo_ = (unsigned)lane * 16u; asm volatile("" : "+v"(lo_)); _Pragma("unroll") for (int k = 0; k < 8; ++k) { const unsigned id = (unsigned)__builtin_amdgcn_readlane((int)(IDV), k); const unsigned char* rp_ = TABU + ((size_t)id << 11) + 1024; VB[k] = *(const u32x4*)(rp_ + lo_); } } while (0)
#define PP_DOTS(UB, XQ) \
        _Pragma("unroll") for (int k = 0; k < 8; ++k) { int a0 = 0; \
            _Pragma("unroll") for (int e = 0; e < 4; ++e) a0 = __builtin_amdgcn_sdot4((int)UB[k][e], XQ[e], a0, false); \
            di[k] = a0; }
#define PP_ACT(TK, J, SX) do { \
        const u32x4 eg = EGg[(TK) * 128 + (J) * 8 + (lane >> 3)]; \
        int r4[4], r2[2], v1; \
        _Pragma("unroll") for (int j_ = 0; j_ < 4; ++j_) { const auto sw = __builtin_amdgcn_permlane32_swap((unsigned)di[j_], (unsigned)di[j_ + 4], false, false); r4[j_] = (int)(sw[0] + sw[1]); }     \
        _Pragma("unroll") for (int j_ = 0; j_ < 2; ++j_) { const auto sw = __builtin_amdgcn_permlane16_swap((unsigned)r4[j_], (unsigned)r4[j_ + 2], false, false); r2[j_] = (int)(sw[0] + sw[1]); }     \
        { const bool h8 = (lane & 8) != 0; const int send = h8 ? r2[0] : r2[1], keep = h8 ? r2[1] : r2[0]; \
          v1 = keep + __builtin_amdgcn_update_dpp(0, send, 0x128, 0xf, 0xf, false);                                         \
          v1 += __builtin_amdgcn_update_dpp(0, v1, 0xB1, 0xf, 0xf, false); v1 += __builtin_amdgcn_update_dpp(0, v1, 0x4E, 0xf, 0xf, false); v1 += __builtin_amdgcn_update_dpp(0, v1, 0x141, 0xf, 0xf, false); }     \
        { const float v = (float)v1 * __uint_as_float(eg.y) * SX; \
          const float t = __builtin_amdgcn_rcpf(fabsf(v) * 0.2316418882f + 1.0f); \
          float q = t * 0.5307027145f + (-0.7265760135f); q = q * t + 0.7107068705f; q = q * t + (-0.142248368f); q = q * t + 0.127414796f; q = q * t; \
          const float m = v * (q * __builtin_amdgcn_exp2f(v * v * (-0.72134752044f))); \
          act = (v < 0.f ? m : v - m) * __uint_as_float(eg.z) * amul; } } while (0)
#define PP_ACC(VB, OUT) \
        _Pragma("unroll") for (int k = 0; k < 8; ++k) { const float a = __uint_as_float(__builtin_amdgcn_readlane((int)__float_as_uint(act), 8 * k)); \
            _Pragma("unroll") for (int e = 0; e < 4; ++e) { OUT[2 * e] += __builtin_amdgcn_cvt_pk_f32_fp8((int)VB[k][e], false) * a; OUT[2 * e + 1] += __builtin_amdgcn_cvt_pk_f32_fp8((int)VB[k][e], true) * a; } }
        for (int _rg = ((PEER_PROBE & 6) ? 0 : 1); _rg < 2; ++_rg) {
            const unsigned idmask = (_rg == 0 && (PEER_PROBE & 4)) ? 1023u : 0xffffffffu; const float amul = _rg ? 1.0f : 0.0f;
            u32x4 ubA[8], vbA[8], ubB[8], vbB[8]; int di[8]; float act;
#define PW_DMA(head) do { if (has_next && lane < 32) { const unsigned char* g_ = (const unsigned char*)(TOPK + ((tokC + (lane >> 4)) * 16 + (head) * 2) * 16) + (lane & 15) * 16; \
                __builtin_amdgcn_global_load_lds((const unsigned*)g_, (LAS unsigned*)(lds_w + PW_ENTB), 16, 0, 0); } } while (0)
            const int cph = 0;
            PW_DMA(0);
            { const unsigned ia = PP_IDS(0, 0), ib = PP_IDS(1, 0); PP_LOAD_U(ubA, ia); PP_LOAD_V(vbA, ia); PP_LOAD_U(ubB, ib); PP_LOAD_V(vbB, ib); }
#pragma unroll 1
            for (int j = 0; j < 16; ++j) {
                if ((PEER_WGSYNC == 3 && (j & 3) == 0) || (PEER_WGSYNC == 4 && (j & 1) == 0) || PEER_WGSYNC == 5) __syncthreads();
                const int nj = (j + 1 < 16) ? j + 1 : 15;
                const unsigned ia = PP_IDS(0, nj), ib = PP_IDS(1, nj);
                PP_DOTS(ubA, x0q); PP_LOAD_U(ubA, ia); PP_ACT(0, j, sx0); PP_ACC(vbA, out0); PP_LOAD_V(vbA, ia);
                if (has_next && (j & 1) == cph) { const int head = j >> 1; asm volatile("s_waitcnt vmcnt(32)" ::: "memory");
                    const u32x2 entN = ((const LAS u32x2*)(lds_w + PW_ENTB))[lane]; for (int _rc = 0; _rc <= ((PEER_PROBE >> 3) & 1); ++_rc) PW_CAND(entN, head, ELc); }
                if ((j & 1) != cph && ((j + 1) >> 1) < 8) PW_DMA((j + 1) >> 1);
                PP_DOTS(ubB, x1q); PP_LOAD_U(ubB, ib); PP_ACT(1, j, sx1); PP_ACC(vbB, out1); PP_LOAD_V(vbB, ib);
            }
        }
#undef PP_IDS
#undef PP_LOAD_U
#undef PP_LOAD_V
#undef PP_DOTS
#undef PP_ACT
#undef PP_ACC
        if (has_next) {
            HIST[lane] = 0u; HIST[64 + lane] = 0u;
        u32x4 ent4[4]; unsigned rk[4];
#pragma unroll
        for (int rep = 0; rep < 4; ++rep) { const int e = lane + 64 * rep; const u32x2 ent = ELc[e]; const float sc = __uint_as_float(ent.y);
            const float su = TSU[ent.x], sv = TSV[ent.x];
            const float mx = row16_max(sc);
            const float p = __expf(sc - mx); const float sm = row16_sum(p);
            ent4[rep].x = ent.x; ent4[rep].y = __float_as_uint(su); ent4[rep].z = __float_as_uint(p / sm * sv); ent4[rep].w = (unsigned)(rep >> 1);
            rk[rep] = atomicAdd((unsigned*)&HIST[(rep >> 1) * 64 + (ent.x >> 8)], 1u); }
        { const unsigned c0 = HIST[2 * lane], c1 = HIST[2 * lane + 1]; const unsigned inc = wave_incl_scan_u32(c0 + c1);
      HIST[128 + 2 * lane] = inc - c0 - c1; HIST[128 + 2 * lane + 1] = inc - c1; }
#pragma unroll
        for (int rep = 0; rep < 4; ++rep) EGc[HIST[128 + (rep >> 1) * 64 + (ent4[rep].x >> 8)] + rk[rep]] = ent4[rep];
        }
        int lr = lane_in; asm volatile("" : "+v"(lr));
#pragma unroll
        for (int tk = 0; tk < 2; ++tk) {
            float xr[16]; float ss = 0.f;
            { const u32x4* hp = (const u32x4*)(HB + (tok0 + tk) * 1024 + lr * 16); const u32x4 qa = hp[0], qb = hp[1];
#pragma unroll
              for (int e = 0; e < 4; ++e) { xr[2 * e] = __uint_as_float(qa[e] << 16); xr[2 * e + 1] = __uint_as_float(qa[e] & 0xffff0000u); xr[8 + 2 * e] = __uint_as_float(qb[e] << 16); xr[8 + 2 * e + 1] = __uint_as_float(qb[e] & 0xffff0000u); } }
#pragma unroll
            for (int c = 0; c < 16; ++c) { const f32x2 o2 = tk ? out1[c >> 1] : out0[c >> 1]; xr[c] += (c & 1) ? o2.y : o2.x; ss += xr[c] * xr[c]; }
            const float rstd = 1.0f / sqrtf(wave_sum_f32(ss) * (1.f / 1024.f) + EPS);
            if (LAST) {
                float* xq = xres + (tok0 + tk) * 1024 + lr * 16;
#pragma unroll
                for (int j = 0; j < 4; ++j) { const f32x4 gg = *(const f32x4*)(gnext + lr * 16 + 4 * j); *(f32x4*)(xq + 4 * j) = (f32x4){xr[4 * j] * rstd * gg[0], xr[4 * j + 1] * rstd * gg[1], xr[4 * j + 2] * rstd * gg[2], xr[4 * j + 3] * rstd * gg[3]}; }
            } else {
                u32x4 o0, o1, r0, r1;
#pragma unroll
                for (int j = 0; j < 4; ++j) { const f32x4 gg = *(const f32x4*)(gnext + lr * 16 + 4 * j);
                    const unsigned lo = cvt_pk_bf16(xr[4 * j] * rstd * gg[0], xr[4 * j + 1] * rstd * gg[1]), hi = cvt_pk_bf16(xr[4 * j + 2] * rstd * gg[2], xr[4 * j + 3] * rstd * gg[3]);
                    const unsigned rl = cvt_pk_bf16(xr[4 * j], xr[4 * j + 1]), rh = cvt_pk_bf16(xr[4 * j + 2], xr[4 * j + 3]);
                    if (j < 2) { o0[2 * j] = lo; o0[2 * j + 1] = hi; r0[2 * j] = rl; r0[2 * j + 1] = rh; } else { o1[2 * (j - 2)] = lo; o1[2 * (j - 2) + 1] = hi; r1[2 * (j - 2)] = rl; r1[2 * (j - 2) + 1] = rh; } }
                u32x4* hq = (u32x4*)(HB + (tok0 + tk) * 1024 + lr * 16); hq[0] = o0; hq[1] = o1;
                u32x4* xq2 = (u32x4*)((bf16*)xres + (tok0 + tk) * 1024 + lr * 16); xq2[0] = r0; xq2[1] = r1;
            }
        }
    }
#undef PW_CAND
#undef PW_ENT
#undef PW_DMA
}

template <bool LAST>
__device__ __forceinline__ void peer_pair(LAS unsigned char* lds_w, size_t tok0, const u32x2* TOPK, const unsigned char* TABU, const unsigned char* TABV, const float* TSU, const float* TSV, bf16* HB, const float* SS, const float* gffn, float* xres, const float* gnext, int lane_in) {
    int lane = lane_in; asm volatile("" : "+v"(lane));
    LAS u32x2* EL = (LAS u32x2*)lds_w;
    LAS u32x4* EG = (LAS u32x4*)(lds_w + 2048);
    LAS unsigned* HIST = (LAS unsigned*)(lds_w + 2048 + 4096);
    if (lane < 32) HIST[lane] = 0u;
    int ri, rj;
    { const int L = lane;
      if (L < 16) { ri = 0; rj = L; } else if (L < 24) { ri = 1; rj = L - 16; } else if (L < 29) { ri = 2; rj = L - 24; } else if (L < 33) { ri = 3; rj = L - 29; }
      else if (L < 36) { ri = 4; rj = L - 33; } else if (L < 38) { ri = 5; rj = L - 36; } else if (L < 40) { ri = 6; rj = L - 38; } else if (L < 42) { ri = 7; rj = L - 40; }
      else if (L < 50) { ri = L - 34; rj = 0; } else { ri = 0; rj = 0; } }
    LAS u32x2* SLs = (LAS u32x2*)(lds_w + 6400);
    for (int _rp = 0; _rp <= (PEER_PROBE & 1); ++_rp)
#pragma unroll 1
    for (int head = 0; head < 8; ++head) {
        const u32x2 ent = TOPK[((tok0 + (lane >> 5)) * 16 + head * 2) * 16 + (lane & 31)];
        const unsigned long long key = ((unsigned long long)sortable_u32(__uint_as_float(ent.x)) << 32) | (unsigned)(15 - (lane & 15));
        unsigned rank = 0u; rank_step<1>(key, rank);
        SLs[(lane >> 4) * 16 + rank] = ent;
#pragma unroll 1
        for (int tk = 0; tk < 2; ++tk) {
            const u32x2 ea = SLs[(tk * 2) * 16 + ri], eb = SLs[(tk * 2 + 1) * 16 + rj];
            const float cs = __uint_as_float(ea.x) + __uint_as_float(eb.x); const unsigned ck = ea.y * 128u + eb.y;
            const unsigned u = (lane < 50) ? sortable_u32(cs) : 0u;
            unsigned T = 0u;
#pragma unroll 1
            for (int bit = 31; bit >= 0; --bit) {
                const unsigned cand = T | (1u << bit); const unsigned cnt = (unsigned)__popcll(__ballot(u >= cand));
                if (cnt >= 16u) T = cand;
                if (cnt == 16u) break;
            }
            const unsigned G = (unsigned)__popcll(__ballot(u > T)); const unsigned need_eq = 16u - G;
            const bool gt = u > T, eq = u == T;
            const unsigned long long meq = __ballot(eq);
            const bool sl = gt || (eq && (mbcnt64(meq) < need_eq));
            const unsigned long long msl = __ballot(sl);
            if (sl) { u32x2 e; e.x = ck; e.y = __float_as_uint(cs); EL[(tk * 8 + head) * 16 + mbcnt64(msl)] = e; }
        }
    }
    u32x4 ent4[4]; unsigned rk[4];
#pragma unroll
    for (int rep = 0; rep < 4; ++rep) { const int e = lane + 64 * rep; const u32x2 ent = EL[e]; const float sc = __uint_as_float(ent.y);
        const float su = TSU[ent.x], sv = TSV[ent.x];
        float mx = sc;
#pragma unroll
        for (int o = 1; o < 16; o <<= 1) mx = fmaxf(mx, __shfl_xor(mx, o));
        const float p = __expf(sc - mx); float sm = p;
#pragma unroll
        for (int o = 1; o < 16; o <<= 1) sm += __shfl_xor(sm, o);
        ent4[rep].x = ent.x; ent4[rep].y = __float_as_uint(su); ent4[rep].z = __float_as_uint(p / sm * sv); ent4[rep].w = (unsigned)(rep >> 1);
        rk[rep] = atomicAdd((unsigned*)&HIST[ent.x >> 9], 1u); }
    { unsigned c = (lane < 32) ? HIST[lane] : 0u, inc = c;
#pragma unroll
      for (int o = 1; o < 32; o <<= 1) { const unsigned t = (unsigned)__shfl_up((int)inc, o); if ((lane & 31) >= o) inc += t; }
      if (lane < 32) HIST[32 + lane] = inc - c; }
#pragma unroll
    for (int rep = 0; rep < 4; ++rep) EG[HIST[32 + (ent4[rep].x >> 9)] + rk[rep]] = ent4[rep];
    int x0q[4], x1q[4]; float sx0, sx1;
    float gf[16];
#pragma unroll
    for (int j = 0; j < 4; ++j) { const f32x4 gg = *(const f32x4*)(gffn + lane * 16 + 4 * j); gf[4 * j] = gg[0]; gf[4 * j + 1] = gg[1]; gf[4 * j + 2] = gg[2]; gf[4 * j + 3] = gg[3]; }
#define PP_QUANT(xq, sx, tk) do { const u32x4* hp = (const u32x4*)(HB + (tok0 + (tk)) * 1024 + lane * 16); const u32x4 qa = hp[0], qb = hp[1]; float f[16]; float am = 0.f; \
        const float rs_ = 1.0f / sqrtf(SS[tok0 + (tk)] * (1.f / 1024.f) + EPS); \
        _Pragma("unroll") for (int e = 0; e < 4; ++e) { f[2 * e] = __uint_as_float(qa[e] << 16); f[2 * e + 1] = __uint_as_float(qa[e] & 0xffff0000u); f[8 + 2 * e] = __uint_as_float(qb[e] << 16); f[8 + 2 * e + 1] = __uint_as_float(qb[e] & 0xffff0000u); } \
        _Pragma("unroll") for (int c = 0; c < 16; ++c) f[c] *= rs_ * gf[c]; \
        _Pragma("unroll") for (int c = 0; c < 16; ++c) am = fmaxf(am, fabsf(f[c])); \
        am = wave_max(am); sx = am > 0.f ? am * (1.0f / 127.0f) : 1.0f; const float inv = 1.0f / sx; \
        _Pragma("unroll") for (int e = 0; e < 4; ++e) { const int q0 = (int)rintf(f[4 * e] * inv), q1 = (int)rintf(f[4 * e + 1] * inv), q2 = (int)rintf(f[4 * e + 2] * inv), q3 = (int)rintf(f[4 * e + 3] * inv); \
            xq[e] = (q0 & 0xff) | ((q1 & 0xff) << 8) | ((q2 & 0xff) << 16) | ((q3 & 0xff) << 24); } } while (0)
    PP_QUANT(x0q, sx0, 0); PP_QUANT(x1q, sx1, 1);
#undef PP_QUANT
    f32x2 outp[16];
#pragma unroll
    for (int c = 0; c < 16; ++c) outp[c] = (f32x2){0.f, 0.f};
#define PP_LOAD(UB, VB, BT) do { _Pragma("unroll") for (int k = 0; k < 8; ++k) { const unsigned id = EG[(BT) * 8 + k].x; UB[k] = *(const u32x4*)(TABU + (size_t)id * 1024 + lane * 16); VB[k] = *(const u32x4*)(TABV + (size_t)id * 1024 + lane * 16); } } while (0)
#define PP_COMPUTE(UB, VB, BT) do { int di[8]; \
        _Pragma("unroll") for (int k = 0; k < 8; ++k) { int a0 = 0, a1 = 0; \
            _Pragma("unroll") for (int e = 0; e < 4; ++e) { a0 = __builtin_amdgcn_sdot4((int)UB[k][e], x0q[e], a0, false); a1 = __builtin_amdgcn_sdot4((int)UB[k][e], x1q[e], a1, false); } \
            const unsigned tkk = (unsigned)__builtin_amdgcn_readfirstlane((int)EG[(BT) * 8 + k].w); di[k] = tkk ? a1 : a0; } \
        int r4[4], r2[2], v1; \
        { const bool h32 = (lane & 32) != 0; \
          _Pragma("unroll") for (int j = 0; j < 4; ++j) { const int send = h32 ? di[j] : di[j + 4], keep = h32 ? di[j + 4] : di[j]; r4[j] = keep + __shfl_xor(send, 32); } \
          const bool h16 = (lane & 16) != 0; \
          _Pragma("unroll") for (int j = 0; j < 2; ++j) { const int send = h16 ? r4[j] : r4[j + 2], keep = h16 ? r4[j + 2] : r4[j]; r2[j] = keep + __shfl_xor(send, 16); } \
          const bool h8 = (lane & 8) != 0; \
          { const int send = h8 ? r2[0] : r2[1], keep = h8 ? r2[1] : r2[0]; v1 = keep + __shfl_xor(send, 8); } \
          v1 += __shfl_xor(v1, 4); v1 += __shfl_xor(v1, 2); v1 += __shfl_xor(v1, 1); } \
        float act; { const u32x4 eg = EG[(BT) * 8 + (lane >> 3)]; const float v = (float)v1 * __uint_as_float(eg.y) * (eg.w ? sx1 : sx0); \
          const float t = __builtin_amdgcn_rcpf(fabsf(v) * 0.2316418882f + 1.0f); \
          float q = t * 0.5307027145f + (-0.7265760135f); q = q * t + 0.7107068705f; q = q * t + (-0.142248368f); q = q * t + 0.127414796f; q = q * t; \
          const float m = v * (q * __builtin_amdgcn_exp2f(v * v * (-0.72134752044f))); \
          act = (v < 0.f ? m : v - m) * __uint_as_float(eg.z); }                        \
        _Pragma("unroll") for (int k = 0; k < 8; ++k) { const float a = __uint_as_float(__builtin_amdgcn_readlane((int)__float_as_uint(act), 8 * k)); \
            const unsigned tkk = (unsigned)__builtin_amdgcn_readfirstlane((int)EG[(BT) * 8 + k].w); \
            const f32x2 a2 = tkk ? (f32x2){0.f, a} : (f32x2){a, 0.f}; \
            _Pragma("unroll") for (int e = 0; e < 4; ++e) { const f32x2 lo = __builtin_amdgcn_cvt_pk_f32_fp8((int)VB[k][e], false), hi = __builtin_amdgcn_cvt_pk_f32_fp8((int)VB[k][e], true); \
                outp[4 * e] += a2 * lo.x; outp[4 * e + 1] += a2 * lo.y; outp[4 * e + 2] += a2 * hi.x; outp[4 * e + 3] += a2 * hi.y; } } } while (0)
    for (int _rg = ((PEER_PROBE & 6) ? 0 : 1); _rg < 2; ++_rg) {
        const bool noload = (PEER_PROBE & 4) && _rg == 0;
#pragma unroll
        for (int c = 0; c < 16; ++c) outp[c] = (f32x2){0.f, 0.f};
        u32x4 ubA[8], vbA[8], ubB[8], vbB[8];
#pragma unroll
        for (int k = 0; k < 8; ++k) { ubA[k] = (u32x4){0u, 0u, 0u, 0u}; vbA[k] = ubA[k]; ubB[k] = ubA[k]; vbB[k] = ubA[k]; }
        if (!noload) PP_LOAD(ubA, vbA, 0);
#pragma unroll 1
        for (int bt = 0; bt < 32; bt += 2) {
            if (!noload) PP_LOAD(ubB, vbB, bt + 1);
            PP_COMPUTE(ubA, vbA, bt);
            const int nb = (bt + 2 < 32) ? bt + 2 : 31;
            if (!noload) PP_LOAD(ubA, vbA, nb);
            PP_COMPUTE(ubB, vbB, bt + 1);
        }
    }
#pragma unroll
    for (int tk = 0; tk < 2; ++tk) {
        f32x4 xr[4]; float ss = 0.f;
        float* xq = xres + (tok0 + tk) * 1024 + lane * 16;
#pragma unroll
        for (int j = 0; j < 4; ++j) { xr[j] = *(const f32x4*)(xq + 4 * j);
#pragma unroll
            for (int e = 0; e < 4; ++e) { xr[j][e] += tk ? outp[4 * j + e].y : outp[4 * j + e].x; ss += xr[j][e] * xr[j][e]; } }
        const float rstd = 1.0f / sqrtf(wave_sum(ss) * (1.f / 1024.f) + EPS);
        if (LAST) {
#pragma unroll
            for (int j = 0; j < 4; ++j) { const f32x4 gg = *(const f32x4*)(gnext + lane * 16 + 4 * j); *(f32x4*)(xq + 4 * j) = xr[j] * rstd * gg; }
        } else {
            u32x4 o0, o1;
#pragma unroll
            for (int j = 0; j < 4; ++j) { *(f32x4*)(xq + 4 * j) = xr[j]; const f32x4 gg = *(const f32x4*)(gnext + lane * 16 + 4 * j);
                const unsigned lo = cvt_pk_bf16(xr[j][0] * rstd * gg[0], xr[j][1] * rstd * gg[1]), hi = cvt_pk_bf16(xr[j][2] * rstd * gg[2], xr[j][3] * rstd * gg[3]);
                if (j < 2) { o0[2 * j] = lo; o0[2 * j + 1] = hi; } else { o1[2 * (j - 2)] = lo; o1[2 * (j - 2) + 1] = hi; } }
            u32x4* hq = (u32x4*)(HB + (tok0 + tk) * 1024 + lane * 16); hq[0] = o0; hq[1] = o1;
        }
    }
}

__device__ __forceinline__ void pair_prepare(LAS unsigned char* lds_w, size_t tok0, const u32x2* TOPK, const float* TSU, const float* TSV, int lane_in) {
    int lane = lane_in; asm volatile("" : "+v"(lane));
    LAS u32x2* EL = (LAS u32x2*)lds_w;
    LAS u32x4* EG = (LAS u32x4*)(lds_w + 2048);
    LAS unsigned* HIST = (LAS unsigned*)(lds_w + 2048 + 4096);
    if (lane < 32) HIST[lane] = 0u;
    for (int _rp = 0; _rp <= (PEER_PROBE & 1); ++_rp)
#pragma unroll 1
    for (int th = 0; th < 16; ++th) { const int tk = th >> 3, head = th & 7;
        const u32x2* base = TOPK + ((tok0 + tk) * 16 + head * 2) * 16;
        const u32x2 e0 = base[lane >> 2];
        const u32x4 e1a = *(const u32x4*)(base + 16 + 4 * (lane & 3)), e1b = *(const u32x4*)(base + 16 + 4 * (lane & 3) + 2);
        const float s0 = __uint_as_float(e0.x);
        float cs[4]; unsigned ck[4], u[4];
        cs[0] = s0 + __uint_as_float(e1a.x); ck[0] = e0.y * 128u + e1a.y; cs[1] = s0 + __uint_as_float(e1a.z); ck[1] = e0.y * 128u + e1a.w;
        cs[2] = s0 + __uint_as_float(e1b.x); ck[2] = e0.y * 128u + e1b.y; cs[3] = s0 + __uint_as_float(e1b.z); ck[3] = e0.y * 128u + e1b.w;
#pragma unroll
        for (int m = 0; m < 4; ++m) u[m] = sortable_u32(cs[m]);
        unsigned T = 0u;
#pragma unroll 1
        for (int bit = 31; bit >= 0; --bit) {
            const unsigned cand = T | (1u << bit); unsigned cnt = 0u;
#pragma unroll
            for (int m = 0; m < 4; ++m) cnt += (unsigned)__popcll(__ballot(u[m] >= cand));
            if (cnt >= 16u) T = cand;
            if (cnt == 16u) break;
        }
        unsigned G = 0u;
#pragma unroll
        for (int m = 0; m < 4; ++m) G += (unsigned)__popcll(__ballot(u[m] > T));
        const unsigned need_eq = 16u - G; unsigned pos = 0u, eq_used = 0u;
#pragma unroll
        for (int m = 0; m < 4; ++m) {
            const bool gt = u[m] > T, eq = u[m] == T;
            const unsigned long long meq = __ballot(eq);
            const bool sl = gt || (eq && (eq_used + mbcnt64(meq) < need_eq));
            const unsigned long long msl = __ballot(sl);
            if (sl) { u32x2 e; e.x = ck[m]; e.y = __float_as_uint(cs[m]); EL[th * 16 + pos + mbcnt64(msl)] = e; }
            pos += (unsigned)__popcll(msl); eq_used += (unsigned)__popcll(meq); }
    }
    u32x4 ent4[4]; unsigned rk[4];
#pragma unroll
    for (int rep = 0; rep < 4; ++rep) { const int e = lane + 64 * rep; const u32x2 ent = EL[e]; const float sc = __uint_as_float(ent.y);
        const float su = TSU[ent.x], sv = TSV[ent.x];
        float mx = sc;
#pragma unroll
        for (int o = 1; o < 16; o <<= 1) mx = fmaxf(mx, __shfl_xor(mx, o));
        const float p = __expf(sc - mx); float sm = p;
#pragma unroll
        for (int o = 1; o < 16; o <<= 1) sm += __shfl_xor(sm, o);
        ent4[rep].x = ent.x; ent4[rep].y = __float_as_uint(su); ent4[rep].z = __float_as_uint(p / sm * sv); ent4[rep].w = (unsigned)(rep >> 1);
        rk[rep] = atomicAdd((unsigned*)&HIST[ent.x >> 9], 1u); }
    { unsigned c = (lane < 32) ? HIST[lane] : 0u, inc = c;
#pragma unroll
      for (int o = 1; o < 32; o <<= 1) { const unsigned t = (unsigned)__shfl_up((int)inc, o); if ((lane & 31) >= o) inc += t; }
      if (lane < 32) HIST[32 + lane] = inc - c; }
#pragma unroll
    for (int rep = 0; rep < 4; ++rep) EG[HIST[32 + (ent4[rep].x >> 9)] + rk[rep]] = ent4[rep];
}
__device__ __forceinline__ void pair_pass1(LAS unsigned char* lds_w, size_t tok0, const unsigned char* TABU, const bf16* HB, int lane_in) {
    int lane = lane_in; asm volatile("" : "+v"(lane));
    LAS u32x4* EG = (LAS u32x4*)(lds_w + 2048);
    f32x2 xp[16];
    { const u32x4* h0 = (const u32x4*)(HB + tok0 * 1024 + lane * 16); const u32x4* h1 = (const u32x4*)(HB + (tok0 + 1) * 1024 + lane * 16);
      const u32x4 a0 = h0[0], b0 = h0[1], a1 = h1[0], b1 = h1[1];
#pragma unroll
      for (int e = 0; e < 4; ++e) { xp[2 * e] = (f32x2){__uint_as_float(a0[e] << 16), __uint_as_float(a1[e] << 16)}; xp[2 * e + 1] = (f32x2){__uint_as_float(a0[e] & 0xffff0000u), __uint_as_float(a1[e] & 0xffff0000u)};
          xp[8 + 2 * e] = (f32x2){__uint_as_float(b0[e] << 16), __uint_as_float(b1[e] << 16)}; xp[8 + 2 * e + 1] = (f32x2){__uint_as_float(b0[e] & 0xffff0000u), __uint_as_float(b1[e] & 0xffff0000u)}; } }
    u32x4 ub[8];
#pragma unroll
    for (int k = 0; k < 8; ++k) ub[k] = *(const u32x4*)(TABU + (size_t)EG[k].x * 1024 + lane * 16);
#pragma unroll 1
    for (int bt = 0; bt < 32; ++bt) {
        u32x4 un[8];
        const int nb = (bt + 1 < 32) ? bt + 1 : bt;
#pragma unroll
        for (int k = 0; k < 8; ++k) un[k] = *(const u32x4*)(TABU + (size_t)EG[nb * 8 + k].x * 1024 + lane * 16);
        float d[8];
#pragma unroll
        for (int k = 0; k < 8; ++k) { f32x2 a = {0.f, 0.f};
#pragma unroll
            for (int e = 0; e < 4; ++e) { const f32x2 lo = __builtin_amdgcn_cvt_pk_f32_fp8((int)ub[k][e], false), hi = __builtin_amdgcn_cvt_pk_f32_fp8((int)ub[k][e], true);
                a += xp[4 * e] * lo.x; a += xp[4 * e + 1] * lo.y; a += xp[4 * e + 2] * hi.x; a += xp[4 * e + 3] * hi.y; }
            const unsigned tkk = (unsigned)__builtin_amdgcn_readfirstlane((int)EG[bt * 8 + k].w);
            d[k] = tkk ? a.y : a.x; }
        float r4[4], r2[2], v1;
        { const bool h32 = (lane & 32) != 0;
#pragma unroll
          for (int j = 0; j < 4; ++j) { const float send = h32 ? d[j] : d[j + 4], keep = h32 ? d[j + 4] : d[j]; r4[j] = keep + __shfl_xor(send, 32); }
          const bool h16 = (lane & 16) != 0;
#pragma unroll
          for (int j = 0; j < 2; ++j) { const float send = h16 ? r4[j] : r4[j + 2], keep = h16 ? r4[j + 2] : r4[j]; r2[j] = keep + __shfl_xor(send, 16); }
          const bool h8 = (lane & 8) != 0;
          { const float send = h8 ? r2[0] : r2[1], keep = h8 ? r2[1] : r2[0]; v1 = keep + __shfl_xor(send, 8); }
          v1 += __shfl_xor(v1, 4); v1 += __shfl_xor(v1, 2); v1 += __shfl_xor(v1, 1); }
        { const u32x4 eg = EG[bt * 8 + (lane >> 3)]; const float x = v1 * __uint_as_float(eg.y);
          const float act = 0.5f * x * (1.0f + erff(x * 0.70710678118654752f)) * __uint_as_float(eg.z);
          if ((lane & 7) == 0) *((LAS float*)&EG[bt * 8 + (lane >> 3)] + 1) = act; }
#pragma unroll
        for (int k = 0; k < 8; ++k) ub[k] = un[k];
    }
}
template <bool LAST>
__device__ __forceinline__ void pair_pass2(LAS unsigned char* lds_w, size_t tok0, const unsigned char* TABV, bf16* HB, float* xres, const float* gnext, int lane_in) {
    int lane = lane_in; asm volatile("" : "+v"(lane));
    LAS u32x4* EG = (LAS u32x4*)(lds_w + 2048);
    f32x2 outp[16];
#pragma unroll
    for (int c = 0; c < 16; ++c) outp[c] = (f32x2){0.f, 0.f};
    u32x4 vb[8];
#pragma unroll
    for (int k = 0; k < 8; ++k) vb[k] = *(const u32x4*)(TABV + (size_t)EG[k].x * 1024 + lane * 16);
#pragma unroll 1
    for (int bt = 0; bt < 32; ++bt) {
        u32x4 vn[8];
        const int nb = (bt + 1 < 32) ? bt + 1 : bt;
#pragma unroll
        for (int k = 0; k < 8; ++k) vn[k] = *(const u32x4*)(TABV + (size_t)EG[nb * 8 + k].x * 1024 + lane * 16);
#pragma unroll
        for (int k = 0; k < 8; ++k) { const u32x4 eg = EG[bt * 8 + k];
            const unsigned tkk = (unsigned)__builtin_amdgcn_readfirstlane((int)eg.w); const float a = __uint_as_float((unsigned)__builtin_amdgcn_readfirstlane((int)eg.y));
            const f32x2 a2 = tkk ? (f32x2){0.f, a} : (f32x2){a, 0.f};
#pragma unroll
            for (int e = 0; e < 4; ++e) { const f32x2 lo = __builtin_amdgcn_cvt_pk_f32_fp8((int)vb[k][e], false), hi = __builtin_amdgcn_cvt_pk_f32_fp8((int)vb[k][e], true);
                outp[4 * e] += a2 * lo.x; outp[4 * e + 1] += a2 * lo.y; outp[4 * e + 2] += a2 * hi.x; outp[4 * e + 3] += a2 * hi.y; } }
#pragma unroll
        for (int k = 0; k < 8; ++k) vb[k] = vn[k];
    }
#pragma unroll
    for (int tk = 0; tk < 2; ++tk) {
        f32x4 xr[4]; float ss = 0.f;
        float* xq = xres + (tok0 + tk) * 1024 + lane * 16;
#pragma unroll
        for (int j = 0; j < 4; ++j) { xr[j] = *(const f32x4*)(xq + 4 * j);
#pragma unroll
            for (int e = 0; e < 4; ++e) { xr[j][e] += tk ? outp[4 * j + e].y : outp[4 * j + e].x; ss += xr[j][e] * xr[j][e]; } }
        const float rstd = 1.0f / sqrtf(wave_sum(ss) * (1.f / 1024.f) + EPS);
        if (LAST) {
#pragma unroll
            for (int j = 0; j < 4; ++j) { const f32x4 gg = *(const f32x4*)(gnext + lane * 16 + 4 * j); *(f32x4*)(xq + 4 * j) = xr[j] * rstd * gg; }
        } else {
            u32x4 o0, o1;
#pragma unroll
            for (int j = 0; j < 4; ++j) { *(f32x4*)(xq + 4 * j) = xr[j]; const f32x4 gg = *(const f32x4*)(gnext + lane * 16 + 4 * j);
                const unsigned lo = cvt_pk_bf16(xr[j][0] * rstd * gg[0], xr[j][1] * rstd * gg[1]), hi = cvt_pk_bf16(xr[j][2] * rstd * gg[2], xr[j][3] * rstd * gg[3]);
                if (j < 2) { o0[2 * j] = lo; o0[2 * j + 1] = hi; } else { o1[2 * (j - 2)] = lo; o1[2 * (j - 2) + 1] = hi; } }
            u32x4* hq = (u32x4*)(HB + (tok0 + tk) * 1024 + lane * 16); hq[0] = o0; hq[1] = o1;
        }
    }
}

constexpr int PQ_EL = 0, PQ_EG = 4096, PQ_HIST = 12288, PQ_BYTES = 12800;
__device__ __forceinline__ void quad_prepare(LAS unsigned char* lds_w, size_t tok0, const u32x2* TOPK, const float* TSU, const float* TSV, int lane_in) {
    int lane = lane_in; asm volatile("" : "+v"(lane));
    LAS u32x2* EL = (LAS u32x2*)(lds_w + PQ_EL); LAS u32x4* EG = (LAS u32x4*)(lds_w + PQ_EG); LAS unsigned* HIST = (LAS unsigned*)(lds_w + PQ_HIST);
    if (lane < 32) HIST[lane] = 0u;
    for (int _rp = 0; _rp <= (PEER_PROBE & 1); ++_rp)
#pragma unroll 1
    for (int th = 0; th < 32; ++th) { const int tk = th >> 3, head = th & 7;
        const u32x2* base = TOPK + ((tok0 + tk) * 16 + head * 2) * 16;
        const u32x2 e0 = base[lane >> 2];
        const u32x4 e1a = *(const u32x4*)(base + 16 + 4 * (lane & 3)), e1b = *(const u32x4*)(base + 16 + 4 * (lane & 3) + 2);
        const float s0 = __uint_as_float(e0.x);
        float cs[4]; unsigned ck[4], u[4];
        cs[0] = s0 + __uint_as_float(e1a.x); ck[0] = e0.y * 128u + e1a.y; cs[1] = s0 + __uint_as_float(e1a.z); ck[1] = e0.y * 128u + e1a.w;
        cs[2] = s0 + __uint_as_float(e1b.x); ck[2] = e0.y * 128u + e1b.y; cs[3] = s0 + __uint_as_float(e1b.z); ck[3] = e0.y * 128u + e1b.w;
#pragma unroll
        for (int m = 0; m < 4; ++m) u[m] = sortable_u32(cs[m]);
        unsigned T = 0u;
#pragma unroll 1
        for (int bit = 31; bit >= 0; --bit) {
            const unsigned cand = T | (1u << bit); unsigned cnt = 0u;
#pragma unroll
            for (int m = 0; m < 4; ++m) cnt += (unsigned)__popcll(__ballot(u[m] >= cand));
            if (cnt >= 16u) T = cand;
            if (cnt == 16u) break;
        }
        unsigned G = 0u;
#pragma unroll
        for (int m = 0; m < 4; ++m) G += (unsigned)__popcll(__ballot(u[m] > T));
        const unsigned need_eq = 16u - G; unsigned pos = 0u, eq_used = 0u;
#pragma unroll
        for (int m = 0; m < 4; ++m) {
            const bool gt = u[m] > T, eq = u[m] == T;
            const unsigned long long meq = __ballot(eq);
            const bool sl = gt || (eq && (eq_used + mbcnt64(meq) < need_eq));
            const unsigned long long msl = __ballot(sl);
            if (sl) { u32x2 e; e.x = ck[m]; e.y = __float_as_uint(cs[m]); EL[th * 16 + pos + mbcnt64(msl)] = e; }
            pos += (unsigned)__popcll(msl); eq_used += (unsigned)__popcll(meq); }
    }
    u32x4 ent8[8]; unsigned rk[8];
#pragma unroll
    for (int rep = 0; rep < 8; ++rep) { const int e = lane + 64 * rep; const u32x2 ent = EL[e]; const float sc = __uint_as_float(ent.y);
        const float su = TSU[ent.x], sv = TSV[ent.x];
        float mx = sc;
#pragma unroll
        for (int o = 1; o < 16; o <<= 1) mx = fmaxf(mx, __shfl_xor(mx, o));
        const float p = __expf(sc - mx); float sm = p;
#pragma unroll
        for (int o = 1; o < 16; o <<= 1) sm += __shfl_xor(sm, o);
        ent8[rep].x = ent.x; ent8[rep].y = __float_as_uint(su); ent8[rep].z = __float_as_uint(p / sm * sv); ent8[rep].w = (unsigned)(rep >> 1);
        rk[rep] = atomicAdd((unsigned*)&HIST[ent.x >> 9], 1u); }
    { unsigned c = (lane < 32) ? HIST[lane] : 0u, inc = c;
#pragma unroll
      for (int o = 1; o < 32; o <<= 1) { const unsigned t = (unsigned)__shfl_up((int)inc, o); if ((lane & 31) >= o) inc += t; }
      if (lane < 32) HIST[32 + lane] = inc - c; }
#pragma unroll
    for (int rep = 0; rep < 8; ++rep) EG[HIST[32 + (ent8[rep].x >> 9)] + rk[rep]] = ent8[rep];
}
__device__ __forceinline__ void quad_pass1(LAS unsigned char* lds_w, size_t tok0, const unsigned char* TABU, const bf16* HB, int lane_in) {
    int lane = lane_in; asm volatile("" : "+v"(lane));
    LAS u32x4* EG = (LAS u32x4*)(lds_w + PQ_EG);
    float x0[16], x1[16], x2[16], x3[16];
#define PQ_LOADX(xx, tk) do { const u32x4* hp = (const u32x4*)(HB + (tok0 + (tk)) * 1024 + lane * 16); const u32x4 a = hp[0], b = hp[1]; \
        _Pragma("unroll") for (int e = 0; e < 4; ++e) { xx[2 * e] = __uint_as_float(a[e] << 16); xx[2 * e + 1] = __uint_as_float(a[e] & 0xffff0000u); xx[8 + 2 * e] = __uint_as_float(b[e] << 16); xx[8 + 2 * e + 1] = __uint_as_float(b[e] & 0xffff0000u); } } while (0)
    PQ_LOADX(x0, 0); PQ_LOADX(x1, 1); PQ_LOADX(x2, 2); PQ_LOADX(x3, 3);
#undef PQ_LOADX
    u32x4 ub[8];
#pragma unroll
    for (int k = 0; k < 8; ++k) ub[k] = *(const u32x4*)(TABU + (size_t)EG[k].x * 1024 + lane * 16);
#pragma unroll 1
    for (int bt = 0; bt < 64; ++bt) {
        u32x4 un[8];
        const int nb = (bt + 1 < 64) ? bt + 1 : bt;
#pragma unroll
        for (int k = 0; k < 8; ++k) un[k] = *(const u32x4*)(TABU + (size_t)EG[nb * 8 + k].x * 1024 + lane * 16);
        float d[8];
#pragma unroll
        for (int k = 0; k < 8; ++k) {
            float f[16];
#pragma unroll
            for (int e = 0; e < 4; ++e) { const f32x2 lo = __builtin_amdgcn_cvt_pk_f32_fp8((int)ub[k][e], false), hi = __builtin_amdgcn_cvt_pk_f32_fp8((int)ub[k][e], true); f[4 * e] = lo.x; f[4 * e + 1] = lo.y; f[4 * e + 2] = hi.x; f[4 * e + 3] = hi.y; }
            const unsigned tkk = (unsigned)__builtin_amdgcn_readfirstlane((int)EG[bt * 8 + k].w);
            float a = 0.f;
            if (tkk == 0u) {
#pragma unroll
                for (int c = 0; c < 16; ++c) a += f[c] * x0[c]; }
            else if (tkk == 1u) {
#pragma unroll
                for (int c = 0; c < 16; ++c) a += f[c] * x1[c]; }
            else if (tkk == 2u) {
#pragma unroll
                for (int c = 0; c < 16; ++c) a += f[c] * x2[c]; }
            else {
#pragma unroll
                for (int c = 0; c < 16; ++c) a += f[c] * x3[c]; }
            d[k] = a; }
        float r4[4], r2[2], v1;
        { const bool h32 = (lane & 32) != 0;
#pragma unroll
          for (int j = 0; j < 4; ++j) { const float send = h32 ? d[j] : d[j + 4], keep = h32 ? d[j + 4] : d[j]; r4[j] = keep + __shfl_xor(send, 32); }
          const bool h16 = (lane & 16) != 0;
#pragma unroll
          for (int j = 0; j < 2; ++j) { const float send = h16 ? r4[j] : r4[j + 2], keep = h16 ? r4[j + 2] : r4[j]; r2[j] = keep + __shfl_xor(send, 16); }
          const bool h8 = (lane & 8) != 0;
          { const float send = h8 ? r2[0] : r2[1], keep = h8 ? r2[1] : r2[0]; v1 = keep + __shfl_xor(send, 8); }
          v1 += __shfl_xor(v1, 4); v1 += __shfl_xor(v1, 2); v1 += __shfl_xor(v1, 1); }
        { const u32x4 eg = EG[bt * 8 + (lane >> 3)]; const float x = v1 * __uint_as_float(eg.y);
          const float act = 0.5f * x * (1.0f + erff(x * 0.70710678118654752f)) * __uint_as_float(eg.z);
          if ((lane & 7) == 0) *((LAS float*)&EG[bt * 8 + (lane >> 3)] + 1) = act; }
#pragma unroll
        for (int k = 0; k < 8; ++k) ub[k] = un[k];
    }
}
template <bool LAST>
__device__ __forceinline__ void quad_pass2(LAS unsigned char* lds_w, size_t tok0, const unsigned char* TABV, bf16* HB, float* xres, const float* gnext, int lane_in) {
    int lane = lane_in; asm volatile("" : "+v"(lane));
    LAS u32x4* EG = (LAS u32x4*)(lds_w + PQ_EG);
    float o0[16], o1[16], o2[16], o3[16];
#pragma unroll
    for (int c = 0; c < 16; ++c) { o0[c] = 0.f; o1[c] = 0.f; o2[c] = 0.f; o3[c] = 0.f; }
    u32x4 vb[8];
#pragma unroll
    for (int k = 0; k < 8; ++k) vb[k] = *(const u32x4*)(TABV + (size_t)EG[k].x * 1024 + lane * 16);
#pragma unroll 1
    for (int bt = 0; bt < 64; ++bt) {
        u32x4 vn[8];
        const int nb = (bt + 1 < 64) ? bt + 1 : bt;
#pragma unroll
        for (int k = 0; k < 8; ++k) vn[k] = *(const u32x4*)(TABV + (size_t)EG[nb * 8 + k].x * 1024 + lane * 16);
#pragma unroll
        for (int k = 0; k < 8; ++k) {
            float f[16];
#pragma unroll
            for (int e = 0; e < 4; ++e) { const f32x2 lo = __builtin_amdgcn_cvt_pk_f32_fp8((int)vb[k][e], false), hi = __builtin_amdgcn_cvt_pk_f32_fp8((int)vb[k][e], true); f[4 * e] = lo.x; f[4 * e + 1] = lo.y; f[4 * e + 2] = hi.x; f[4 * e + 3] = hi.y; }
            const u32x4 eg = EG[bt * 8 + k];
            const unsigned tkk = (unsigned)__builtin_amdgcn_readfirstlane((int)eg.w); const float a = __uint_as_float((unsigned)__builtin_amdgcn_readfirstlane((int)eg.y));
            if (tkk == 0u) {
#pragma unroll
                for (int c = 0; c < 16; ++c) o0[c] += a * f[c]; }
            else if (tkk == 1u) {
#pragma unroll
                for (int c = 0; c < 16; ++c) o1[c] += a * f[c]; }
            else if (tkk == 2u) {
#pragma unroll
                for (int c = 0; c < 16; ++c) o2[c] += a * f[c]; }
            else {
#pragma unroll
                for (int c = 0; c < 16; ++c) o3[c] += a * f[c]; } }
#pragma unroll
        for (int k = 0; k < 8; ++k) vb[k] = vn[k];
    }
#define PQ_FINAL(oo, tk) do { f32x4 xr[4]; float ss = 0.f; float* xq = xres + (tok0 + (tk)) * 1024 + lane * 16; \
        _Pragma("unroll") for (int j = 0; j < 4; ++j) { xr[j] = *(const f32x4*)(xq + 4 * j); _Pragma("unroll") for (int e = 0; e < 4; ++e) { xr[j][e] += oo[4 * j + e]; ss += xr[j][e] * xr[j][e]; } } \
        const float rstd = 1.0f / sqrtf(wave_sum(ss) * (1.f / 1024.f) + EPS); \
        if (LAST) { _Pragma("unroll") for (int j = 0; j < 4; ++j) { const f32x4 gg = *(const f32x4*)(gnext + lane * 16 + 4 * j); *(f32x4*)(xq + 4 * j) = xr[j] * rstd * gg; } } \
        else { u32x4 q0, q1; \
            _Pragma("unroll") for (int j = 0; j < 4; ++j) { *(f32x4*)(xq + 4 * j) = xr[j]; const f32x4 gg = *(const f32x4*)(gnext + lane * 16 + 4 * j); \
                const unsigned lo = cvt_pk_bf16(xr[j][0] * rstd * gg[0], xr[j][1] * rstd * gg[1]), hi = cvt_pk_bf16(xr[j][2] * rstd * gg[2], xr[j][3] * rstd * gg[3]); \
                if (j < 2) { q0[2 * j] = lo; q0[2 * j + 1] = hi; } else { q1[2 * (j - 2)] = lo; q1[2 * (j - 2) + 1] = hi; } } \
            u32x4* hq = (u32x4*)(HB + (tok0 + (tk)) * 1024 + lane * 16); hq[0] = q0; hq[1] = q1; } } while (0)
    PQ_FINAL(o0, 0); PQ_FINAL(o1, 1); PQ_FINAL(o2, 2); PQ_FINAL(o3, 3);
#undef PQ_FINAL
}
__device__ __forceinline__ void xcc_sync(unsigned* ctr, unsigned nloc, unsigned target) {
    __syncthreads();
    if (threadIdx.x == 0 && nloc > 0u) {
        __hip_atomic_fetch_add(ctr, 1u, __ATOMIC_RELAXED, __HIP_MEMORY_SCOPE_AGENT);
        unsigned sp = 0u;
        while (__hip_atomic_load(ctr, __ATOMIC_RELAXED, __HIP_MEMORY_SCOPE_AGENT) < nloc * target) { __builtin_amdgcn_s_sleep(1); if (++sp > (1u << 16)) break; }
    }
    __syncthreads();
}

__device__ __forceinline__ void row_to_fp8(const float* src, unsigned char* dst, float* scale, int lane) {
    const f32x4* sp = (const f32x4*)(src + lane * 16); f32x4 v[4]; float am = 0.f;
#pragma unroll
    for (int j = 0; j < 4; ++j) { v[j] = sp[j]; am = fmaxf(am, fmaxf(fmaxf(fabsf(v[j].x), fabsf(v[j].y)), fmaxf(fabsf(v[j].z), fabsf(v[j].w)))); }
    am = wave_max(am);
    const float sc = am > 0.f ? am * (1.0f / 448.0f) : 1.0f, inv = 1.0f / sc;
    u32x4 o;
#pragma unroll
    for (int j = 0; j < 4; ++j) { int w = 0; w = __builtin_amdgcn_cvt_pk_fp8_f32(v[j].x * inv, v[j].y * inv, w, false); w = __builtin_amdgcn_cvt_pk_fp8_f32(v[j].z * inv, v[j].w * inv, w, true); o[j] = (unsigned)w; }
    *(u32x4*)(dst + lane * 16) = o;
    if (lane == 0) *scale = sc;
}

__device__ __forceinline__ void row_to_int8(const float* src, unsigned char* dst, float* scale, int lane) {
    const f32x4* sp = (const f32x4*)(src + lane * 16); f32x4 v[4]; float am = 0.f;
#pragma unroll
    for (int j = 0; j < 4; ++j) { v[j] = sp[j]; am = fmaxf(am, fmaxf(fmaxf(fabsf(v[j].x), fabsf(v[j].y)), fmaxf(fabsf(v[j].z), fabsf(v[j].w)))); }
    am = wave_max(am);
    const float sc = am > 0.f ? am * (1.0f / 127.0f) : 1.0f, inv = 1.0f / sc;
    u32x4 o;
#pragma unroll
    for (int j = 0; j < 4; ++j) { const int q0 = (int)rintf(v[j].x * inv), q1 = (int)rintf(v[j].y * inv), q2 = (int)rintf(v[j].z * inv), q3 = (int)rintf(v[j].w * inv);
        o[j] = (unsigned)((q0 & 0xff) | ((q1 & 0xff) << 8) | ((q2 & 0xff) << 16) | ((q3 & 0xff) << 24)); }
    *(u32x4*)(dst + lane * 16) = o;
    if (lane == 0) *scale = sc;
}

template <bool FP8>
__device__ __forceinline__ void rows4_to_q8(const float* src, size_t rstride_f, unsigned char* dst, size_t rstride_b, float* scale, size_t sstride, int lane) {
    f32x4 v[4][4];
#pragma unroll
    for (int i = 0; i < 4; ++i) { const f32x4* sp = (const f32x4*)(src + (size_t)i * rstride_f + lane * 16);
#pragma unroll
        for (int j = 0; j < 4; ++j) v[i][j] = sp[j]; }
#pragma unroll
    for (int i = 0; i < 4; ++i) { float am = 0.f;
#pragma unroll
        for (int j = 0; j < 4; ++j) am = fmaxf(am, fmaxf(fmaxf(fabsf(v[i][j].x), fabsf(v[i][j].y)), fmaxf(fabsf(v[i][j].z), fabsf(v[i][j].w))));
        am = wave_max(am);
        const float sc = am > 0.f ? am * (FP8 ? (1.0f / 448.0f) : (1.0f / 127.0f)) : 1.0f, inv = 1.0f / sc;
        u32x4 o;
#pragma unroll
        for (int j = 0; j < 4; ++j) {
            if (FP8) { int w = 0; w = __builtin_amdgcn_cvt_pk_fp8_f32(v[i][j].x * inv, v[i][j].y * inv, w, false); w = __builtin_amdgcn_cvt_pk_fp8_f32(v[i][j].z * inv, v[i][j].w * inv, w, true); o[j] = (unsigned)w; }
            else { const int q0 = (int)rintf(v[i][j].x * inv), q1 = (int)rintf(v[i][j].y * inv), q2 = (int)rintf(v[i][j].z * inv), q3 = (int)rintf(v[i][j].w * inv);
                o[j] = (unsigned)((q0 & 0xff) | ((q1 & 0xff) << 8) | ((q2 & 0xff) << 16) | ((q3 & 0xff) << 24)); } }
        *(u32x4*)(dst + (size_t)i * rstride_b + lane * 16) = o;
        if (lane == 0) scale[(size_t)i * sstride] = sc; }
}

__global__ void __launch_bounds__(NTHR, 2) trunk_fwd(Args args) {
    extern __shared__ __attribute__((aligned(16))) unsigned char lds_raw[];
    LAS unsigned char* lds = (LAS unsigned char*)lds_raw;
    const int tid = threadIdx.x, lane = tid & 63, wave = __builtin_amdgcn_readfirstlane(tid >> 6);
    const int G = gridDim.x, bx = blockIdx.x;
    unsigned char* ws = args.ws;
    unsigned* ctl = (unsigned*)(ws + WS_CTL);
    volatile LAS unsigned* LCTL = (volatile LAS unsigned*)(lds + LDS_CTL);
    for (int u = tid; u < 512; u += NTHR) LCTL[u] = 0u;
    __syncthreads();
    XcdBarrier bar; bar.bar = ctl + CW_BAR; bar.x = 0; bar.st = nullptr;
    if (!MK_PER_PHASE) bar = xcd_barrier_post(ctl + CW_BAR, LCTL + 8);
    const int lo = args.ph_lo, hi = args.ph_hi;
#define IN(k) (lo <= (k) && (k) < hi)
#define SEAM(k) do { if (IN(k) && IN((k) + 1)) xcd_barrier(bar); } while (0)
#define SEAM2(k) do { if (IN(k) && IN((k) + 2)) xcd_barrier(bar); } while (0)
#define REP(k) for (int _r = 0; _r <= ((PROBE_MASK >> (k)) & 1); ++_r)
    const size_t gtid = (size_t)bx * NTHR + tid, gthreads = (size_t)G * NTHR;
    const int gw = bx * NWAVES + wave, NGW = G * NWAVES;

    const float* x_in = args.in[I_X];
    float* xres = args.out;
    bf16* WA = (bf16*)(ws + WS_WA); bf16* WB = (bf16*)(ws + WS_WB); bf16* WO = (bf16*)(ws + WS_WO); bf16* WKV = (bf16*)(ws + WS_WKV); bf16* WQ = (bf16*)(ws + WS_WQ);
    bf16* MEMN = (bf16*)(ws + WS_MEMN); bf16* KV = (bf16*)(ws + WS_KV); bf16* HB = (bf16*)(ws + WS_HB); bf16* MIX = (bf16*)(ws + WS_MIX);
    unsigned char* TAB8 = ws + WS_TAB;
    float* TSC = (float*)(ws + WS_TSC);
    unsigned char* AR = ws + WS_AR;
    bf16* QMEM = (bf16*)(AR + AR_QMEM);
    bf16* Qb = (bf16*)args.out; bf16* QMEM0 = (bf16*)args.out + (size_t)M * 768;
    bf16* QLb = (bf16*)(AR + AR_QL);
    bf16* Zb = (bf16*)(AR + AR_Z); bf16* XBC = (bf16*)(AR + AR_XBC); float* DTb = (float*)(AR + AR_DT); bf16* XC = (bf16*)(AR + AR_XC); bf16* STATES = (bf16*)(AR + AR_ST); bf16* Yb = (bf16*)(AR + AR_Y);
    float* DEC = (float*)(ws + WS_DEC); float* SSb = (float*)(ws + WS_SS);
    bf16* UKb = (bf16*)(ws + WS_UK); bf16* UVTb = (bf16*)(ws + WS_UVT); bf16* SUBKb = (bf16*)(ws + WS_SUBK);
    bf16* PQb = (bf16*)(AR + AR_PQ); u32x2* TOPK = (u32x2*)(AR + AR_TOPK);

    if (IN(0)) REP(0) {
        LAS float* scr = (LAS float*)(lds + LDS_SCR + wave * 8704);
        const float* awin = args.in[I_AWIN]; const float* bwin = args.in[I_BWIN];
        const int nA0 = titems(1536), nA1 = titems(256), nA2 = titems(64), nA3 = titems(8);
        const int nB0 = titems(2048), nB1 = titems(256), nB2 = titems(12);
        const int nO = titems(1024), nKV = titems(512), nQ = titems(2048);
        const int NIT = nA0 + nA1 + nA2 + nA3 + nB0 + nB1 + nB2 + 2 * nO + 2 * nKV + 2 * nQ;
        for (int it = gw; it < NIT; it += NGW) {
            int r = it;
            if (r < nA0) { transpose_item(awin, 1864, 0, 1536, WA, 0, scr, r, lane); continue; } r -= nA0;
            if (r < nA1) { transpose_item(awin, 1864, 1608, 256, WA, 1536, scr, r, lane); continue; } r -= nA1;
            if (r < nA2) { transpose_item(awin, 1864, 1536, 64, WA, 1792, scr, r, lane); continue; } r -= nA2;
            if (r < nA3) { transpose_item(awin, 1864, 1600, 8, WA, 1856, scr, r, lane); continue; } r -= nA3;
            if (r < nB0) { transpose_item(bwin, 2316, 0, 2048, WB, 0, scr, r, lane); continue; } r -= nB0;
            if (r < nB1) { transpose_item(bwin, 2316, 2060, 256, WB, 2048, scr, r, lane); continue; } r -= nB1;
            if (r < nB2) { transpose_item(bwin, 2316, 2048, 12, WB, 2304, scr, r, lane); continue; } r -= nB2;
            if (r < 2 * nO) { const int l = r / nO; transpose_item(args.in[I_WO] + (size_t)l * 1024 * 1024, 1024, 0, 1024, WO, l * 1024, scr, r - l * nO, lane); continue; } r -= 2 * nO;
            if (r < 2 * nKV) { const int l = r / nKV; transpose_item(args.in[I_WMEMKV] + (size_t)l * 1024 * 512, 512, 0, 512, WKV, l * 512, scr, r - l * nKV, lane); continue; } r -= 2 * nKV;
            { const int l = r / nQ; transpose_item(args.in[I_PWQ] + (size_t)l * 1024 * 2048, 2048, 0, 2048, WQ, l * 2048, scr, r - l * nQ, lane, args.in[I_FFNNORM] + l * D); }
        }
        for (size_t i = gtid; i < (size_t)(2048 - 1864) * 128; i += gthreads) *((u32x4*)(WA + (size_t)1864 * 1024) + i) = (u32x4){0u, 0u, 0u, 0u};
        for (size_t i = gtid; i < (size_t)(2560 - 2316) * 128; i += gthreads) *((u32x4*)(WB + (size_t)2316 * 1024) + i) = (u32x4){0u, 0u, 0u, 0u};
        for (size_t i = gtid; i < (size_t)2 * M; i += gthreads) SSb[i] = 0.f;
        for (int m = gw; m < BATCH * MEMLEN; m += NGW) rms_row_to_bf16(args.in[I_MEM] + (size_t)m * D, args.in[I_MEMNORM], MEMN + (size_t)m * D, lane);
        for (int m = gw; m < M; m += 4 * NGW) rms_rows4_to_bf16(x_in + (size_t)m * D, (size_t)NGW * D, args.in[I_MIXNORM], HB + (size_t)m * D, lane);
        cvt_stream(args.in[I_AWUK], UKb, (size_t)12 * 256 * 64, gtid, gthreads);
        for (size_t i = gtid; i < (size_t)12 * 64 * 256; i += gthreads) { const int h = (int)(i >> 14), d = (int)((i >> 8) & 63), c = (int)(i & 255);
            UVTb[i] = (bf16)(cvt_pk_bf16(args.in[I_AWUV][((size_t)h * 256 + c) * 64 + d], 0.f) & 0xffffu); }
        cvt_stream(args.in[I_PSUBK], SUBKb, (size_t)2 * 2 * 128 * 128, gtid, gthreads);
        for (int tbl = 0; tbl < 2; ++tbl) { const int l = tbl >> 1, tv = tbl & 1;
            const float* srcb = args.in[tv ? I_PV : I_PU] + (size_t)l * 16384 * 1024; unsigned char* dstb = TAB8 + (size_t)l * 32 * MiB + (size_t)tv * 1024; float* scb = TSC + (l * 2 + tv) * 16384;
            for (int e = gw; e < 16384; e += 4 * NGW) {
                if (tv) rows4_to_q8<true>(srcb + (size_t)e * 1024, (size_t)NGW * 1024, dstb + (size_t)e * 2048, (size_t)NGW * 2048, scb + e, NGW, lane);
                else rows4_to_q8<false>(srcb + (size_t)e * 1024, (size_t)NGW * 1024, dstb + (size_t)e * 2048, (size_t)NGW * 2048, scb + e, NGW, lane); } }
    }
    SEAM(0);
    if (IN(1)) REP(1) {
        { pg8::Gemm g{HB, WA, M, NA, D}; pg8::StaticOrder S; S.init(M, NA, G, bx);
          EpiInA E{Qb, (float*)(AR + AR_CKV32), (bf16*)(AR + AR_IQ), QMEM0, (bf16*)(AR + AR_IK), (float*)(AR + AR_IW)};
          pg8::gemm_phase<EpiInA, pg8::StaticOrder, true, true>(lds + LDS_SCR, g, S, E); }
        { pg8::Gemm g{MEMN, WKV, BATCH * MEMLEN, 1024, D}; pg8::StaticOrder S; S.init(BATCH * MEMLEN, 1024, G, bx);
          EpiPlain E{KV, 1024};
          pg8::gemm_phase<EpiPlain, pg8::StaticOrder, true, true>(lds + LDS_SCR, g, S, E); }
        if (bx >= 32) { const int gw2 = (bx - 32) * NWAVES + wave, NGW2 = (G - 32) * NWAVES;
            for (int tv = 0; tv < 2; ++tv) {
                const float* srcb = args.in[tv ? I_PV : I_PU] + (size_t)16384 * 1024; unsigned char* dstb = TAB8 + (size_t)32 * MiB + (size_t)tv * 1024; float* scb = TSC + (2 + tv) * 16384;
                for (int e = gw2; e < 4096; e += NGW2) {
                    if (tv) rows4_to_q8<true>(srcb + (size_t)e * 1024, (size_t)4096 * 1024, dstb + (size_t)e * 2048, (size_t)4096 * 2048, scb + e, 4096, lane);
                    else rows4_to_q8<false>(srcb + (size_t)e * 1024, (size_t)4096 * 1024, dstb + (size_t)e * 2048, (size_t)4096 * 2048, scb + e, 4096, lane); } } }
    }
    SEAM(1);
    if (IN(2)) REP(2) {
        { const float* src = (const float*)(AR + AR_CKV32); bf16* dst = (bf16*)(AR + AR_CKV); const f32x4 gg = *((const f32x4*)args.in[I_AKVNORM] + lane);
          for (int m = gw; m < M; m += 4 * NGW) {
              f32x4 v[4];
#pragma unroll
              for (int i = 0; i < 4; ++i) v[i] = *((const f32x4*)(src + (size_t)(m + i * NGW) * 256) + lane);
#pragma unroll
              for (int i = 0; i < 4; ++i) { const float ss = wave_sum((v[i].x * v[i].x + v[i].y * v[i].y) + (v[i].z * v[i].z + v[i].w * v[i].w)); const float rstd = 1.0f / sqrtf(ss * (1.f / 256.f) + EPS);
                  u32x2 o; o.x = cvt_pk_bf16(v[i].x * rstd * gg.x, v[i].y * rstd * gg.y); o.y = cvt_pk_bf16(v[i].z * rstd * gg.z, v[i].w * rstd * gg.w);
                  *((u32x2*)(dst + (size_t)(m + i * NGW) * 256) + lane) = o; } } }
        for (int u = bx; u < 512; u += G) memattn_unit(lds + LDS_SCR, u, 0, KV, QMEM0, MIX, tid, wave, lane);
        qlat_phase(lds + LDS_SCR, bx, G, 3072, Qb, UKb, QLb, tid, wave, lane);
    }
    SEAM(2);
    if (IN(3)) REP(3) {
        { LAS float* RB = (LAS float*)(lds + LDS_SCR + DS_RB); const float* rbias = args.in[I_RELBIAS];
          for (int i = tid; i < 512; i += NTHR) { const int bk = i >> 4, h = i & 15; RB[i] = h < 12 ? rbias[bk * 12 + h] : 0.f; } }
        for (int u = bx; u < 4096; u += G) dsa_unit(lds + LDS_SCR, u, QLb, (const bf16*)(AR + AR_CKV), (const bf16*)(AR + AR_IQ), (const bf16*)(AR + AR_IK), (const float*)(AR + AR_IW), tid, wave, lane);
    }
    SEAM(3);
    if (IN(4)) REP(4) { uv_phase(lds + LDS_SCR, bx, G, 3072, QLb, UVTb, MIX, tid, wave, lane); }
    SEAM(4);
    if (IN(5)) REP(5) {
        pg8::Gemm g{MIX, WO, M, D, D}; pg8::StaticOrder S; S.init(M, D, G, bx);
        EpiResid<false> E{x_in, HB, SSb};
        pg8::gemm_phase<EpiResid<false>, pg8::StaticOrder, true, true>(lds + LDS_SCR, g, S, E);
    }
    SEAM2(5);
    if (IN(7)) REP(7) {
        pg8::Gemm g{HB, WQ, M, 2048, D}; pg8::StaticOrder S; S.init(M, 2048, G, bx);
        EpiPQ E{PQb, SSb};
        pg8::gemm_phase<EpiPQ, pg8::StaticOrder, true, true>(lds + LDS_SCR, g, S, E);
    }
    SEAM(7);
    if (IN(8)) REP(8) { peer_topk_load_sk(lds + LDS_SCR, SUBKb, tid); for (int task = gw; task < 16384; task += NGW) peer_topk_task(lds + LDS_SCR, task, PQb, TOPK, wave, lane); }
    SEAM(8);
    if (IN(9)) { peer_wave<false>(lds + LDS_SCR + wave * PW_BYTES, gw, NGW, M / 2, TOPK, TAB8, TAB8 + 1024, TSC, TSC + 16384, HB, SSb, args.in[I_FFNNORM], xres, args.in[I_MIXNORM] + D, lane, ctl + CW_XS + 64 * xb_xcc_id(), MK_PER_PHASE ? 0u : LCTL[8], 0u); }
    SEAM(9);
    if (IN(10)) REP(10) {
        pg8::Gemm g{HB, WB, M, NB, D}; pg8::StaticOrder S; S.init(M, NB, G, bx);
        EpiInB E{(bf16*)(AR + AR_Z), (bf16*)(AR + AR_XBC), QMEM, (float*)(AR + AR_DT)};
        pg8::gemm_phase<EpiInB, pg8::StaticOrder, true, true>(lds + LDS_SCR, g, S, E);
    }
    SEAM(10);
    if (IN(11)) REP(11) {
        for (int u = bx; u < 512; u += G) memattn_unit(lds + LDS_SCR, u, 1, KV, QMEM, MIX, tid, wave, lane);
        for (int u = bx; u < 256; u += G) ssd_states_unit(lds + LDS_SCR, u, XBC, DTb, args.in[I_BCONVW], args.in[I_BCONVB], args.in[I_BDTBIAS], args.in[I_BALOG], XC, STATES, DEC, tid, wave, lane);
    }
    SEAM(11);
    if (IN(12)) { ssd_scan(STATES, DEC, gtid, gthreads); }
    SEAM(12);
    if (IN(13)) REP(13) { for (int u = bx; u < 256; u += G) ssd_out_unit(lds + LDS_SCR, u, XC, DTb, Zb, STATES, args.in[I_BDTBIAS], args.in[I_BALOG], args.in[I_BDSKIP], args.in[I_BOUTNORM], Yb, MIX, tid, wave, lane); }
    SEAM(13);
    if (IN(14)) {
        pg8::Gemm g{MIX, WO + (size_t)1024 * 1024, M, D, D}; pg8::StaticOrder S; S.init(M, D, G, bx);
        EpiResid<true> E{(const bf16*)xres, HB, SSb + M};
        pg8::gemm_phase<EpiResid<true>, pg8::StaticOrder, true, true>(lds + LDS_SCR, g, S, E);
    }
    SEAM2(14);
    if (IN(16)) REP(16) {
        pg8::Gemm g{HB, WQ + (size_t)2048 * 1024, M, 2048, D}; pg8::StaticOrder S; S.init(M, 2048, G, bx);
        EpiPQ E{PQb, SSb + M};
        pg8::gemm_phase<EpiPQ, pg8::StaticOrder, true, true>(lds + LDS_SCR, g, S, E);
    }
    SEAM(16);
    if (IN(17)) REP(17) { peer_topk_load_sk(lds + LDS_SCR, SUBKb + 32768, tid); for (int task = gw; task < 16384; task += NGW) peer_topk_task(lds + LDS_SCR, task, PQb, TOPK, wave, lane); }
    SEAM(17);
    if (IN(18)) { peer_wave<true>(lds + LDS_SCR + wave * PW_BYTES, gw, NGW, M / 2, TOPK, TAB8 + 32 * MiB, TAB8 + 32 * MiB + 1024, TSC + 32768, TSC + 49152, HB, SSb + M, args.in[I_FFNNORM] + D, xres, args.in[I_FINALNORM], lane, ctl + CW_XS + 64 * xb_xcc_id(), MK_PER_PHASE ? 0u : LCTL[8], 8u); }
#undef IN
#undef SEAM
#undef SEAM2
#undef REP
}

extern "C" void kernel_launch(void* const* d_in, const int* in_sizes, int n_in, void* d_out, int out_size, void* d_ws, size_t ws_size, hipStream_t stream) {
    static int grid = 0;
    if (grid == 0) {
        if (n_in != 24 || in_sizes[0] != M * D || out_size != M * D || ws_size < WS_END) { fprintf(stderr, "kernel_launch: unexpected shapes (n_in %d, ws %zu); nothing launched\n", n_in, ws_size); grid = -1; return; }
        int dev = 0, cus = 0, per_cu = 0;
        if (hipGetDevice(&dev) != hipSuccess || hipDeviceGetAttribute(&cus, hipDeviceAttributeMultiprocessorCount, dev) != hipSuccess) { grid = -1; return; }
        if (hipFuncSetAttribute((const void*)trunk_fwd, hipFuncAttributeMaxDynamicSharedMemorySize, LDS_BYTES) != hipSuccess) { fprintf(stderr, "kernel_launch: hipFuncSetAttribute failed\n"); grid = -1; return; }
        if (hipOccupancyMaxActiveBlocksPerMultiprocessor(&per_cu, (const void*)trunk_fwd, NTHR, LDS_BYTES) != hipSuccess || per_cu < 1) { fprintf(stderr, "kernel_launch: occupancy query says %d\n", per_cu); }
        (void)hipGetLastError();
        grid = cus;
    }
    if (grid < 0) return;
    if (hipMemsetAsync((char*)d_ws + WS_CTL, 0, CTL_ZERO_BYTES, stream) != hipSuccess) return;
    Args a{};
    for (int i = 0; i < 24; ++i) a.in[i] = (const float*)d_in[i];
    a.out = (float*)d_out; a.ws = (unsigned char*)d_ws;
#if MK_PER_PHASE
    for (int p = 0; p < NPHASE; ++p) { a.ph_lo = p; a.ph_hi = p + 1; hipLaunchKernelGGL(trunk_fwd, dim3(grid), dim3(NTHR), LDS_BYTES, stream, a); }
#else
    a.ph_lo = 0; a.ph_hi = NPHASE;
    hipLaunchKernelGGL(trunk_fwd, dim3(grid), dim3(NTHR), LDS_BYTES, stream, a);
#endif
}
```

```cpp
#include <hip/hip_runtime.h>
#include <cstdio>
#include <cstdint>
#ifndef PROBE_MASK
#define PROBE_MASK 0
#endif
#ifndef DSA_PROBE
#define DSA_PROBE 0
#endif
#ifndef PEER_PROBE
#define PEER_PROBE 0
#endif
#ifndef SSD_PROBE
#define SSD_PROBE 0
#endif
#ifndef FORCE_FALLBACK
#define FORCE_FALLBACK 0
#endif
#define BIS_CAP(n) (FORCE_FALLBACK ? 0 : (n))
#ifndef PEER_ROT
#define PEER_ROT 0
#endif
#ifndef PRIO_STATIC
#define PRIO_STATIC 1
#endif
#ifndef PEER_XMID
#define PEER_XMID 1
#endif
#ifndef PEER_WGSYNC
#define PEER_WGSYNC 4
#endif
#ifndef MK_PER_PHASE
#define MK_PER_PHASE 0
#endif
namespace pg8 {
#define PG8_LAS __attribute__((address_space(3)))
typedef unsigned short bf16_t;
typedef short bf16x8 __attribute__((ext_vector_type(8)));
typedef float f32x4 __attribute__((ext_vector_type(4)));
typedef unsigned u32x4 __attribute__((ext_vector_type(4)));
constexpr int BM = 256, BK = 64, HALF = 128, HTB = HALF * BK * 2  , STAGE_BYTES = 8 * HTB, NXCD = 8, WGM = 8;

__host__ __device__ __forceinline__ int lds_byte(int r, int c) { const int st = (r >> 4) * 2 + (c >> 5), rr = r & 15, cc = c & 31, ob = rr * 64 + cc * 2; return st * 1024 + (ob ^ (((ob >> 9) & 1) << 5)); }
__host__ __device__ __forceinline__ void stage_rc(int b, int& R, int& C) { const int st = b / 1024, sb = b % 1024, swz = sb ^ (((sb >> 9) & 1) << 5); R = (st >> 1) * 16 + swz / 64; C = (st & 1) * 32 + (swz % 64) / 2; }
__host__ __device__ __forceinline__ int perm32(int rho) { const int n = rho >> 4, i = rho & 15; return 8 * (i >> 2) + 4 * n + (i & 3); }

struct Unit { int pm, pn; };
struct Gemm { const bf16_t* A; const bf16_t* Bt; int M, N, K; };

struct StaticOrder {
    int nM, nN, nwg, G, c;
    __host__ __device__ void init(int M, int N, int G_, int c_) { nM = M / BM; nN = N / BM; nwg = nM * nN; G = G_; c = c_; }
    __host__ __device__ bool next(int i, Unit& u) const {
        const long L = (long)i * G + c; if (L >= nwg) return false;
        int wgid = (int)L; { const int q = nwg / NXCD, r = nwg % NXCD, xcd = wgid % NXCD, off = wgid / NXCD; wgid = (xcd < r ? xcd * (q + 1) : r * (q + 1) + (xcd - r) * q) + off; }
        const int nig = WGM * nN, gid = wgid / nig, fm = gid * WGM, gsz = (nM - fm) < WGM ? (nM - fm) : WGM;
        u.pm = fm + ((wgid % nig) % gsz); u.pn = (wgid % nig) / gsz; return true;
    }
    __device__ __forceinline__ void a_ready(const Unit&) const {}
    __device__ __forceinline__ void done(const Unit&) const {}
};
__device__ __forceinline__ unsigned cvt_pk_bf16(float lo, float hi) { unsigned r; asm volatile("v_cvt_pk_bf16_f32 %0, %1, %2" : "=v"(r) : "v"(lo), "v"(hi)); return r; }
template <class Epi, class Sched, bool ALIGN_EPI = false, bool SP2 = false>
__device__ __forceinline__ void gemm_phase(PG8_LAS unsigned char* lds, const Gemm g, const Sched& S, const Epi& E) {
    const int tid = threadIdx.x, wid = __builtin_amdgcn_readfirstlane(tid >> 6), lane = tid & 63, wr = wid >> 2, wc = wid & 3, fr = lane & 15, fq = lane >> 4;
    const int K = g.K, nt = K / BK;
    unsigned voffA[2], voffB[2];
#pragma unroll
    for (int i = 0; i < 2; ++i) { int R, C; stage_rc(tid * 16 + i * 8192, R, C); const int Rb = Epi::PERM ? ((R & ~31) + perm32(R & 31)) : R;
        voffA[i] = (unsigned)(R * K + C) * 2u; voffB[i] = (unsigned)(Rb * K + C) * 2u; }
    const size_t kstep = (size_t)(BK * 2);
    const size_t hstep = (size_t)HALF * K * 2;
    const size_t tstep = 2 * hstep;
    const unsigned ldsw = (unsigned)wid * 1024u;
    const int aoff = lds_byte(wr * 64 + fr, fq * 8), boff = lds_byte(wc * 32 + fr, fq * 8);
#define PG8_SA(b, h) (((b) * 2 + (h)) * HTB)
#define PG8_SB(b, h) ((4 + (b) * 2 + (h)) * HTB)
#define PG8_STAGE(bufoff, gbase, voff) do { _Pragma("unroll") for (int _i = 0; _i < 2; ++_i) \
        __builtin_amdgcn_global_load_lds((const unsigned*)((const char*)(gbase) + (voff)[_i]), (PG8_LAS unsigned*)(lds + (bufoff) + ldsw + _i * 8192), 16, 0, 0); } while (0)
#define PG8_LDA(dst, b, h) do { _Pragma("unroll") for (int m = 0; m < 4; ++m) _Pragma("unroll") for (int k = 0; k < 2; ++k) dst[m][k] = *(const PG8_LAS bf16x8*)(lds + PG8_SA(b, h) + aoff + m * 2048 + k * 1024); } while (0)
#define PG8_LDB(dst, b, h) do { _Pragma("unroll") for (int n = 0; n < 2; ++n) _Pragma("unroll") for (int k = 0; k < 2; ++k) dst[n][k] = *(const PG8_LAS bf16x8*)(lds + PG8_SB(b, h) + boff + n * 2048 + k * 1024); } while (0)
#define PG8_MMA(ai, bj, At, Bt) do { __builtin_amdgcn_s_setprio(1); _Pragma("unroll") for (int m = 0; m < 4; ++m) _Pragma("unroll") for (int n = 0; n < 2; ++n) _Pragma("unroll") for (int k = 0; k < 2; ++k) \
        acc[ai][bj][m][n] = __builtin_amdgcn_mfma_f32_16x16x32_bf16(Bt[n][k], At[m][k], acc[ai][bj][m][n], 0, 0, 0); __builtin_amdgcn_s_setprio(0); } while (0)
#define PG8_WAIT_V(n) asm volatile("s_waitcnt vmcnt(" #n ")" ::: "memory")
#define PG8_WAIT_L(n) asm volatile("s_waitcnt lgkmcnt(" #n ")" ::: "memory")
#define PG8_BAR __builtin_amdgcn_s_barrier()
#define PG8_SCHED __builtin_amdgcn_sched_barrier(0)
    Unit cur, nxt; int ui = 0;
    if (!S.next(0, cur)) return;
    f32x4 acc[2][2][4][2];
#pragma unroll
    for (int a = 0; a < 2; ++a)
#pragma unroll
        for (int b = 0; b < 2; ++b)
#pragma unroll
            for (int m = 0; m < 4; ++m)
#pragma unroll
                for (int n = 0; n < 2; ++n) acc[a][b][m][n] = (f32x4){0.f, 0.f, 0.f, 0.f};
    bf16x8 At[4][2], B0[2][2], B1[2][2];
    const char* cA = (const char*)g.A + (size_t)cur.pm * tstep; const char* cB = (const char*)g.Bt + (size_t)cur.pn * tstep;
    S.a_ready(cur);
    if constexpr (SP2) {
        PG8_STAGE(PG8_SB(0, 0), cB, voffB); PG8_STAGE(PG8_SB(0, 1), cB + hstep, voffB); PG8_STAGE(PG8_SA(0, 0), cA, voffA); PG8_STAGE(PG8_SA(0, 1), cA + hstep, voffA);
        if (wr == 1) PG8_BAR;
        PG8_WAIT_V(2); PG8_BAR;
        PG8_STAGE(PG8_SB(1, 0), cB + kstep, voffB); PG8_STAGE(PG8_SA(1, 0), cA + kstep, voffA); PG8_STAGE(PG8_SB(1, 1), cB + hstep + kstep, voffB);
        PG8_WAIT_V(6); PG8_BAR;
    } else {
        PG8_STAGE(PG8_SB(0, 0), cB, voffB); PG8_STAGE(PG8_SA(0, 0), cA, voffA); PG8_STAGE(PG8_SB(0, 1), cB + hstep, voffB); PG8_STAGE(PG8_SA(0, 1), cA + hstep, voffA);
        if (wr == 1) PG8_BAR;
        PG8_WAIT_V(4); PG8_BAR;
        PG8_STAGE(PG8_SB(1, 0), cB + kstep, voffB); PG8_STAGE(PG8_SA(1, 0), cA + kstep, voffA); PG8_STAGE(PG8_SB(1, 1), cB + hstep + kstep, voffB);
        PG8_WAIT_V(6); PG8_BAR;
    }
    for (;;) {
        const bool has_next = S.next(ui + 1, nxt);
        const char* nA = has_next ? (const char*)g.A + (size_t)nxt.pm * tstep : cA; const char* nB = has_next ? (const char*)g.Bt + (size_t)nxt.pn * tstep : cB;
        for (int t = 0; t < nt; t += 2) {
            const bool last = (t == nt - 2);
            const char* a1 = cA + (size_t)(t + 1) * kstep;
            const char* a2 = last ? nA : cA + (size_t)(t + 2) * kstep; const char* b2 = last ? nB : cB + (size_t)(t + 2) * kstep;
            const char* a3 = a2 + kstep; const char* b3 = b2 + kstep;
            if (last && has_next) S.a_ready(nxt);
            if constexpr (SP2) {
            PG8_LDB(B0, 0, 0); PG8_LDB(B1, 0, 1); PG8_SCHED; PG8_LDA(At, 0, 0); PG8_STAGE(PG8_SA(1, 1), a1 + hstep, voffA);
            PG8_WAIT_V(8); PG8_WAIT_L(0); PG8_BAR; PG8_MMA(0, 0, At, B0); PG8_MMA(0, 1, At, B1); PG8_BAR; PG8_SCHED;
            PG8_LDA(At, 0, 1); PG8_STAGE(PG8_SB(0, 0), b2, voffB); PG8_STAGE(PG8_SB(0, 1), b2 + hstep, voffB); PG8_STAGE(PG8_SA(0, 0), a2, voffA);
            PG8_WAIT_V(8); PG8_WAIT_L(0); PG8_BAR; PG8_MMA(1, 0, At, B0); PG8_MMA(1, 1, At, B1); PG8_BAR; PG8_SCHED;
            PG8_LDB(B0, 1, 0); PG8_LDB(B1, 1, 1); PG8_SCHED; PG8_LDA(At, 1, 0); PG8_STAGE(PG8_SA(0, 1), a2 + hstep, voffA);
            PG8_WAIT_V(8); PG8_WAIT_L(0); PG8_BAR; PG8_MMA(0, 0, At, B0); PG8_MMA(0, 1, At, B1); PG8_BAR; PG8_SCHED;
            PG8_LDA(At, 1, 1); PG8_STAGE(PG8_SB(1, 0), b3, voffB); PG8_STAGE(PG8_SB(1, 1), b3 + hstep, voffB); PG8_STAGE(PG8_SA(1, 0), a3, voffA);
            PG8_WAIT_V(8); PG8_WAIT_L(0); PG8_BAR; PG8_MMA(1, 0, At, B0); PG8_MMA(1, 1, At, B1); PG8_BAR; PG8_SCHED;
            } else {
            PG8_LDB(B0, 0, 0); PG8_SCHED; PG8_LDA(At, 0, 0); PG8_STAGE(PG8_SA(1, 1), a1 + hstep, voffA);
            PG8_WAIT_L(8); PG8_BAR; PG8_WAIT_L(0); PG8_MMA(0, 0, At, B0); PG8_BAR; PG8_SCHED;
            PG8_LDB(B1, 0, 1); PG8_STAGE(PG8_SB(0, 0), b2, voffB);
            PG8_BAR; PG8_WAIT_L(0); PG8_MMA(0, 1, At, B1); PG8_BAR;
            PG8_LDA(At, 0, 1); PG8_STAGE(PG8_SA(0, 0), a2, voffA);
            PG8_BAR; PG8_WAIT_L(0); PG8_MMA(1, 0, At, B0); PG8_BAR; PG8_SCHED;
            PG8_STAGE(PG8_SB(0, 1), b2 + hstep, voffB);
            PG8_WAIT_V(6); PG8_BAR; PG8_MMA(1, 1, At, B1); PG8_BAR;
            PG8_LDB(B0, 1, 0); PG8_SCHED; PG8_LDA(At, 1, 0); PG8_STAGE(PG8_SA(0, 1), a2 + hstep, voffA);
            PG8_WAIT_L(8); PG8_BAR; PG8_WAIT_L(0); PG8_MMA(0, 0, At, B0); PG8_BAR; PG8_SCHED;
            PG8_LDB(B1, 1, 1); PG8_STAGE(PG8_SB(1, 0), b3, voffB);
            PG8_BAR; PG8_WAIT_L(0); PG8_MMA(0, 1, At, B1); PG8_BAR;
            PG8_LDA(At, 1, 1); PG8_STAGE(PG8_SA(1, 0), a3, voffA);
            PG8_BAR; PG8_WAIT_L(0); PG8_MMA(1, 0, At, B0); PG8_BAR; PG8_SCHED;
            PG8_STAGE(PG8_SB(1, 1), b3 + hstep, voffB);
            PG8_WAIT_V(6); PG8_BAR; PG8_MMA(1, 1, At, B1); PG8_BAR;
            }
        }
        if constexpr (ALIGN_EPI) { if (wr == 0) PG8_BAR; }
        if constexpr (!Epi::AFTER_DRAIN) { E(acc, cur, wr, wc, fr, fq); S.done(cur); }
        if (!has_next) break;
#pragma unroll
        for (int a = 0; a < 2; ++a)
#pragma unroll
            for (int b = 0; b < 2; ++b)
#pragma unroll
                for (int m = 0; m < 4; ++m)
#pragma unroll
                    for (int n = 0; n < 2; ++n) acc[a][b][m][n] = (f32x4){0.f, 0.f, 0.f, 0.f};
        cur = nxt; cA = nA; cB = nB; ++ui;
        if constexpr (ALIGN_EPI) { if (wr == 1) PG8_BAR; }
    }
    PG8_WAIT_V(0);
    if constexpr (!ALIGN_EPI) { if (wr == 0) PG8_BAR; }
    PG8_BAR;
    if constexpr (Epi::AFTER_DRAIN) { E.fused(acc, cur, wr, wc, fr, fq, lds, wid, lane); S.done(cur); }
#undef PG8_SA
#undef PG8_SB
#undef PG8_STAGE
#undef PG8_LDA
#undef PG8_LDB
#undef PG8_MMA
#undef PG8_WAIT_V
#undef PG8_WAIT_L
#undef PG8_BAR
#undef PG8_SCHED
}
}

#define LAS __attribute__((address_space(3)))
typedef unsigned short bf16;
typedef short bf16x8 __attribute__((ext_vector_type(8)));
typedef short bf16x4 __attribute__((ext_vector_type(4)));
typedef float f32x4 __attribute__((ext_vector_type(4)));
typedef float f32x16 __attribute__((ext_vector_type(16)));
typedef unsigned u32x4 __attribute__((ext_vector_type(4)));
typedef unsigned u32x2 __attribute__((ext_vector_type(2)));
typedef __bf16 bf16v2_t __attribute__((ext_vector_type(2)));
__device__ __forceinline__ unsigned cvt_pk_bf16(float lo, float hi) { bf16v2_t v; v.x = (__bf16)lo; v.y = (__bf16)hi; return __builtin_bit_cast(unsigned, v); }

constexpr int NWAVES = 8, NTHR = 512;
constexpr int D = 1024, BATCH = 8, SEQ = 4096, M = BATCH * SEQ, MEMLEN = 256;
constexpr int NA = 2048, NB = 2560;
constexpr float EPS = 1e-6f;
constexpr int NPHASE = 19;

constexpr size_t MiB = 1u << 20;
constexpr size_t WS_CTL = 0, CTL_ZERO_BYTES = 1 * MiB;
constexpr size_t WS_WA = 1 * MiB, WS_WB = 5 * MiB, WS_WO = 10 * MiB, WS_WKV = 14 * MiB, WS_WQ = 16 * MiB;
constexpr size_t WS_DEC = 25 * MiB + 512 * 1024, WS_TSC = 26 * MiB, WS_SS = 27 * MiB;
constexpr size_t WS_UK = 24 * MiB, WS_UVT = 24 * MiB + 512 * 1024, WS_SUBK = 25 * MiB;
constexpr size_t WS_MEMN = 32 * MiB, WS_KV = 36 * MiB, WS_HB = 40 * MiB, WS_MIX = 104 * MiB, WS_TAB = 168 * MiB, WS_AR = 232 * MiB, WS_END = 512 * MiB;
constexpr size_t AR_CKV32 = 0, AR_CKV = 32 * MiB, AR_IQ = 48 * MiB, AR_IK = 80 * MiB, AR_IW = 84 * MiB, AR_QL = 88 * MiB, AR_QMEM = 136 * MiB;
constexpr size_t AR_Z = 0, AR_XBC = 48 * MiB, AR_DT = 128 * MiB, AR_XC = 152 * MiB, AR_ST = 232 * MiB, AR_Y = 48 * MiB;
constexpr size_t AR_PQ = 152 * MiB, AR_TOPK = 0;
constexpr int CW_XS = 8192;
constexpr int CW_BAR = 4096;

constexpr int LDS_BYTES = 163840;
constexpr int LDS_SCR = 0, LDS_SCR_BYTES = 161792;
constexpr int LDS_CTL = 161792;

__device__ __forceinline__ float bf2f(unsigned short b) { return __uint_as_float(((unsigned)b) << 16); }
__device__ __forceinline__ float wave_sum(float v) {
#pragma unroll
    for (int o = 1; o < 64; o <<= 1) v += __shfl_xor(v, o);
    return v;
}
__device__ __forceinline__ float wave_max(float v) {
#pragma unroll
    for (int o = 1; o < 64; o <<= 1) v = fmaxf(v, __shfl_xor(v, o));
    return v;
}
#define LDS_WAIT() asm volatile("s_waitcnt lgkmcnt(0)" ::: "memory")
#define VM_WAIT() asm volatile("s_waitcnt vmcnt(0)" ::: "memory")

#define XB_TMO      128
#define XB_XCNT(j)  (256  + 64 * (j))
#define XB_XSUB(j)  (1280 + 64 * (j))
#define XB_XGEN(j)  (2304 + 64 * (j))
#define XB_TOP      3328
#define XB_TOPGEN   3392
#define XCD_BAR_WORDS 3456
#define XB_SPIN_CAP (1u << 22)

__device__ __forceinline__ unsigned xb_ld(unsigned* p)              { return __hip_atomic_load(p, __ATOMIC_RELAXED, __HIP_MEMORY_SCOPE_AGENT); }
__device__ __forceinline__ unsigned xb_add(unsigned* p, unsigned v) { return __hip_atomic_fetch_add(p, v, __ATOMIC_RELAXED, __HIP_MEMORY_SCOPE_AGENT); }
__device__ __forceinline__ unsigned xb_xcc_id() { return (unsigned)__builtin_amdgcn_s_getreg((3 << 11) | 20) & 0xFu; }
#define XB_SPIN(cond, bar) do { unsigned _sp = 0; while (cond) { __builtin_amdgcn_s_sleep(1); \
    if ((++_sp & 255u) == 0u) { if (xb_ld(&(bar)[XB_TMO])) break; if (_sp > XB_SPIN_CAP) { atomicAdd(&(bar)[XB_TMO], 1u); break; } } } } while (0)

struct XcdBarrier {
    unsigned* bar; unsigned x;
    volatile LAS unsigned* st;
};

__device__ __forceinline__ XcdBarrier xcd_barrier_post(unsigned* bar, volatile LAS unsigned* st) {
    XcdBarrier b; b.bar = bar; b.x = xb_xcc_id(); b.st = st;
    if (threadIdx.x == 0) (void)xb_add(&bar[XB_XCNT(b.x)], 1u);
    return b;
}
__device__ __forceinline__ void xcd_barrier_complete(unsigned* bar, unsigned x, unsigned& nloc, unsigned& nx) {
    const unsigned G = gridDim.x * gridDim.y * gridDim.z;
    unsigned sum, cnt, mine, sp = 0u;
    for (;;) {
        sum = 0u; cnt = 0u; mine = 0u;
#pragma unroll
        for (unsigned j = 0; j < 16; ++j) { const unsigned c = xb_ld(&bar[XB_XCNT(j)]); sum += c; cnt += (c > 0u) ? 1u : 0u; mine = (j == x) ? c : mine; }
        if (sum == G) break;
        __builtin_amdgcn_s_sleep(1);
        if ((++sp & 255u) == 0u) { if (xb_ld(&bar[XB_TMO])) break; if (sp > XB_SPIN_CAP) { atomicAdd(&bar[XB_TMO], 1u); break; } }
    }
    nloc = mine > 0u ? mine : 1u; nx = cnt > 0u ? cnt : 1u;
}

__device__ __forceinline__ void xcd_barrier(const XcdBarrier& b) {
    asm volatile("s_waitcnt vmcnt(0)" ::: "memory");
    __syncthreads();
    if (threadIdx.x == 0) {
        unsigned* bar = b.bar;
        __builtin_amdgcn_s_waitcnt(0);
        unsigned nloc = b.st[0], nx = b.st[1];
        if (nloc == 0u) { xcd_barrier_complete(bar, b.x, nloc, nx); b.st[0] = nloc; b.st[1] = nx; }
        const unsigned old = xb_add(&bar[XB_XSUB(b.x)], 1u);
        const unsigned gen = old / nloc;
        if (old + 1u == (gen + 1u) * nloc) {
            __builtin_amdgcn_fence(__ATOMIC_RELEASE, "agent");
            asm volatile("s_waitcnt vmcnt(0)" ::: "memory");
            const unsigned og = xb_add(&bar[XB_TOP], 1u);
            const unsigned tg = og / nx;
            if (og + 1u == (tg + 1u) * nx) xb_add(&bar[XB_TOPGEN], 1u);
            else XB_SPIN(xb_ld(&bar[XB_TOPGEN]) == tg, bar);
            __builtin_amdgcn_fence(__ATOMIC_ACQUIRE, "agent");
            xb_add(&bar[XB_XGEN(b.x)], 1u);
            asm volatile("s_waitcnt vmcnt(0)" ::: "memory");
        } else {
            XB_SPIN(xb_ld(&bar[XB_XGEN(b.x)]) == gen, bar);
            __builtin_amdgcn_fence(__ATOMIC_ACQUIRE, "agent");
            asm volatile("s_waitcnt vmcnt(0)" ::: "memory");
        }
    }
    __syncthreads();
}

struct Args { const float* in[24]; float* out; unsigned char* ws; int ph_lo, ph_hi; };
enum { I_X = 0, I_MEM, I_MEMNORM, I_RELBIAS, I_MIXNORM, I_FFNNORM, I_FINALNORM, I_WO, I_WMEMKV, I_AWIN, I_AKVNORM, I_AWUK, I_AWUV,
       I_BWIN, I_BCONVW, I_BCONVB, I_BDTBIAS, I_BALOG, I_BDSKIP, I_BOUTNORM, I_PWQ, I_PSUBK, I_PU, I_PV };

__device__ __forceinline__ u32x4 pack8(const f32x4 v0, const f32x4 v1) {
    u32x4 w; w.x = pg8::cvt_pk_bf16(v0[0], v0[1]); w.y = pg8::cvt_pk_bf16(v0[2], v0[3]); w.z = pg8::cvt_pk_bf16(v1[0], v1[1]); w.w = pg8::cvt_pk_bf16(v1[2], v1[3]); return w;
}
struct EpiPlain {
    static constexpr bool PERM = true, AFTER_DRAIN = false;
    bf16* O; int ld;
    __device__ __forceinline__ void operator()(const f32x4 (&acc)[2][2][4][2], const pg8::Unit& u, int wr, int wc, int fr, int fq) const {
        const int row0 = u.pm * 256 + wr * 64 + fr, col0 = u.pn * 256 + wc * 32 + 8 * fq;
#pragma unroll
        for (int ai = 0; ai < 2; ++ai)
#pragma unroll
            for (int m = 0; m < 4; ++m) { bf16* rowp = O + (size_t)(row0 + ai * 128 + m * 16) * ld + col0;
#pragma unroll
                for (int bj = 0; bj < 2; ++bj) *(u32x4*)(rowp + bj * 128) = pack8(acc[ai][bj][m][0], acc[ai][bj][m][1]); }
    }
};
struct EpiInA {
    static constexpr bool PERM = true, AFTER_DRAIN = false;
    bf16* Q; float* CKV32; bf16* IQ; bf16* QMEM; bf16* IK; float* IW;
    __device__ __forceinline__ void operator()(const f32x4 (&acc)[2][2][4][2], const pg8::Unit& u, int wr, int wc, int fr, int fq) const {
        const int row0 = u.pm * 256 + wr * 64 + fr, cb0 = wc * 32 + 8 * fq, pn = u.pn;
#pragma unroll
        for (int ai = 0; ai < 2; ++ai)
#pragma unroll
            for (int m = 0; m < 4; ++m) { const size_t row = (size_t)(row0 + ai * 128 + m * 16);
#pragma unroll
                for (int bj = 0; bj < 2; ++bj) { const int cb = cb0 + bj * 128; const f32x4 v0 = acc[ai][bj][m][0], v1 = acc[ai][bj][m][1];
                    if (pn < 3) *(u32x4*)(Q + row * 768 + pn * 256 + cb) = pack8(v0, v1);
                    else if (pn == 3) { *(f32x4*)(CKV32 + row * 256 + cb) = v0; *(f32x4*)(CKV32 + row * 256 + cb + 4) = v1; }
                    else if (pn < 6) *(u32x4*)(IQ + row * 512 + (pn - 4) * 256 + cb) = pack8(v0, v1);
                    else if (pn == 6) *(u32x4*)(QMEM + row * 256 + cb) = pack8(v0, v1);
                    else { if (cb < 64) *(u32x4*)(IK + row * 64 + cb) = pack8(v0, v1);
                           else if (cb == 64) { *(f32x4*)(IW + row * 8) = v0; *(f32x4*)(IW + row * 8 + 4) = v1; } } } }
    }
};
struct EpiInB {
    static constexpr bool PERM = true, AFTER_DRAIN = false;
    bf16* Z; bf16* XBC; bf16* QMEM; float* DT;
    __device__ __forceinline__ void operator()(const f32x4 (&acc)[2][2][4][2], const pg8::Unit& u, int wr, int wc, int fr, int fq) const {
        const int row0 = u.pm * 256 + wr * 64 + fr, cb0 = wc * 32 + 8 * fq, pn = u.pn;
#pragma unroll
        for (int ai = 0; ai < 2; ++ai)
#pragma unroll
            for (int m = 0; m < 4; ++m) { const size_t row = (size_t)(row0 + ai * 128 + m * 16);
#pragma unroll
                for (int bj = 0; bj < 2; ++bj) { const int cb = cb0 + bj * 128; const f32x4 v0 = acc[ai][bj][m][0], v1 = acc[ai][bj][m][1];
                    if (pn < 3) *(u32x4*)(Z + row * 768 + pn * 256 + cb) = pack8(v0, v1);
                    else if (pn < 8) *(u32x4*)(XBC + row * 1280 + (pn - 3) * 256 + cb) = pack8(v0, v1);
                    else if (pn == 8) *(u32x4*)(QMEM + row * 256 + cb) = pack8(v0, v1);
                    else if (cb < 16) { *(f32x4*)(DT + row * 16 + cb) = v0; *(f32x4*)(DT + row * 16 + cb + 4) = v1; } } }
    }
};
template <bool RES_BF16> struct EpiResid {
    static constexpr bool PERM = true, AFTER_DRAIN = false;
    const void* RES; bf16* XB; float* SS;
    __device__ __forceinline__ void operator()(const f32x4 (&acc)[2][2][4][2], const pg8::Unit& u, int wr, int wc, int fr, int fq) const {
        const int row0 = u.pm * 256 + wr * 64 + fr, col0 = u.pn * 256 + wc * 32 + 8 * fq;
#pragma unroll
        for (int ai = 0; ai < 2; ++ai) {
            f32x4 r[4][2][2];
#pragma unroll
            for (int m = 0; m < 4; ++m) { const size_t ro = (size_t)(row0 + ai * 128 + m * 16) * 1024 + col0;
#pragma unroll
                for (int bj = 0; bj < 2; ++bj) {
                    if (RES_BF16) { const u32x4 t = *(const u32x4*)((const bf16*)RES + ro + bj * 128);
                        r[m][bj][0] = (f32x4){__uint_as_float(t.x << 16), __uint_as_float(t.x & 0xffff0000u), __uint_as_float(t.y << 16), __uint_as_float(t.y & 0xffff0000u)};
                        r[m][bj][1] = (f32x4){__uint_as_float(t.z << 16), __uint_as_float(t.z & 0xffff0000u), __uint_as_float(t.w << 16), __uint_as_float(t.w & 0xffff0000u)}; }
                    else { r[m][bj][0] = *(const f32x4*)((const float*)RES + ro + bj * 128); r[m][bj][1] = *(const f32x4*)((const float*)RES + ro + bj * 128 + 4); } } }
#pragma unroll
            for (int m = 0; m < 4; ++m) { const int row = row0 + ai * 128 + m * 16; const size_t ro = (size_t)row * 1024 + col0; float ss = 0.f;
#pragma unroll
                for (int bj = 0; bj < 2; ++bj) { const f32x4 o0 = r[m][bj][0] + acc[ai][bj][m][0], o1 = r[m][bj][1] + acc[ai][bj][m][1];
                    u32x4 w; w.x = cvt_pk_bf16(o0[0], o0[1]); w.y = cvt_pk_bf16(o0[2], o0[3]); w.z = cvt_pk_bf16(o1[0], o1[1]); w.w = cvt_pk_bf16(o1[2], o1[3]); *(u32x4*)(XB + ro + bj * 128) = w;
                    ss += ((o0[0] * o0[0] + o0[1] * o0[1]) + (o0[2] * o0[2] + o0[3] * o0[3])) + ((o1[0] * o1[0] + o1[1] * o1[1]) + (o1[2] * o1[2] + o1[3] * o1[3])); }
                { const auto a = __builtin_amdgcn_permlane16_swap(__float_as_uint(ss), __float_as_uint(ss), false, false); ss = __uint_as_float(a[0]) + __uint_as_float(a[1]); }
                { const auto b = __builtin_amdgcn_permlane32_swap(__float_as_uint(ss), __float_as_uint(ss), false, false); ss = __uint_as_float(b[0]) + __uint_as_float(b[1]); }
                if (fq == 0) atomicAdd(SS + row, ss); } }
    }
};
struct EpiPQ {
    static constexpr bool PERM = true, AFTER_DRAIN = false;
    bf16* O; const float* SS;
    __device__ __forceinline__ void operator()(const f32x4 (&acc)[2][2][4][2], const pg8::Unit& u, int wr, int wc, int fr, int fq) const {
        const int row0 = u.pm * 256 + wr * 64 + fr, col0 = u.pn * 256 + wc * 32 + 8 * fq;
        float ssv[8];
#pragma unroll
        for (int i = 0; i < 8; ++i) ssv[i] = SS[row0 + (i >> 2) * 128 + (i & 3) * 16];
#pragma unroll
        for (int ai = 0; ai < 2; ++ai)
#pragma unroll
            for (int m = 0; m < 4; ++m) { const int row = row0 + ai * 128 + m * 16; const float rs = __builtin_amdgcn_rsqf(ssv[ai * 4 + m] * (1.f / 1024.f) + EPS); bf16* rowp = O + (size_t)row * 2048 + col0;
#pragma unroll
                for (int bj = 0; bj < 2; ++bj) *(u32x4*)(rowp + bj * 128) = pack8(acc[ai][bj][m][0] * rs, acc[ai][bj][m][1] * rs); }
    }
};

__device__ __forceinline__ void transpose_item(const float* W, int ldw, int src0, int ncols, bf16* WT, int dst0, LAS float* scr, int item, int lane, const float* kgain = nullptr) {
    const int nblk = (ncols + 31) >> 5, kb = item / nblk, nb = item - kb * nblk, k0 = 64 * kb, n0 = 32 * nb;
    const int nn = n0 + (lane & 31);
    float wv_[32];
    const int nc = nn < ncols ? nn : ncols - 1;
#pragma unroll
    for (int i = 0; i < 32; ++i) { const int kk = 2 * i + (lane >> 5); wv_[i] = W[(size_t)(k0 + kk) * ldw + src0 + nc]; }
#pragma unroll
    for (int i = 0; i < 32; ++i) { const int kk = 2 * i + (lane >> 5); const float gk = kgain ? kgain[k0 + kk] : 1.0f; scr[kk * 33 + (lane & 31)] = (nn < ncols) ? wv_[i] * gk : 0.f; }
    LDS_WAIT(); asm volatile("" ::: "memory");
    const int c = lane & 7;
#pragma unroll
    for (int j = 0; j < 4; ++j) { const int n = (lane >> 3) + 8 * j; const LAS float* s = scr + (8 * c) * 33 + n;
        u32x4 o; o.x = cvt_pk_bf16(s[0 * 33], s[1 * 33]); o.y = cvt_pk_bf16(s[2 * 33], s[3 * 33]); o.z = cvt_pk_bf16(s[4 * 33], s[5 * 33]); o.w = cvt_pk_bf16(s[6 * 33], s[7 * 33]);
        if (n0 + n < ncols) *(u32x4*)(WT + (size_t)(dst0 + n0 + n) * 1024 + k0 + 8 * c) = o; }
    LDS_WAIT(); asm volatile("" ::: "memory");
}
__device__ __forceinline__ int titems(int ncols) { return 16 * ((ncols + 31) >> 5); }
__device__ __forceinline__ void rms_row_to_bf16(const float* xrow, const float* g, bf16* orow, int lane) {
    const f32x4* xr = (const f32x4*)xrow + lane; const f32x4* gr = (const f32x4*)g + lane;
    f32x4 v[4]; float s = 0.f;
#pragma unroll
    for (int j = 0; j < 4; ++j) { v[j] = xr[64 * j]; s += (v[j].x * v[j].x + v[j].y * v[j].y) + (v[j].z * v[j].z + v[j].w * v[j].w); }
    const float rstd = 1.0f / sqrtf(wave_sum(s) * (1.f / 1024.f) + EPS);
    u32x2* o8 = (u32x2*)orow + lane;
#pragma unroll
    for (int j = 0; j < 4; ++j) { const f32x4 gg = gr[64 * j]; u32x2 o; o.x = cvt_pk_bf16(v[j].x * rstd * gg.x, v[j].y * rstd * gg.y); o.y = cvt_pk_bf16(v[j].z * rstd * gg.z, v[j].w * rstd * gg.w); o8[64 * j] = o; }
}
__device__ __forceinline__ void rms_rows4_to_bf16(const float* x0, size_t rstride, const float* g, bf16* o0, int lane) {
    f32x4 v[4][4], gg[4];
#pragma unroll
    for (int j = 0; j < 4; ++j) gg[j] = *((const f32x4*)(g + 8 * lane + 512 * (j >> 1)) + (j & 1));
#pragma unroll
    for (int i = 0; i < 4; ++i) { const float* xr = x0 + (size_t)i * rstride + 8 * lane;
#pragma unroll
        for (int j = 0; j < 4; ++j) v[i][j] = *((const f32x4*)(xr + 512 * (j >> 1)) + (j & 1)); }
#pragma unroll
    for (int i = 0; i < 4; ++i) { float s = 0.f;
#pragma unroll
        for (int j = 0; j < 4; ++j) s += (v[i][j].x * v[i][j].x + v[i][j].y * v[i][j].y) + (v[i][j].z * v[i][j].z + v[i][j].w * v[i][j].w);
        const float rstd = __builtin_amdgcn_rsqf(wave_sum(s) * (1.f / 1024.f) + EPS);
        bf16* orow = o0 + (size_t)i * rstride + 8 * lane;
#pragma unroll
        for (int jj = 0; jj < 2; ++jj) { const f32x4 a = v[i][2 * jj], c = v[i][2 * jj + 1], ga = gg[2 * jj], gc = gg[2 * jj + 1]; u32x4 o;
            o.x = cvt_pk_bf16(a.x * rstd * ga.x, a.y * rstd * ga.y); o.y = cvt_pk_bf16(a.z * rstd * ga.z, a.w * rstd * ga.w);
            o.z = cvt_pk_bf16(c.x * rstd * gc.x, c.y * rstd * gc.y); o.w = cvt_pk_bf16(c.z * rstd * gc.z, c.w * rstd * gc.w);
            *(u32x4*)(orow + 512 * jj) = o; } }
}
__device__ __forceinline__ void rms_row_to_f32(const float* xrow, const float* g, float* orow, int lane) {
    const f32x4* xr = (const f32x4*)xrow + lane; const f32x4* gr = (const f32x4*)g + lane;
    f32x4 v[4]; float s = 0.f;
#pragma unroll
    for (int j = 0; j < 4; ++j) { v[j] = xr[64 * j]; s += (v[j].x * v[j].x + v[j].y * v[j].y) + (v[j].z * v[j].z + v[j].w * v[j].w); }
    const float rstd = 1.0f / sqrtf(wave_sum(s) * (1.f / 1024.f) + EPS);
    f32x4* o = (f32x4*)orow + lane;
#pragma unroll
    for (int j = 0; j < 4; ++j) { const f32x4 gg = gr[64 * j]; o[64 * j] = v[j] * rstd * gg; }
}
__device__ __forceinline__ void cvt_stream(const float* src, bf16* dst, size_t n, size_t gtid, size_t gthreads) {
    for (size_t i = gtid * 8; i < n; i += gthreads * 8) { const f32x4 a = *(const f32x4*)(src + i), b = *(const f32x4*)(src + i + 4); *(u32x4*)(dst + i) = pack8(a, b); }
}

__device__ __forceinline__ void memattn_unit(LAS unsigned char* lds, int unit, int layer, const bf16* KV, const bf16* QMEM, bf16* MIX, int tid, int wave, int lane) {
    const int b = unit >> 6, qb = (unit >> 2) & 15, hd = unit & 3;
    const bf16* kvb = KV + (size_t)(b * 256) * 1024 + layer * 512 + hd * 64;
    LAS unsigned char* Ks = lds; LAS unsigned char* Vt = lds + 36864;
    { u32x4 kk[4], vv[4];
#pragma unroll
      for (int it = 0; it < 4; ++it) { const int idx = tid + it * NTHR, key = idx >> 3, ch = idx & 7;
          kk[it] = *(const u32x4*)(kvb + (size_t)key * 1024 + ch * 8); vv[it] = *(const u32x4*)(kvb + 256 + (size_t)key * 1024 + ch * 8); }
#pragma unroll
      for (int it = 0; it < 4; ++it) { const int idx = tid + it * NTHR, key = idx >> 3, ch = idx & 7;
          *(LAS u32x4*)(Ks + key * 144 + ch * 16) = kk[it];
#pragma unroll
          for (int e = 0; e < 4; ++e) { const unsigned w = vv[it][e];
              *(LAS unsigned short*)(Vt + (ch * 8 + 2 * e) * 520 + key * 2) = (unsigned short)(w & 0xffffu);
              *(LAS unsigned short*)(Vt + (ch * 8 + 2 * e + 1) * 520 + key * 2) = (unsigned short)(w >> 16); } } }
    __syncthreads();
    const int q = lane & 31, hh = lane >> 5;
    const size_t t = (size_t)b * SEQ + qb * 256 + wave * 32 + q;
    bf16x8 qf[4];
#pragma unroll
    for (int ks = 0; ks < 4; ++ks) qf[ks] = *(const bf16x8*)(QMEM + t * 256 + hd * 64 + ks * 16 + hh * 8);
    f32x16 s[8];
#pragma unroll
    for (int kt = 0; kt < 8; ++kt) {
#pragma unroll
        for (int r = 0; r < 16; ++r) s[kt][r] = 0.f;
#pragma unroll
        for (int ks = 0; ks < 4; ++ks) { const bf16x8 a = *(const LAS bf16x8*)(Ks + (kt * 32 + q) * 144 + (ks * 16 + hh * 8) * 2);
            s[kt] = __builtin_amdgcn_mfma_f32_32x32x16_bf16(a, qf[ks], s[kt], 0, 0, 0); } }
    float mx = -3.0e38f;
#pragma unroll
    for (int kt = 0; kt < 8; ++kt)
#pragma unroll
        for (int r = 0; r < 16; ++r) mx = fmaxf(mx, s[kt][r]);
    mx = fmaxf(mx, __shfl_xor(mx, 32));
    float l = 0.f;
#pragma unroll
    for (int kt = 0; kt < 8; ++kt)
#pragma unroll
        for (int r = 0; r < 16; ++r) { const float p = __expf((s[kt][r] - mx) * 0.125f); s[kt][r] = p; l += p; }
    l += __shfl_xor(l, 32);
    f32x16 o[2];
#pragma unroll
    for (int dt = 0; dt < 2; ++dt)
#pragma unroll
        for (int r = 0; r < 16; ++r) o[dt][r] = 0.f;
#pragma unroll
    for (int kt = 0; kt < 8; ++kt)
#pragma unroll
        for (int si = 0; si < 2; ++si) {
            union { bf16x8 v; unsigned u[4]; } pb;
#pragma unroll
            for (int e = 0; e < 4; ++e) pb.u[e] = cvt_pk_bf16(s[kt][8 * si + 2 * e], s[kt][8 * si + 2 * e + 1]);
#pragma unroll
            for (int dt = 0; dt < 2; ++dt) { const LAS unsigned char* vp = Vt + (dt * 32 + q) * 520 + (kt * 32 + 16 * si + 4 * hh) * 2;
                union { bf16x8 v; u32x2 h[2]; } va; va.h[0] = *(const LAS u32x2*)vp; va.h[1] = *(const LAS u32x2*)(vp + 16);
                o[dt] = __builtin_amdgcn_mfma_f32_32x32x16_bf16(va.v, pb.v, o[dt], 0, 0, 0); } }
    const float inv = 1.0f / l;
#pragma unroll
    for (int dt = 0; dt < 2; ++dt)
#pragma unroll
        for (int g = 0; g < 4; g += 2) {
            u32x2 w0, w1; w0.x = cvt_pk_bf16(o[dt][4 * g] * inv, o[dt][4 * g + 1] * inv); w0.y = cvt_pk_bf16(o[dt][4 * g + 2] * inv, o[dt][4 * g + 3] * inv);
            w1.x = cvt_pk_bf16(o[dt][4 * g + 4] * inv, o[dt][4 * g + 5] * inv); w1.y = cvt_pk_bf16(o[dt][4 * g + 6] * inv, o[dt][4 * g + 7] * inv);
            const auto s0 = __builtin_amdgcn_permlane32_swap(w0.x, w1.x, false, false); const auto s1 = __builtin_amdgcn_permlane32_swap(w0.y, w1.y, false, false);
            u32x4 ov; ov.x = s0[0]; ov.y = s1[0]; ov.z = s0[1]; ov.w = s1[1];
            *(u32x4*)(MIX + t * 1024 + 768 + hd * 64 + dt * 32 + 8 * (g + hh)) = ov; }
    __syncthreads();
}

constexpr int SS_ACS = 0, SS_DTV = 6144, SS_WW = 12288, SS_XS = 18432;
constexpr int SS_BT = SS_XS + 6 * 64 * 272;
static_assert(SS_BT + 128 * 272 <= LDS_SCR_BYTES, "SSD LDS map");

__device__ __forceinline__ float softplus_f(float x) { return fmaxf(x, 0.f) + log1pf(__expf(-fabsf(x))); }
__device__ __forceinline__ float silu_f(float v) { return v * __builtin_amdgcn_rcpf(1.0f + __expf(-v)); }

__device__ __forceinline__ void ssd_chunk_scalars(LAS unsigned char* lds, const float* DT, size_t t0, const float* dt_bias, const float* a_log, float* dec, int wave, int lane) {
    LAS float* ACS = (LAS float*)(lds + SS_ACS); LAS float* DTV = (LAS float*)(lds + SS_DTV); LAS float* WW = (LAS float*)(lds + SS_WW);
    for (int h = wave; h < 12; h += NWAVES) {
        const float bias = dt_bias[h], a = -__expf(a_log[h]);
        const float d0 = softplus_f(DT[(t0 + 2 * lane) * 16 + h] + bias), d1 = softplus_f(DT[(t0 + 2 * lane + 1) * 16 + h] + bias);
        const float da0 = d0 * a, da1 = d1 * a;
        float v = da0 + da1;
#pragma unroll
        for (int o = 1; o < 64; o <<= 1) { const float t = __shfl_up(v, o); if (lane >= o) v += t; }
        const float total = __shfl(v, 63);
        const float c1 = v, c0 = v - da1;
        ACS[h * 128 + 2 * lane] = c0; ACS[h * 128 + 2 * lane + 1] = c1;
        DTV[h * 128 + 2 * lane] = d0; DTV[h * 128 + 2 * lane + 1] = d1;
        WW[h * 128 + 2 * lane] = __expf(total - c0) * d0; WW[h * 128 + 2 * lane + 1] = __expf(total - c1) * d1;
        if (dec != nullptr && lane == 0) dec[h] = __expf(total);
    }
}

__device__ __forceinline__ void ssd_states_unit(LAS unsigned char* lds, int unit, const bf16* XBC, const float* DT, const float* conv_w, const float* conv_b,
                                                const float* dt_bias, const float* a_log, bf16* XC, bf16* STATES, float* DEC, int tid, int wave, int lane) {
    const int b = unit >> 5, c = unit & 31; const size_t t0 = (size_t)b * SEQ + c * 128;
    __syncthreads();
    ssd_chunk_scalars(lds, DT, t0, dt_bias, a_log, DEC + (size_t)unit * 12, wave, lane);
    __syncthreads();
    const LAS float* WW = (const LAS float*)(lds + SS_WW);
    const int q = lane & 31, hh = lane >> 5;
    for (int g = 0; g < 2; ++g) {
        for (int idx = tid; idx < 1280; idx += NTHR) {
            const int cg = idx % 80, tg = idx / 80;
            const int col = cg < 48 ? g * 384 + cg * 8 : (cg < 64 ? 768 + g * 128 + (cg - 48) * 8 : 1024 + g * 128 + (cg - 64) * 8);
            float w[4][8], bs[8];
#pragma unroll
            for (int j = 0; j < 4; ++j) { const f32x4 a = *(const f32x4*)(conv_w + j * 1280 + col), bb = *(const f32x4*)(conv_w + j * 1280 + col + 4);
                w[j][0] = a.x; w[j][1] = a.y; w[j][2] = a.z; w[j][3] = a.w; w[j][4] = bb.x; w[j][5] = bb.y; w[j][6] = bb.z; w[j][7] = bb.w; }
            { const f32x4 a = *(const f32x4*)(conv_b + col), bb = *(const f32x4*)(conv_b + col + 4); bs[0] = a.x; bs[1] = a.y; bs[2] = a.z; bs[3] = a.w; bs[4] = bb.x; bs[5] = bb.y; bs[6] = bb.z; bs[7] = bb.w; }
            u32x4 rows[11];
#pragma unroll
            for (int i = 0; i < 11; ++i) { const int lt = tg * 8 - 3 + i;
                const bool inseq = (c * 128 + lt >= 0); const u32x4 rv = *(const u32x4*)(XBC + (t0 + (inseq ? lt : 0)) * 1280 + col);
                rows[i] = inseq ? rv : (u32x4){0u, 0u, 0u, 0u}; }
            float o[8][8];
#pragma unroll
            for (int tt = 0; tt < 8; ++tt)
#pragma unroll
                for (int e = 0; e < 8; ++e) { float acc = bs[e];
#pragma unroll
                    for (int j = 0; j < 4; ++j) { const unsigned wd = rows[tt + j][e >> 1]; const float xv = (e & 1) ? __uint_as_float(wd & 0xffff0000u) : __uint_as_float(wd << 16); acc += w[j][e] * xv; }
                    o[tt][e] = silu_f(acc); }
#pragma unroll
            for (int tt = 0; tt < 8; ++tt) { u32x4 pk; pk.x = pg8::cvt_pk_bf16(o[tt][0], o[tt][1]); pk.y = pg8::cvt_pk_bf16(o[tt][2], o[tt][3]); pk.z = pg8::cvt_pk_bf16(o[tt][4], o[tt][5]); pk.w = pg8::cvt_pk_bf16(o[tt][6], o[tt][7]);
                *(u32x4*)(XC + (t0 + tg * 8 + tt) * 1280 + col) = pk; }
            if (cg < 48) {
                const int hl = cg >> 3, h = g * 6 + hl;
                float ws8[8];
#pragma unroll
                for (int tt = 0; tt < 8; ++tt) ws8[tt] = WW[h * 128 + tg * 8 + tt];
#pragma unroll
                for (int e = 0; e < 8; ++e) { u32x4 pk; pk.x = pg8::cvt_pk_bf16(o[0][e] * ws8[0], o[1][e] * ws8[1]); pk.y = pg8::cvt_pk_bf16(o[2][e] * ws8[2], o[3][e] * ws8[3]);
                    pk.z = pg8::cvt_pk_bf16(o[4][e] * ws8[4], o[5][e] * ws8[5]); pk.w = pg8::cvt_pk_bf16(o[6][e] * ws8[6], o[7][e] * ws8[7]);
                    *(LAS u32x4*)(lds + SS_XS + (cg * 8 + e) * 272 + tg * 16) = pk; }
            } else if (cg < 64) {
#pragma unroll
                for (int e = 0; e < 8; ++e) { u32x4 pk; pk.x = pg8::cvt_pk_bf16(o[0][e], o[1][e]); pk.y = pg8::cvt_pk_bf16(o[2][e], o[3][e]); pk.z = pg8::cvt_pk_bf16(o[4][e], o[5][e]); pk.w = pg8::cvt_pk_bf16(o[6][e], o[7][e]);
                    *(LAS u32x4*)(lds + SS_BT + ((cg - 48) * 8 + e) * 272 + tg * 16) = pk; }
            }
        }
        __syncthreads();
        const int pt = wave >> 2, nt = wave & 3;
#pragma unroll 1
        for (int hl = 0; hl < 6; ++hl) {
            f32x16 acc;
#pragma unroll
            for (int r = 0; r < 16; ++r) acc[r] = 0.f;
#pragma unroll
            for (int ks = 0; ks < 8; ++ks) {
                const bf16x8 a = *(const LAS bf16x8*)(lds + SS_XS + (hl * 64 + pt * 32 + q) * 272 + (ks * 16 + hh * 8) * 2);
                const bf16x8 bb = *(const LAS bf16x8*)(lds + SS_BT + (nt * 32 + q) * 272 + (ks * 16 + hh * 8) * 2);
                acc = __builtin_amdgcn_mfma_f32_32x32x16_bf16(bb, a, acc, 0, 0, 0); }
            bf16* st = STATES + ((size_t)unit * 12 + g * 6 + hl) * 8192 + (pt * 32 + q) * 128 + nt * 32;
            u32x2 pk[4];
#pragma unroll
            for (int gq = 0; gq < 4; ++gq) { pk[gq].x = cvt_pk_bf16(acc[4 * gq], acc[4 * gq + 1]); pk[gq].y = cvt_pk_bf16(acc[4 * gq + 2], acc[4 * gq + 3]); }
#pragma unroll
            for (int gp = 0; gp < 4; gp += 2) {
                const auto s0 = __builtin_amdgcn_permlane32_swap(pk[gp].x, pk[gp + 1].x, false, false);
                const auto s1 = __builtin_amdgcn_permlane32_swap(pk[gp].y, pk[gp + 1].y, false, false);
                u32x4 o; o.x = s0[0]; o.y = s1[0]; o.z = s0[1]; o.w = s1[1];
                *(u32x4*)(st + 8 * (gp + hh)) = o; }
        }
        __syncthreads();
    }
}

__device__ __forceinline__ void ssd_scan(bf16* STATES, const float* DEC, size_t gtid, size_t gthreads) {
    for (size_t i = gtid; i < (size_t)BATCH * 12 * 64 * 16; i += gthreads) {
        const int b = (int)(i / (12 * 64 * 16)); const int rem = (int)(i - (size_t)b * (12 * 64 * 16)); const int h = rem / 1024, pn = rem - h * 1024;
        float hs[8];
#pragma unroll
        for (int e = 0; e < 8; ++e) hs[e] = 0.f;
        bf16* base = STATES + ((size_t)b * 32 * 12 + h) * 8192 + (size_t)pn * 8;
#pragma unroll 1
        for (int c0 = 0; c0 < 32; c0 += 16) {
            u32x4 sv[16]; float dc[16];
#pragma unroll
            for (int k = 0; k < 16; ++k) { sv[k] = *(const u32x4*)(base + (size_t)(c0 + k) * 12 * 8192); dc[k] = DEC[(b * 32 + c0 + k) * 12 + h]; }
#pragma unroll
            for (int k = 0; k < 16; ++k) {
                u32x4 ov; ov.x = cvt_pk_bf16(hs[0], hs[1]); ov.y = cvt_pk_bf16(hs[2], hs[3]); ov.z = cvt_pk_bf16(hs[4], hs[5]); ov.w = cvt_pk_bf16(hs[6], hs[7]);
                *(u32x4*)(base + (size_t)(c0 + k) * 12 * 8192) = ov;
#pragma unroll
                for (int e = 0; e < 4; ++e) { hs[2 * e] = hs[2 * e] * dc[k] + __uint_as_float(sv[k][e] << 16); hs[2 * e + 1] = hs[2 * e + 1] * dc[k] + __uint_as_float(sv[k][e] & 0xffff0000u); }
            }
        }
    }
}

__device__ __forceinline__ void ssd_out_unit(LAS unsigned char* lds, int unit, const bf16* XC, const float* DT, const bf16* Z, const bf16* HPREV, const float* dt_bias, const float* a_log,
                                             const float* d_skip, const float* out_norm, bf16* Y, bf16* MIX, int tid, int wave, int lane) {
    const int b = unit >> 5, c = unit & 31; const size_t t0 = (size_t)b * SEQ + c * 128;
    __syncthreads();
    ssd_chunk_scalars(lds, DT, t0, dt_bias, a_log, nullptr, wave, lane);
    const LAS float* ACS = (const LAS float*)(lds + SS_ACS); const LAS float* DTV = (const LAS float*)(lds + SS_DTV);
    const int q = lane & 31, hh = lane >> 5, lt = wave >> 1, pt = wave & 1;
    const bf16* hp = HPREV + (size_t)unit * 12 * 8192;
    unsigned dmask = 0u;
#pragma unroll
    for (int r = 0; r < 16; ++r) dmask |= (((r & 3) + 8 * (r >> 2) + 4 * hh) <= q) ? (1u << r) : 0u;
    for (int _rs = 0; _rs <= (SSD_PROBE & 1); ++_rs)
    for (int g = 0; g < 2; ++g) {
        __syncthreads();
        for (int idx = tid; idx < 768; idx += NTHR) { const int cg = idx % 48, tg = idx / 48;
            u32x4 rows[8];
#pragma unroll
            for (int i = 0; i < 8; ++i) rows[i] = *(const u32x4*)(XC + (t0 + tg * 8 + i) * 1280 + g * 384 + cg * 8);
#pragma unroll
            for (int e = 0; e < 8; ++e) { u32x4 pk;
#pragma unroll
                for (int k2 = 0; k2 < 4; ++k2) { const unsigned lo = rows[2 * k2][e >> 1], hi2 = rows[2 * k2 + 1][e >> 1];
                    pk[k2] = (e & 1) ? ((lo >> 16) | (hi2 & 0xffff0000u)) : ((lo & 0xffffu) | (hi2 << 16)); }
                *(LAS u32x4*)(lds + SS_XS + (cg * 8 + e) * 272 + tg * 16) = pk; } }
        bf16x8 cf[8];
#pragma unroll
        for (int ks = 0; ks < 8; ++ks) cf[ks] = *(const bf16x8*)(XC + (t0 + lt * 32 + q) * 1280 + 1024 + g * 128 + ks * 16 + hh * 8);
        f32x16 cb[4];
#pragma unroll
        for (int st = 0; st < 4; ++st) {
#pragma unroll
            for (int r = 0; r < 16; ++r) cb[st][r] = 0.f;
            if (st <= lt) {
                bf16x8 av[8];
#pragma unroll
                for (int ks = 0; ks < 8; ++ks) av[ks] = *(const bf16x8*)(XC + (t0 + st * 32 + q) * 1280 + 768 + g * 128 + ks * 16 + hh * 8);
                asm volatile("" : "+v"(av[0]), "+v"(av[1]), "+v"(av[2]), "+v"(av[3]), "+v"(av[4]), "+v"(av[5]), "+v"(av[6]), "+v"(av[7]));
#pragma unroll
                for (int ks = 0; ks < 8; ++ks) cb[st] = __builtin_amdgcn_mfma_f32_32x32x16_bf16(av[ks], cf[ks], cb[st], 0, 0, 0); } }
        __syncthreads();
#pragma unroll 1
        for (int hl = 0; hl < 6; ++hl) {
            const int h = g * 6 + hl;
            f32x16 yd, yo;
#pragma unroll
            for (int r = 0; r < 16; ++r) { yd[r] = 0.f; yo[r] = 0.f; }
            const int l = lt * 32 + q; const float al = ACS[h * 128 + l];
            bf16x8 hbv[8];
#pragma unroll
            for (int ks = 0; ks < 8; ++ks) hbv[ks] = *(const bf16x8*)(hp + (size_t)h * 8192 + (pt * 32 + q) * 128 + ks * 16 + hh * 8);
            u32x2 xg[4];
#pragma unroll
            for (int gq = 0; gq < 4; ++gq) xg[gq] = *(const u32x2*)(XC + (t0 + l) * 1280 + g * 384 + hl * 64 + pt * 32 + 8 * gq + 4 * hh);
#pragma unroll
            for (int st = 0; st < 4; ++st) {
                if (st <= lt) {
                    float mm[16];
#pragma unroll
                    for (int r = 0; r < 16; ++r) { const int s = st * 32 + (r & 3) + 8 * (r >> 2) + 4 * hh;
                        const float v = cb[st][r] * __expf(al - ACS[h * 128 + s]) * DTV[h * 128 + s]; mm[r] = (st < lt || ((dmask >> r) & 1u)) ? v : 0.f; }
#pragma unroll
                    for (int si = 0; si < 2; ++si) {
                        union { bf16x8 v; unsigned u[4]; } af;
#pragma unroll
                        for (int e = 0; e < 4; ++e) af.u[e] = cvt_pk_bf16(mm[8 * si + 2 * e], mm[8 * si + 2 * e + 1]);
                        const LAS unsigned char* xp = lds + SS_XS + (hl * 64 + pt * 32 + q) * 272 + (st * 32 + 16 * si + 4 * hh) * 2;
                        union { bf16x8 v; u32x2 hv[2]; } xb; xb.hv[0] = *(const LAS u32x2*)xp; xb.hv[1] = *(const LAS u32x2*)(xp + 16);
                        yd = __builtin_amdgcn_mfma_f32_32x32x16_bf16(xb.v, af.v, yd, 0, 0, 0); } } }
#pragma unroll
            for (int ks = 0; ks < 8; ++ks) yo = __builtin_amdgcn_mfma_f32_32x32x16_bf16(hbv[ks], cf[ks], yo, 0, 0, 0);
            const float dsk = d_skip[h]; const float eal = __expf(al);
            u32x2 pk[4];
#pragma unroll
            for (int gq = 0; gq < 4; ++gq) { const u32x2 xv = xg[gq]; float yv[4];
#pragma unroll
                for (int e = 0; e < 4; ++e) { const unsigned wd = xv[e >> 1]; const float xs = (e & 1) ? __uint_as_float(wd & 0xffff0000u) : __uint_as_float(wd << 16);
                    yv[e] = yd[4 * gq + e] + eal * yo[4 * gq + e] + xs * dsk; }
                pk[gq].x = cvt_pk_bf16(yv[0], yv[1]); pk[gq].y = cvt_pk_bf16(yv[2], yv[3]); }
#pragma unroll
            for (int gp = 0; gp < 4; gp += 2) {
                const auto s0 = __builtin_amdgcn_permlane32_swap(pk[gp].x, pk[gp + 1].x, false, false);
                const auto s1 = __builtin_amdgcn_permlane32_swap(pk[gp].y, pk[gp + 1].y, false, false);
                u32x4 o; o.x = s0[0]; o.y = s1[0]; o.z = s0[1]; o.w = s1[1];
                *(u32x4*)(Y + (t0 + l) * 768 + h * 64 + pt * 32 + 8 * (gp + hh)) = o; }
        }
    }
    VM_WAIT(); __syncthreads();
    __builtin_amdgcn_fence(__ATOMIC_ACQUIRE, "agent"); VM_WAIT();
    f32x4 gno[3];
#pragma unroll
    for (int j = 0; j < 3; ++j) gno[j] = *(const f32x4*)(out_norm + j * 256 + lane * 4);
    for (int _rs2 = 0; _rs2 <= ((SSD_PROBE >> 1) & 1); ++_rs2)
    for (int t4 = wave * 16; t4 < wave * 16 + 16; t4 += 4) {
        u32x2 yv[4][3], zv[4][3];
#pragma unroll
        for (int k = 0; k < 4; ++k)
#pragma unroll
            for (int j = 0; j < 3; ++j) { const size_t t = t0 + t4 + k; yv[k][j] = *(const u32x2*)(Y + t * 768 + j * 256 + lane * 4); zv[k][j] = *(const u32x2*)(Z + t * 768 + j * 256 + lane * 4); }
#pragma unroll
        for (int k = 0; k < 4; ++k) { const size_t t = t0 + t4 + k;
            float v[12]; float ss = 0.f;
#pragma unroll
            for (int j = 0; j < 3; ++j)
#pragma unroll
                for (int e = 0; e < 4; ++e) { const unsigned yw = yv[k][j][e >> 1], zw = zv[k][j][e >> 1];
                    const float yy = (e & 1) ? __uint_as_float(yw & 0xffff0000u) : __uint_as_float(yw << 16), zz = (e & 1) ? __uint_as_float(zw & 0xffff0000u) : __uint_as_float(zw << 16);
                    const float x = yy * silu_f(zz); v[4 * j + e] = x; ss += x * x; }
            const float rstd = __builtin_amdgcn_rsqf(wave_sum(ss) * (1.f / 768.f) + EPS);
#pragma unroll
            for (int j = 0; j < 3; ++j) { const f32x4 gg = gno[j];
                u32x2 o; o.x = cvt_pk_bf16(v[4 * j] * rstd * gg.x, v[4 * j + 1] * rstd * gg.y); o.y = cvt_pk_bf16(v[4 * j + 2] * rstd * gg.z, v[4 * j + 3] * rstd * gg.w);
                *(u32x2*)(MIX + t * 1024 + j * 256 + lane * 4) = o; } } }
}

constexpr int DS_IKL = 145408;
constexpr int DS_SC = 0, DS_IMG = 0, DS_IMG_W = 32 * 528, DS_QL = 0, DS_SEL = 8 * DS_IMG_W, DS_RB = DS_SEL + 8192, DS_END = DS_RB + 2048;
static_assert(DS_SEL >= 8 * 4096 * 4 && DS_END <= DS_IKL && DS_IKL + 16384 <= LDS_SCR_BYTES, "DSA LDS map");
typedef short s16x4 __attribute__((ext_vector_type(4)));

__device__ __forceinline__ int t5_bucket(int n) {
    if (n < 16) return n;
    const float v = logf((float)n / 16.0f) / 2.0794415416798357f * 16.0f;
    const int l = 16 + (int)v; return l < 31 ? l : 31;
}
__device__ __forceinline__ unsigned sortable_u32(float f) { const unsigned b = __float_as_uint(f); return b ^ ((unsigned)((int)b >> 31) | 0x80000000u); }
__device__ __forceinline__ unsigned mbcnt64(unsigned long long m) { return __builtin_amdgcn_mbcnt_hi((unsigned)(m >> 32), __builtin_amdgcn_mbcnt_lo((unsigned)m, 0u)); }
__device__ __forceinline__ unsigned wave_sum_u32(unsigned x) {
    x += (unsigned)__builtin_amdgcn_update_dpp(0, (int)x, 0xB1, 0xf, 0xf, false);
    x += (unsigned)__builtin_amdgcn_update_dpp(0, (int)x, 0x4E, 0xf, 0xf, false);
    x += (unsigned)__builtin_amdgcn_update_dpp(0, (int)x, 0x141, 0xf, 0xf, false);
    x += (unsigned)__builtin_amdgcn_update_dpp(0, (int)x, 0x140, 0xf, 0xf, false);
    { const auto a = __builtin_amdgcn_permlane16_swap(x, x, false, false); x = a[0] + a[1]; }
    { const auto b = __builtin_amdgcn_permlane32_swap(x, x, false, false); x = b[0] + b[1]; }
    return x;
}
__device__ __forceinline__ float kg_max(float v) {
    { const auto a = __builtin_amdgcn_permlane16_swap(__float_as_uint(v), __float_as_uint(v), false, false); v = fmaxf(__uint_as_float(a[0]), __uint_as_float(a[1])); }
    { const auto b = __builtin_amdgcn_permlane32_swap(__float_as_uint(v), __float_as_uint(v), false, false); v = fmaxf(__uint_as_float(b[0]), __uint_as_float(b[1])); }
    return v;
}
#define CNT_GE(cnt, uu, cand) asm volatile("v_cmp_ge_u32 vcc, %1, %2\n\tv_addc_co_u32 %0, vcc, 0, %0, vcc" : "+v"(cnt) : "v"(uu), "v"(cand) : "vcc")
#define CNT_GT(cnt, uu, cand) asm volatile("v_cmp_gt_u32 vcc, %1, %2\n\tv_addc_co_u32 %0, vcc, 0, %0, vcc" : "+v"(cnt) : "v"(uu), "v"(cand) : "vcc")
__device__ __forceinline__ float wave_min_f32(float x) {
    x = fminf(x, __uint_as_float((unsigned)__builtin_amdgcn_update_dpp(0, (int)__float_as_uint(x), 0xB1, 0xf, 0xf, false)));
    x = fminf(x, __uint_as_float((unsigned)__builtin_amdgcn_update_dpp(0, (int)__float_as_uint(x), 0x4E, 0xf, 0xf, false)));
    x = fminf(x, __uint_as_float((unsigned)__builtin_amdgcn_update_dpp(0, (int)__float_as_uint(x), 0x141, 0xf, 0xf, false)));
    x = fminf(x, __uint_as_float((unsigned)__builtin_amdgcn_update_dpp(0, (int)__float_as_uint(x), 0x140, 0xf, 0xf, false)));
    { const auto a = __builtin_amdgcn_permlane16_swap(__float_as_uint(x), __float_as_uint(x), false, false); x = fminf(__uint_as_float(a[0]), __uint_as_float(a[1])); }
    { const auto b = __builtin_amdgcn_permlane32_swap(__float_as_uint(x), __float_as_uint(x), false, false); x = fminf(__uint_as_float(b[0]), __uint_as_float(b[1])); }
    return x;
}
__device__ __forceinline__ float wave_max_f32(float x) {
    x = fmaxf(x, __uint_as_float((unsigned)__builtin_amdgcn_update_dpp(0, (int)__float_as_uint(x), 0xB1, 0xf, 0xf, false)));
    x = fmaxf(x, __uint_as_float((unsigned)__builtin_amdgcn_update_dpp(0, (int)__float_as_uint(x), 0x4E, 0xf, 0xf, false)));
    x = fmaxf(x, __uint_as_float((unsigned)__builtin_amdgcn_update_dpp(0, (int)__float_as_uint(x), 0x141, 0xf, 0xf, false)));
    x = fmaxf(x, __uint_as_float((unsigned)__builtin_amdgcn_update_dpp(0, (int)__float_as_uint(x), 0x140, 0xf, 0xf, false)));
    { const auto a = __builtin_amdgcn_permlane16_swap(__float_as_uint(x), __float_as_uint(x), false, false); x = fmaxf(__uint_as_float(a[0]), __uint_as_float(a[1])); }
    { const auto b = __builtin_amdgcn_permlane32_swap(__float_as_uint(x), __float_as_uint(x), false, false); x = fmaxf(__uint_as_float(b[0]), __uint_as_float(b[1])); }
    return x;
}
__device__ __forceinline__ f32x4 mfma16(bf16x8 a, bf16x8 b, f32x4 c) { return __builtin_amdgcn_mfma_f32_16x16x32_bf16(a, b, c, 0, 0, 0); }

__device__ __forceinline__ void dsa_unit(LAS unsigned char* lds, int unit, bf16* QL, const bf16* CKV, const bf16* IQ, const bf16* IK, const float* IW, const float* tabU, const float* tabV, unsigned char* tab8, float* tsc, int tid, int wave, int lane_in) {
    const int lane = lane_in;
    const int b = unit & 7, qb = unit >> 3, t0 = qb * 8; const size_t tok0 = (size_t)b * SEQ + t0;
    LAS float* SC = (LAS float*)(lds + DS_SC); LAS unsigned* SEL = (LAS unsigned*)(lds + DS_SEL); const LAS float* RB = (const LAS float*)(lds + DS_RB);
    __syncthreads();
    const int trow = unit * 8 + wave, ttv = trow >> 14, te = trow & 16383;
    f32x4 trv[4];
    { const f32x4* sp = (const f32x4*)((ttv ? tabV : tabU) + (size_t)te * 1024 + lane * 16);
#pragma unroll
      for (int j = 0; j < 4; ++j) trv[j] = sp[j]; }
    for (int _ra = 0; _ra <= (DSA_PROBE & 1); ++_ra) {
        int lnA = lane; asm volatile("" : "+v"(lnA));
        const int n16 = lnA & 15, g = lnA >> 4;
        bf16x8 af[4][2];
#pragma unroll
        for (int mt = 0; mt < 4; ++mt)
#pragma unroll
            for (int ks = 0; ks < 2; ++ks) af[mt][ks] = *(const bf16x8*)(IQ + (tok0 + 2 * mt + (n16 >> 3)) * 512 + (n16 & 7) * 64 + ks * 32 + g * 8);
        f32x4 wv[4];
#pragma unroll
        for (int mt = 0; mt < 4; ++mt) wv[mt] = *(const f32x4*)(IW + (tok0 + 2 * mt + (g >> 1)) * 8 + 4 * (g & 1));
        const int ntl = (t0 + 8 + 15) >> 4;
        LAS unsigned char* slot = lds + DS_IKL + wave * 2048;
        const u32x4* ikg = (const u32x4*)(IK + (size_t)b * SEQ * 64) + lnA;
        const int wr0 = (lnA >> 3) * 128 + (((lnA & 7) ^ ((lnA >> 3) & 7)) << 4), wr1 = wr0 + 8 * 128;
        const int rdb = n16 * 128; const int rx = n16 & 7;
        u32x4 gq[2][2];
#pragma unroll
        for (int p = 0; p < 2; ++p) { const int tp = (wave + 8 * p < ntl) ? wave + 8 * p : ntl - 1; gq[p][0] = ikg[(size_t)tp * 128]; gq[p][1] = ikg[(size_t)tp * 128 + 64]; }
#define DSA_A_TILE(P, tl_) do { \
            *(LAS u32x4*)(slot + wr0) = gq[P][0]; *(LAS u32x4*)(slot + wr1) = gq[P][1]; \
            { const int tn = ((tl_) + 16 < ntl) ? (tl_) + 16 : ntl - 1; gq[P][0] = ikg[(size_t)tn * 128]; gq[P][1] = ikg[(size_t)tn * 128 + 64]; } \
            const bf16x8 b0 = *(const LAS bf16x8*)(slot + rdb + ((g ^ rx) << 4)), b1 = *(const LAS bf16x8*)(slot + rdb + (((4 + g) ^ rx) << 4)); \
            float sq[4]; \
            _Pragma("unroll") for (int mt = 0; mt < 4; ++mt) { f32x4 d = {0.f, 0.f, 0.f, 0.f}; \
                d = mfma16(af[mt][0], b0, d); d = mfma16(af[mt][1], b1, d); \
                float sv_ = wv[mt][0] * fmaxf(d[0], 0.f); sv_ += wv[mt][1] * fmaxf(d[1], 0.f); sv_ += wv[mt][2] * fmaxf(d[2], 0.f); sv_ += wv[mt][3] * fmaxf(d[3], 0.f); \
                const auto sw = __builtin_amdgcn_permlane16_swap(__float_as_uint(sv_), __float_as_uint(sv_), false, false);     \
                sq[mt] = __uint_as_float(sw[0]) + __uint_as_float(sw[1]); } \
            if ((g & 1) == 0 && (tl_) < ntl) { \
                const int key = (tl_) * 16 + n16; \
                _Pragma("unroll") for (int mt = 0; mt < 4; ++mt) SC[(2 * mt + (g >> 1)) * 4096 + key] = sq[mt]; } } while (0)
#pragma unroll 1
        for (int tl = wave; tl < ntl; tl += 16) { DSA_A_TILE(0, tl); DSA_A_TILE(1, tl + 8); }
#undef DSA_A_TILE
    }
    { float am = 0.f;
#pragma unroll
      for (int j = 0; j < 4; ++j) am = fmaxf(am, fmaxf(fmaxf(fabsf(trv[j].x), fabsf(trv[j].y)), fmaxf(fabsf(trv[j].z), fabsf(trv[j].w))));
      am = wave_max_f32(am);
      const float sc = am > 0.f ? am * (ttv ? (1.0f / 448.0f) : (1.0f / 127.0f)) : 1.0f, inv = 1.0f / sc;
      u32x4 o;
      if (ttv) {
#pragma unroll
          for (int j = 0; j < 4; ++j) { int w = 0; w = __builtin_amdgcn_cvt_pk_fp8_f32(trv[j].x * inv, trv[j].y * inv, w, false); w = __builtin_amdgcn_cvt_pk_fp8_f32(trv[j].z * inv, trv[j].w * inv, w, true); o[j] = (unsigned)w; }
      } else {
#pragma unroll
          for (int j = 0; j < 4; ++j) { const int q0 = (int)rintf(trv[j].x * inv), q1 = (int)rintf(trv[j].y * inv), q2 = (int)rintf(trv[j].z * inv), q3 = (int)rintf(trv[j].w * inv);
              o[j] = (unsigned)((q0 & 0xff) | ((q1 & 0xff) << 8) | ((q2 & 0xff) << 16) | ((q3 & 0xff) << 24)); } }
      *(u32x4*)(tab8 + (size_t)te * 2048 + (size_t)ttv * 1024 + lane * 16) = o;
      if (lane == 0) tsc[ttv * 16384 + te] = sc; }
    __syncthreads();
    int lnD = lane_in; asm volatile("" : "+v"(lnD));
    const int fr = lnD & 15, kg = lnD >> 4;
    bf16x8 ql[8];
#pragma unroll
    for (int ks = 0; ks < 8; ++ks) ql[ks] = *(const bf16x8*)(QL + ((tok0 + wave) * 12 + (fr < 12 ? fr : 11)) * 256 + ks * 32 + kg * 8);
    const int t = t0 + wave, n = t + 1; const int nsel = n < 256 ? n : 256;
    for (int _rb = 0; _rb <= ((DSA_PROBE >> 1) & 1); ++_rb) {
        int lane = lane_in; asm volatile("" : "+v"(lane));
        LAS unsigned* selw = SEL + wave * 256;
        if (n <= 256) {
            for (int i = lane; i < 256; i += 64) { const int ii = i < n ? i : n - 1; selw[i] = (unsigned)ii | ((unsigned)t5_bucket(t - ii) << 16); }
        } else {
            const LAS float* sc = SC + wave * 4096;
            const int ni = (n + 63) >> 6;
            float f[64];
            for (int _rb4 = 0; _rb4 <= ((DSA_PROBE >> 10) & 1); ++_rb4) { asm volatile("" ::: "memory");
#pragma unroll
            for (int i = 0; i < 64; ++i) f[i] = sc[64 * i + lane];
#pragma unroll
            for (int g4 = 0; g4 < 4; ++g4) if (ni > 16 * g4 && ni < 16 * g4 + 17) {
#pragma unroll
                for (int i = 16 * g4; i < 16 * g4 + 16; ++i) { const int s = 64 * i + lane; f[i] = (s < n) ? f[i] : -3.0e38f; } }
            }
            float lo, hi, T = 0.f; bool conv = false; unsigned clast = 0u;
            { float m0 = -3.0e38f, m1 = -3.0e38f, m2 = -3.0e38f, m3 = -3.0e38f;
#pragma unroll
              for (int g4 = 0; g4 < 4; ++g4) if (ni > 16 * g4) {
#pragma unroll
                  for (int i = 16 * g4; i < 16 * g4 + 16; i += 4) { m0 = fmaxf(m0, f[i]); m1 = fmaxf(m1, f[i + 1]); m2 = fmaxf(m2, f[i + 2]); m3 = fmaxf(m3, f[i + 3]); } }
              lo = wave_min_f32(fminf(fminf(m0, m1), fminf(m2, m3))); hi = wave_max_f32(fmaxf(fmaxf(m0, m1), fmaxf(m2, m3))); }
            const float lo_s = lo, hi_s = hi;
            for (int _rb2 = 0; _rb2 <= ((DSA_PROBE >> 8) & 1); ++_rb2) { lo = lo_s; hi = hi_s; conv = false;
#pragma unroll 1
            for (int it = 0; it < BIS_CAP(26); ++it) {
                const float mid = 0.5f * lo + 0.5f * hi; unsigned cl = 0u;
#pragma unroll
                for (int g4 = 0; g4 < 4; ++g4) if (ni > 16 * g4) { unsigned sg = 0u;
#pragma unroll
                    for (int i = 16 * g4; i < 16 * g4 + 16; ++i) { const float d_ = f[i] - mid; sg = __builtin_amdgcn_alignbit(sg, __float_as_uint(d_), 31); }
                    cl += 16u - (unsigned)__builtin_popcount(sg); }
                const unsigned cnt = (unsigned)__builtin_amdgcn_readfirstlane((int)wave_sum_u32(cl));
                if (cnt == 256u) { T = mid; conv = true; clast = cl; break; }
                if (cnt > 256u) lo = mid; else hi = mid;
            }
            }
            if (!conv) {
                unsigned Tu = 0u;
#pragma unroll 1
                for (int bit = 31; bit >= 0; --bit) {
                    const unsigned cand = Tu | (1u << bit); unsigned cl = 0u;
#pragma unroll
                    for (int g4 = 0; g4 < 4; ++g4) if (ni > 16 * g4) {
#pragma unroll
                        for (int i = 16 * g4; i < 16 * g4 + 16; ++i) { const unsigned uu = (f[i] == -3.0e38f) ? 0u : sortable_u32(f[i]); CNT_GE(cl, uu, cand); } }
                    asm volatile("s_nop 1" ::: "memory");
                    const unsigned cnt = (unsigned)__builtin_amdgcn_readfirstlane((int)wave_sum_u32(cl));
                    if (cnt >= 256u) Tu = cand;
                    if (cnt == 256u) break;
                }
                T = __uint_as_float((Tu & 0x80000000u) ? (Tu ^ 0x80000000u) : ~Tu);
            }
            for (int _rb3 = 0; _rb3 <= ((DSA_PROBE >> 9) & 1); ++_rb3)
            if (conv) {
                unsigned inc = clast;
#pragma unroll
                for (int o = 1; o < 64; o <<= 1) { const unsigned t_ = (unsigned)__shfl_up((int)inc, o); if (lane >= o) inc += t_; }
                unsigned p = inc - clast;
#pragma unroll
                for (int g4 = 0; g4 < 4; ++g4) if (ni > 16 * g4) {
#pragma unroll
                    for (int i = 16 * g4; i < 16 * g4 + 16; ++i) { if (f[i] >= T) { selw[p] = (unsigned)(64 * i + lane); p += 1u; } } }
            } else {
            unsigned G;
            { unsigned gl = 0u;
#pragma unroll
              for (int g4 = 0; g4 < 4; ++g4) if (ni > 16 * g4) {
#pragma unroll
                  for (int i = 16 * g4; i < 16 * g4 + 16; ++i) asm volatile("v_cmp_gt_f32 vcc, %1, %2\n\tv_addc_co_u32 %0, vcc, 0, %0, vcc" : "+v"(gl) : "v"(f[i]), "v"(T) : "vcc"); }
              asm volatile("s_nop 1" ::: "memory");
              G = (unsigned)__builtin_amdgcn_readfirstlane((int)wave_sum_u32(gl)); }
            const unsigned need_eq = 256u - G;
            unsigned pos = 0u, eq_used = 0u;
#pragma unroll
            for (int g4 = 0; g4 < 4; ++g4) if (ni > 16 * g4) {
#pragma unroll
                for (int i = 16 * g4; i < 16 * g4 + 16; ++i) {
                    const bool gt = f[i] > T, eq = f[i] == T;
                    const unsigned long long meq = __ballot(eq);
                    const bool sl = gt || (eq && (eq_used + mbcnt64(meq) < need_eq));
                    const unsigned long long msl = __ballot(sl);
                    if (sl) selw[pos + mbcnt64(msl)] = (unsigned)(64 * i + lane);
                    pos += (unsigned)__popcll(msl); eq_used += (unsigned)__popcll(meq); } }
            }
#pragma unroll 1
            for (int i = lane; i < 256; i += 64) { const unsigned s = selw[i]; selw[i] = s | ((unsigned)t5_bucket(t - (int)s) << 16); }
        }
    }
    __syncthreads();
    f32x4 O[16];
#pragma unroll
    for (int ct = 0; ct < 16; ++ct) O[ct] = (f32x4){0.f, 0.f, 0.f, 0.f};
    float mrun = -3.0e38f, lrun = 0.f;
    for (int _rd = 0; _rd <= ((DSA_PROBE >> 3) & 1); ++_rd) {
        const unsigned rowmask = ((DSA_PROBE & 32) && _rd == 0) ? 0x7ffu : 0xffffu;
        if (_rd) { mrun = -3.0e38f; lrun = 0.f;
_Pragma("unroll") for (int ct = 0; ct < 16; ++ct) O[ct] = (f32x4){0.f, 0.f, 0.f, 0.f}; }
        const LAS unsigned* selw = SEL + wave * 256;
        LAS unsigned char* img = lds + DS_IMG + wave * DS_IMG_W;
        const int nsteps = (nsel + 31) >> 5;
        const int hh2 = lnD >> 5, c32 = lnD & 31; const __amdgpu_buffer_rsrc_t rsK = __builtin_amdgcn_make_buffer_rsrc((void*)(CKV + (size_t)b * SEQ * 256), 0, SEQ * 512, 0x00020000); const unsigned c32off = (unsigned)c32 * 16u;
        bf16x8 b0[8], b1[8], b2[8];
#pragma unroll
        for (int ks = 0; ks < 8; ++ks) { b0[ks] = (bf16x8){0, 0, 0, 0, 0, 0, 0, 0}; b1[ks] = b0[ks]; b2[ks] = b0[ks]; }
        const int ntiles = 2 * nsteps;
#define DSA_GATHER(X, tile) do { _Pragma("unroll") for (int j = 0; j < 8; ++j) { const unsigned e_ = selw[(tile) * 16 + 2 * j + hh2];     \
            X[j] = __builtin_bit_cast(bf16x8, __builtin_amdgcn_raw_buffer_load_b128(rsK, ((e_ & 0xffffu) << 9) + c32off, 0, 0)); } } while (0)
#define DSA_STEP(X0, X1, st) do { \
            f32x4 d0 = {0.f, 0.f, 0.f, 0.f}, d1 = {0.f, 0.f, 0.f, 0.f}; \
            _Pragma("unroll") for (int j = 0; j < 8; ++j) *(LAS bf16x8*)(img + (2 * j + hh2) * 528 + c32 * 16) = X0[j]; \
            if (2 * (st) + 3 < ntiles) DSA_GATHER(X0, 2 * (st) + 3);                \
            _Pragma("unroll") for (int j = 0; j < 8; ++j) *(LAS bf16x8*)(img + (16 + 2 * j + hh2) * 528 + c32 * 16) = X1[j]; \
            if (2 * (st) + 4 < ntiles) DSA_GATHER(X1, 2 * (st) + 4); \
            _Pragma("unroll") for (int k4 = 0; k4 < 8; k4 += 2) { bf16x8 fa[2], fb[2]; \
                _Pragma("unroll") for (int ks = 0; ks < 2; ++ks) { fa[ks] = *(const LAS bf16x8*)(img + fr * 528 + ((k4 + ks) * 32 + kg * 8) * 2); fb[ks] = *(const LAS bf16x8*)(img + (16 + fr) * 528 + ((k4 + ks) * 32 + kg * 8) * 2); } \
                _Pragma("unroll") for (int ks = 0; ks < 2; ++ks) { d0 = mfma16(fa[ks], ql[k4 + ks], d0); d1 = mfma16(fb[ks], ql[k4 + ks], d1); } } \
            const u32x4 s0 = *(const LAS u32x4*)(selw + (st) * 32 + kg * 4), s1 = *(const LAS u32x4*)(selw + (st) * 32 + 16 + kg * 4); \
            float lg[8]; float mloc = -3.0e38f; \
            _Pragma("unroll") for (int r = 0; r < 4; ++r) { \
                const float v0 = d0[r] + RB[((s0[r] >> 16) & 31u) * 16 + fr], v1 = d1[r] + RB[((s1[r] >> 16) & 31u) * 16 + fr]; \
                lg[r] = ((st) * 32 + kg * 4 + r < nsel) ? v0 : -3.0e38f; lg[4 + r] = ((st) * 32 + 16 + kg * 4 + r < nsel) ? v1 : -3.0e38f; \
                mloc = fmaxf(mloc, fmaxf(lg[r], lg[4 + r])); } \
            if (__any(mloc > mrun + 16.0f)) {                                       \
                mloc = kg_max(mloc); \
                const float mnew = fmaxf(mrun, mloc); \
                const float alpha = __expf(mrun - mnew); lrun *= alpha; \
                float ar[4]; \
                _Pragma("unroll") for (int r = 0; r < 4; ++r) ar[r] = __shfl(alpha, kg * 4 + r); \
                _Pragma("unroll") for (int ct = 0; ct < 16; ++ct) _Pragma("unroll") for (int r = 0; r < 4; ++r) O[ct][r] *= ar[r]; \
                mrun = mnew; } \
            float p[8]; \
            _Pragma("unroll") for (int r = 0; r < 8; ++r) { p[r] = (lg[r] > -1.0e38f) ? __expf(lg[r] - mrun) : 0.f; lrun += p[r]; } \
            union { bf16x8 v; unsigned w[4]; } pa; \
            pa.w[0] = cvt_pk_bf16(p[0], p[1]); pa.w[1] = cvt_pk_bf16(p[2], p[3]); pa.w[2] = cvt_pk_bf16(p[4], p[5]); pa.w[3] = cvt_pk_bf16(p[6], p[7]); \
            const LAS unsigned char* tb = img + (kg * 4 + (fr >> 2)) * 528 + (fr & 3) * 8; \
            if (!((DSA_PROBE & 64) && _rd == 0)) { \
            _Pragma("unroll") for (int c8 = 0; c8 < 16; c8 += 4) { \
                union { bf16x8 v; s16x4 h[2]; } bb[4]; \
                _Pragma("unroll") for (int cj = 0; cj < 4; ++cj) { bb[cj].h[0] = __builtin_amdgcn_ds_read_tr16_b64_v4i16((LAS s16x4*)(tb + (c8 + cj) * 32)); \
                    bb[cj].h[1] = __builtin_amdgcn_ds_read_tr16_b64_v4i16((LAS s16x4*)(tb + 16 * 528 + (c8 + cj) * 32)); } \
                _Pragma("unroll") for (int cj = 0; cj < 4; ++cj) O[c8 + cj] = mfma16(pa.v, bb[cj].v, O[c8 + cj]); } } } while (0)
        DSA_GATHER(b0, 0); DSA_GATHER(b1, 1); if (ntiles > 2) DSA_GATHER(b2, 2);
        for (int st = 0; st < nsteps; st += 3) {
            DSA_STEP(b0, b1, st);
            if (st + 1 < nsteps) DSA_STEP(b2, b0, st + 1);
            if (st + 2 < nsteps) DSA_STEP(b1, b2, st + 2);
        }
    }
#undef DSA_GATHER
#undef DSA_STEP
    lrun += __shfl_xor(lrun, 16); lrun += __shfl_xor(lrun, 32);
    const float inv = 1.0f / lrun;
    float ir[4];
#pragma unroll
    for (int r = 0; r < 4; ++r) ir[r] = __shfl(inv, kg * 4 + r);
    __syncthreads();
    if (kg < 3) {
#pragma unroll
        for (int ct = 0; ct < 16; ++ct)
#pragma unroll
            for (int r = 0; r < 4; ++r) *(LAS unsigned short*)(lds + DS_QL + ((wave * 12 + kg * 4 + r) * 256 + ct * 16 + fr) * 2) = (unsigned short)(cvt_pk_bf16(O[ct][r] * ir[r], 0.f) & 0xffffu);
    }
    __syncthreads();
    { const LAS u32x4* src = (const LAS u32x4*)(lds + DS_QL + wave * 12 * 256 * 2); u32x4* dst = (u32x4*)(QL + (tok0 + wave) * 12 * 256);
#pragma unroll
      for (int j = 0; j < 6; ++j) dst[j * 64 + lnD] = src[j * 64 + lnD]; }
}

__device__ __forceinline__ void qlat_phase(LAS unsigned char* lds, int u0, int ustep, int nunits, const bf16* Q, const bf16* UK, bf16* QL, int tid, int wave, int lane_in) {
    int lane = lane_in; asm volatile("" : "+v"(lane));
    const int q = lane & 31, hh = lane >> 5;
    u32x4 pre[2]; bf16x8 af[4];
#define QL_LOAD(unit) do { const int tb_ = (unit) / 12, h_ = (unit) - tb_ * 12; \
        _Pragma("unroll") for (int i = 0; i < 2; ++i) { const int idx = tid + i * NTHR, row = idx >> 3, ch = idx & 7; pre[i] = *(const u32x4*)(Q + ((size_t)tb_ * 128 + row) * 768 + h_ * 64 + ch * 8); } \
        _Pragma("unroll") for (int ks = 0; ks < 4; ++ks) af[ks] = *(const bf16x8*)(UK + ((size_t)h_ * 256 + wave * 32 + q) * 64 + ks * 16 + hh * 8); } while (0)
    if (u0 < nunits) QL_LOAD(u0);
    for (int unit = u0; unit < nunits; unit += ustep) {
        const int tb = unit / 12, h = unit - tb * 12; const size_t tok0 = (size_t)tb * 128;
        __syncthreads();
#pragma unroll
        for (int i = 0; i < 2; ++i) { const int idx = tid + i * NTHR, row = idx >> 3, ch = idx & 7; *(LAS u32x4*)(lds + row * 144 + ch * 16) = pre[i]; }
        bf16x8 afc[4];
#pragma unroll
        for (int ks = 0; ks < 4; ++ks) afc[ks] = af[ks];
        __syncthreads();
        if (unit + ustep < nunits) QL_LOAD(unit + ustep);
#pragma unroll
        for (int nt = 0; nt < 4; ++nt) {
            f32x16 acc;
#pragma unroll
            for (int r = 0; r < 16; ++r) acc[r] = 0.f;
#pragma unroll
            for (int ks = 0; ks < 4; ++ks) { const bf16x8 bq = *(const LAS bf16x8*)(lds + (nt * 32 + q) * 144 + (ks * 16 + hh * 8) * 2); acc = __builtin_amdgcn_mfma_f32_32x32x16_bf16(afc[ks], bq, acc, 0, 0, 0); }
#pragma unroll
            for (int g = 0; g < 4; ++g) { u32x2 w; w.x = cvt_pk_bf16(acc[4 * g] * 0.125f, acc[4 * g + 1] * 0.125f); w.y = cvt_pk_bf16(acc[4 * g + 2] * 0.125f, acc[4 * g + 3] * 0.125f);
                *(LAS u32x2*)(lds + 18432 + (nt * 32 + q) * 528 + (wave * 32 + 8 * g + 4 * hh) * 2) = w; }
        }
        __syncthreads();
        for (int idx = tid; idx < 4096; idx += NTHR) { const int row = idx >> 5, ch = idx & 31;
            *(u32x4*)(QL + ((tok0 + row) * 12 + h) * 256 + ch * 8) = *(const LAS u32x4*)(lds + 18432 + row * 528 + ch * 16); }
    }
#undef QL_LOAD
}
__device__ __forceinline__ void uv_phase(LAS unsigned char* lds, int u0, int ustep, int nunits, const bf16* QL, const bf16* UVT, bf16* MIX, int tid, int wave, int lane_in) {
    int lane = lane_in; asm volatile("" : "+v"(lane));
    const int q = lane & 31, hh = lane >> 5, mt = wave >> 1, nt = wave & 1;
    u32x4 pre[8];
#define UV_LOAD(unit) do { const int tb_ = (unit) / 12, h_ = (unit) - tb_ * 12; _Pragma("unroll") for (int i = 0; i < 8; ++i) { const int idx = tid + i * NTHR, row = idx >> 5, ch = idx & 31; \
        pre[i] = *(const u32x4*)(QL + (((size_t)tb_ * 128 + row) * 12 + h_) * 256 + ch * 8); } } while (0)
    if (u0 < nunits) UV_LOAD(u0);
    for (int unit = u0; unit < nunits; unit += ustep) {
        const int tb = unit / 12, h = unit - tb * 12; const size_t tok0 = (size_t)tb * 128;
        __syncthreads();
#pragma unroll
        for (int i = 0; i < 8; ++i) { const int idx = tid + i * NTHR, row = idx >> 5, ch = idx & 31; *(LAS u32x4*)(lds + row * 528 + ch * 16) = pre[i]; }
        const bf16* bp = UVT + ((size_t)h * 64 + nt * 32 + q) * 256 + hh * 8;
        bf16x8 bw[16];
#pragma unroll
        for (int ks = 0; ks < 16; ++ks) bw[ks] = *(const bf16x8*)(bp + ks * 16);
        __syncthreads();
        if (unit + ustep < nunits) UV_LOAD(unit + ustep);
        f32x16 acc;
#pragma unroll
        for (int r = 0; r < 16; ++r) acc[r] = 0.f;
#pragma unroll
        for (int ks = 0; ks < 16; ++ks) { const bf16x8 a = *(const LAS bf16x8*)(lds + (mt * 32 + q) * 528 + (ks * 16 + hh * 8) * 2); acc = __builtin_amdgcn_mfma_f32_32x32x16_bf16(a, bw[ks], acc, 0, 0, 0); }
#pragma unroll
        for (int r = 0; r < 16; ++r) *(LAS unsigned short*)(lds + 67584 + (mt * 32 + (r & 3) + 8 * (r >> 2) + 4 * hh) * 144 + (nt * 32 + q) * 2) = (unsigned short)(cvt_pk_bf16(acc[r], 0.f) & 0xffffu);
        __syncthreads();
        for (int idx = tid; idx < 1024; idx += NTHR) { const int row = idx >> 3, ch = idx & 7;
            *(u32x4*)(MIX + (tok0 + row) * 1024 + h * 64 + ch * 8) = *(const LAS u32x4*)(lds + 67584 + row * 144 + ch * 16); }
    }
#undef UV_LOAD
}

typedef __bf16 bf16v2_tt __attribute__((ext_vector_type(2)));
typedef float f32x2 __attribute__((ext_vector_type(2)));
__device__ __forceinline__ float dot2bf(unsigned a, unsigned b, float c) { return __builtin_amdgcn_fdot2_f32_bf16(__builtin_bit_cast(bf16v2_tt, a), __builtin_bit_cast(bf16v2_tt, b), c, false); }
__device__ __forceinline__ float unsortable_f32(unsigned u) { return __uint_as_float((u & 0x80000000u) ? (u ^ 0x80000000u) : ~u); }

constexpr int PA_SK = 0, PA_WB = 2 * 128 * 272, PA_WBYTES = 32 * 272;
static_assert(PA_WB + 8 * PA_WBYTES <= LDS_SCR_BYTES, "PEER-A LDS map");
__device__ __forceinline__ unsigned wave_max_u32(unsigned x) {
    { const unsigned t = (unsigned)__builtin_amdgcn_update_dpp(0, (int)x, 0xB1, 0xf, 0xf, false); x = t > x ? t : x; }
    { const unsigned t = (unsigned)__builtin_amdgcn_update_dpp(0, (int)x, 0x4E, 0xf, 0xf, false); x = t > x ? t : x; }
    { const unsigned t = (unsigned)__builtin_amdgcn_update_dpp(0, (int)x, 0x141, 0xf, 0xf, false); x = t > x ? t : x; }
    { const unsigned t = (unsigned)__builtin_amdgcn_update_dpp(0, (int)x, 0x140, 0xf, 0xf, false); x = t > x ? t : x; }
    { const auto a = __builtin_amdgcn_permlane16_swap(x, x, false, false); x = a[0] > a[1] ? a[0] : a[1]; }
    { const auto b = __builtin_amdgcn_permlane32_swap(x, x, false, false); x = b[0] > b[1] ? b[0] : b[1]; }
    return (unsigned)__builtin_amdgcn_readfirstlane((int)x);
}
__device__ __forceinline__ void peer_topk_load_sk(LAS unsigned char* lds, const bf16* SK, int tid) {
    __syncthreads();
    for (int idx = tid; idx < 4096; idx += NTHR) { const int row = idx >> 4, ch = idx & 15;
        *(LAS u32x4*)(lds + PA_SK + row * 272 + ch * 16) = *(const u32x4*)(SK + (size_t)row * 128 + ch * 8); }
    __syncthreads();
}
#define PA_LOADPQ(dst, task_) do { const int tg_ = (task_) >> 4, sl_ = (task_) & 15; \
        _Pragma("unroll") for (int j = 0; j < 8; ++j) { const int row = 4 * j + (lane >> 4), ch = lane & 15; dst[j] = *(const u32x4*)(PQ + ((size_t)tg_ * 32 + row) * 2048 + sl_ * 128 + ch * 8); } } while (0)
__device__ __forceinline__ void peer_topk_task(LAS unsigned char* lds, int task, int task_next, u32x4 (&pqn)[8], const bf16* PQ, u32x2* TOPK, int wave, int lane_in) {
    int lane = lane_in; asm volatile("" : "+v"(lane));
    const int tg = task >> 4, sl = task & 15, half = sl & 1, q = lane & 31, hh = lane >> 5;
    LAS unsigned char* wb = lds + PA_WB + wave * PA_WBYTES;
#pragma unroll
    for (int j = 0; j < 8; ++j) { const int row = 4 * j + (lane >> 4), ch = lane & 15; *(LAS u32x4*)(wb + row * 272 + ch * 16) = pqn[j]; }
    if (task_next >= 0) PA_LOADPQ(pqn, task_next);
    bf16x8 bq[8];
#pragma unroll
    for (int ks = 0; ks < 8; ++ks) bq[ks] = *(const LAS bf16x8*)(wb + q * 272 + (ks * 16 + hh * 8) * 2);
    float f[64];
    const LAS unsigned char* skp = lds + PA_SK + (half * 128 + q) * 272 + hh * 16;
#pragma unroll
    for (int kt = 0; kt < 4; ++kt) {
        f32x16 acc;
#pragma unroll
        for (int r = 0; r < 16; ++r) acc[r] = 0.f;
#pragma unroll
        for (int ks = 0; ks < 8; ++ks) { const bf16x8 a = *(const LAS bf16x8*)(skp + kt * 32 * 272 + ks * 32); acc = __builtin_amdgcn_mfma_f32_32x32x16_bf16(a, bq[ks], acc, 0, 0, 0); }
#pragma unroll
        for (int r = 0; r < 16; ++r) f[kt * 16 + r] = acc[r] + 0.f;
    }
    float lo, hi, T = 0.f;
    { float mn = 3.0e38f, mx = -3.0e38f;
#pragma unroll
      for (int g = 0; g < 8; ++g) { float m = f[8 * g];
#pragma unroll
          for (int i = 1; i < 8; ++i) m = fmaxf(m, f[8 * g + i]);
          mn = fminf(mn, m); mx = fmaxf(mx, m); }
      { const auto a2 = __builtin_amdgcn_permlane32_swap(__float_as_uint(mn), __float_as_uint(mn), false, false); mn = fminf(__uint_as_float(a2[0]), __uint_as_float(a2[1]));
        const auto b2 = __builtin_amdgcn_permlane32_swap(__float_as_uint(mx), __float_as_uint(mx), false, false); mx = fmaxf(__uint_as_float(b2[0]), __uint_as_float(b2[1])); }
      lo = mn; hi = mx; }
    bool done = false; unsigned mycnt = 0u;
#pragma unroll 1
    for (int it = 0; it < BIS_CAP(22); ++it) {
        const float mid = 0.5f * lo + 0.5f * hi; unsigned cnt = 0u;
#pragma unroll
        for (int i = 0; i < 64; ++i) asm volatile("v_cmp_ge_f32 vcc, %1, %2\n\tv_addc_co_u32 %0, vcc, 0, %0, vcc" : "+v"(cnt) : "v"(f[i]), "v"(mid) : "vcc");
        asm volatile("s_nop 1" ::: "memory");
        const auto sw = __builtin_amdgcn_permlane32_swap(cnt, cnt, false, false);
        const unsigned tot = sw[0] + sw[1];
        if (!done) { if (tot >= 16u) lo = mid; else hi = mid; if (tot == 16u) { T = mid; done = true; mycnt = cnt; } }
        if (__all(done)) break;
    }
    LAS u32x2* stg = (LAS u32x2*)wb + q * 16;
    if (__all(done)) {
        unsigned pos = hh ? (16u - mycnt) : 0u;
#pragma unroll
        for (int i = 0; i < 64; ++i) {
            if (f[i] >= T) { u32x2 e; e.x = __float_as_uint(f[i]); e.y = (unsigned)((i >> 4) * 32 + (i & 3) + 8 * ((i >> 2) & 3) + 4 * hh); stg[pos] = e; pos += 1u; }
        }
    } else {
        if (!__all(done)) {
            unsigned Tu = 0u;
#pragma unroll 1
            for (int bit = 31; bit >= 0; --bit) {
                const unsigned cand = Tu | (1u << bit); unsigned cnt = 0u;
#pragma unroll
                for (int i = 0; i < 64; ++i) { const unsigned uu = sortable_u32(f[i]); CNT_GE(cnt, uu, cand); }
                asm volatile("s_nop 1" ::: "memory");
                const auto sw = __builtin_amdgcn_permlane32_swap(cnt, cnt, false, false);
                if (sw[0] + sw[1] >= 16u) Tu = cand;
            }
            if (!done) T = unsortable_f32(Tu);
        }
        unsigned gtc = 0u, eqc = 0u;
#pragma unroll
        for (int i = 0; i < 64; ++i) { asm volatile("v_cmp_gt_f32 vcc, %1, %2\n\tv_addc_co_u32 %0, vcc, 0, %0, vcc" : "+v"(gtc) : "v"(f[i]), "v"(T) : "vcc");
            asm volatile("v_cmp_eq_f32 vcc, %1, %2\n\tv_addc_co_u32 %0, vcc, 0, %0, vcc" : "+v"(eqc) : "v"(f[i]), "v"(T) : "vcc"); }
        asm volatile("s_nop 1" ::: "memory");
        unsigned pg, pe;
        { const auto a = __builtin_amdgcn_permlane32_swap(gtc, gtc, false, false); pg = a[0] + a[1] - gtc; const auto e = __builtin_amdgcn_permlane32_swap(eqc, eqc, false, false); pe = e[0] + e[1] - eqc; }
        const unsigned need_eq = 16u - (gtc + pg);
        const unsigned take0 = hh ? (pe < need_eq ? pe : need_eq) : (eqc < need_eq ? eqc : need_eq);
        const unsigned my_take = hh ? need_eq - take0 : take0;
        unsigned pos = hh ? (pg + take0) : 0u, eq_seen = 0u;
#pragma unroll
        for (int i = 0; i < 64; ++i) {
            const bool eq = (f[i] == T); const bool sel = (f[i] > T) || (eq && eq_seen < my_take);
            if (sel) { u32x2 e; e.x = __float_as_uint(f[i]); e.y = (unsigned)((i >> 4) * 32 + (i & 3) + 8 * ((i >> 2) & 3) + 4 * hh); stg[pos] = e; pos += 1u; }
            eq_seen += eq ? 1u : 0u;
        }
    }
#pragma unroll
    for (int j = 0; j < 4; ++j) { const int tk = 8 * j + (lane >> 3), ch = lane & 7;
        *(u32x4*)((unsigned char*)(TOPK + (((size_t)tg * 32 + tk) * 16 + sl) * 16) + ch * 16) = *(const LAS u32x4*)(wb + tk * 128 + ch * 16); }
}

template <bool LAST>
__device__ __forceinline__ void peer_tok(LAS unsigned char* lds_w, size_t tok, const u32x2* TOPK, const unsigned char* TABU, const unsigned char* TABV, const float* TSU, const float* TSV, bf16* HB, const float* SS, const float* gffn, float* xres, const float* gnext, int lane_in) {
    int lane = lane_in; asm volatile("" : "+v"(lane));
    LAS u32x2* EL = (LAS u32x2*)lds_w;
    LAS u32x4* EG = (LAS u32x4*)(lds_w + 1024);
    for (int _rp = 0; _rp <= (PEER_PROBE & 1); ++_rp)
#pragma unroll 1
    for (int head = 0; head < 8; ++head) {
        const u32x2* base = TOPK + (tok * 16 + head * 2) * 16;
        const u32x2 e0 = base[lane >> 2];
        const u32x4 e1a = *(const u32x4*)(base + 16 + 4 * (lane & 3)), e1b = *(const u32x4*)(base + 16 + 4 * (lane & 3) + 2);
        const float s0 = __uint_as_float(e0.x);
        float cs[4]; unsigned ck[4], u[4];
        cs[0] = s0 + __uint_as_float(e1a.x); ck[0] = e0.y * 128u + e1a.y; cs[1] = s0 + __uint_as_float(e1a.z); ck[1] = e0.y * 128u + e1a.w;
        cs[2] = s0 + __uint_as_float(e1b.x); ck[2] = e0.y * 128u + e1b.y; cs[3] = s0 + __uint_as_float(e1b.z); ck[3] = e0.y * 128u + e1b.w;
#pragma unroll
        for (int m = 0; m < 4; ++m) u[m] = sortable_u32(cs[m]);
        unsigned T = 0u;
#pragma unroll 1
        for (int bit = 31; bit >= 0; --bit) {
            const unsigned cand = T | (1u << bit); unsigned cnt = 0u;
#pragma unroll
            for (int m = 0; m < 4; ++m) cnt += (unsigned)__popcll(__ballot(u[m] >= cand));
            if (cnt >= 16u) T = cand;
            if (cnt == 16u) break;
        }
        unsigned G = 0u;
#pragma unroll
        for (int m = 0; m < 4; ++m) G += (unsigned)__popcll(__ballot(u[m] > T));
        const unsigned need_eq = 16u - G; unsigned pos = 0u, eq_used = 0u;
#pragma unroll
        for (int m = 0; m < 4; ++m) {
            const bool gt = u[m] > T, eq = u[m] == T;
            const unsigned long long meq = __ballot(eq);
            const bool sl = gt || (eq && (eq_used + mbcnt64(meq) < need_eq));
            const unsigned long long msl = __ballot(sl);
            if (sl) { u32x2 e; e.x = ck[m]; e.y = __float_as_uint(cs[m]); EL[head * 16 + pos + mbcnt64(msl)] = e; }
            pos += (unsigned)__popcll(msl); eq_used += (unsigned)__popcll(meq); }
    }
#pragma unroll
    for (int rep = 0; rep < 2; ++rep) { const int e = lane + 64 * rep; const u32x2 ent = EL[e]; const float sc = __uint_as_float(ent.y);
        const float su = TSU[ent.x], sv = TSV[ent.x];
        float mx = sc;
#pragma unroll
        for (int o = 1; o < 16; o <<= 1) mx = fmaxf(mx, __shfl_xor(mx, o));
        const float p = __expf(sc - mx); float sm = p;
#pragma unroll
        for (int o = 1; o < 16; o <<= 1) sm += __shfl_xor(sm, o);
        u32x4 w; w.x = ent.x; w.y = __float_as_uint(su); w.z = __float_as_uint(p / sm * sv); w.w = 0u; EG[e] = w; }
    int xq[4]; float sx;
    { const u32x4* hp = (const u32x4*)(HB + tok * 1024 + lane * 16); const u32x4 qa = hp[0], qb = hp[1]; float f[16]; float am = 0.f;
#pragma unroll
      for (int e = 0; e < 4; ++e) { f[2 * e] = __uint_as_float(qa[e] << 16); f[2 * e + 1] = __uint_as_float(qa[e] & 0xffff0000u); f[8 + 2 * e] = __uint_as_float(qb[e] << 16); f[8 + 2 * e + 1] = __uint_as_float(qb[e] & 0xffff0000u); }
      { const float rs_ = 1.0f / sqrtf(SS[tok] * (1.f / 1024.f) + EPS);
#pragma unroll
        for (int j = 0; j < 4; ++j) { const f32x4 gg = *(const f32x4*)(gffn + lane * 16 + 4 * j); f[4 * j] *= rs_ * gg[0]; f[4 * j + 1] *= rs_ * gg[1]; f[4 * j + 2] *= rs_ * gg[2]; f[4 * j + 3] *= rs_ * gg[3]; } }
#pragma unroll
      for (int c = 0; c < 16; ++c) am = fmaxf(am, fabsf(f[c]));
      am = wave_max(am); sx = am > 0.f ? am * (1.0f / 127.0f) : 1.0f; const float inv = 1.0f / sx;
#pragma unroll
      for (int e = 0; e < 4; ++e) { const int q0 = (int)rintf(f[4 * e] * inv), q1 = (int)rintf(f[4 * e + 1] * inv), q2 = (int)rintf(f[4 * e + 2] * inv), q3 = (int)rintf(f[4 * e + 3] * inv);
          xq[e] = (q0 & 0xff) | ((q1 & 0xff) << 8) | ((q2 & 0xff) << 16) | ((q3 & 0xff) << 24); } }
    f32x2 out2[8];
#pragma unroll
    for (int c = 0; c < 8; ++c) out2[c] = (f32x2){0.f, 0.f};
    const unsigned char* ubase = TABU + lane * 16; const unsigned char* vbase = TABV + lane * 16;
#define PT_LOAD(UB, VB, BT) do { _Pragma("unroll") for (int k = 0; k < 8; ++k) { const size_t ro = (size_t)EG[(BT) * 8 + k].x << 10; UB[k] = *(const u32x4*)(ubase + ro); VB[k] = *(const u32x4*)(vbase + ro); } } while (0)
#define PT_COMPUTE(UB, VB, BT) do { int di[8]; \
        _Pragma("unroll") for (int k = 0; k < 8; ++k) { int a0 = 0; \
            _Pragma("unroll") for (int e = 0; e < 4; ++e) a0 = __builtin_amdgcn_sdot4((int)UB[k][e], xq[e], a0, false); di[k] = a0; } \
        int r4[4], r2[2], v1; \
        { const bool h32 = (lane & 32) != 0; \
          _Pragma("unroll") for (int j = 0; j < 4; ++j) { const int send = h32 ? di[j] : di[j + 4], keep = h32 ? di[j + 4] : di[j]; r4[j] = keep + __shfl_xor(send, 32); } \
          const bool h16 = (lane & 16) != 0; \
          _Pragma("unroll") for (int j = 0; j < 2; ++j) { const int send = h16 ? r4[j] : r4[j + 2], keep = h16 ? r4[j + 2] : r4[j]; r2[j] = keep + __shfl_xor(send, 16); } \
          const bool h8 = (lane & 8) != 0; \
          { const int send = h8 ? r2[0] : r2[1], keep = h8 ? r2[1] : r2[0]; v1 = keep + __shfl_xor(send, 8); } \
          v1 += __shfl_xor(v1, 4); v1 += __shfl_xor(v1, 2); v1 += __shfl_xor(v1, 1); } \
        float act; { const u32x4 eg = EG[(BT) * 8 + (lane >> 3)]; const float v = (float)v1 * (__uint_as_float(eg.y) * sx); \
          const float t = __builtin_amdgcn_rcpf(fabsf(v) * 0.2316418882f + 1.0f); \
          float q = t * 0.5307027145f + (-0.7265760135f); q = q * t + 0.7107068705f; q = q * t + (-0.142248368f); q = q * t + 0.127414796f; q = q * t; \
          const float m = v * (q * __builtin_amdgcn_exp2f(v * v * (-0.72134752044f))); \
          act = (v < 0.f ? m : v - m) * __uint_as_float(eg.z); }                        \
        _Pragma("unroll") for (int k = 0; k < 8; ++k) { const float a = __uint_as_float(__builtin_amdgcn_readlane((int)__float_as_uint(act), 8 * k)); \
            _Pragma("unroll") for (int e = 0; e < 4; ++e) { out2[2 * e] += __builtin_amdgcn_cvt_pk_f32_fp8((int)VB[k][e], false) * a; out2[2 * e + 1] += __builtin_amdgcn_cvt_pk_f32_fp8((int)VB[k][e], true) * a; } } } while (0)
    {
        u32x4 ubA[8], vbA[8], ubB[8], vbB[8], ubC[8], vbC[8];
        PT_LOAD(ubA, vbA, 0); PT_LOAD(ubB, vbB, 1);
#pragma unroll 1
        for (int bt = 0; bt < 16; bt += 3) {
            { const int n2 = (bt + 2 < 16) ? bt + 2 : 15; PT_LOAD(ubC, vbC, n2); }
            PT_COMPUTE(ubA, vbA, bt);
            if (bt + 1 < 16) {
                { const int n3 = (bt + 3 < 16) ? bt + 3 : 15; PT_LOAD(ubA, vbA, n3); }
                PT_COMPUTE(ubB, vbB, bt + 1);
                { const int n4 = (bt + 4 < 16) ? bt + 4 : 15; PT_LOAD(ubB, vbB, n4); }
                PT_COMPUTE(ubC, vbC, bt + 2);
            }
        }
    }
#undef PT_LOAD
#undef PT_COMPUTE
    f32x4 xr[4]; float ss = 0.f;
    float* xq4 = xres + tok * 1024 + lane * 16;
#pragma unroll
    for (int j = 0; j < 4; ++j) { xr[j] = *(const f32x4*)(xq4 + 4 * j);
        xr[j][0] += out2[2 * j].x; xr[j][1] += out2[2 * j].y; xr[j][2] += out2[2 * j + 1].x; xr[j][3] += out2[2 * j + 1].y;
#pragma unroll
        for (int e = 0; e < 4; ++e) ss += xr[j][e] * xr[j][e]; }
    const float rstd = 1.0f / sqrtf(wave_sum(ss) * (1.f / 1024.f) + EPS);
    if (LAST) {
#pragma unroll
        for (int j = 0; j < 4; ++j) { const f32x4 gg = *(const f32x4*)(gnext + lane * 16 + 4 * j); *(f32x4*)(xq4 + 4 * j) = xr[j] * rstd * gg; }
    } else {
        u32x4 o0, o1;
#pragma unroll
        for (int j = 0; j < 4; ++j) { *(f32x4*)(xq4 + 4 * j) = xr[j]; const f32x4 gg = *(const f32x4*)(gnext + lane * 16 + 4 * j);
            const unsigned lo = cvt_pk_bf16(xr[j][0] * rstd * gg[0], xr[j][1] * rstd * gg[1]), hi = cvt_pk_bf16(xr[j][2] * rstd * gg[2], xr[j][3] * rstd * gg[3]);
            if (j < 2) { o0[2 * j] = lo; o0[2 * j + 1] = hi; } else { o1[2 * (j - 2)] = lo; o1[2 * (j - 2) + 1] = hi; } }
        u32x4* hq = (u32x4*)(HB + tok * 1024 + lane * 16); hq[0] = o0; hq[1] = o1;
    }
}

__device__ __forceinline__ float row16_max(float x) {
    x = fmaxf(x, __uint_as_float((unsigned)__builtin_amdgcn_update_dpp(0, (int)__float_as_uint(x), 0xB1, 0xf, 0xf, false)));
    x = fmaxf(x, __uint_as_float((unsigned)__builtin_amdgcn_update_dpp(0, (int)__float_as_uint(x), 0x4E, 0xf, 0xf, false)));
    x = fmaxf(x, __uint_as_float((unsigned)__builtin_amdgcn_update_dpp(0, (int)__float_as_uint(x), 0x141, 0xf, 0xf, false)));
    x = fmaxf(x, __uint_as_float((unsigned)__builtin_amdgcn_update_dpp(0, (int)__float_as_uint(x), 0x140, 0xf, 0xf, false)));
    return x;
}
__device__ __forceinline__ float row16_sum(float x) {
    x += __uint_as_float((unsigned)__builtin_amdgcn_update_dpp(0, (int)__float_as_uint(x), 0xB1, 0xf, 0xf, false));
    x += __uint_as_float((unsigned)__builtin_amdgcn_update_dpp(0, (int)__float_as_uint(x), 0x4E, 0xf, 0xf, false));
    x += __uint_as_float((unsigned)__builtin_amdgcn_update_dpp(0, (int)__float_as_uint(x), 0x141, 0xf, 0xf, false));
    x += __uint_as_float((unsigned)__builtin_amdgcn_update_dpp(0, (int)__float_as_uint(x), 0x140, 0xf, 0xf, false));
    return x;
}
__device__ __forceinline__ float wave_sum_f32(float x) {
    x = row16_sum(x);
    { const auto a = __builtin_amdgcn_permlane16_swap(__float_as_uint(x), __float_as_uint(x), false, false); x = __uint_as_float(a[0]) + __uint_as_float(a[1]); }
    { const auto b = __builtin_amdgcn_permlane32_swap(__float_as_uint(x), __float_as_uint(x), false, false); x = __uint_as_float(b[0]) + __uint_as_float(b[1]); }
    return x;
}
__device__ __forceinline__ unsigned wave_incl_scan_u32(unsigned v) {
    v += (unsigned)__builtin_amdgcn_update_dpp(0, (int)v, 0x111, 0xf, 0xf, true);
    v += (unsigned)__builtin_amdgcn_update_dpp(0, (int)v, 0x112, 0xf, 0xf, true);
    v += (unsigned)__builtin_amdgcn_update_dpp(0, (int)v, 0x114, 0xf, 0xf, true);
    v += (unsigned)__builtin_amdgcn_update_dpp(0, (int)v, 0x118, 0xf, 0xf, true);
    v += (unsigned)__builtin_amdgcn_update_dpp(0, (int)v, 0x142, 0xa, 0xf, false);
    v += (unsigned)__builtin_amdgcn_update_dpp(0, (int)v, 0x143, 0xc, 0xf, false);
    return v;
}
template <int R> __device__ __forceinline__ void rank_step(unsigned long long key, unsigned& rank) {
    const unsigned lo = (unsigned)__builtin_amdgcn_update_dpp(0, (int)(unsigned)key, 0x120 + R, 0xf, 0xf, false);
    const unsigned hi = (unsigned)__builtin_amdgcn_update_dpp(0, (int)(unsigned)(key >> 32), 0x120 + R, 0xf, 0xf, false);
    rank += ((((unsigned long long)hi << 32) | lo) > key) ? 1u : 0u;
    if constexpr (R < 15) rank_step<R + 1>(key, rank);
}
__device__ __forceinline__ void xcc_sync(unsigned* ctr, unsigned nloc, unsigned target);
constexpr int PW_SET = 6144, PW_HIST = 2 * PW_SET, PW_SL = PW_HIST + 1024, PW_ENTB = PW_SL + 512, PW_BYTES = PW_ENTB + 512;
template <bool LAST>
__device__ __forceinline__ void peer_wave(LAS unsigned char* lds_w, int m0, int mstep, int mcount, const u32x2* TOPK, const unsigned char* TABU, const unsigned char* TABV, const float* TSU, const float* TSV,
                                          bf16* HB, const float* SS, const float* gffn, float* xres, const float* gnext, int lane_in, unsigned* xctr, unsigned nloc, unsigned xbase, volatile LAS unsigned* wgctr) {
    int lane = lane_in; asm volatile("" : "+v"(lane));
    LAS unsigned* HIST = (LAS unsigned*)(lds_w + PW_HIST);
    LAS u32x2* SLs = (LAS u32x2*)(lds_w + PW_SL);
    int ri, rj;
    { const int L = lane;
      if (L < 16) { ri = 0; rj = L; } else if (L < 24) { ri = 1; rj = L - 16; } else if (L < 29) { ri = 2; rj = L - 24; } else if (L < 33) { ri = 3; rj = L - 29; }
      else if (L < 36) { ri = 4; rj = L - 33; } else if (L < 38) { ri = 5; rj = L - 36; } else if (L < 40) { ri = 6; rj = L - 38; } else if (L < 42) { ri = 7; rj = L - 40; }
      else if (L < 50) { ri = L - 34; rj = 0; } else { ri = 0; rj = 0; } }
#define PW_ENT(tokC, head) TOPK[((tokC + (lane >> 5)) * 16 + (head) * 2) * 16 + (lane & 31)]
#define PW_CAND(ent, head, ELc) do { \
        const unsigned long long key = ((unsigned long long)sortable_u32(__uint_as_float(ent.x)) << 32) | (unsigned)(15 - (lane & 15)); \
        unsigned rank = 0u; rank_step<1>(key, rank); \
        SLs[(lane >> 4) * 16 + rank] = ent; \
        { const u32x2 ea0 = SLs[ri], eb0 = SLs[16 + rj], ea1 = SLs[32 + ri], eb1 = SLs[48 + rj]; \
          const float cs0 = __uint_as_float(ea0.x) + __uint_as_float(eb0.x), cs1 = __uint_as_float(ea1.x) + __uint_as_float(eb1.x); \
          const unsigned ck0 = ea0.y * 128u + eb0.y, ck1 = ea1.y * 128u + eb1.y; \
          const bool vld = lane < 50; \
            \
            \
          float lo0 = __uint_as_float((unsigned)__builtin_amdgcn_readlane((int)__float_as_uint(cs0), 32)), hi0 = __uint_as_float((unsigned)__builtin_amdgcn_readlane((int)__float_as_uint(cs0), 0)); \
          float lo1 = __uint_as_float((unsigned)__builtin_amdgcn_readlane((int)__float_as_uint(cs1), 32)), hi1 = __uint_as_float((unsigned)__builtin_amdgcn_readlane((int)__float_as_uint(cs1), 0)); \
          bool sl0 = false, sl1 = false, cv0 = false, cv1 = false; float mid0 = lo0, mid1 = lo1; \
          _Pragma("unroll 1") for (int it = 0; it < BIS_CAP(24); ++it) { \
              const bool ge0 = vld && (cs0 >= mid0), ge1 = vld && (cs1 >= mid1); \
              const unsigned n0 = (unsigned)__popcll(__ballot(ge0)), n1 = (unsigned)__popcll(__ballot(ge1)); \
              if (!cv0) { if (n0 == 16u) { sl0 = ge0; cv0 = true; } else if (n0 > 16u) lo0 = mid0; else hi0 = mid0; } \
              if (!cv1) { if (n1 == 16u) { sl1 = ge1; cv1 = true; } else if (n1 > 16u) lo1 = mid1; else hi1 = mid1; } \
              if (cv0 && cv1) break; \
              mid0 = 0.5f * lo0 + 0.5f * hi0; mid1 = 0.5f * lo1 + 0.5f * hi1; } \
          _Pragma("unroll 1") for (int tk = 0; tk < 2; ++tk) { if (tk ? cv1 : cv0) continue;                \
              const unsigned u = vld ? sortable_u32(tk ? cs1 : cs0) : 0u; \
              unsigned T = 0u; \
              _Pragma("unroll 1") for (int bit = 31; bit >= 0; --bit) { \
                  const unsigned cand = T | (1u << bit); const unsigned cnt = (unsigned)__popcll(__ballot(u >= cand)); \
                  if (cnt >= 16u) T = cand; \
                  if (cnt == 16u) break; \
              } \
              const unsigned G = (unsigned)__popcll(__ballot(u > T)); const unsigned need_eq = 16u - G; \
              const bool gt = u > T, eq = u == T; \
              const unsigned long long meq = __ballot(eq); \
              const bool slx = gt || (eq && (mbcnt64(meq) < need_eq)); if (tk) sl1 = slx; else sl0 = slx; } \
          { const unsigned long long msl = __ballot(sl0); if (sl0) { u32x2 e; e.x = ck0; e.y = __float_as_uint(cs0); ELc[(head) * 16 + mbcnt64(msl)] = e; } } \
          { const unsigned long long msl = __ballot(sl1); if (sl1) { u32x2 e; e.x = ck1; e.y = __float_as_uint(cs1); ELc[(8 + head) * 16 + mbcnt64(msl)] = e; } } \
        } \
        } while (0)
    if (m0 >= mcount) return;
    const __amdgpu_buffer_rsrc_t trs = __builtin_amdgcn_make_buffer_rsrc((void*)TABU, 0, 32 * 1024 * 1024, 0x00020000);
    const unsigned lofs = (unsigned)lane * 16u;
    {
        LAS u32x2* ELc = (LAS u32x2*)lds_w; LAS u32x4* EGc = (LAS u32x4*)(lds_w + 2048); const size_t tokC = (size_t)m0 * 2;
        HIST[lane] = 0u; HIST[64 + lane] = 0u;
        for (int _rp = 0; _rp <= (PEER_PROBE & 1); ++_rp)
#pragma unroll 1
        for (int head = 0; head < 8; ++head) { const u32x2 ent = PW_ENT(tokC, head); PW_CAND(ent, head, ELc); }
    u32x4 ent4[4]; unsigned rk[4];
#pragma unroll
    for (int rep = 0; rep < 4; ++rep) { const int e = lane + 64 * rep; const u32x2 ent = ELc[e]; const float sc = __uint_as_float(ent.y);
        const float su = TSU[ent.x], sv = TSV[ent.x];
        const float mx = row16_max(sc);
        const float p = __expf(sc - mx); const float sm = row16_sum(p);
        ent4[rep].x = ent.x; ent4[rep].y = __float_as_uint(su); ent4[rep].z = __float_as_uint(p / sm * sv); ent4[rep].w = (unsigned)(rep >> 1);
        rk[rep] = atomicAdd((unsigned*)&HIST[(rep >> 1) * 64 + (ent.x >> 8)], 1u); }
    { const unsigned c0 = HIST[2 * lane], c1 = HIST[2 * lane + 1]; const unsigned inc = wave_incl_scan_u32(c0 + c1);
      HIST[128 + 2 * lane] = inc - c0 - c1; HIST[128 + 2 * lane + 1] = inc - c1; }
#pragma unroll
    for (int rep = 0; rep < 4; ++rep) EGc[HIST[128 + (rep >> 1) * 64 + (ent4[rep].x >> 8)] + rk[rep]] = ent4[rep];
    }
    int par = 0; unsigned ckpt = 0u;
#pragma unroll 1
    for (int m = m0; m < mcount; m += mstep, par ^= 1) {
        const size_t tok0 = (size_t)m * 2; const bool has_next = (m + mstep) < mcount; const size_t tokC = (size_t)(m + mstep) * 2;
        if (PEER_WGSYNC == 1 || (PEER_WGSYNC >= 3 && PEER_WGSYNC < 6) || PEER_WGSYNC == 9) __syncthreads();
        if (PEER_WGSYNC == 2 || PEER_WGSYNC == 8) xcc_sync(xctr, nloc, xbase + (unsigned)((m - m0) / mstep) + 1u);
        if (PEER_XMID && (m - m0) / mstep == 4) xcc_sync(xctr, nloc, xbase / 8u + 1u);
        const unsigned xseq = (xbase + (unsigned)((m - m0) / mstep)) * (PEER_WGSYNC == 6 ? 4u : 8u);
        if (PEER_WGSYNC == 6 || PEER_WGSYNC == 7) xcc_sync(xctr, nloc, xseq + 1u);
        LAS u32x4* EGg = (LAS u32x4*)(lds_w + par * PW_SET + 2048);
        LAS u32x2* ELc = (LAS u32x2*)(lds_w + (par ^ 1) * PW_SET); LAS u32x4* EGc = (LAS u32x4*)(lds_w + (par ^ 1) * PW_SET + 2048);
        int x0q[4], x1q[4]; float sx0, sx1;
        {
    int lq = lane_in; asm volatile("" : "+v"(lq));
    float gf[16];
#pragma unroll
    for (int j = 0; j < 4; ++j) { const f32x4 gg = *(const f32x4*)(gffn + lq * 16 + 4 * j); gf[4 * j] = gg[0]; gf[4 * j + 1] = gg[1]; gf[4 * j + 2] = gg[2]; gf[4 * j + 3] = gg[3]; }

#define PP_QUANT(xq, sx, tk) do { const u32x4* hp = (const u32x4*)(HB + (tok0 + (tk)) * 1024 + lq * 16); const u32x4 qa = hp[0], qb = hp[1]; float f[16]; float am = 0.f; \
        const float rs_ = 1.0f / sqrtf(SS[tok0 + (tk)] * (1.f / 1024.f) + EPS); \
        _Pragma("unroll") for (int e = 0; e < 4; ++e) { f[2 * e] = __uint_as_float(qa[e] << 16); f[2 * e + 1] = __uint_as_float(qa[e] & 0xffff0000u); f[8 + 2 * e] = __uint_as_float(qb[e] << 16); f[8 + 2 * e + 1] = __uint_as_float(qb[e] & 0xffff0000u); } \
        _Pragma("unroll") for (int c = 0; c < 16; ++c) f[c] *= rs_ * gf[c]; \
        _Pragma("unroll") for (int c = 0; c < 16; ++c) am = fmaxf(am, fabsf(f[c])); \
        am = wave_max_f32(am); sx = am > 0.f ? am * (1.0f / 127.0f) : 1.0f; const float inv = 1.0f / sx; \
        _Pragma("unroll") for (int e = 0; e < 4; ++e) { const int q0 = (int)rintf(f[4 * e] * inv), q1 = (int)rintf(f[4 * e + 1] * inv), q2 = (int)rintf(f[4 * e + 2] * inv), q3 = (int)rintf(f[4 * e + 3] * inv); \
            xq[e] = (q0 & 0xff) | ((q1 & 0xff) << 8) | ((q2 & 0xff) << 16) | ((q3 & 0xff) << 24); } } while (0)
        PP_QUANT(x0q, sx0, 0); PP_QUANT(x1q, sx1, 1);
#undef PP_QUANT
        }
        f32x2 out0[8], out1[8];
#pragma unroll
        for (int c = 0; c < 8; ++c) { out0[c] = (f32x2){0.f, 0.f}; out1[c] = (f32x2){0.f, 0.f}; }
#define PP_IDS(TK, J) (EGg[(TK) * 128 + (J) * 8 + (lane & 7)].x & idmask)
#define PP_LOAD_U(UB, IDV) do { _Pragma("unroll") for (int k = 0; k < 8; ++k) { const unsigned id = (unsigned)__builtin_amdgcn_readlane((int)(IDV), k); \
            UB[k] = __builtin_amdgcn_raw_buffer_load_b128(trs, lofs, (int)(id << 11), 0); } } while (0)
#define PP_LOAD_V(VB, IDV) do { _Pragma("unroll") for (int k = 0; k < 8; ++k) { const unsigned id = (unsigned)__builtin_amdgcn_readlane((int)(IDV), k); \
            VB[k] = __builtin_amdgcn_raw_buffer_load_b128(trs, lofs + 1024u, (int)(id << 11), 0); } } while (0)
#define PP_DOTS(UB, XQ) \
        _Pragma("unroll") for (int k = 0; k < 8; ++k) { int a0 = 0; \
            _Pragma("unroll") for (int e = 0; e < 4; ++e) a0 = __builtin_amdgcn_sdot4((int)UB[k][e], XQ[e], a0, false); \
            di[k] = a0; }
#define PP_ACT(TK, J, SX) do { \
        const u32x4 eg = EGg[(TK) * 128 + (J) * 8 + (lane >> 3)]; \
        int r4[4], r2[2], v1; \
        _Pragma("unroll") for (int j_ = 0; j_ < 4; ++j_) { const auto sw = __builtin_amdgcn_permlane32_swap((unsigned)di[j_], (unsigned)di[j_ + 4], false, false); r4[j_] = (int)(sw[0] + sw[1]); }     \
        _Pragma("unroll") for (int j_ = 0; j_ < 2; ++j_) { const auto sw = __builtin_amdgcn_permlane16_swap((unsigned)r4[j_], (unsigned)r4[j_ + 2], false, false); r2[j_] = (int)(sw[0] + sw[1]); }     \
        { const bool h8 = (lane & 8) != 0; const int send = h8 ? r2[0] : r2[1], keep = h8 ? r2[1] : r2[0]; \
          v1 = keep + __builtin_amdgcn_update_dpp(0, send, 0x128, 0xf, 0xf, false);                                         \
          v1 += __builtin_amdgcn_update_dpp(0, v1, 0xB1, 0xf, 0xf, false); v1 += __builtin_amdgcn_update_dpp(0, v1, 0x4E, 0xf, 0xf, false); v1 += __builtin_amdgcn_update_dpp(0, v1, 0x141, 0xf, 0xf, false); }     \
        { const float v = (float)v1 * __uint_as_float(eg.y) * SX; \
          const float t = __builtin_amdgcn_rcpf(fabsf(v) * 0.2316418882f + 1.0f); \
          float q = t * 0.5307027145f + (-0.7265760135f); q = q * t + 0.7107068705f; q = q * t + (-0.142248368f); q = q * t + 0.127414796f; q = q * t; \
          const float m = v * (q * __builtin_amdgcn_exp2f(v * v * (-0.72134752044f))); \
          act = (v < 0.f ? m : v - m) * __uint_as_float(eg.z) * amul; } } while (0)
#define PP_ACC(VB, OUT) \
        _Pragma("unroll") for (int k = 0; k < 8; ++k) { const float a = __uint_as_float(__builtin_amdgcn_readlane((int)__float_as_uint(act), 8 * k)); \
            _Pragma("unroll") for (int e = 0; e < 4; ++e) { OUT[2 * e] += __builtin_amdgcn_cvt_pk_f32_fp8((int)VB[k][e], false) * a; OUT[2 * e + 1] += __builtin_amdgcn_cvt_pk_f32_fp8((int)VB[k][e], true) * a; } }
        for (int _rg = ((PEER_PROBE & 6) ? 0 : 1); _rg < 2; ++_rg) {
            const unsigned idmask = (_rg == 0 && (PEER_PROBE & 4)) ? 1023u : 0xffffffffu; const float amul = _rg ? 1.0f : 0.0f;
            u32x4 ubA[8], vbA[8], ubB[8], vbB[8]; int di[8]; float act;
#define PW_DMA(head) do { if (has_next && lane < 32) { const unsigned char* g_ = (const unsigned char*)(TOPK + ((tokC + (lane >> 4)) * 16 + (head) * 2) * 16) + (lane & 15) * 16; \
                __builtin_amdgcn_global_load_lds((const unsigned*)g_, (LAS unsigned*)(lds_w + PW_ENTB), 16, 0, 0); } } while (0)
            const int cph = 0;
            PW_DMA(0);
            { const unsigned ia = PP_IDS(0, 0), ib = PP_IDS(1, 0); PP_LOAD_U(ubA, ia); PP_LOAD_V(vbA, ia); PP_LOAD_U(ubB, ib); PP_LOAD_V(vbB, ib); }
#pragma unroll 1
            for (int j = 0; j < 16; ++j) {
                if ((PEER_WGSYNC == 3 && (j & 3) == 0) || ((PEER_WGSYNC == 4 || PEER_WGSYNC == 8) && (j & 1) == 0) || PEER_WGSYNC == 5) __syncthreads();
                if (PEER_WGSYNC == 9 && (j & 1) == 0) {
                    if (lane == 0) __hip_atomic_fetch_add((LAS unsigned*)wgctr, 1u, __ATOMIC_RELAXED, __HIP_MEMORY_SCOPE_WORKGROUP);
                    ckpt += 1u;
                    unsigned sp_ = 0u; while (*wgctr < 8u * (ckpt - 1u)) { __builtin_amdgcn_s_sleep(1); if (++sp_ > (1u << 16)) break; } }
                const int nj = (j + 1 < 16) ? j + 1 : 15;
                const unsigned ia = PP_IDS(0, nj), ib = PP_IDS(1, nj);
                PP_DOTS(ubA, x0q); PP_LOAD_U(ubA, ia); PP_ACT(0, j, sx0); PP_ACC(vbA, out0); PP_LOAD_V(vbA, ia);
                if (has_next && (j & 1) == cph) { const int head = j >> 1; asm volatile("s_waitcnt vmcnt(32)" ::: "memory");
                    const u32x2 entN = ((const LAS u32x2*)(lds_w + PW_ENTB))[lane]; for (int _rc = 0; _rc <= ((PEER_PROBE >> 3) & 1); ++_rc) PW_CAND(entN, head, ELc); }
                if ((j & 1) != cph && ((j + 1) >> 1) < 8) PW_DMA((j + 1) >> 1);
                PP_DOTS(ubB, x1q); PP_LOAD_U(ubB, ib); PP_ACT(1, j, sx1); PP_ACC(vbB, out1); PP_LOAD_V(vbB, ib);
            }
        }
#undef PP_IDS
#undef PP_LOAD_U
#undef PP_LOAD_V
#undef PP_DOTS
#undef PP_ACT
#undef PP_ACC
        if (has_next) {
            HIST[lane] = 0u; HIST[64 + lane] = 0u;
        u32x4 ent4[4]; unsigned rk[4];
#pragma unroll
        for (int rep = 0; rep < 4; ++rep) { const int e = lane + 64 * rep; const u32x2 ent = ELc[e]; const float sc = __uint_as_float(ent.y);
            const float su = TSU[ent.x], sv = TSV[ent.x];
            const float mx = row16_max(sc);
            const float p = __expf(sc - mx); const float sm = row16_sum(p);
            ent4[rep].x = ent.x; ent4[rep].y = __float_as_uint(su); ent4[rep].z = __float_as_uint(p / sm * sv); ent4[rep].w = (unsigned)(rep >> 1);
            rk[rep] = atomicAdd((unsigned*)&HIST[(rep >> 1) * 64 + (ent.x >> 8)], 1u); }
        { const unsigned c0 = HIST[2 * lane], c1 = HIST[2 * lane + 1]; const unsigned inc = wave_incl_scan_u32(c0 + c1);
      HIST[128 + 2 * lane] = inc - c0 - c1; HIST[128 + 2 * lane + 1] = inc - c1; }
#pragma unroll
        for (int rep = 0; rep < 4; ++rep) EGc[HIST[128 + (rep >> 1) * 64 + (ent4[rep].x >> 8)] + rk[rep]] = ent4[rep];
        }
        int lr = lane_in; asm volatile("" : "+v"(lr));
        f32x4 gnx[4];
#pragma unroll
        for (int j = 0; j < 4; ++j) gnx[j] = *(const f32x4*)(gnext + lr * 16 + 4 * j);
#pragma unroll
        for (int tk = 0; tk < 2; ++tk) {
            float xr[16]; float ss = 0.f;
            { const u32x4* hp = (const u32x4*)(HB + (tok0 + tk) * 1024 + lr * 16); const u32x4 qa = hp[0], qb = hp[1];
#pragma unroll
              for (int e = 0; e < 4; ++e) { xr[2 * e] = __uint_as_float(qa[e] << 16); xr[2 * e + 1] = __uint_as_float(qa[e] & 0xffff0000u); xr[8 + 2 * e] = __uint_as_float(qb[e] << 16); xr[8 + 2 * e + 1] = __uint_as_float(qb[e] & 0xffff0000u); } }
#pragma unroll
            for (int c = 0; c < 16; ++c) { const f32x2 o2 = tk ? out1[c >> 1] : out0[c >> 1]; xr[c] += (c & 1) ? o2.y : o2.x; ss += xr[c] * xr[c]; }
            const float rstd = __builtin_amdgcn_rsqf(wave_sum_f32(ss) * (1.f / 1024.f) + EPS);
            if (LAST) {
                float* xq = xres + (tok0 + tk) * 1024 + lr * 16;
#pragma unroll
                for (int j = 0; j < 4; ++j) { const f32x4 gg = gnx[j]; *(f32x4*)(xq + 4 * j) = (f32x4){xr[4 * j] * rstd * gg[0], xr[4 * j + 1] * rstd * gg[1], xr[4 * j + 2] * rstd * gg[2], xr[4 * j + 3] * rstd * gg[3]}; }
            } else {
                u32x4 o0, o1, r0, r1;
#pragma unroll
                for (int j = 0; j < 4; ++j) { const f32x4 gg = gnx[j];
                    const unsigned lo = cvt_pk_bf16(xr[4 * j] * rstd * gg[0], xr[4 * j + 1] * rstd * gg[1]), hi = cvt_pk_bf16(xr[4 * j + 2] * rstd * gg[2], xr[4 * j + 3] * rstd * gg[3]);
                    const unsigned rl = cvt_pk_bf16(xr[4 * j], xr[4 * j + 1]), rh = cvt_pk_bf16(xr[4 * j + 2], xr[4 * j + 3]);
                    if (j < 2) { o0[2 * j] = lo; o0[2 * j + 1] = hi; r0[2 * j] = rl; r0[2 * j + 1] = rh; } else { o1[2 * (j - 2)] = lo; o1[2 * (j - 2) + 1] = hi; r1[2 * (j - 2)] = rl; r1[2 * (j - 2) + 1] = rh; } }
                u32x4* hq = (u32x4*)(HB + (tok0 + tk) * 1024 + lr * 16); hq[0] = o0; hq[1] = o1;
                u32x4* xq2 = (u32x4*)((bf16*)xres + (tok0 + tk) * 1024 + lr * 16); xq2[0] = r0; xq2[1] = r1;
            }
        }
    }
#undef PW_CAND
#undef PW_ENT
#undef PW_DMA
}

template <bool LAST>
__device__ __forceinline__ void peer_pair(LAS unsigned char* lds_w, size_t tok0, const u32x2* TOPK, const unsigned char* TABU, const unsigned char* TABV, const float* TSU, const float* TSV, bf16* HB, const float* SS, const float* gffn, float* xres, const float* gnext, int lane_in) {
    int lane = lane_in; asm volatile("" : "+v"(lane));
    LAS u32x2* EL = (LAS u32x2*)lds_w;
    LAS u32x4* EG = (LAS u32x4*)(lds_w + 2048);
    LAS unsigned* HIST = (LAS unsigned*)(lds_w + 2048 + 4096);
    if (lane < 32) HIST[lane] = 0u;
    int ri, rj;
    { const int L = lane;
      if (L < 16) { ri = 0; rj = L; } else if (L < 24) { ri = 1; rj = L - 16; } else if (L < 29) { ri = 2; rj = L - 24; } else if (L < 33) { ri = 3; rj = L - 29; }
      else if (L < 36) { ri = 4; rj = L - 33; } else if (L < 38) { ri = 5; rj = L - 36; } else if (L < 40) { ri = 6; rj = L - 38; } else if (L < 42) { ri = 7; rj = L - 40; }
      else if (L < 50) { ri = L - 34; rj = 0; } else { ri = 0; rj = 0; } }
    LAS u32x2* SLs = (LAS u32x2*)(lds_w + 6400);
    for (int _rp = 0; _rp <= (PEER_PROBE & 1); ++_rp)
#pragma unroll 1
    for (int head = 0; head < 8; ++head) {
        const u32x2 ent = TOPK[((tok0 + (lane >> 5)) * 16 + head * 2) * 16 + (lane & 31)];
        const unsigned long long key = ((unsigned long long)sortable_u32(__uint_as_float(ent.x)) << 32) | (unsigned)(15 - (lane & 15));
        unsigned rank = 0u; rank_step<1>(key, rank);
        SLs[(lane >> 4) * 16 + rank] = ent;
#pragma unroll 1
        for (int tk = 0; tk < 2; ++tk) {
            const u32x2 ea = SLs[(tk * 2) * 16 + ri], eb = SLs[(tk * 2 + 1) * 16 + rj];
            const float cs = __uint_as_float(ea.x) + __uint_as_float(eb.x); const unsigned ck = ea.y * 128u + eb.y;
            const unsigned u = (lane < 50) ? sortable_u32(cs) : 0u;
            unsigned T = 0u;
#pragma unroll 1
            for (int bit = 31; bit >= 0; --bit) {
                const unsigned cand = T | (1u << bit); const unsigned cnt = (unsigned)__popcll(__ballot(u >= cand));
                if (cnt >= 16u) T = cand;
                if (cnt == 16u) break;
            }
            const unsigned G = (unsigned)__popcll(__ballot(u > T)); const unsigned need_eq = 16u - G;
            const bool gt = u > T, eq = u == T;
            const unsigned long long meq = __ballot(eq);
            const bool sl = gt || (eq && (mbcnt64(meq) < need_eq));
            const unsigned long long msl = __ballot(sl);
            if (sl) { u32x2 e; e.x = ck; e.y = __float_as_uint(cs); EL[(tk * 8 + head) * 16 + mbcnt64(msl)] = e; }
        }
    }
    u32x4 ent4[4]; unsigned rk[4];
#pragma unroll
    for (int rep = 0; rep < 4; ++rep) { const int e = lane + 64 * rep; const u32x2 ent = EL[e]; const float sc = __uint_as_float(ent.y);
        const float su = TSU[ent.x], sv = TSV[ent.x];
        float mx = sc;
#pragma unroll
        for (int o = 1; o < 16; o <<= 1) mx = fmaxf(mx, __shfl_xor(mx, o));
        const float p = __expf(sc - mx); float sm = p;
#pragma unroll
        for (int o = 1; o < 16; o <<= 1) sm += __shfl_xor(sm, o);
        ent4[rep].x = ent.x; ent4[rep].y = __float_as_uint(su); ent4[rep].z = __float_as_uint(p / sm * sv); ent4[rep].w = (unsigned)(rep >> 1);
        rk[rep] = atomicAdd((unsigned*)&HIST[ent.x >> 9], 1u); }
    { unsigned c = (lane < 32) ? HIST[lane] : 0u, inc = c;
#pragma unroll
      for (int o = 1; o < 32; o <<= 1) { const unsigned t = (unsigned)__shfl_up((int)inc, o); if ((lane & 31) >= o) inc += t; }
      if (lane < 32) HIST[32 + lane] = inc - c; }
#pragma unroll
    for (int rep = 0; rep < 4; ++rep) EG[HIST[32 + (ent4[rep].x >> 9)] + rk[rep]] = ent4[rep];
    int x0q[4], x1q[4]; float sx0, sx1;
    float gf[16];
#pragma unroll
    for (int j = 0; j < 4; ++j) { const f32x4 gg = *(const f32x4*)(gffn + lane * 16 + 4 * j); gf[4 * j] = gg[0]; gf[4 * j + 1] = gg[1]; gf[4 * j + 2] = gg[2]; gf[4 * j + 3] = gg[3]; }
#define PP_QUANT(xq, sx, tk) do { const u32x4* hp = (const u32x4*)(HB + (tok0 + (tk)) * 1024 + lane * 16); const u32x4 qa = hp[0], qb = hp[1]; float f[16]; float am = 0.f; \
        const float rs_ = 1.0f / sqrtf(SS[tok0 + (tk)] * (1.f / 1024.f) + EPS); \
        _Pragma("unroll") for (int e = 0; e < 4; ++e) { f[2 * e] = __uint_as_float(qa[e] << 16); f[2 * e + 1] = __uint_as_float(qa[e] & 0xffff0000u); f[8 + 2 * e] = __uint_as_float(qb[e] << 16); f[8 + 2 * e + 1] = __uint_as_float(qb[e] & 0xffff0000u); } \
        _Pragma("unroll") for (int c = 0; c < 16; ++c) f[c] *= rs_ * gf[c]; \
        _Pragma("unroll") for (int c = 0; c < 16; ++c) am = fmaxf(am, fabsf(f[c])); \
        am = wave_max(am); sx = am > 0.f ? am * (1.0f / 127.0f) : 1.0f; const float inv = 1.0f / sx; \
        _Pragma("unroll") for (int e = 0; e < 4; ++e) { const int q0 = (int)rintf(f[4 * e] * inv), q1 = (int)rintf(f[4 * e + 1] * inv), q2 = (int)rintf(f[4 * e + 2] * inv), q3 = (int)rintf(f[4 * e + 3] * inv); \
            xq[e] = (q0 & 0xff) | ((q1 & 0xff) << 8) | ((q2 & 0xff) << 16) | ((q3 & 0xff) << 24); } } while (0)
    PP_QUANT(x0q, sx0, 0); PP_QUANT(x1q, sx1, 1);
#undef PP_QUANT
    f32x2 outp[16];
#pragma unroll
    for (int c = 0; c < 16; ++c) outp[c] = (f32x2){0.f, 0.f};
#define PP_LOAD(UB, VB, BT) do { _Pragma("unroll") for (int k = 0; k < 8; ++k) { const unsigned id = EG[(BT) * 8 + k].x; UB[k] = *(const u32x4*)(TABU + (size_t)id * 1024 + lane * 16); VB[k] = *(const u32x4*)(TABV + (size_t)id * 1024 + lane * 16); } } while (0)
#define PP_COMPUTE(UB, VB, BT) do { int di[8]; \
        _Pragma("unroll") for (int k = 0; k < 8; ++k) { int a0 = 0, a1 = 0; \
            _Pragma("unroll") for (int e = 0; e < 4; ++e) { a0 = __builtin_amdgcn_sdot4((int)UB[k][e], x0q[e], a0, false); a1 = __builtin_amdgcn_sdot4((int)UB[k][e], x1q[e], a1, false); } \
            const unsigned tkk = (unsigned)__builtin_amdgcn_readfirstlane((int)EG[(BT) * 8 + k].w); di[k] = tkk ? a1 : a0; } \
        int r4[4], r2[2], v1; \
        { const bool h32 = (lane & 32) != 0; \
          _Pragma("unroll") for (int j = 0; j < 4; ++j) { const int send = h32 ? di[j] : di[j + 4], keep = h32 ? di[j + 4] : di[j]; r4[j] = keep + __shfl_xor(send, 32); } \
          const bool h16 = (lane & 16) != 0; \
          _Pragma("unroll") for (int j = 0; j < 2; ++j) { const int send = h16 ? r4[j] : r4[j + 2], keep = h16 ? r4[j + 2] : r4[j]; r2[j] = keep + __shfl_xor(send, 16); } \
          const bool h8 = (lane & 8) != 0; \
          { const int send = h8 ? r2[0] : r2[1], keep = h8 ? r2[1] : r2[0]; v1 = keep + __shfl_xor(send, 8); } \
          v1 += __shfl_xor(v1, 4); v1 += __shfl_xor(v1, 2); v1 += __shfl_xor(v1, 1); } \
        float act; { const u32x4 eg = EG[(BT) * 8 + (lane >> 3)]; const float v = (float)v1 * __uint_as_float(eg.y) * (eg.w ? sx1 : sx0); \
          const float t = __builtin_amdgcn_rcpf(fabsf(v) * 0.2316418882f + 1.0f); \
          float q = t * 0.5307027145f + (-0.7265760135f); q = q * t + 0.7107068705f; q = q * t + (-0.142248368f); q = q * t + 0.127414796f; q = q * t; \
          const float m = v * (q * __builtin_amdgcn_exp2f(v * v * (-0.72134752044f))); \
          act = (v < 0.f ? m : v - m) * __uint_as_float(eg.z); }                        \
        _Pragma("unroll") for (int k = 0; k < 8; ++k) { const float a = __uint_as_float(__builtin_amdgcn_readlane((int)__float_as_uint(act), 8 * k)); \
            const unsigned tkk = (unsigned)__builtin_amdgcn_readfirstlane((int)EG[(BT) * 8 + k].w); \
            const f32x2 a2 = tkk ? (f32x2){0.f, a} : (f32x2){a, 0.f}; \
            _Pragma("unroll") for (int e = 0; e < 4; ++e) { const f32x2 lo = __builtin_amdgcn_cvt_pk_f32_fp8((int)VB[k][e], false), hi = __builtin_amdgcn_cvt_pk_f32_fp8((int)VB[k][e], true); \
                outp[4 * e] += a2 * lo.x; outp[4 * e + 1] += a2 * lo.y; outp[4 * e + 2] += a2 * hi.x; outp[4 * e + 3] += a2 * hi.y; } } } while (0)
    for (int _rg = ((PEER_PROBE & 6) ? 0 : 1); _rg < 2; ++_rg) {
        const bool noload = (PEER_PROBE & 4) && _rg == 0;
#pragma unroll
        for (int c = 0; c < 16; ++c) outp[c] = (f32x2){0.f, 0.f};
        u32x4 ubA[8], vbA[8], ubB[8], vbB[8];
#pragma unroll
        for (int k = 0; k < 8; ++k) { ubA[k] = (u32x4){0u, 0u, 0u, 0u}; vbA[k] = ubA[k]; ubB[k] = ubA[k]; vbB[k] = ubA[k]; }
        if (!noload) PP_LOAD(ubA, vbA, 0);
#pragma unroll 1
        for (int bt = 0; bt < 32; bt += 2) {
            if (!noload) PP_LOAD(ubB, vbB, bt + 1);
            PP_COMPUTE(ubA, vbA, bt);
            const int nb = (bt + 2 < 32) ? bt + 2 : 31;
            if (!noload) PP_LOAD(ubA, vbA, nb);
            PP_COMPUTE(ubB, vbB, bt + 1);
        }
    }
#pragma unroll
    for (int tk = 0; tk < 2; ++tk) {
        f32x4 xr[4]; float ss = 0.f;
        float* xq = xres + (tok0 + tk) * 1024 + lane * 16;
#pragma unroll
        for (int j = 0; j < 4; ++j) { xr[j] = *(const f32x4*)(xq + 4 * j);
#pragma unroll
            for (int e = 0; e < 4; ++e) { xr[j][e] += tk ? outp[4 * j + e].y : outp[4 * j + e].x; ss += xr[j][e] * xr[j][e]; } }
        const float rstd = 1.0f / sqrtf(wave_sum(ss) * (1.f / 1024.f) + EPS);
        if (LAST) {
#pragma unroll
            for (int j = 0; j < 4; ++j) { const f32x4 gg = *(const f32x4*)(gnext + lane * 16 + 4 * j); *(f32x4*)(xq + 4 * j) = xr[j] * rstd * gg; }
        } else {
            u32x4 o0, o1;
#pragma unroll
            for (int j = 0; j < 4; ++j) { *(f32x4*)(xq + 4 * j) = xr[j]; const f32x4 gg = *(const f32x4*)(gnext + lane * 16 + 4 * j);
                const unsigned lo = cvt_pk_bf16(xr[j][0] * rstd * gg[0], xr[j][1] * rstd * gg[1]), hi = cvt_pk_bf16(xr[j][2] * rstd * gg[2], xr[j][3] * rstd * gg[3]);
                if (j < 2) { o0[2 * j] = lo; o0[2 * j + 1] = hi; } else { o1[2 * (j - 2)] = lo; o1[2 * (j - 2) + 1] = hi; } }
            u32x4* hq = (u32x4*)(HB + (tok0 + tk) * 1024 + lane * 16); hq[0] = o0; hq[1] = o1;
        }
    }
}

__device__ __forceinline__ void pair_prepare(LAS unsigned char* lds_w, size_t tok0, const u32x2* TOPK, const float* TSU, const float* TSV, int lane_in) {
    int lane = lane_in; asm volatile("" : "+v"(lane));
    LAS u32x2* EL = (LAS u32x2*)lds_w;
    LAS u32x4* EG = (LAS u32x4*)(lds_w + 2048);
    LAS unsigned* HIST = (LAS unsigned*)(lds_w + 2048 + 4096);
    if (lane < 32) HIST[lane] = 0u;
    for (int _rp = 0; _rp <= (PEER_PROBE & 1); ++_rp)
#pragma unroll 1
    for (int th = 0; th < 16; ++th) { const int tk = th >> 3, head = th & 7;
        const u32x2* base = TOPK + ((tok0 + tk) * 16 + head * 2) * 16;
        const u32x2 e0 = base[lane >> 2];
        const u32x4 e1a = *(const u32x4*)(base + 16 + 4 * (lane & 3)), e1b = *(const u32x4*)(base + 16 + 4 * (lane & 3) + 2);
        const float s0 = __uint_as_float(e0.x);
        float cs[4]; unsigned ck[4], u[4];
        cs[0] = s0 + __uint_as_float(e1a.x); ck[0] = e0.y * 128u + e1a.y; cs[1] = s0 + __uint_as_float(e1a.z); ck[1] = e0.y * 128u + e1a.w;
        cs[2] = s0 + __uint_as_float(e1b.x); ck[2] = e0.y * 128u + e1b.y; cs[3] = s0 + __uint_as_float(e1b.z); ck[3] = e0.y * 128u + e1b.w;
#pragma unroll
        for (int m = 0; m < 4; ++m) u[m] = sortable_u32(cs[m]);
        unsigned T = 0u;
#pragma unroll 1
        for (int bit = 31; bit >= 0; --bit) {
            const unsigned cand = T | (1u << bit); unsigned cnt = 0u;
#pragma unroll
            for (int m = 0; m < 4; ++m) cnt += (unsigned)__popcll(__ballot(u[m] >= cand));
            if (cnt >= 16u) T = cand;
            if (cnt == 16u) break;
        }
        unsigned G = 0u;
#pragma unroll
        for (int m = 0; m < 4; ++m) G += (unsigned)__popcll(__ballot(u[m] > T));
        const unsigned need_eq = 16u - G; unsigned pos = 0u, eq_used = 0u;
#pragma unroll
        for (int m = 0; m < 4; ++m) {
            const bool gt = u[m] > T, eq = u[m] == T;
            const unsigned long long meq = __ballot(eq);
            const bool sl = gt || (eq && (eq_used + mbcnt64(meq) < need_eq));
            const unsigned long long msl = __ballot(sl);
            if (sl) { u32x2 e; e.x = ck[m]; e.y = __float_as_uint(cs[m]); EL[th * 16 + pos + mbcnt64(msl)] = e; }
            pos += (unsigned)__popcll(msl); eq_used += (unsigned)__popcll(meq); }
    }
    u32x4 ent4[4]; unsigned rk[4];
#pragma unroll
    for (int rep = 0; rep < 4; ++rep) { const int e = lane + 64 * rep; const u32x2 ent = EL[e]; const float sc = __uint_as_float(ent.y);
        const float su = TSU[ent.x], sv = TSV[ent.x];
        float mx = sc;
#pragma unroll
        for (int o = 1; o < 16; o <<= 1) mx = fmaxf(mx, __shfl_xor(mx, o));
        const float p = __expf(sc - mx); float sm = p;
#pragma unroll
        for (int o = 1; o < 16; o <<= 1) sm += __shfl_xor(sm, o);
        ent4[rep].x = ent.x; ent4[rep].y = __float_as_uint(su); ent4[rep].z = __float_as_uint(p / sm * sv); ent4[rep].w = (unsigned)(rep >> 1);
        rk[rep] = atomicAdd((unsigned*)&HIST[ent.x >> 9], 1u); }
    { unsigned c = (lane < 32) ? HIST[lane] : 0u, inc = c;
#pragma unroll
      for (int o = 1; o < 32; o <<= 1) { const unsigned t = (unsigned)__shfl_up((int)inc, o); if ((lane & 31) >= o) inc += t; }
      if (lane < 32) HIST[32 + lane] = inc - c; }
#pragma unroll
    for (int rep = 0; rep < 4; ++rep) EG[HIST[32 + (ent4[rep].x >> 9)] + rk[rep]] = ent4[rep];
}
__device__ __forceinline__ void pair_pass1(LAS unsigned char* lds_w, size_t tok0, const unsigned char* TABU, const bf16* HB, int lane_in) {
    int lane = lane_in; asm volatile("" : "+v"(lane));
    LAS u32x4* EG = (LAS u32x4*)(lds_w + 2048);
    f32x2 xp[16];
    { const u32x4* h0 = (const u32x4*)(HB + tok0 * 1024 + lane * 16); const u32x4* h1 = (const u32x4*)(HB + (tok0 + 1) * 1024 + lane * 16);
      const u32x4 a0 = h0[0], b0 = h0[1], a1 = h1[0], b1 = h1[1];
#pragma unroll
      for (int e = 0; e < 4; ++e) { xp[2 * e] = (f32x2){__uint_as_float(a0[e] << 16), __uint_as_float(a1[e] << 16)}; xp[2 * e + 1] = (f32x2){__uint_as_float(a0[e] & 0xffff0000u), __uint_as_float(a1[e] & 0xffff0000u)};
          xp[8 + 2 * e] = (f32x2){__uint_as_float(b0[e] << 16), __uint_as_float(b1[e] << 16)}; xp[8 + 2 * e + 1] = (f32x2){__uint_as_float(b0[e] & 0xffff0000u), __uint_as_float(b1[e] & 0xffff0000u)}; } }
    u32x4 ub[8];
#pragma unroll
    for (int k = 0; k < 8; ++k) ub[k] = *(const u32x4*)(TABU + (size_t)EG[k].x * 1024 + lane * 16);
#pragma unroll 1
    for (int bt = 0; bt < 32; ++bt) {
        u32x4 un[8];
        const int nb = (bt + 1 < 32) ? bt + 1 : bt;
#pragma unroll
        for (int k = 0; k < 8; ++k) un[k] = *(const u32x4*)(TABU + (size_t)EG[nb * 8 + k].x * 1024 + lane * 16);
        float d[8];
#pragma unroll
        for (int k = 0; k < 8; ++k) { f32x2 a = {0.f, 0.f};
#pragma unroll
            for (int e = 0; e < 4; ++e) { const f32x2 lo = __builtin_amdgcn_cvt_pk_f32_fp8((int)ub[k][e], false), hi = __builtin_amdgcn_cvt_pk_f32_fp8((int)ub[k][e], true);
                a += xp[4 * e] * lo.x; a += xp[4 * e + 1] * lo.y; a += xp[4 * e + 2] * hi.x; a += xp[4 * e + 3] * hi.y; }
            const unsigned tkk = (unsigned)__builtin_amdgcn_readfirstlane((int)EG[bt * 8 + k].w);
            d[k] = tkk ? a.y : a.x; }
        float r4[4], r2[2], v1;
        { const bool h32 = (lane & 32) != 0;
#pragma unroll
          for (int j = 0; j < 4; ++j) { const float send = h32 ? d[j] : d[j + 4], keep = h32 ? d[j + 4] : d[j]; r4[j] = keep + __shfl_xor(send, 32); }
          const bool h16 = (lane & 16) != 0;
#pragma unroll
          for (int j = 0; j < 2; ++j) { const float send = h16 ? r4[j] : r4[j + 2], keep = h16 ? r4[j + 2] : r4[j]; r2[j] = keep + __shfl_xor(send, 16); }
          const bool h8 = (lane & 8) != 0;
          { const float send = h8 ? r2[0] : r2[1], keep = h8 ? r2[1] : r2[0]; v1 = keep + __shfl_xor(send, 8); }
          v1 += __shfl_xor(v1, 4); v1 += __shfl_xor(v1, 2); v1 += __shfl_xor(v1, 1); }
        { const u32x4 eg = EG[bt * 8 + (lane >> 3)]; const float x = v1 * __uint_as_float(eg.y);
          const float act = 0.5f * x * (1.0f + erff(x * 0.70710678118654752f)) * __uint_as_float(eg.z);
          if ((lane & 7) == 0) *((LAS float*)&EG[bt * 8 + (lane >> 3)] + 1) = act; }
#pragma unroll
        for (int k = 0; k < 8; ++k) ub[k] = un[k];
    }
}
template <bool LAST>
__device__ __forceinline__ void pair_pass2(LAS unsigned char* lds_w, size_t tok0, const unsigned char* TABV, bf16* HB, float* xres, const float* gnext, int lane_in) {
    int lane = lane_in; asm volatile("" : "+v"(lane));
    LAS u32x4* EG = (LAS u32x4*)(lds_w + 2048);
    f32x2 outp[16];
#pragma unroll
    for (int c = 0; c < 16; ++c) outp[c] = (f32x2){0.f, 0.f};
    u32x4 vb[8];
#pragma unroll
    for (int k = 0; k < 8; ++k) vb[k] = *(const u32x4*)(TABV + (size_t)EG[k].x * 1024 + lane * 16);
#pragma unroll 1
    for (int bt = 0; bt < 32; ++bt) {
        u32x4 vn[8];
        const int nb = (bt + 1 < 32) ? bt + 1 : bt;
#pragma unroll
        for (int k = 0; k < 8; ++k) vn[k] = *(const u32x4*)(TABV + (size_t)EG[nb * 8 + k].x * 1024 + lane * 16);
#pragma unroll
        for (int k = 0; k < 8; ++k) { const u32x4 eg = EG[bt * 8 + k];
            const unsigned tkk = (unsigned)__builtin_amdgcn_readfirstlane((int)eg.w); const float a = __uint_as_float((unsigned)__builtin_amdgcn_readfirstlane((int)eg.y));
            const f32x2 a2 = tkk ? (f32x2){0.f, a} : (f32x2){a, 0.f};
#pragma unroll
            for (int e = 0; e < 4; ++e) { const f32x2 lo = __builtin_amdgcn_cvt_pk_f32_fp8((int)vb[k][e], false), hi = __builtin_amdgcn_cvt_pk_f32_fp8((int)vb[k][e], true);
                outp[4 * e] += a2 * lo.x; outp[4 * e + 1] += a2 * lo.y; outp[4 * e + 2] += a2 * hi.x; outp[4 * e + 3] += a2 * hi.y; } }
#pragma unroll
        for (int k = 0; k < 8; ++k) vb[k] = vn[k];
    }
#pragma unroll
    for (int tk = 0; tk < 2; ++tk) {
        f32x4 xr[4]; float ss = 0.f;
        float* xq = xres + (tok0 + tk) * 1024 + lane * 16;
#pragma unroll
        for (int j = 0; j < 4; ++j) { xr[j] = *(const f32x4*)(xq + 4 * j);
#pragma unroll
            for (int e = 0; e < 4; ++e) { xr[j][e] += tk ? outp[4 * j + e].y : outp[4 * j + e].x; ss += xr[j][e] * xr[j][e]; } }
        const float rstd = 1.0f / sqrtf(wave_sum(ss) * (1.f / 1024.f) + EPS);
        if (LAST) {
#pragma unroll
            for (int j = 0; j < 4; ++j) { const f32x4 gg = *(const f32x4*)(gnext + lane * 16 + 4 * j); *(f32x4*)(xq + 4 * j) = xr[j] * rstd * gg; }
        } else {
            u32x4 o0, o1;
#pragma unroll
            for (int j = 0; j < 4; ++j) { *(f32x4*)(xq + 4 * j) = xr[j]; const f32x4 gg = *(const f32x4*)(gnext + lane * 16 + 4 * j);
                const unsigned lo = cvt_pk_bf16(xr[j][0] * rstd * gg[0], xr[j][1] * rstd * gg[1]), hi = cvt_pk_bf16(xr[j][2] * rstd * gg[2], xr[j][3] * rstd * gg[3]);
                if (j < 2) { o0[2 * j] = lo; o0[2 * j + 1] = hi; } else { o1[2 * (j - 2)] = lo; o1[2 * (j - 2) + 1] = hi; } }
            u32x4* hq = (u32x4*)(HB + (tok0 + tk) * 1024 + lane * 16); hq[0] = o0; hq[1] = o1;
        }
    }
}

constexpr int PQ_EL = 0, PQ_EG = 4096, PQ_HIST = 12288, PQ_BYTES = 12800;
__device__ __forceinline__ void quad_prepare(LAS unsigned char* lds_w, size_t tok0, const u32x2* TOPK, const float* TSU, const float* TSV, int lane_in) {
    int lane = lane_in; asm volatile("" : "+v"(lane));
    LAS u32x2* EL = (LAS u32x2*)(lds_w + PQ_EL); LAS u32x4* EG = (LAS u32x4*)(lds_w + PQ_EG); LAS unsigned* HIST = (LAS unsigned*)(lds_w + PQ_HIST);
    if (lane < 32) HIST[lane] = 0u;
    for (int _rp = 0; _rp <= (PEER_PROBE & 1); ++_rp)
#pragma unroll 1
    for (int th = 0; th < 32; ++th) { const int tk = th >> 3, head = th & 7;
        const u32x2* base = TOPK + ((tok0 + tk) * 16 + head * 2) * 16;
        const u32x2 e0 = base[lane >> 2];
        const u32x4 e1a = *(const u32x4*)(base + 16 + 4 * (lane & 3)), e1b = *(const u32x4*)(base + 16 + 4 * (lane & 3) + 2);
        const float s0 = __uint_as_float(e0.x);
        float cs[4]; unsigned ck[4], u[4];
        cs[0] = s0 + __uint_as_float(e1a.x); ck[0] = e0.y * 128u + e1a.y; cs[1] = s0 + __uint_as_float(e1a.z); ck[1] = e0.y * 128u + e1a.w;
        cs[2] = s0 + __uint_as_float(e1b.x); ck[2] = e0.y * 128u + e1b.y; cs[3] = s0 + __uint_as_float(e1b.z); ck[3] = e0.y * 128u + e1b.w;
#pragma unroll
        for (int m = 0; m < 4; ++m) u[m] = sortable_u32(cs[m]);
        unsigned T = 0u;
#pragma unroll 1
        for (int bit = 31; bit >= 0; --bit) {
            const unsigned cand = T | (1u << bit); unsigned cnt = 0u;
#pragma unroll
            for (int m = 0; m < 4; ++m) cnt += (unsigned)__popcll(__ballot(u[m] >= cand));
            if (cnt >= 16u) T = cand;
            if (cnt == 16u) break;
        }
        unsigned G = 0u;
#pragma unroll
        for (int m = 0; m < 4; ++m) G += (unsigned)__popcll(__ballot(u[m] > T));
        const unsigned need_eq = 16u - G; unsigned pos = 0u, eq_used = 0u;
#pragma unroll
        for (int m = 0; m < 4; ++m) {
            const bool gt = u[m] > T, eq = u[m] == T;
            const unsigned long long meq = __ballot(eq);
            const bool sl = gt || (eq && (eq_used + mbcnt64(meq) < need_eq));
            const unsigned long long msl = __ballot(sl);
            if (sl) { u32x2 e; e.x = ck[m]; e.y = __float_as_uint(cs[m]); EL[th * 16 + pos + mbcnt64(msl)] = e; }
            pos += (unsigned)__popcll(msl); eq_used += (unsigned)__popcll(meq); }
    }
    u32x4 ent8[8]; unsigned rk[8];
#pragma unroll
    for (int rep = 0; rep < 8; ++rep) { const int e = lane + 64 * rep; const u32x2 ent = EL[e]; const float sc = __uint_as_float(ent.y);
        const float su = TSU[ent.x], sv = TSV[ent.x];
        float mx = sc;
#pragma unroll
        for (int o = 1; o < 16; o <<= 1) mx = fmaxf(mx, __shfl_xor(mx, o));
        const float p = __expf(sc - mx); float sm = p;
#pragma unroll
        for (int o = 1; o < 16; o <<= 1) sm += __shfl_xor(sm, o);
        ent8[rep].x = ent.x; ent8[rep].y = __float_as_uint(su); ent8[rep].z = __float_as_uint(p / sm * sv); ent8[rep].w = (unsigned)(rep >> 1);
        rk[rep] = atomicAdd((unsigned*)&HIST[ent.x >> 9], 1u); }
    { unsigned c = (lane < 32) ? HIST[lane] : 0u, inc = c;
#pragma unroll
      for (int o = 1; o < 32; o <<= 1) { const unsigned t = (unsigned)__shfl_up((int)inc, o); if ((lane & 31) >= o) inc += t; }
      if (lane < 32) HIST[32 + lane] = inc - c; }
#pragma unroll
    for (int rep = 0; rep < 8; ++rep) EG[HIST[32 + (ent8[rep].x >> 9)] + rk[rep]] = ent8[rep];
}
__device__ __forceinline__ void quad_pass1(LAS unsigned char* lds_w, size_t tok0, const unsigned char* TABU, const bf16* HB, int lane_in) {
    int lane = lane_in; asm volatile("" : "+v"(lane));
    LAS u32x4* EG = (LAS u32x4*)(lds_w + PQ_EG);
    float x0[16], x1[16], x2[16], x3[16];
#define PQ_LOADX(xx, tk) do { const u32x4* hp = (const u32x4*)(HB + (tok0 + (tk)) * 1024 + lane * 16); const u32x4 a = hp[0], b = hp[1]; \
        _Pragma("unroll") for (int e = 0; e < 4; ++e) { xx[2 * e] = __uint_as_float(a[e] << 16); xx[2 * e + 1] = __uint_as_float(a[e] & 0xffff0000u); xx[8 + 2 * e] = __uint_as_float(b[e] << 16); xx[8 + 2 * e + 1] = __uint_as_float(b[e] & 0xffff0000u); } } while (0)
    PQ_LOADX(x0, 0); PQ_LOADX(x1, 1); PQ_LOADX(x2, 2); PQ_LOADX(x3, 3);
#undef PQ_LOADX
    u32x4 ub[8];
#pragma unroll
    for (int k = 0; k < 8; ++k) ub[k] = *(const u32x4*)(TABU + (size_t)EG[k].x * 1024 + lane * 16);
#pragma unroll 1
    for (int bt = 0; bt < 64; ++bt) {
        u32x4 un[8];
        const int nb = (bt + 1 < 64) ? bt + 1 : bt;
#pragma unroll
        for (int k = 0; k < 8; ++k) un[k] = *(const u32x4*)(TABU + (size_t)EG[nb * 8 + k].x * 1024 + lane * 16);
        float d[8];
#pragma unroll
        for (int k = 0; k < 8; ++k) {
            float f[16];
#pragma unroll
            for (int e = 0; e < 4; ++e) { const f32x2 lo = __builtin_amdgcn_cvt_pk_f32_fp8((int)ub[k][e], false), hi = __builtin_amdgcn_cvt_pk_f32_fp8((int)ub[k][e], true); f[4 * e] = lo.x; f[4 * e + 1] = lo.y; f[4 * e + 2] = hi.x; f[4 * e + 3] = hi.y; }
            const unsigned tkk = (unsigned)__builtin_amdgcn_readfirstlane((int)EG[bt * 8 + k].w);
            float a = 0.f;
            if (tkk == 0u) {
#pragma unroll
                for (int c = 0; c < 16; ++c) a += f[c] * x0[c]; }
            else if (tkk == 1u) {
#pragma unroll
                for (int c = 0; c < 16; ++c) a += f[c] * x1[c]; }
            else if (tkk == 2u) {
#pragma unroll
                for (int c = 0; c < 16; ++c) a += f[c] * x2[c]; }
            else {
#pragma unroll
                for (int c = 0; c < 16; ++c) a += f[c] * x3[c]; }
            d[k] = a; }
        float r4[4], r2[2], v1;
        { const bool h32 = (lane & 32) != 0;
#pragma unroll
          for (int j = 0; j < 4; ++j) { const float send = h32 ? d[j] : d[j + 4], keep = h32 ? d[j + 4] : d[j]; r4[j] = keep + __shfl_xor(send, 32); }
          const bool h16 = (lane & 16) != 0;
#pragma unroll
          for (int j = 0; j < 2; ++j) { const float send = h16 ? r4[j] : r4[j + 2], keep = h16 ? r4[j + 2] : r4[j]; r2[j] = keep + __shfl_xor(send, 16); }
          const bool h8 = (lane & 8) != 0;
          { const float send = h8 ? r2[0] : r2[1], keep = h8 ? r2[1] : r2[0]; v1 = keep + __shfl_xor(send, 8); }
          v1 += __shfl_xor(v1, 4); v1 += __shfl_xor(v1, 2); v1 += __shfl_xor(v1, 1); }
        { const u32x4 eg = EG[bt * 8 + (lane >> 3)]; const float x = v1 * __uint_as_float(eg.y);
          const float act = 0.5f * x * (1.0f + erff(x * 0.70710678118654752f)) * __uint_as_float(eg.z);
          if ((lane & 7) == 0) *((LAS float*)&EG[bt * 8 + (lane >> 3)] + 1) = act; }
#pragma unroll
        for (int k = 0; k < 8; ++k) ub[k] = un[k];
    }
}
template <bool LAST>
__device__ __forceinline__ void quad_pass2(LAS unsigned char* lds_w, size_t tok0, const unsigned char* TABV, bf16* HB, float* xres, const float* gnext, int lane_in) {
    int lane = lane_in; asm volatile("" : "+v"(lane));
    LAS u32x4* EG = (LAS u32x4*)(lds_w + PQ_EG);
    float o0[16], o1[16], o2[16], o3[16];
#pragma unroll
    for (int c = 0; c < 16; ++c) { o0[c] = 0.f; o1[c] = 0.f; o2[c] = 0.f; o3[c] = 0.f; }
    u32x4 vb[8];
#pragma unroll
    for (int k = 0; k < 8; ++k) vb[k] = *(const u32x4*)(TABV + (size_t)EG[k].x * 1024 + lane * 16);
#pragma unroll 1
    for (int bt = 0; bt < 64; ++bt) {
        u32x4 vn[8];
        const int nb = (bt + 1 < 64) ? bt + 1 : bt;
#pragma unroll
        for (int k = 0; k < 8; ++k) vn[k] = *(const u32x4*)(TABV + (size_t)EG[nb * 8 + k].x * 1024 + lane * 16);
#pragma unroll
        for (int k = 0; k < 8; ++k) {
            float f[16];
#pragma unroll
            for (int e = 0; e < 4; ++e) { const f32x2 lo = __builtin_amdgcn_cvt_pk_f32_fp8((int)vb[k][e], false), hi = __builtin_amdgcn_cvt_pk_f32_fp8((int)vb[k][e], true); f[4 * e] = lo.x; f[4 * e + 1] = lo.y; f[4 * e + 2] = hi.x; f[4 * e + 3] = hi.y; }
            const u32x4 eg = EG[bt * 8 + k];
            const unsigned tkk = (unsigned)__builtin_amdgcn_readfirstlane((int)eg.w); const float a = __uint_as_float((unsigned)__builtin_amdgcn_readfirstlane((int)eg.y));
            if (tkk == 0u) {
#pragma unroll
                for (int c = 0; c < 16; ++c) o0[c] += a * f[c]; }
            else if (tkk == 1u) {
#pragma unroll
                for (int c = 0; c < 16; ++c) o1[c] += a * f[c]; }
            else if (tkk == 2u) {
#pragma unroll
                for (int c = 0; c < 16; ++c) o2[c] += a * f[c]; }
            else {
#pragma unroll
                for (int c = 0; c < 16; ++c) o3[c] += a * f[c]; } }
#pragma unroll
        for (int k = 0; k < 8; ++k) vb[k] = vn[k];
    }
#define PQ_FINAL(oo, tk) do { f32x4 xr[4]; float ss = 0.f; float* xq = xres + (tok0 + (tk)) * 1024 + lane * 16; \
        _Pragma("unroll") for (int j = 0; j < 4; ++j) { xr[j] = *(const f32x4*)(xq + 4 * j); _Pragma("unroll") for (int e = 0; e < 4; ++e) { xr[j][e] += oo[4 * j + e]; ss += xr[j][e] * xr[j][e]; } } \
        const float rstd = 1.0f / sqrtf(wave_sum(ss) * (1.f / 1024.f) + EPS); \
        if (LAST) { _Pragma("unroll") for (int j = 0; j < 4; ++j) { const f32x4 gg = *(const f32x4*)(gnext + lane * 16 + 4 * j); *(f32x4*)(xq + 4 * j) = xr[j] * rstd * gg; } } \
        else { u32x4 q0, q1; \
            _Pragma("unroll") for (int j = 0; j < 4; ++j) { *(f32x4*)(xq + 4 * j) = xr[j]; const f32x4 gg = *(const f32x4*)(gnext + lane * 16 + 4 * j); \
                const unsigned lo = cvt_pk_bf16(xr[j][0] * rstd * gg[0], xr[j][1] * rstd * gg[1]), hi = cvt_pk_bf16(xr[j][2] * rstd * gg[2], xr[j][3] * rstd * gg[3]); \
                if (j < 2) { q0[2 * j] = lo; q0[2 * j + 1] = hi; } else { q1[2 * (j - 2)] = lo; q1[2 * (j - 2) + 1] = hi; } } \
            u32x4* hq = (u32x4*)(HB + (tok0 + (tk)) * 1024 + lane * 16); hq[0] = q0; hq[1] = q1; } } while (0)
    PQ_FINAL(o0, 0); PQ_FINAL(o1, 1); PQ_FINAL(o2, 2); PQ_FINAL(o3, 3);
#undef PQ_FINAL
}
__device__ __forceinline__ void xcc_sync(unsigned* ctr, unsigned nloc, unsigned target) {
    __syncthreads();
    if (threadIdx.x == 0 && nloc > 0u) {
        __hip_atomic_fetch_add(ctr, 1u, __ATOMIC_RELAXED, __HIP_MEMORY_SCOPE_AGENT);
        unsigned sp = 0u;
        while (__hip_atomic_load(ctr, __ATOMIC_RELAXED, __HIP_MEMORY_SCOPE_AGENT) < nloc * target) { __builtin_amdgcn_s_sleep(1); if (++sp > (1u << 16)) break; }
    }
    __syncthreads();
}

__device__ __forceinline__ void row_to_fp8(const float* src, unsigned char* dst, float* scale, int lane) {
    const f32x4* sp = (const f32x4*)(src + lane * 16); f32x4 v[4]; float am = 0.f;
#pragma unroll
    for (int j = 0; j < 4; ++j) { v[j] = sp[j]; am = fmaxf(am, fmaxf(fmaxf(fabsf(v[j].x), fabsf(v[j].y)), fmaxf(fabsf(v[j].z), fabsf(v[j].w)))); }
    am = wave_max(am);
    const float sc = am > 0.f ? am * (1.0f / 448.0f) : 1.0f, inv = 1.0f / sc;
    u32x4 o;
#pragma unroll
    for (int j = 0; j < 4; ++j) { int w = 0; w = __builtin_amdgcn_cvt_pk_fp8_f32(v[j].x * inv, v[j].y * inv, w, false); w = __builtin_amdgcn_cvt_pk_fp8_f32(v[j].z * inv, v[j].w * inv, w, true); o[j] = (unsigned)w; }
    *(u32x4*)(dst + lane * 16) = o;
    if (lane == 0) *scale = sc;
}

__device__ __forceinline__ void row_to_int8(const float* src, unsigned char* dst, float* scale, int lane) {
    const f32x4* sp = (const f32x4*)(src + lane * 16); f32x4 v[4]; float am = 0.f;
#pragma unroll
    for (int j = 0; j < 4; ++j) { v[j] = sp[j]; am = fmaxf(am, fmaxf(fmaxf(fabsf(v[j].x), fabsf(v[j].y)), fmaxf(fabsf(v[j].z), fabsf(v[j].w)))); }
    am = wave_max(am);
    const float sc = am > 0.f ? am * (1.0f / 127.0f) : 1.0f, inv = 1.0f / sc;
    u32x4 o;
#pragma unroll
    for (int j = 0; j < 4; ++j) { const int q0 = (int)rintf(v[j].x * inv), q1 = (int)rintf(v[j].y * inv), q2 = (int)rintf(v[j].z * inv), q3 = (int)rintf(v[j].w * inv);
        o[j] = (unsigned)((q0 & 0xff) | ((q1 & 0xff) << 8) | ((q2 & 0xff) << 16) | ((q3 & 0xff) << 24)); }
    *(u32x4*)(dst + lane * 16) = o;
    if (lane == 0) *scale = sc;
}

template <bool FP8>
__device__ __forceinline__ void rows4_to_q8(const float* src, size_t rstride_f, unsigned char* dst, size_t rstride_b, float* scale, size_t sstride, int lane) {
    f32x4 v[4][4];
#pragma unroll
    for (int i = 0; i < 4; ++i) { const f32x4* sp = (const f32x4*)(src + (size_t)i * rstride_f + lane * 16);
#pragma unroll
        for (int j = 0; j < 4; ++j) v[i][j] = sp[j]; }
#pragma unroll
    for (int i = 0; i < 4; ++i) { float am = 0.f;
#pragma unroll
        for (int j = 0; j < 4; ++j) am = fmaxf(am, fmaxf(fmaxf(fabsf(v[i][j].x), fabsf(v[i][j].y)), fmaxf(fabsf(v[i][j].z), fabsf(v[i][j].w))));
        am = wave_max(am);
        const float sc = am > 0.f ? am * (FP8 ? (1.0f / 448.0f) : (1.0f / 127.0f)) : 1.0f, inv = 1.0f / sc;
        u32x4 o;
#pragma unroll
        for (int j = 0; j < 4; ++j) {
            if (FP8) { int w = 0; w = __builtin_amdgcn_cvt_pk_fp8_f32(v[i][j].x * inv, v[i][j].y * inv, w, false); w = __builtin_amdgcn_cvt_pk_fp8_f32(v[i][j].z * inv, v[i][j].w * inv, w, true); o[j] = (unsigned)w; }
            else { const int q0 = (int)rintf(v[i][j].x * inv), q1 = (int)rintf(v[i][j].y * inv), q2 = (int)rintf(v[i][j].z * inv), q3 = (int)rintf(v[i][j].w * inv);
                o[j] = (unsigned)((q0 & 0xff) | ((q1 & 0xff) << 8) | ((q2 & 0xff) << 16) | ((q3 & 0xff) << 24)); } }
        *(u32x4*)(dst + (size_t)i * rstride_b + lane * 16) = o;
        if (lane == 0) scale[(size_t)i * sstride] = sc; }
}

__global__ void __launch_bounds__(NTHR, 2) trunk_fwd(Args args) {
    extern __shared__ __attribute__((aligned(16))) unsigned char lds_raw[];
    LAS unsigned char* lds = (LAS unsigned char*)lds_raw;
    const int tid = threadIdx.x, lane = tid & 63, wave = __builtin_amdgcn_readfirstlane(tid >> 6);
    const int G = gridDim.x, bx = blockIdx.x;
    unsigned char* ws = args.ws;
    unsigned* ctl = (unsigned*)(ws + WS_CTL);
    volatile LAS unsigned* LCTL = (volatile LAS unsigned*)(lds + LDS_CTL);
    for (int u = tid; u < 512; u += NTHR) LCTL[u] = 0u;
    __syncthreads();
    XcdBarrier bar; bar.bar = ctl + CW_BAR; bar.x = 0; bar.st = nullptr;
    if (!MK_PER_PHASE) bar = xcd_barrier_post(ctl + CW_BAR, LCTL + 8);
    const int lo = args.ph_lo, hi = args.ph_hi;
#define IN(k) (lo <= (k) && (k) < hi)
#define SEAM(k) do { if (IN(k) && IN((k) + 1)) xcd_barrier(bar); } while (0)
#define SEAM2(k) do { if (IN(k) && IN((k) + 2)) xcd_barrier(bar); } while (0)
#define REP(k) for (int _r = 0; _r <= ((PROBE_MASK >> (k)) & 1); ++_r)
#define PRIO_YOUNG() do { if (PRIO_STATIC && wave >= 4) __builtin_amdgcn_s_setprio(1); } while (0)
    const size_t gtid = (size_t)bx * NTHR + tid, gthreads = (size_t)G * NTHR;
    const int gw = bx * NWAVES + wave, NGW = G * NWAVES;

    const float* x_in = args.in[I_X];
    float* xres = args.out;
    bf16* WA = (bf16*)(ws + WS_WA); bf16* WB = (bf16*)(ws + WS_WB); bf16* WO = (bf16*)(ws + WS_WO); bf16* WKV = (bf16*)(ws + WS_WKV); bf16* WQ = (bf16*)(ws + WS_WQ);
    bf16* MEMN = (bf16*)(ws + WS_MEMN); bf16* KV = (bf16*)(ws + WS_KV); bf16* HB = (bf16*)(ws + WS_HB); bf16* MIX = (bf16*)(ws + WS_MIX);
    unsigned char* TAB8 = ws + WS_TAB;
    float* TSC = (float*)(ws + WS_TSC);
    unsigned char* AR = ws + WS_AR;
    bf16* QMEM = (bf16*)(AR + AR_QMEM);
    bf16* Qb = (bf16*)args.out; bf16* QMEM0 = (bf16*)args.out + (size_t)M * 768;
    bf16* QLb = (bf16*)(AR + AR_QL);
    bf16* Zb = (bf16*)(AR + AR_Z); bf16* XBC = (bf16*)(AR + AR_XBC); float* DTb = (float*)(AR + AR_DT); bf16* XC = (bf16*)(AR + AR_XC); bf16* STATES = (bf16*)(AR + AR_ST); bf16* Yb = (bf16*)(AR + AR_Y);
    float* DEC = (float*)(ws + WS_DEC); float* SSb = (float*)(ws + WS_SS);
    bf16* UKb = (bf16*)(ws + WS_UK); bf16* UVTb = (bf16*)(ws + WS_UVT); bf16* SUBKb = (bf16*)(ws + WS_SUBK);
    bf16* PQb = (bf16*)(AR + AR_PQ); u32x2* TOPK = (u32x2*)(AR + AR_TOPK);

    if (IN(0)) REP(0) {
        LAS float* scr = (LAS float*)(lds + LDS_SCR + wave * 8704);
        const float* awin = args.in[I_AWIN]; const float* bwin = args.in[I_BWIN];
        const int nA0 = titems(1536), nA1 = titems(256), nA2 = titems(64), nA3 = titems(8);
        const int nB0 = titems(2048), nB1 = titems(256), nB2 = titems(12);
        const int nO = titems(1024), nKV = titems(512), nQ = titems(2048);
        const int NIT = nA0 + nA1 + nA2 + nA3 + nB0 + nB1 + nB2 + 2 * nO + 2 * nKV + 2 * nQ;
        for (int it = gw; it < NIT; it += NGW) {
            int r = it;
            if (r < nA0) { transpose_item(awin, 1864, 0, 1536, WA, 0, scr, r, lane); continue; } r -= nA0;
            if (r < nA1) { transpose_item(awin, 1864, 1608, 256, WA, 1536, scr, r, lane); continue; } r -= nA1;
            if (r < nA2) { transpose_item(awin, 1864, 1536, 64, WA, 1792, scr, r, lane); continue; } r -= nA2;
            if (r < nA3) { transpose_item(awin, 1864, 1600, 8, WA, 1856, scr, r, lane); continue; } r -= nA3;
            if (r < nB0) { transpose_item(bwin, 2316, 0, 2048, WB, 0, scr, r, lane); continue; } r -= nB0;
            if (r < nB1) { transpose_item(bwin, 2316, 2060, 256, WB, 2048, scr, r, lane); continue; } r -= nB1;
            if (r < nB2) { transpose_item(bwin, 2316, 2048, 12, WB, 2304, scr, r, lane); continue; } r -= nB2;
            if (r < 2 * nO) { const int l = r / nO; transpose_item(args.in[I_WO] + (size_t)l * 1024 * 1024, 1024, 0, 1024, WO, l * 1024, scr, r - l * nO, lane); continue; } r -= 2 * nO;
            if (r < 2 * nKV) { const int l = r / nKV; transpose_item(args.in[I_WMEMKV] + (size_t)l * 1024 * 512, 512, 0, 512, WKV, l * 512, scr, r - l * nKV, lane); continue; } r -= 2 * nKV;
            { const int l = r / nQ; transpose_item(args.in[I_PWQ] + (size_t)l * 1024 * 2048, 2048, 0, 2048, WQ, l * 2048, scr, r - l * nQ, lane, args.in[I_FFNNORM] + l * D); }
        }
        for (size_t i = gtid; i < (size_t)(2048 - 1864) * 128; i += gthreads) *((u32x4*)(WA + (size_t)1864 * 1024) + i) = (u32x4){0u, 0u, 0u, 0u};
        for (size_t i = gtid; i < (size_t)(2560 - 2316) * 128; i += gthreads) *((u32x4*)(WB + (size_t)2316 * 1024) + i) = (u32x4){0u, 0u, 0u, 0u};
        for (size_t i = gtid; i < (size_t)2 * M; i += gthreads) SSb[i] = 0.f;
        for (int m = gw; m < BATCH * MEMLEN; m += NGW) rms_row_to_bf16(args.in[I_MEM] + (size_t)m * D, args.in[I_MEMNORM], MEMN + (size_t)m * D, lane);
        for (int m = gw; m < M; m += 4 * NGW) rms_rows4_to_bf16(x_in + (size_t)m * D, (size_t)NGW * D, args.in[I_MIXNORM], HB + (size_t)m * D, lane);
        cvt_stream(args.in[I_AWUK], UKb, (size_t)12 * 256 * 64, gtid, gthreads);
        for (size_t i = gtid; i < (size_t)12 * 64 * 256; i += gthreads) { const int h = (int)(i >> 14), d = (int)((i >> 8) & 63), c = (int)(i & 255);
            UVTb[i] = (bf16)(cvt_pk_bf16(args.in[I_AWUV][((size_t)h * 256 + c) * 64 + d], 0.f) & 0xffffu); }
        cvt_stream(args.in[I_PSUBK], SUBKb, (size_t)2 * 2 * 128 * 128, gtid, gthreads);
    }
    SEAM(0);
    if (IN(1)) REP(1) {
        { pg8::Gemm g{HB, WA, M, NA, D}; pg8::StaticOrder S; S.init(M, NA, G, bx);
          EpiInA E{Qb, (float*)(AR + AR_CKV32), (bf16*)(AR + AR_IQ), QMEM0, (bf16*)(AR + AR_IK), (float*)(AR + AR_IW)};
          pg8::gemm_phase<EpiInA, pg8::StaticOrder, true, true>(lds + LDS_SCR, g, S, E); }
        { pg8::Gemm g{MEMN, WKV, BATCH * MEMLEN, 1024, D}; pg8::StaticOrder S; S.init(BATCH * MEMLEN, 1024, G, bx);
          EpiPlain E{KV, 1024};
          pg8::gemm_phase<EpiPlain, pg8::StaticOrder, true, true>(lds + LDS_SCR, g, S, E); }
        if (bx >= 32) { const int gw2 = (bx - 32) * NWAVES + wave, NGW2 = (G - 32) * NWAVES;
            for (int tv = 0; tv < 2; ++tv) {
                const float* srcb = args.in[tv ? I_PV : I_PU] + (size_t)16384 * 1024; unsigned char* dstb = TAB8 + (size_t)32 * MiB + (size_t)tv * 1024; float* scb = TSC + (2 + tv) * 16384;
                for (int e = gw2; e < 4096; e += NGW2) {
                    if (tv) rows4_to_q8<true>(srcb + (size_t)e * 1024, (size_t)4096 * 1024, dstb + (size_t)e * 2048, (size_t)4096 * 2048, scb + e, 4096, lane);
                    else rows4_to_q8<false>(srcb + (size_t)e * 1024, (size_t)4096 * 1024, dstb + (size_t)e * 2048, (size_t)4096 * 2048, scb + e, 4096, lane); } } }
    }
    SEAM(1);
    if (IN(2)) REP(2) {
        PRIO_YOUNG();
        { const float* src = (const float*)(AR + AR_CKV32); bf16* dst = (bf16*)(AR + AR_CKV); const f32x4 gg = *((const f32x4*)args.in[I_AKVNORM] + lane);
          for (int m = gw; m < M; m += 4 * NGW) {
              f32x4 v[4];
#pragma unroll
              for (int i = 0; i < 4; ++i) v[i] = *((const f32x4*)(src + (size_t)(m + i * NGW) * 256) + lane);
#pragma unroll
              for (int i = 0; i < 4; ++i) { const float ss = wave_sum((v[i].x * v[i].x + v[i].y * v[i].y) + (v[i].z * v[i].z + v[i].w * v[i].w)); const float rstd = 1.0f / sqrtf(ss * (1.f / 256.f) + EPS);
                  u32x2 o; o.x = cvt_pk_bf16(v[i].x * rstd * gg.x, v[i].y * rstd * gg.y); o.y = cvt_pk_bf16(v[i].z * rstd * gg.z, v[i].w * rstd * gg.w);
                  *((u32x2*)(dst + (size_t)(m + i * NGW) * 256) + lane) = o; } } }
        for (int u = bx; u < 512; u += G) memattn_unit(lds + LDS_SCR, u, 0, KV, QMEM0, MIX, tid, wave, lane);
        qlat_phase(lds + LDS_SCR, bx, G, 3072, Qb, UKb, QLb, tid, wave, lane);
    }
    SEAM(2);
#if (PROBE_MASK >> 30) & 1
    for (int _b = 0; _b < 20; ++_b) xcd_barrier(bar);
#endif
    if (IN(3)) REP(3) {
        PRIO_YOUNG();
        { LAS float* RB = (LAS float*)(lds + LDS_SCR + DS_RB); const float* rbias = args.in[I_RELBIAS];
          for (int i = tid; i < 512; i += NTHR) { const int bk = i >> 4, h = i & 15; RB[i] = h < 12 ? rbias[bk * 12 + h] : 0.f; } }
        const bool mir = ((G & 7) == 0) && (4096 % G == 0);
        for (int k = 0; k * G + bx < 4096; ++k) { const int u = ((mir && (k & 1)) ? (((((G >> 3) - 1) - (bx >> 3)) << 3) | (bx & 7)) : bx) + k * G;
            dsa_unit(lds + LDS_SCR, u, QLb, (const bf16*)(AR + AR_CKV), (const bf16*)(AR + AR_IQ), (const bf16*)(AR + AR_IK), (const float*)(AR + AR_IW), args.in[I_PU], args.in[I_PV], TAB8, TSC, tid, wave, lane); }
    }
    SEAM(3);
    if (IN(4)) REP(4) { PRIO_YOUNG(); uv_phase(lds + LDS_SCR, bx, G, 3072, QLb, UVTb, MIX, tid, wave, lane); }
    SEAM(4);
    if (IN(5)) REP(5) {
        pg8::Gemm g{MIX, WO, M, D, D}; pg8::StaticOrder S; S.init(M, D, G, bx);
        EpiResid<false> E{x_in, HB, SSb};
        pg8::gemm_phase<EpiResid<false>, pg8::StaticOrder, true, true>(lds + LDS_SCR, g, S, E);
    }
    SEAM2(5);
    if (IN(7)) REP(7) {
        pg8::Gemm g{HB, WQ, M, 2048, D}; pg8::StaticOrder S; S.init(M, 2048, G, bx);
        EpiPQ E{PQb, SSb};
        pg8::gemm_phase<EpiPQ, pg8::StaticOrder, true, true>(lds + LDS_SCR, g, S, E);
    }
    SEAM(7);
    if (IN(8)) REP(8) { PRIO_YOUNG(); peer_topk_load_sk(lds + LDS_SCR, SUBKb, tid); u32x4 pqn[8]; { const bf16* PQ = PQb; if (gw < 16384) PA_LOADPQ(pqn, gw); }
        for (int task = gw; task < 16384; task += NGW) peer_topk_task(lds + LDS_SCR, task, (task + NGW < 16384) ? task + NGW : -1, pqn, PQb, TOPK, wave, lane); }
    SEAM(8);
    if (IN(9)) { PRIO_YOUNG(); peer_wave<false>(lds + LDS_SCR + wave * PW_BYTES, gw, NGW, M / 2, TOPK, TAB8, TAB8 + 1024, TSC, TSC + 16384, HB, SSb, args.in[I_FFNNORM], xres, args.in[I_MIXNORM] + D, lane, ctl + CW_XS + 64 * xb_xcc_id(), MK_PER_PHASE ? 0u : LCTL[8], 0u, LCTL + 16); }
    SEAM(9);
    if (IN(10)) REP(10) {
        pg8::Gemm g{HB, WB, M, NB, D}; pg8::StaticOrder S; S.init(M, NB, G, bx);
        EpiInB E{(bf16*)(AR + AR_Z), (bf16*)(AR + AR_XBC), QMEM, (float*)(AR + AR_DT)};
        pg8::gemm_phase<EpiInB, pg8::StaticOrder, true, true>(lds + LDS_SCR, g, S, E);
    }
    SEAM(10);
    if (IN(11)) REP(11) {
        PRIO_YOUNG();
        for (int u = bx; u < 512; u += G) memattn_unit(lds + LDS_SCR, u, 1, KV, QMEM, MIX, tid, wave, lane);
        for (int u = bx; u < 256; u += G) ssd_states_unit(lds + LDS_SCR, u, XBC, DTb, args.in[I_BCONVW], args.in[I_BCONVB], args.in[I_BDTBIAS], args.in[I_BALOG], XC, STATES, DEC, tid, wave, lane);
    }
    SEAM(11);
    if (IN(12)) { ssd_scan(STATES, DEC, gtid, gthreads); }
    SEAM(12);
    if (IN(13)) REP(13) { PRIO_YOUNG(); for (int u = bx; u < 256; u += G) ssd_out_unit(lds + LDS_SCR, u, XC, DTb, Zb, STATES, args.in[I_BDTBIAS], args.in[I_BALOG], args.in[I_BDSKIP], args.in[I_BOUTNORM], Yb, MIX, tid, wave, lane); }
    SEAM(13);
    if (IN(14)) {
        pg8::Gemm g{MIX, WO + (size_t)1024 * 1024, M, D, D}; pg8::StaticOrder S; S.init(M, D, G, bx);
        EpiResid<true> E{(const bf16*)xres, HB, SSb + M};
        pg8::gemm_phase<EpiResid<true>, pg8::StaticOrder, true, true>(lds + LDS_SCR, g, S, E);
    }
    SEAM2(14);
#if (PROBE_MASK >> 15) & 1
    {
        float a0 = (float)lane, a1 = a0 + 1.f, a2 = a0 + 2.f, a3 = a0 + 3.f, a4 = a0 + 4.f, a5 = a0 + 5.f, a6 = a0 + 6.f, a7 = a0 + 7.f; const float m_ = 1.0000001f, c_ = 1e-9f;
#pragma unroll 1
        for (int it = 0; it < 65536; ++it) { asm volatile("v_fma_f32 %0, %0, %8, %9\n\tv_fma_f32 %1, %1, %8, %9\n\tv_fma_f32 %2, %2, %8, %9\n\tv_fma_f32 %3, %3, %8, %9\n\tv_fma_f32 %4, %4, %8, %9\n\tv_fma_f32 %5, %5, %8, %9\n\tv_fma_f32 %6, %6, %8, %9\n\tv_fma_f32 %7, %7, %8, %9"
                : "+v"(a0), "+v"(a1), "+v"(a2), "+v"(a3), "+v"(a4), "+v"(a5), "+v"(a6), "+v"(a7) : "v"(m_), "v"(c_)); }
        if (a0 + a1 + a2 + a3 + a4 + a5 + a6 + a7 == 12345.678f) ctl[100000] = 1u; }
#endif
    if (IN(16)) REP(16) {
        pg8::Gemm g{HB, WQ + (size_t)2048 * 1024, M, 2048, D}; pg8::StaticOrder S; S.init(M, 2048, G, bx);
        EpiPQ E{PQb, SSb + M};
        pg8::gemm_phase<EpiPQ, pg8::StaticOrder, true, true>(lds + LDS_SCR, g, S, E);
    }
    SEAM(16);
    if (IN(17)) REP(17) { PRIO_YOUNG(); peer_topk_load_sk(lds + LDS_SCR, SUBKb + 32768, tid); u32x4 pqn[8]; { const bf16* PQ = PQb; if (gw < 16384) PA_LOADPQ(pqn, gw); }
        for (int task = gw; task < 16384; task += NGW) peer_topk_task(lds + LDS_SCR, task, (task + NGW < 16384) ? task + NGW : -1, pqn, PQb, TOPK, wave, lane); }
    SEAM(17);
    if (IN(18)) { PRIO_YOUNG(); peer_wave<true>(lds + LDS_SCR + wave * PW_BYTES, gw, NGW, M / 2, TOPK, TAB8 + 32 * MiB, TAB8 + 32 * MiB + 1024, TSC + 32768, TSC + 49152, HB, SSb + M, args.in[I_FFNNORM] + D, xres, args.in[I_FINALNORM], lane, ctl + CW_XS + 64 * xb_xcc_id(), MK_PER_PHASE ? 0u : LCTL[8], 8u, LCTL + 17); }
#undef IN
#undef SEAM
#undef SEAM2
#undef REP
}

extern "C" void kernel_launch(void* const* d_in, const int* in_sizes, int n_in, void* d_out, int out_size, void* d_ws, size_t ws_size, hipStream_t stream) {
    static int grid = 0;
    if (grid == 0) {
        if (n_in != 24 || in_sizes[0] != M * D || out_size != M * D || ws_size < WS_END) { fprintf(stderr, "kernel_launch: unexpected shapes (n_in %d, ws %zu); nothing launched\n", n_in, ws_size); grid = -1; return; }
        int dev = 0, cus = 0, per_cu = 0;
        if (hipGetDevice(&dev) != hipSuccess || hipDeviceGetAttribute(&cus, hipDeviceAttributeMultiprocessorCount, dev) != hipSuccess) { grid = -1; return; }
        if (hipFuncSetAttribute((const void*)trunk_fwd, hipFuncAttributeMaxDynamicSharedMemorySize, LDS_BYTES) != hipSuccess) { fprintf(stderr, "kernel_launch: hipFuncSetAttribute failed\n"); grid = -1; return; }
        if (hipOccupancyMaxActiveBlocksPerMultiprocessor(&per_cu, (const void*)trunk_fwd, NTHR, LDS_BYTES) != hipSuccess || per_cu < 1) { fprintf(stderr, "kernel_launch: occupancy query says %d\n", per_cu); }
        (void)hipGetLastError();
        grid = cus;
    }
    if (grid < 0) return;
    if (hipMemsetAsync((char*)d_ws + WS_CTL, 0, CTL_ZERO_BYTES, stream) != hipSuccess) return;
    Args a{};
    for (int i = 0; i < 24; ++i) a.in[i] = (const float*)d_in[i];
    a.out = (float*)d_out; a.ws = (unsigned char*)d_ws;
#if MK_PER_PHASE
    for (int p = 0; p < NPHASE; ++p) { a.ph_lo = p; a.ph_hi = p + 1; hipLaunchKernelGGL(trunk_fwd, dim3(grid), dim3(NTHR), LDS_BYTES, stream, a); }
#else
    a.ph_lo = 0; a.ph_hi = NPHASE;
    hipLaunchKernelGGL(trunk_fwd, dim3(grid), dim3(NTHR), LDS_BYTES, stream, a);
#endif
}
```
